# Optimizing an MI355X kernel written in HIP

```python
import math
import jax, jax.numpy as jnp
from jax import lax
import numpy as np

D_MODEL = 1024
BATCH = 8
SEQ = 4096
DEPTH = 2

NSA_Q_HEADS = 8
NSA_KV_HEADS = 2
HEAD_DIM = 64
NSA_GROUP = NSA_Q_HEADS // NSA_KV_HEADS
CMP_LEN = 32
CMP_STRIDE = 16
CMP_HIDDEN = 256
SEL_LEN = 64
SEL_TOPN = 16
WINDOW = 512
NSA_QBLOCK = 64
ROPE_THETA = 10000.0
Q_WIDTH = NSA_Q_HEADS * HEAD_DIM
KV_WIDTH = NSA_KV_HEADS * HEAD_DIM
GM_GROUPS = 8
GM_GROUP_DIM = 64
GM_WIDTH = GM_GROUPS * GM_GROUP_DIM
GM_CHUNK = 128
N_EXPERTS = 256
TOP_K = 8
D_EXPERT = 256
D_SHARED = 256
ROUTE_SCALE = 2.5
MOE_BLOCK = 128
MOE_BLOCKS_PER_STEP = 8
SPLIT_SIZES = (Q_WIDTH, KV_WIDTH, KV_WIDTH, KV_WIDTH, KV_WIDTH, KV_WIDTH, KV_WIDTH, NSA_Q_HEADS * 3, GM_WIDTH, GM_WIDTH, D_MODEL, D_MODEL)
IN_COLS = Q_WIDTH + 6 * KV_WIDTH + NSA_Q_HEADS * 3 + 2 * GM_WIDTH + 2 * D_MODEL
EPS = 1e-6

kernel_name = "hybrid_nsa_gmlp_moe_adaln"


def _rms(x):
    xf = x.astype(jnp.float32)
    return (xf * lax.rsqrt(jnp.mean(xf * xf, -1, keepdims=True) + EPS)).astype(x.dtype)


def _rope(x, pos):
    half = HEAD_DIM // 2
    inv = ROPE_THETA ** (-jnp.arange(half, dtype=jnp.float32) / half)
    ang = pos.astype(jnp.float32)[..., None] * inv
    cos = jnp.cos(ang)[:, :, None, :]
    sin = jnp.sin(ang)[:, :, None, :]
    x1 = x[..., :half].astype(jnp.float32)
    x2 = x[..., half:].astype(jnp.float32)
    return jnp.concatenate([x1 * cos - x2 * sin, x2 * cos + x1 * sin], -1).astype(x.dtype)


def _masked_softmax(s, mask):
    s = jnp.where(mask, s.astype(jnp.float32), -jnp.inf)
    m = jnp.max(s, -1, keepdims=True)
    m = jnp.where(jnp.isfinite(m), m, 0.0)
    e = jnp.where(mask, jnp.exp(s - m), 0.0)
    return e / jnp.maximum(jnp.sum(e, -1, keepdims=True), 1e-30)


def _nsa(q, k_cmp, v_cmp, k_slc, v_slc, k_win, v_win, gate_logits, pos, q_gain, k_gain, pos_k, pos_v, w1k, w2k, w1v, w2v):
    B, S = q.shape[:2]
    Hkv, G, hd, QB = NSA_KV_HEADS, NSA_GROUP, HEAD_DIM, NSA_QBLOCK
    q = _rms(q) * q_gain
    q_rot = _rope(q, pos)
    k_slc = _rope(_rms(k_slc) * k_gain, pos)
    k_win = _rope(_rms(k_win) * k_gain, pos)

    n_cmp = (S - CMP_LEN) // CMP_STRIDE + 1
    blk = np.arange(n_cmp)[:, None] * CMP_STRIDE + np.arange(CMP_LEN)[None, :]

    def compress(t, pe, w1, w2):
        tb = t[:, blk] + pe[None, None, :, None, :]
        tb = jnp.swapaxes(tb, 2, 3).reshape(B, n_cmp, Hkv, CMP_LEN * hd)
        return jax.nn.gelu(tb @ w1) @ w2

    kc = _rms(compress(k_cmp, pos_k, w1k, w2k)) * k_gain
    vc = compress(v_cmp, pos_v, w1v, w2v)
    cmp_start = blk[:, 0]
    cmp_end = blk[:, -1]

    n_sel = S // SEL_LEN
    top_n = min(SEL_TOPN, n_sel)
    sel_start = np.arange(n_sel) * SEL_LEN
    overlap = jnp.asarray(((cmp_start[:, None] <= sel_start[None, :] + SEL_LEN - 1) & (cmp_end[:, None] >= sel_start[None, :])).astype(np.float32))
    kb = k_slc.reshape(B, n_sel, SEL_LEN, Hkv, hd).transpose(0, 3, 1, 2, 4)
    vb = v_slc.reshape(B, n_sel, SEL_LEN, Hkv, hd).transpose(0, 3, 1, 2, 4)

    kw = jnp.pad(k_win, ((0, 0), (WINDOW, 0), (0, 0), (0, 0)))
    vw = jnp.pad(v_win, ((0, 0), (WINDOW, 0), (0, 0), (0, 0)))

    g = jax.nn.sigmoid(gate_logits.astype(jnp.float32)).astype(q.dtype)
    scale = HEAD_DIM ** -0.5
    cmp_end_j = jnp.asarray(cmp_end)
    bi = jnp.arange(B)[:, None, None, None]
    hi = jnp.arange(Hkv)[None, :, None, None]
    jsel = jnp.arange(n_sel)

    def block(q0):
        t = q0 + jnp.arange(QB)
        qn = lax.dynamic_slice_in_dim(q, q0, QB, 1).reshape(B, QB, Hkv, G, hd)
        qr = lax.dynamic_slice_in_dim(q_rot, q0, QB, 1).reshape(B, QB, Hkv, G, hd)
        gb = lax.dynamic_slice_in_dim(g, q0, QB, 1)

        s_c = jnp.einsum('bqkgd,bnkd->bkgqn', qn, kc) * scale
        p_c = _masked_softmax(s_c, cmp_end_j[None, :] <= t[:, None])
        o_c = jnp.einsum('bkgqn,bnkd->bqkgd', p_c.astype(vc.dtype), vc)

        imp = jnp.einsum('bkgqn,nj->bkqj', p_c, overlap)
        cur = t // SEL_LEN
        valid = jsel[None, :] <= cur[:, None]
        forced = (jsel[None, :] == 0) | (jsel[None, :] == cur[:, None]) | (jsel[None, :] == cur[:, None] - 1)
        rank = jnp.where(forced, jnp.inf, jnp.where(valid, imp, -jnp.inf))
        _, idx = lax.top_k(rank, top_n)
        ks = kb[bi, hi, idx]
        vs = vb[bi, hi, idx].reshape(B, Hkv, QB, top_n * SEL_LEN, hd)
        tok = idx[..., None] * SEL_LEN + jnp.arange(SEL_LEN)
        m_s = (tok <= t[None, None, :, None, None]).reshape(B, Hkv, 1, QB, top_n * SEL_LEN)
        s_s = jnp.einsum('bqkgd,bkqnld->bkgqnl', qr, ks).reshape(B, Hkv, G, QB, top_n * SEL_LEN) * scale
        p_s = _masked_softmax(s_s, m_s)
        o_s = jnp.einsum('bkgqm,bkqmd->bqkgd', p_s.astype(vs.dtype), vs)

        kwin = lax.dynamic_slice_in_dim(kw, q0, WINDOW + QB, 1)
        vwin = lax.dynamic_slice_in_dim(vw, q0, WINDOW + QB, 1)
        kpos = q0 - WINDOW + jnp.arange(WINDOW + QB)
        m_w = (kpos[None, :] <= t[:, None]) & (kpos[None, :] > t[:, None] - WINDOW) & (kpos[None, :] >= 0)
        s_w = jnp.einsum('bqkgd,bmkd->bkgqm', qr, kwin) * scale
        p_w = _masked_softmax(s_w, m_w)
        o_w = jnp.einsum('bkgqm,bmkd->bqkgd', p_w.astype(vwin.dtype), vwin)

        shp = (B, QB, NSA_Q_HEADS, hd)
        return (gb[..., 0:1] * o_c.reshape(shp) + gb[..., 1:2] * o_s.reshape(shp) + gb[..., 2:3] * o_w.reshape(shp))

    out = lax.map(block, jnp.arange(S // QB) * QB)
    return jnp.moveaxis(out, 0, 1).reshape(B, S, Q_WIDTH)


def _gmlp(u, v, ln_g, ln_b, ws, bs):
    B, S, _ = v.shape
    vf = v.astype(jnp.float32)
    mu = jnp.mean(vf, -1, keepdims=True)
    var = jnp.mean(jnp.square(vf - mu), -1, keepdims=True)
    vn = ((vf - mu) * lax.rsqrt(var + EPS)).astype(v.dtype) * ln_g + ln_b
    vc = vn.reshape(B, S // GM_CHUNK, GM_CHUNK, GM_GROUPS, GM_GROUP_DIM)
    causal = jnp.tril(jnp.ones((GM_CHUNK, GM_CHUNK), ws.dtype))
    mixed = jnp.einsum('gts,bnsgc->bntgc', ws * causal, vc) + jnp.swapaxes(bs, 0, 1)[None, None, :, :, None]
    return u * mixed.reshape(B, S, GM_WIDTH)


def _moe(h, w_router, b_router, w_gate_e, w_up_e, w_down_e, w_gate_sh, w_up_sh, w_down_sh):
    T, D = h.shape
    aff = jax.nn.sigmoid(jnp.dot(h, w_router).astype(jnp.float32))
    _, idx = lax.top_k(aff + b_router.astype(jnp.float32), TOP_K)
    top = jnp.take_along_axis(aff, idx, -1)
    wts = top / jnp.sum(top, -1, keepdims=True) * ROUTE_SCALE

    n_as = T * TOP_K
    flat_e = idx.reshape(-1)
    order = jnp.argsort(flat_e)
    se = flat_e[order]
    tok = (order // TOP_K).astype(jnp.int32)
    counts = jnp.bincount(flat_e, length=N_EXPERTS)
    padded = (counts + MOE_BLOCK - 1) // MOE_BLOCK * MOE_BLOCK
    pad_end = jnp.cumsum(padded)
    pad_start = pad_end - padded
    grp_start = jnp.cumsum(counts) - counts
    dest = pad_start[se] + jnp.arange(n_as) - grp_start[se]
    step_rows = MOE_BLOCK * MOE_BLOCKS_PER_STEP
    n_rows = -(-(n_as + N_EXPERTS * MOE_BLOCK) // step_rows) * step_rows
    row_tok = jnp.zeros((n_rows,), jnp.int32).at[dest].set(tok)
    row_w = jnp.zeros((n_rows,), jnp.float32).at[dest].set(wts.reshape(-1)[order])
    blk_e = jnp.minimum(jnp.searchsorted(pad_end, jnp.arange(n_rows // MOE_BLOCK) * MOE_BLOCK, side='right'), N_EXPERTS - 1)
    n_steps = n_rows // step_rows
    xs = (row_tok.reshape(n_steps, MOE_BLOCKS_PER_STEP, MOE_BLOCK),
          row_w.reshape(n_steps, MOE_BLOCKS_PER_STEP, MOE_BLOCK),
          blk_e.reshape(n_steps, MOE_BLOCKS_PER_STEP))

    def step(acc, blk):
        rt, rw, be = blk
        xb = h[rt]
        a = jnp.einsum('pnd,pdf->pnf', xb, w_gate_e[be])
        b = jnp.einsum('pnd,pdf->pnf', xb, w_up_e[be])
        y = jnp.einsum('pnf,pfd->pnd', jax.nn.silu(a) * b, w_down_e[be])
        acc = acc.at[rt.reshape(-1)].add((y.astype(jnp.float32) * rw[..., None]).reshape(-1, D))
        return acc, None

    routed, _ = lax.scan(step, jnp.zeros((T, D), jnp.float32), xs)
    shared = (jax.nn.silu(h @ w_gate_sh) * (h @ w_up_sh)) @ w_down_sh
    return routed.astype(h.dtype) + shared


def setup_inputs(seed: int = 0) -> dict:
    key = jax.random.key(seed)
    ks = jax.random.split(key, 32)
    L, D, hd = DEPTH, D_MODEL, HEAD_DIM
    nrm = lambda k, shp, s: jax.random.normal(k, shp, jnp.float32) * s
    return {
        "x": nrm(ks[0], (BATCH, SEQ, D), 1.0),
        "c": nrm(ks[1], (BATCH, D), 1.0),
        "positions": jnp.broadcast_to(jnp.arange(SEQ, dtype=jnp.int32), (BATCH, SEQ)),
        "w_mod": nrm(ks[2], (L, D, 6 * D), 0.5 * D ** -0.5),
        "b_mod": nrm(ks[3], (L, 6 * D), 0.02),
        "w_in": nrm(ks[4], (L, D, IN_COLS), D ** -0.5),
        "q_gain": 1.0 + nrm(ks[5], (L, hd), 0.02),
        "k_gain": 1.0 + nrm(ks[6], (L, hd), 0.02),
        "cmp_pos_k": nrm(ks[7], (L, CMP_LEN, hd), 0.02),
        "cmp_pos_v": nrm(ks[8], (L, CMP_LEN, hd), 0.02),
        "cmp_w1_k": nrm(ks[9], (L, CMP_LEN * hd, CMP_HIDDEN), (CMP_LEN * hd) ** -0.5),
        "cmp_w2_k": nrm(ks[10], (L, CMP_HIDDEN, hd), CMP_HIDDEN ** -0.5),
        "cmp_w1_v": nrm(ks[11], (L, CMP_LEN * hd, CMP_HIDDEN), (CMP_LEN * hd) ** -0.5),
        "cmp_w2_v": nrm(ks[12], (L, CMP_HIDDEN, hd), CMP_HIDDEN ** -0.5),
        "gm_ln_g": 1.0 + nrm(ks[13], (L, GM_WIDTH), 0.02),
        "gm_ln_b": nrm(ks[14], (L, GM_WIDTH), 0.02),
        "gm_ws": nrm(ks[15], (L, GM_GROUPS, GM_CHUNK, GM_CHUNK), GM_CHUNK ** -0.5),
        "gm_bs": 1.0 + nrm(ks[16], (L, GM_GROUPS, GM_CHUNK), 0.02),
        "w_proj_nsa": nrm(ks[17], (L, Q_WIDTH, D), Q_WIDTH ** -0.5),
        "w_proj_gm": nrm(ks[18], (L, GM_WIDTH, D), GM_WIDTH ** -0.5),
        "w_out": nrm(ks[19], (L, D, D), D ** -0.5),
        "w_router": nrm(ks[20], (L, D, N_EXPERTS), D ** -0.5),
        "b_router": nrm(ks[21], (L, N_EXPERTS), 0.01),
        "w_gate_e": nrm(ks[22], (L, N_EXPERTS, D, D_EXPERT), D ** -0.5),
        "w_up_e": nrm(ks[23], (L, N_EXPERTS, D, D_EXPERT), D ** -0.5),
        "w_down_e": nrm(ks[24], (L, N_EXPERTS, D_EXPERT, D), D_EXPERT ** -0.5),
        "w_gate_sh": nrm(ks[25], (L, D, D_SHARED), D ** -0.5),
        "w_up_sh": nrm(ks[26], (L, D, D_SHARED), D ** -0.5),
        "w_down_sh": nrm(ks[27], (L, D_SHARED, D), D_SHARED ** -0.5),
    }


def reference(x, c, positions, w_mod, b_mod, w_in, q_gain, k_gain, cmp_pos_k, cmp_pos_v, cmp_w1_k, cmp_w2_k, cmp_w1_v, cmp_w2_v, gm_ln_g, gm_ln_b, gm_ws, gm_bs, w_proj_nsa, w_proj_gm, w_out, w_router, b_router, w_gate_e, w_up_e, w_down_e, w_gate_sh, w_up_sh, w_down_sh):
    B, S, D = x.shape
    split_pts = [int(p) for p in np.cumsum(SPLIT_SIZES)[:-1]]
    kv_shape = (B, S, NSA_KV_HEADS, HEAD_DIM)
    for l in range(DEPTH):
        mod = jax.nn.silu(c) @ w_mod[l] + b_mod[l]
        sh_a, sc_a, gt_a, sh_f, sc_f, gt_f = jnp.split(mod, 6, axis=-1)

        h = _rms(x) * (1.0 + sc_a[:, None, :]) + sh_a[:, None, :]
        z = h @ w_in[l]
        (zq, zkc, zvc, zks, zvs, zkw, zvw, zg, zu, zv, zga, zgb) = jnp.split(z, split_pts, axis=-1)
        o_nsa = _nsa(zq.reshape(B, S, NSA_Q_HEADS, HEAD_DIM),
                     zkc.reshape(kv_shape), zvc.reshape(kv_shape),
                     zks.reshape(kv_shape), zvs.reshape(kv_shape),
                     zkw.reshape(kv_shape), zvw.reshape(kv_shape),
                     zg.reshape(B, S, NSA_Q_HEADS, 3), positions,
                     q_gain[l], k_gain[l], cmp_pos_k[l], cmp_pos_v[l],
                     cmp_w1_k[l], cmp_w2_k[l], cmp_w1_v[l], cmp_w2_v[l])
        o_gm = _gmlp(jax.nn.gelu(zu), jax.nn.gelu(zv), gm_ln_g[l], gm_ln_b[l], gm_ws[l], gm_bs[l])
        y_a = o_nsa @ w_proj_nsa[l]
        y_b = o_gm @ w_proj_gm[l]
        merged = jax.nn.sigmoid(zga) * y_a + jax.nn.sigmoid(zgb) * y_b
        x = x + gt_a[:, None, :] * (merged @ w_out[l])

        h2 = _rms(x) * (1.0 + sc_f[:, None, :]) + sh_f[:, None, :]
        y = _moe(h2.reshape(B * S, D), w_router[l], b_router[l], w_gate_e[l], w_up_e[l], w_down_e[l],
                 w_gate_sh[l], w_up_sh[l], w_down_sh[l]).reshape(B, S, D)
        x = x + gt_f[:, None, :] * y
    return x
```

```cpp
#include <hip/hip_runtime.h>
#include <stdint.h>
#include <string.h>
#include <stdio.h>

#ifndef ONE_LAUNCH
#define ONE_LAUNCH 0
#endif

#define NB 8
#define NS 4096
#define ND 1024
#define NT (NB * NS)
#define NL 2
#define INC 4376
#define NCMP 255
#define NE 256
#define MAXROWS 294912
#define MAXBLK 2304
#define ZQ 0
#define ZKC 512
#define ZVC 640
#define ZKS 768
#define ZVS 896
#define ZKW 1024
#define ZVW 1152
#define ZG 1280
#define ZU 1304
#define ZV 1816
#define ZGA 2328
#define ZGB 3352

struct Params {
    const float *x, *c; const int* pos;
    const float *w_mod, *b_mod, *w_in, *q_gain, *k_gain, *pe_k, *pe_v, *w1k, *w2k, *w1v, *w2v, *ln_g, *ln_b, *gm_ws, *gm_bs,
                *wpn, *wpg, *w_out, *w_router, *b_router, *wge, *wue, *wde, *wgs, *wus, *wds;
    float* out;
    float *mod, *h, *z, *qn, *qr, *ks, *kw, *kc, *vc, *onsa, *vn, *ogm, *ya;
    float *logits, *gs, *sact, *shout, *routed, *ag, *act, *row_w, *wts;
    int *idx, *counts, *cursor, *pad_start, *row_tok, *blk_e;
    unsigned* bar;
};

__device__ __forceinline__ float sigmoidf_(float x) { return 1.0f / (1.0f + expf(-x)); }
__device__ __forceinline__ float siluf_(float x) { return x / (1.0f + expf(-x)); }
__device__ __forceinline__ float geluf_(float x) { return 0.5f * x * (1.0f + tanhf(0.7978845608028654f * (x + 0.044715f * x * x * x))); }
__device__ __forceinline__ float wave_sum(float v) {
#pragma unroll
    for (int o = 32; o >= 1; o >>= 1) v += __shfl_xor(v, o);
    return v;
}

enum { M_STORE = 0, M_RESID = 1, M_SILU_MUL = 2, M_SIG_SET = 3, M_SIG_ADD = 4, M_SCATTER = 5 };
struct GemmArgs {
    const float* A; int lda; const int* gather;
    const float* Bm; int ldb; size_t strideB; const int* blk_e;
    float* C; int ldc; int M, N, K;
    const float* aux; int ldaux; const float* aux2;
};

template <int MODE, bool GATHER>
__device__ __forceinline__ void sgemm(const GemmArgs& g, float* smem, int bid, int nb) {
    float (*As)[128] = (float (*)[128])smem;
    float (*Bs)[128] = (float (*)[128])(smem + 16 * 128);
    const int tid = threadIdx.x, tx = tid & 15, ty = tid >> 4;
    const int ntn = (g.N + 127) / 128, ntm = g.M / 128, ntiles = ntm * ntn;
    for (int tile = bid; tile < ntiles; tile += nb) {
        const int tm = tile / ntn, tn = tile % ntn;
        const int row0 = tm * 128, col0 = tn * 128;
        const float* Bp = g.Bm;
        if (g.blk_e) { const int e = g.blk_e[tm]; if (e < 0) continue; Bp += (size_t)e * g.strideB; }
        float acc[8][8];
#pragma unroll
        for (int i = 0; i < 8; ++i)
#pragma unroll
            for (int j = 0; j < 8; ++j) acc[i][j] = 0.f;
        const float* arow[2];
#pragma unroll
        for (int i = 0; i < 2; ++i) {
            const int id = tid + i * 256, r = id >> 2;
            int srow = row0 + r;
            if (GATHER) { srow = g.gather[row0 + r]; srow = srow < 0 ? 0 : srow; }
            arow[i] = g.A + (size_t)srow * g.lda + (id & 3) * 4;
        }
        for (int k0 = 0; k0 < g.K; k0 += 16) {
            float4 av[2], bv[2];
#pragma unroll
            for (int i = 0; i < 2; ++i) av[i] = *(const float4*)(arow[i] + k0);
#pragma unroll
            for (int i = 0; i < 2; ++i) {
                const int id = tid + i * 256, kr = id >> 5, cq = (id & 31) * 4, cc = col0 + cq;
                if (cc < g.N) bv[i] = *(const float4*)(Bp + (size_t)(k0 + kr) * g.ldb + cc);
                else bv[i] = make_float4(0.f, 0.f, 0.f, 0.f);
            }
            __syncthreads();
#pragma unroll
            for (int i = 0; i < 2; ++i) {
                const int id = tid + i * 256, r = id >> 2, kq = (id & 3) * 4;
                As[kq + 0][r] = av[i].x; As[kq + 1][r] = av[i].y; As[kq + 2][r] = av[i].z; As[kq + 3][r] = av[i].w;
                const int kr = id >> 5, cq = (id & 31) * 4;
                *(float4*)&Bs[kr][cq] = bv[i];
            }
            __syncthreads();
#pragma unroll
            for (int k = 0; k < 16; ++k) {
                const float4 a0 = *(const float4*)&As[k][ty * 4], a1 = *(const float4*)&As[k][64 + ty * 4];
                const float4 b0 = *(const float4*)&Bs[k][tx * 4], b1 = *(const float4*)&Bs[k][64 + tx * 4];
                const float a[8] = {a0.x, a0.y, a0.z, a0.w, a1.x, a1.y, a1.z, a1.w};
                const float b[8] = {b0.x, b0.y, b0.z, b0.w, b1.x, b1.y, b1.z, b1.w};
#pragma unroll
                for (int i = 0; i < 8; ++i)
#pragma unroll
                    for (int j = 0; j < 8; ++j) acc[i][j] = fmaf(a[i], b[j], acc[i][j]);
            }
        }
#pragma unroll
        for (int i = 0; i < 8; ++i) {
            const int r = row0 + (i < 4 ? ty * 4 + i : 64 + ty * 4 + (i - 4));
            int tok = 0; float rw = 0.f;
            if (MODE == M_SCATTER) { tok = g.gather[r]; rw = g.aux[r]; if (tok < 0) continue; }
#pragma unroll
            for (int jh = 0; jh < 2; ++jh) {
                const int cidx = col0 + jh * 64 + tx * 4;
                if (cidx >= g.N) continue;
                float4 v = make_float4(acc[i][jh * 4 + 0], acc[i][jh * 4 + 1], acc[i][jh * 4 + 2], acc[i][jh * 4 + 3]);
                if (MODE == M_STORE) {
                    *(float4*)(g.C + (size_t)r * g.ldc + cidx) = v;
                } else if (MODE == M_RESID) {
                    const float4 rr = *(const float4*)(g.aux + (size_t)r * g.ldaux + cidx);
                    const float4 gt = *(const float4*)(g.aux2 + (size_t)(r >> 12) * 6144 + cidx);
                    v.x = rr.x + gt.x * v.x; v.y = rr.y + gt.y * v.y; v.z = rr.z + gt.z * v.z; v.w = rr.w + gt.w * v.w;
                    *(float4*)(g.C + (size_t)r * g.ldc + cidx) = v;
                } else if (MODE == M_SILU_MUL) {
                    const float4 a = *(const float4*)(g.aux + (size_t)r * g.ldaux + cidx);
                    v.x *= siluf_(a.x); v.y *= siluf_(a.y); v.z *= siluf_(a.z); v.w *= siluf_(a.w);
                    *(float4*)(g.C + (size_t)r * g.ldc + cidx) = v;
                } else if (MODE == M_SIG_SET || MODE == M_SIG_ADD) {
                    const float4 a = *(const float4*)(g.aux + (size_t)r * g.ldaux + cidx);
                    v.x *= sigmoidf_(a.x); v.y *= sigmoidf_(a.y); v.z *= sigmoidf_(a.z); v.w *= sigmoidf_(a.w);
                    float4* cp = (float4*)(g.C + (size_t)r * g.ldc + cidx);
                    if (MODE == M_SIG_ADD) { const float4 o = *cp; v.x += o.x; v.y += o.y; v.z += o.z; v.w += o.w; }
                    *cp = v;
                } else if (MODE == M_SCATTER) {
                    float* cp = g.C + (size_t)tok * g.ldc + cidx;
                    atomicAdd(cp + 0, rw * v.x); atomicAdd(cp + 1, rw * v.y); atomicAdd(cp + 2, rw * v.z); atomicAdd(cp + 3, rw * v.w);
                }
            }
        }
    }
}

__device__ __forceinline__ void ph_mod(const Params& p, float* smem, int bid, int nb) {
    for (int i = threadIdx.x; i < NB * ND; i += 256) smem[i] = siluf_(p.c[i]);
    __syncthreads();
    for (int it = bid * 256 + threadIdx.x; it < NL * 6144; it += nb * 256) {
        const int l = it / 6144, j = it % 6144;
        float acc[NB];
#pragma unroll
        for (int b = 0; b < NB; ++b) acc[b] = 0.f;
        const float* w = p.w_mod + (size_t)l * ND * 6144 + j;
        for (int d = 0; d < ND; ++d) {
            const float wv = w[(size_t)d * 6144];
#pragma unroll
            for (int b = 0; b < NB; ++b) acc[b] = fmaf(smem[b * ND + d], wv, acc[b]);
        }
        const float bb = p.b_mod[l * 6144 + j];
#pragma unroll
        for (int b = 0; b < NB; ++b) p.mod[((size_t)l * NB + b) * 6144 + j] = acc[b] + bb;
    }
    __syncthreads();
}

__device__ __forceinline__ void ph_norm(const Params& p, const float* xin, int l, int sh_off, int sc_off, int bid, int nb) {
    const int lane = threadIdx.x & 63, w = threadIdx.x >> 6;
    for (int t = bid * 4 + w; t < NT; t += nb * 4) {
        const float* xr = xin + (size_t)t * ND;
        float4 v[4]; float ss = 0.f;
#pragma unroll
        for (int i = 0; i < 4; ++i) { v[i] = *(const float4*)(xr + i * 256 + lane * 4); ss += v[i].x * v[i].x + v[i].y * v[i].y + v[i].z * v[i].z + v[i].w * v[i].w; }
        ss = wave_sum(ss);
        const float rstd = rsqrtf(ss * (1.0f / ND) + 1e-6f);
        const float* mb = p.mod + ((size_t)l * NB + (t >> 12)) * 6144;
#pragma unroll
        for (int i = 0; i < 4; ++i) {
            const int cidx = i * 256 + lane * 4;
            const float4 sc = *(const float4*)(mb + sc_off + cidx), sh = *(const float4*)(mb + sh_off + cidx);
            float4 o;
            o.x = v[i].x * rstd * (1.f + sc.x) + sh.x; o.y = v[i].y * rstd * (1.f + sc.y) + sh.y;
            o.z = v[i].z * rstd * (1.f + sc.z) + sh.z; o.w = v[i].w * rstd * (1.f + sc.w) + sh.w;
            *(float4*)(p.h + (size_t)t * ND + cidx) = o;
        }
    }
}

__device__ __forceinline__ void ph_prep(const Params& p, int l, int bid, int nb) {
    const int lane = threadIdx.x & 63, w = threadIdx.x >> 6;
    const int i32 = lane & 31;
    const float inv = (float)pow(10000.0, -(double)i32 / 32.0);
    for (long it = (long)bid * 4 + w; it < (long)NT * 12; it += (long)nb * 4) {
        const int t = (int)(it / 12), hv = (int)(it % 12);
        int zc; const float* gain; float* dst; float* dst_norot = nullptr;
        if (hv < 8) { zc = ZQ + hv * 64; gain = p.q_gain + l * 64; dst = p.qr + (size_t)t * 512 + hv * 64; dst_norot = p.qn + (size_t)t * 512 + hv * 64; }
        else if (hv < 10) { zc = ZKS + (hv - 8) * 64; gain = p.k_gain + l * 64; dst = p.ks + (size_t)t * 128 + (hv - 8) * 64; }
        else { zc = ZKW + (hv - 10) * 64; gain = p.k_gain + l * 64; dst = p.kw + (size_t)t * 128 + (hv - 10) * 64; }
        const float v = p.z[(size_t)t * INC + zc + lane];
        const float ss = wave_sum(v * v);
        const float y = v * rsqrtf(ss * (1.0f / 64.f) + 1e-6f) * gain[lane];
        if (dst_norot) dst_norot[lane] = y;
        const float ang = (float)p.pos[t] * inv;
        const float cs = cosf(ang), sn = sinf(ang);
        const float other = __shfl_xor(y, 32);
        const float r = lane < 32 ? (y * cs - other * sn) : (y * cs + other * sn);
        dst[lane] = r;
    }
}

__device__ __forceinline__ void ph_compress(const Params& p, int l, float* smem, int bid, int nb) {
    float* A = smem;
    float* hid = smem + 2048;
    float* red = smem + 2048 + 256;
    const int tid = threadIdx.x;
    for (int u = bid; u < 2 * NB * NCMP * 2; u += nb) {
        const int kv = u / (NB * NCMP * 2), r = u % (NB * NCMP * 2), b = r / (NCMP * 2), n = (r / 2) % NCMP, hh = r & 1;
        const float* pe = (kv ? p.pe_v : p.pe_k) + l * 2048;
        const float* w1 = (kv ? p.w1v : p.w1k) + (size_t)l * 2048 * 256;
        const float* w2 = (kv ? p.w2v : p.w2k) + (size_t)l * 256 * 64;
        const int zc = (kv ? ZVC : ZKC) + hh * 64;
        __syncthreads();
        for (int k = tid; k < 2048; k += 256) { const int li = k >> 6, d = k & 63; A[k] = p.z[((size_t)b * NS + 16 * n + li) * INC + zc + d] + pe[k]; }
        __syncthreads();
        float acc = 0.f;
        for (int k = 0; k < 2048; ++k) acc = fmaf(A[k], w1[(size_t)k * 256 + tid], acc);
        hid[tid] = geluf_(acc);
        __syncthreads();
        if (tid < 64) {
            float o = 0.f;
            for (int f = 0; f < 256; ++f) o = fmaf(hid[f], w2[f * 64 + tid], o);
            float* dst = (kv ? p.vc : p.kc) + (((size_t)b * NCMP + n) * 2 + hh) * 64;
            if (kv) dst[tid] = o;
            else { const float ss = wave_sum(o * o); dst[tid] = o * rsqrtf(ss * (1.f / 64.f) + 1e-6f) * p.k_gain[l * 64 + tid]; }
        }
    }
    __syncthreads();
}

__device__ __forceinline__ void ph_gmln(const Params& p, int l, int bid, int nb) {
    const int lane = threadIdx.x & 63, w = threadIdx.x >> 6;
    for (int t = bid * 4 + w; t < NT; t += nb * 4) {
        float v[8]; float s = 0.f;
#pragma unroll
        for (int i = 0; i < 8; ++i) { v[i] = geluf_(p.z[(size_t)t * INC + ZV + i * 64 + lane]); s += v[i]; }
        const float mu = wave_sum(s) * (1.f / 512.f);
        float q = 0.f;
#pragma unroll
        for (int i = 0; i < 8; ++i) { const float d = v[i] - mu; q += d * d; }
        const float rstd = rsqrtf(wave_sum(q) * (1.f / 512.f) + 1e-6f);
#pragma unroll
        for (int i = 0; i < 8; ++i) { const int cidx = i * 64 + lane; p.vn[(size_t)t * 512 + cidx] = (v[i] - mu) * rstd * p.ln_g[l * 512 + cidx] + p.ln_b[l * 512 + cidx]; }
    }
}

__device__ __forceinline__ void ph_gmmix(const Params& p, int l, float* smem, int bid, int nb) {
    const int tid = threadIdx.x, cidx = tid & 63, w = tid >> 6;
    for (int u = bid; u < 256 * 8; u += nb) {
        const int ch = u >> 3, g = u & 7;
        const size_t base = (size_t)ch * 128;
        __syncthreads();
        for (int i = tid; i < 128 * 64; i += 256) smem[i] = p.vn[(base + (i >> 6)) * 512 + g * 64 + (i & 63)];
        __syncthreads();
        const float* ws = p.gm_ws + ((size_t)l * 8 + g) * 128 * 128;
        for (int tl = w; tl < 128; tl += 4) {
            float acc = 0.f;
            for (int s = 0; s <= tl; ++s) acc = fmaf(ws[tl * 128 + s], smem[s * 64 + cidx], acc);
            const float mixed = acc + p.gm_bs[(l * 8 + g) * 128 + tl];
            const float uu = geluf_(p.z[(base + tl) * INC + ZU + g * 64 + cidx]);
            p.ogm[(base + tl) * 512 + g * 64 + cidx] = uu * mixed;
        }
    }
    __syncthreads();
}

__device__ __forceinline__ float dot64(const float (&q)[64], const float* k) {
    float s = 0.f;
#pragma unroll
    for (int i = 0; i < 16; ++i) { const float4 kv = *(const float4*)(k + i * 4); s = fmaf(q[i * 4], kv.x, s); s = fmaf(q[i * 4 + 1], kv.y, s); s = fmaf(q[i * 4 + 2], kv.z, s); s = fmaf(q[i * 4 + 3], kv.w, s); }
    return s;
}
__device__ __forceinline__ void axpy64(float (&o)[64], float e, const float* v) {
#pragma unroll
    for (int i = 0; i < 16; ++i) { const float4 vv = *(const float4*)(v + i * 4); o[i * 4] = fmaf(e, vv.x, o[i * 4]); o[i * 4 + 1] = fmaf(e, vv.y, o[i * 4 + 1]); o[i * 4 + 2] = fmaf(e, vv.z, o[i * 4 + 2]); o[i * 4 + 3] = fmaf(e, vv.w, o[i * 4 + 3]); }
}

__device__ __forceinline__ void ph_attn(const Params& p, int l, float* smem, int bid, int nb) {
    float* imp = smem;
    unsigned long long* selm = (unsigned long long*)(smem + 4096);
    const int tid = threadIdx.x, qi = tid >> 2, g = tid & 3;
    const float scale = 0.125f;
    for (int unit = bid; unit < 1024; unit += nb) {
        const int qb = 63 - (unit >> 4), b = (unit & 15) >> 1, kvh = unit & 1;
        const int t = qb * 64 + qi, hq = kvh * 4 + g;
        const size_t tok = (size_t)b * NS + t;
        float q[64], o[64];
        const float gate0 = sigmoidf_(p.z[tok * INC + ZG + hq * 3 + 0]), gate1 = sigmoidf_(p.z[tok * INC + ZG + hq * 3 + 1]), gate2 = sigmoidf_(p.z[tok * INC + ZG + hq * 3 + 2]);
        float* outp = p.onsa + tok * 512 + hq * 64;
#pragma unroll
        for (int i = 0; i < 16; ++i) { const float4 v = *(const float4*)(p.qn + tok * 512 + hq * 64 + i * 4); q[i * 4] = v.x; q[i * 4 + 1] = v.y; q[i * 4 + 2] = v.z; q[i * 4 + 3] = v.w; }
        int nvis = t >= 31 ? (t - 31) / 16 + 1 : 0; if (nvis > NCMP) nvis = NCMP;
        const float* kcb = p.kc + ((size_t)b * NCMP * 2 + kvh) * 64;
        const float* vcb = p.vc + ((size_t)b * NCMP * 2 + kvh) * 64;
        float m = -INFINITY;
        for (int n = 0; n < nvis; ++n) { const float s = dot64(q, kcb + n * 128) * scale; m = fmaxf(m, s); }
        float lsum = 0.f;
#pragma unroll
        for (int i = 0; i < 64; ++i) o[i] = 0.f;
        for (int n = 0; n < nvis; ++n) { const float s = dot64(q, kcb + n * 128) * scale; const float e = expf(s - m); lsum += e; axpy64(o, e, vcb + n * 128); }
        const float inv = 1.0f / fmaxf(lsum, 1e-30f);
#pragma unroll
        for (int i = 0; i < 16; ++i) *(float4*)(outp + i * 4) = make_float4(gate0 * o[i * 4] * inv, gate0 * o[i * 4 + 1] * inv, gate0 * o[i * 4 + 2] * inv, gate0 * o[i * 4 + 3] * inv);
        __syncthreads();
        for (int j = 0; j <= qb; ++j) {
            float a = 0.f;
            for (int n = 4 * j - 1; n <= 4 * j + 3; ++n) if (n >= 0 && n < nvis) { const float s = dot64(q, kcb + n * 128) * scale; a += expf(s - m) * inv; }
            a += __shfl_xor(a, 1); a += __shfl_xor(a, 2);
            if (g == 0) imp[qi * 64 + j] = a;
        }
        __syncthreads();
        if (g == 0) {
            unsigned long long mask = 0ull;
            for (int it = 0; it < 16; ++it) {
                int best = -1; float bv = 0.f;
                for (int j = 0; j < 64; ++j) {
                    if ((mask >> j) & 1ull) continue;
                    const bool forced = (j == 0) || (j == qb) || (j == qb - 1);
                    const float v = forced ? INFINITY : (j <= qb ? imp[qi * 64 + j] : -INFINITY);
                    if (best < 0 || v > bv) { best = j; bv = v; }
                }
                mask |= 1ull << best;
            }
            selm[qi] = mask;
        }
        __syncthreads();
        const unsigned long long mask = selm[qi];
#pragma unroll
        for (int i = 0; i < 16; ++i) { const float4 v = *(const float4*)(p.qr + tok * 512 + hq * 64 + i * 4); q[i * 4] = v.x; q[i * 4 + 1] = v.y; q[i * 4 + 2] = v.z; q[i * 4 + 3] = v.w; }
        {
            float mm = -INFINITY, ll = 0.f;
#pragma unroll
            for (int i = 0; i < 64; ++i) o[i] = 0.f;
            for (int j = 0; j <= qb; ++j) {
                if (!((mask >> j) & 1ull)) continue;
                for (int s = 0; s < 64; ++s) {
                    const int tk = j * 64 + s; if (tk > t) break;
                    const size_t kt = (size_t)b * NS + tk;
                    const float sc = dot64(q, p.ks + kt * 128 + kvh * 64) * scale;
                    if (sc > mm) { const float corr = expf(mm - sc); ll *= corr;
#pragma unroll
                        for (int i = 0; i < 64; ++i) o[i] *= corr;
                        mm = sc; }
                    const float e = expf(sc - mm); ll += e; axpy64(o, e, p.z + kt * INC + ZVS + kvh * 64);
                }
            }
            const float iv = gate1 / fmaxf(ll, 1e-30f);
#pragma unroll
            for (int i = 0; i < 16; ++i) { float4 c = *(float4*)(outp + i * 4); c.x += o[i * 4] * iv; c.y += o[i * 4 + 1] * iv; c.z += o[i * 4 + 2] * iv; c.w += o[i * 4 + 3] * iv; *(float4*)(outp + i * 4) = c; }
        }
        {
            float mm = -INFINITY, ll = 0.f;
#pragma unroll
            for (int i = 0; i < 64; ++i) o[i] = 0.f;
            const int k0 = t - 511 > 0 ? t - 511 : 0;
            for (int tk = k0; tk <= t; ++tk) {
                const size_t kt = (size_t)b * NS + tk;
                const float sc = dot64(q, p.kw + kt * 128 + kvh * 64) * scale;
                if (sc > mm) { const float corr = expf(mm - sc); ll *= corr;
#pragma unroll
                    for (int i = 0; i < 64; ++i) o[i] *= corr;
                    mm = sc; }
                const float e = expf(sc - mm); ll += e; axpy64(o, e, p.z + kt * INC + ZVW + kvh * 64);
            }
            const float iv = gate2 / fmaxf(ll, 1e-30f);
#pragma unroll
            for (int i = 0; i < 16; ++i) { float4 c = *(float4*)(outp + i * 4); c.x += o[i * 4] * iv; c.y += o[i * 4 + 1] * iv; c.z += o[i * 4 + 2] * iv; c.w += o[i * 4 + 3] * iv; *(float4*)(outp + i * 4) = c; }
        }
    }
    __syncthreads();
}

__device__ __forceinline__ void ph_topk(const Params& p, int l, int bid, int nb) {
    const int lane = threadIdx.x & 63, w = threadIdx.x >> 6;
    for (int t = bid * 4 + w; t < NT; t += nb * 4) {
        float aff[4], key[4]; bool used[4];
#pragma unroll
        for (int i = 0; i < 4; ++i) { const int e = i * 64 + lane; aff[i] = sigmoidf_(p.logits[(size_t)t * NE + e]); key[i] = aff[i] + p.b_router[l * NE + e]; used[i] = false; }
        float topv[8]; int tope[8]; float sum = 0.f;
#pragma unroll
        for (int r = 0; r < 8; ++r) {
            float bv = -INFINITY; int be = 1 << 30; float ba = 0.f;
#pragma unroll
            for (int i = 0; i < 4; ++i) { const int e = i * 64 + lane; if (!used[i] && (key[i] > bv || (key[i] == bv && e < be))) { bv = key[i]; be = e; ba = aff[i]; } }
#pragma unroll
            for (int o = 32; o >= 1; o >>= 1) {
                const float ov = __shfl_xor(bv, o); const int oe = __shfl_xor(be, o); const float oa = __shfl_xor(ba, o);
                if (ov > bv || (ov == bv && oe < be)) { bv = ov; be = oe; ba = oa; }
            }
#pragma unroll
            for (int i = 0; i < 4; ++i) if (i * 64 + lane == be) used[i] = true;
            topv[r] = ba; tope[r] = be; sum += ba;
        }
        if (lane < 8) {
            float tv = 0.f; int te = 0;
#pragma unroll
            for (int r = 0; r < 8; ++r) if (lane == r) { tv = topv[r]; te = tope[r]; }
            p.idx[(size_t)t * 8 + lane] = te;
            p.wts[(size_t)t * 8 + lane] = tv / sum * 2.5f;
            atomicAdd(&p.counts[te], 1);
        }
    }
}

__device__ __forceinline__ void ph_scan(const Params& p, int* ismem, int bid) {
    if (bid != 0) return;
    const int tid = threadIdx.x;
    ismem[tid] = (p.counts[tid] + 127) / 128 * 128;
    __syncthreads();
    if (tid == 0) { int run = 0; for (int e = 0; e < NE; ++e) { const int v = ismem[e]; ismem[e] = run; run += v; } ismem[NE] = run; }
    __syncthreads();
    const int st = ismem[tid], en = (tid == NE - 1) ? ismem[NE] : ismem[tid + 1];
    p.pad_start[tid] = st; p.cursor[tid] = 0;
    for (int i = st / 128; i < en / 128; ++i) p.blk_e[i] = tid;
    for (int i = ismem[NE] / 128 + tid; i < MAXBLK; i += 256) p.blk_e[i] = -1;
    __syncthreads();
}

__device__ __forceinline__ void ph_place(const Params& p, int bid, int nb) {
    for (int a = bid * 256 + threadIdx.x; a < NT * 8; a += nb * 256) {
        const int e = p.idx[a];
        const int pos = atomicAdd(&p.cursor[e], 1);
        const int dest = p.pad_start[e] + pos;
        p.row_tok[dest] = a >> 3; p.row_w[dest] = p.wts[a];
    }
}

enum { PH_MOD = 0, PH_NORM_A, PH_GEMM_Z, PH_PREP, PH_ATTN, PH_PROJ, PH_OUT, PH_NORM_F, PH_ROUTER, PH_TOPK, PH_SCAN, PH_PLACE, PH_EGATE, PH_EUP, PH_EDOWN, PH_FINAL, PH_COUNT };

template <int PH>
__device__ __forceinline__ void run_phase(const Params& p, int l, float* smem, int bid, int nb) {
    const float* xin = (l == 0) ? p.x : p.out;
    if constexpr (PH == PH_MOD) { ph_mod(p, smem, bid, nb); }
    else if constexpr (PH == PH_NORM_A) { ph_norm(p, xin, l, 0, 1024, bid, nb); }
    else if constexpr (PH == PH_GEMM_Z) {
        GemmArgs g{}; g.A = p.h; g.lda = ND; g.Bm = p.w_in + (size_t)l * ND * INC; g.ldb = INC; g.C = p.z; g.ldc = INC; g.M = NT; g.N = INC; g.K = ND;
        sgemm<M_STORE, false>(g, smem, bid, nb);
    }
    else if constexpr (PH == PH_PREP) { ph_prep(p, l, bid, nb); ph_compress(p, l, smem, bid, nb); ph_gmln(p, l, bid, nb); }
    else if constexpr (PH == PH_ATTN) { ph_attn(p, l, smem, bid, nb); ph_gmmix(p, l, smem, bid, nb); }
    else if constexpr (PH == PH_PROJ) {
        GemmArgs g{}; g.A = p.onsa; g.lda = 512; g.Bm = p.wpn + (size_t)l * 512 * ND; g.ldb = ND; g.C = p.ya; g.ldc = ND; g.M = NT; g.N = ND; g.K = 512; g.aux = p.z + ZGA; g.ldaux = INC;
        sgemm<M_SIG_SET, false>(g, smem, bid, nb);
        g.A = p.ogm; g.Bm = p.wpg + (size_t)l * 512 * ND; g.aux = p.z + ZGB;
        sgemm<M_SIG_ADD, false>(g, smem, bid, nb);
    }
    else if constexpr (PH == PH_OUT) {
        GemmArgs g{}; g.A = p.ya; g.lda = ND; g.Bm = p.w_out + (size_t)l * ND * ND; g.ldb = ND; g.C = p.out; g.ldc = ND; g.M = NT; g.N = ND; g.K = ND;
        g.aux = xin; g.ldaux = ND; g.aux2 = p.mod + (size_t)l * NB * 6144 + 2048;
        sgemm<M_RESID, false>(g, smem, bid, nb);
    }
    else if constexpr (PH == PH_NORM_F) {
        ph_norm(p, p.out, l, 3072, 4096, bid, nb);
        for (size_t i = (size_t)bid * 256 + threadIdx.x; i < (size_t)NT * ND / 4; i += (size_t)nb * 256) ((float4*)p.routed)[i] = make_float4(0.f, 0.f, 0.f, 0.f);
        for (int i = bid * 256 + threadIdx.x; i < MAXROWS; i += nb * 256) { p.row_tok[i] = -1; p.row_w[i] = 0.f; }
        if (bid == 0) p.counts[threadIdx.x] = 0;
    }
    else if constexpr (PH == PH_ROUTER) {
        GemmArgs g{}; g.A = p.h; g.lda = ND; g.Bm = p.w_router + (size_t)l * ND * NE; g.ldb = NE; g.C = p.logits; g.ldc = NE; g.M = NT; g.N = NE; g.K = ND;
        sgemm<M_STORE, false>(g, smem, bid, nb);
        g.Bm = p.wgs + (size_t)l * ND * 256; g.C = p.gs;
        sgemm<M_STORE, false>(g, smem, bid, nb);
    }
    else if constexpr (PH == PH_TOPK) {
        ph_topk(p, l, bid, nb);
        GemmArgs g{}; g.A = p.h; g.lda = ND; g.Bm = p.wus + (size_t)l * ND * 256; g.ldb = 256; g.C = p.sact; g.ldc = 256; g.M = NT; g.N = 256; g.K = ND; g.aux = p.gs; g.ldaux = 256;
        sgemm<M_SILU_MUL, false>(g, smem, bid, nb);
    }
    else if constexpr (PH == PH_SCAN) {
        ph_scan(p, (int*)smem, bid);
        GemmArgs g{}; g.A = p.sact; g.lda = 256; g.Bm = p.wds + (size_t)l * 256 * ND; g.ldb = ND; g.C = p.shout; g.ldc = ND; g.M = NT; g.N = ND; g.K = 256;
        sgemm<M_STORE, false>(g, smem, bid, nb);
    }
    else if constexpr (PH == PH_PLACE) { ph_place(p, bid, nb); }
    else if constexpr (PH == PH_EGATE) {
        GemmArgs g{}; g.A = p.h; g.lda = ND; g.gather = p.row_tok; g.Bm = p.wge + (size_t)l * NE * ND * 256; g.ldb = 256; g.strideB = (size_t)ND * 256; g.blk_e = p.blk_e;
        g.C = p.ag; g.ldc = 256; g.M = MAXROWS; g.N = 256; g.K = ND;
        sgemm<M_STORE, true>(g, smem, bid, nb);
    }
    else if constexpr (PH == PH_EUP) {
        GemmArgs g{}; g.A = p.h; g.lda = ND; g.gather = p.row_tok; g.Bm = p.wue + (size_t)l * NE * ND * 256; g.ldb = 256; g.strideB = (size_t)ND * 256; g.blk_e = p.blk_e;
        g.C = p.act; g.ldc = 256; g.M = MAXROWS; g.N = 256; g.K = ND; g.aux = p.ag; g.ldaux = 256;
        sgemm<M_SILU_MUL, true>(g, smem, bid, nb);
    }
    else if constexpr (PH == PH_EDOWN) {
        GemmArgs g{}; g.A = p.act; g.lda = 256; g.gather = p.row_tok; g.Bm = p.wde + (size_t)l * NE * 256 * ND; g.ldb = ND; g.strideB = (size_t)256 * ND; g.blk_e = p.blk_e;
        g.C = p.routed; g.ldc = ND; g.M = MAXROWS; g.N = ND; g.K = 256; g.aux = p.row_w;
        sgemm<M_SCATTER, false>(g, smem, bid, nb);
    }
    else if constexpr (PH == PH_FINAL) {
        const float* gt = p.mod + (size_t)l * NB * 6144 + 5120;
        for (size_t i = (size_t)bid * 256 + threadIdx.x; i < (size_t)NT * ND / 4; i += (size_t)nb * 256) {
            const size_t e0 = i * 4; const int r = (int)(e0 >> 10), cidx = (int)(e0 & 1023);
            const float4 g4 = *(const float4*)(gt + (size_t)(r >> 12) * 6144 + cidx);
            const float4 a = ((const float4*)p.routed)[i], s = ((const float4*)p.shout)[i]; float4 o = ((float4*)p.out)[i];
            o.x += g4.x * (a.x + s.x); o.y += g4.y * (a.y + s.y); o.z += g4.z * (a.z + s.z); o.w += g4.w * (a.w + s.w);
            ((float4*)p.out)[i] = o;
        }
    }
}

#define SMEM_FLOATS 8192

template <int PH>
__global__ void __launch_bounds__(256, 2) k_phase(Params p, int l) {
    __shared__ float smem[SMEM_FLOATS];
    run_phase<PH>(p, l, smem, blockIdx.x, gridDim.x);
}

template <int PH> static void launch_phase(const Params& p, int l, int grid, hipStream_t s) {
    hipLaunchKernelGGL(k_phase<PH>, dim3(grid), dim3(256), 0, s, p, l);
}

extern "C" void kernel_launch(void* const* d_in, const int* in_sizes, int n_in, void* d_out, int out_size, void* d_ws, size_t ws_size, hipStream_t stream) {
    Params p; memset(&p, 0, sizeof(p));
    p.x = (const float*)d_in[0]; p.c = (const float*)d_in[1]; p.pos = (const int*)d_in[2];
    p.w_mod = (const float*)d_in[3]; p.b_mod = (const float*)d_in[4]; p.w_in = (const float*)d_in[5]; p.q_gain = (const float*)d_in[6]; p.k_gain = (const float*)d_in[7];
    p.pe_k = (const float*)d_in[8]; p.pe_v = (const float*)d_in[9]; p.w1k = (const float*)d_in[10]; p.w2k = (const float*)d_in[11]; p.w1v = (const float*)d_in[12]; p.w2v = (const float*)d_in[13];
    p.ln_g = (const float*)d_in[14]; p.ln_b = (const float*)d_in[15]; p.gm_ws = (const float*)d_in[16]; p.gm_bs = (const float*)d_in[17];
    p.wpn = (const float*)d_in[18]; p.wpg = (const float*)d_in[19]; p.w_out = (const float*)d_in[20]; p.w_router = (const float*)d_in[21]; p.b_router = (const float*)d_in[22];
    p.wge = (const float*)d_in[23]; p.wue = (const float*)d_in[24]; p.wde = (const float*)d_in[25]; p.wgs = (const float*)d_in[26]; p.wus = (const float*)d_in[27]; p.wds = (const float*)d_in[28];
    p.out = (float*)d_out;
    char* w = (char*)d_ws; size_t off = 0;
    auto take = [&](size_t bytes) { void* r = w + off; off += (bytes + 255) & ~(size_t)255; return r; };
    p.bar = (unsigned*)take(16384);
    p.mod = (float*)take((size_t)NL * NB * 6144 * 4);
    p.h = (float*)take((size_t)NT * ND * 4);
    p.counts = (int*)take(NE * 4); p.cursor = (int*)take(NE * 4); p.pad_start = (int*)take(NE * 4); p.blk_e = (int*)take(MAXBLK * 4);
    p.row_tok = (int*)take((size_t)MAXROWS * 4); p.row_w = (float*)take((size_t)MAXROWS * 4);
    p.idx = (int*)take((size_t)NT * 8 * 4); p.wts = (float*)take((size_t)NT * 8 * 4);
    p.kc = (float*)take((size_t)NB * NCMP * 2 * 64 * 4); p.vc = (float*)take((size_t)NB * NCMP * 2 * 64 * 4);
    const size_t region = off;
    p.z = (float*)take((size_t)NT * INC * 4);
    p.qn = (float*)take((size_t)NT * 512 * 4); p.qr = (float*)take((size_t)NT * 512 * 4);
    p.ks = (float*)take((size_t)NT * 128 * 4); p.kw = (float*)take((size_t)NT * 128 * 4);
    p.onsa = (float*)take((size_t)NT * 512 * 4); p.vn = (float*)take((size_t)NT * 512 * 4); p.ogm = (float*)take((size_t)NT * 512 * 4);
    p.ya = (float*)take((size_t)NT * ND * 4);
    const size_t end_mix = off;
    off = region;
    p.logits = (float*)take((size_t)NT * NE * 4); p.gs = (float*)take((size_t)NT * 256 * 4); p.sact = (float*)take((size_t)NT * 256 * 4);
    p.shout = (float*)take((size_t)NT * ND * 4); p.routed = (float*)take((size_t)NT * ND * 4);
    p.ag = (float*)take((size_t)MAXROWS * 256 * 4); p.act = (float*)take((size_t)MAXROWS * 256 * 4);
    const size_t end_moe = off;
    if ((end_mix > end_moe ? end_mix : end_moe) > ws_size) { fprintf(stderr, "workspace too small: need %zu have %zu\n", end_mix > end_moe ? end_mix : end_moe, ws_size); return; }

    const int G = 2048;
    launch_phase<PH_MOD>(p, 0, 48, stream);
    for (int l = 0; l < NL; ++l) {
        launch_phase<PH_NORM_A>(p, l, G, stream);
        launch_phase<PH_GEMM_Z>(p, l, G, stream);
        launch_phase<PH_PREP>(p, l, G, stream);
        launch_phase<PH_ATTN>(p, l, 1024, stream);
        launch_phase<PH_PROJ>(p, l, G, stream);
        launch_phase<PH_OUT>(p, l, G, stream);
        launch_phase<PH_NORM_F>(p, l, G, stream);
        launch_phase<PH_ROUTER>(p, l, G, stream);
        launch_phase<PH_TOPK>(p, l, G, stream);
        launch_phase<PH_SCAN>(p, l, G, stream);
        launch_phase<PH_PLACE>(p, l, G, stream);
        launch_phase<PH_EGATE>(p, l, G, stream);
        launch_phase<PH_EUP>(p, l, G, stream);
        launch_phase<PH_EDOWN>(p, l, G, stream);
        launch_phase<PH_FINAL>(p, l, G, stream);
    }
}
```

```cpp
#include <hip/hip_runtime.h>
#include <stdint.h>
#include <string.h>
#include <stdio.h>

#ifndef ONE_LAUNCH
#define ONE_LAUNCH 1
#endif

#define NB 8
#define NS 4096
#define ND 1024
#define NT (NB * NS)
#define NL 2
#define INC 4376
#define NCMP 255
#define NE 256
#define MAXROWS 294912
#define MAXBLK 2304
#define ZQ 0
#define ZKC 512
#define ZVC 640
#define ZKS 768
#define ZVS 896
#define ZKW 1024
#define ZVW 1152
#define ZG 1280
#define ZU 1304
#define ZV 1816
#define ZGA 2328
#define ZGB 3352

struct Params {
    const float *x, *c; const int* pos;
    const float *w_mod, *b_mod, *w_in, *q_gain, *k_gain, *pe_k, *pe_v, *w1k, *w2k, *w1v, *w2v, *ln_g, *ln_b, *gm_ws, *gm_bs,
                *wpn, *wpg, *w_out, *w_router, *b_router, *wge, *wue, *wde, *wgs, *wus, *wds;
    float* out;
    float *mod, *h, *z, *qn, *qr, *ks, *kw, *kc, *vc, *onsa, *vn, *ogm, *ya;
    float *logits, *gs, *sact, *shout, *routed, *ag, *act, *row_w, *wts;
    int *idx, *counts, *cursor, *pad_start, *row_tok, *blk_e;
    unsigned* bar;
};


#define XB_TMO      128
#define XB_XCNT(j)  (256  + 64 * (j))
#define XB_XSUB(j)  (1280 + 64 * (j))
#define XB_XGEN(j)  (2304 + 64 * (j))
#define XB_TOP      3328
#define XB_TOPGEN   3392
#define XCD_BAR_WORDS 3456
#define XB_SPIN_CAP (1u << 22)
#define LAS __attribute__((address_space(3)))

__device__ __forceinline__ unsigned xb_ld(unsigned* p)              { return __hip_atomic_load(p, __ATOMIC_RELAXED, __HIP_MEMORY_SCOPE_AGENT); }
__device__ __forceinline__ unsigned xb_add(unsigned* p, unsigned v) { return __hip_atomic_fetch_add(p, v, __ATOMIC_RELAXED, __HIP_MEMORY_SCOPE_AGENT); }
__device__ __forceinline__ unsigned xb_xcc_id() { return (unsigned)__builtin_amdgcn_s_getreg((3 << 11) | 20) & 0xFu; }
#define XB_SPIN(cond, bar) do { unsigned _sp = 0; while (cond) { __builtin_amdgcn_s_sleep(1); \
    if ((++_sp & 255u) == 0u) { if (xb_ld(&(bar)[XB_TMO])) break; if (_sp > XB_SPIN_CAP) { atomicAdd(&(bar)[XB_TMO], 1u); break; } } } } while (0)

struct XcdBarrier { unsigned* bar; unsigned x; volatile LAS unsigned* st; };

__device__ __forceinline__ XcdBarrier xcd_barrier_post(unsigned* bar, volatile LAS unsigned* st) {
    XcdBarrier b; b.bar = bar; b.x = xb_xcc_id(); b.st = st;
    if (threadIdx.x == 0) (void)xb_add(&bar[XB_XCNT(b.x)], 1u);
    return b;
}
__device__ __forceinline__ void xcd_barrier_complete(unsigned* bar, unsigned x, unsigned& nloc, unsigned& nx) {
    const unsigned G = gridDim.x * gridDim.y * gridDim.z;
    unsigned sum, cnt, mine, sp = 0u;
    for (;;) {
        sum = 0u; cnt = 0u; mine = 0u;
#pragma unroll
        for (unsigned j = 0; j < 16; ++j) { const unsigned c = xb_ld(&bar[XB_XCNT(j)]); sum += c; cnt += (c > 0u) ? 1u : 0u; mine = (j == x) ? c : mine; }
        if (sum == G) break;
        __builtin_amdgcn_s_sleep(1);
        if ((++sp & 255u) == 0u) { if (xb_ld(&bar[XB_TMO])) break; if (sp > XB_SPIN_CAP) { atomicAdd(&bar[XB_TMO], 1u); break; } }
    }
    nloc = mine > 0u ? mine : 1u; nx = cnt > 0u ? cnt : 1u;
}
__device__ __forceinline__ void xcd_barrier(const XcdBarrier& b) {
    asm volatile("s_waitcnt vmcnt(0)" ::: "memory");
    __syncthreads();
    if (threadIdx.x == 0) {
        unsigned* bar = b.bar;
        __builtin_amdgcn_s_waitcnt(0);
        unsigned nloc = b.st[0], nx = b.st[1];
        if (nloc == 0u) { xcd_barrier_complete(bar, b.x, nloc, nx); b.st[0] = nloc; b.st[1] = nx; }
        const unsigned old = xb_add(&bar[XB_XSUB(b.x)], 1u);
        const unsigned gen = old / nloc;
        if (old + 1u == (gen + 1u) * nloc) {
            __builtin_amdgcn_fence(__ATOMIC_RELEASE, "agent");
            asm volatile("s_waitcnt vmcnt(0)" ::: "memory");
            const unsigned og = xb_add(&bar[XB_TOP], 1u);
            const unsigned tg = og / nx;
            if (og + 1u == (tg + 1u) * nx) xb_add(&bar[XB_TOPGEN], 1u);
            else XB_SPIN(xb_ld(&bar[XB_TOPGEN]) == tg, bar);
            __builtin_amdgcn_fence(__ATOMIC_ACQUIRE, "agent");
            xb_add(&bar[XB_XGEN(b.x)], 1u);
            asm volatile("s_waitcnt vmcnt(0)" ::: "memory");
        } else {
            XB_SPIN(xb_ld(&bar[XB_XGEN(b.x)]) == gen, bar);
            __builtin_amdgcn_fence(__ATOMIC_ACQUIRE, "agent");
            asm volatile("s_waitcnt vmcnt(0)" ::: "memory");
        }
    }
    __syncthreads();
}

__device__ __forceinline__ int tid_() { int t = threadIdx.x; asm volatile("" : "+v"(t)); return t; }
__device__ __forceinline__ float sigmoidf_(float x) { return 1.0f / (1.0f + expf(-x)); }
__device__ __forceinline__ float siluf_(float x) { return x / (1.0f + expf(-x)); }
__device__ __forceinline__ float geluf_(float x) { return 0.5f * x * (1.0f + tanhf(0.7978845608028654f * (x + 0.044715f * x * x * x))); }
__device__ __forceinline__ float wave_sum(float v) {
#pragma unroll
    for (int o = 32; o >= 1; o >>= 1) v += __shfl_xor(v, o);
    return v;
}

enum { M_STORE = 0, M_RESID = 1, M_SILU_MUL = 2, M_SIG_SET = 3, M_SIG_ADD = 4, M_SCATTER = 5 };
struct GemmArgs {
    const float* A; int lda; const int* gather;
    const float* Bm; int ldb; size_t strideB; const int* blk_e;
    float* C; int ldc; int M, N, K;
    const float* aux; int ldaux; const float* aux2;
};

template <int MODE, bool GATHER>
__device__ __forceinline__ void sgemm(const GemmArgs& g, float* smem, int bid, int nb) {
    float (*As)[128] = (float (*)[128])smem;
    float (*Bs)[128] = (float (*)[128])(smem + 16 * 128);
    const int tid = tid_(), tx = tid & 15, ty = tid >> 4;
    const int ntn = (g.N + 127) / 128, ntm = g.M / 128, ntiles = ntm * ntn;
    for (int tile = bid; tile < ntiles; tile += nb) {
        const int tm = tile / ntn, tn = tile % ntn;
        const int row0 = tm * 128, col0 = tn * 128;
        const float* Bp = g.Bm;
        if (g.blk_e) { const int e = g.blk_e[tm]; if (e < 0) continue; Bp += (size_t)e * g.strideB; }
        float acc[8][8];
#pragma unroll
        for (int i = 0; i < 8; ++i)
#pragma unroll
            for (int j = 0; j < 8; ++j) acc[i][j] = 0.f;
        const float* arow[2];
#pragma unroll
        for (int i = 0; i < 2; ++i) {
            const int id = tid + i * 256, r = id >> 2;
            int srow = row0 + r;
            if (GATHER) { srow = g.gather[row0 + r]; srow = srow < 0 ? 0 : srow; }
            arow[i] = g.A + (size_t)srow * g.lda + (id & 3) * 4;
        }
        for (int k0 = 0; k0 < g.K; k0 += 16) {
            float4 av[2], bv[2];
#pragma unroll
            for (int i = 0; i < 2; ++i) av[i] = *(const float4*)(arow[i] + k0);
#pragma unroll
            for (int i = 0; i < 2; ++i) {
                const int id = tid + i * 256, kr = id >> 5, cq = (id & 31) * 4, cc = col0 + cq;
                if (cc < g.N) bv[i] = *(const float4*)(Bp + (size_t)(k0 + kr) * g.ldb + cc);
                else bv[i] = make_float4(0.f, 0.f, 0.f, 0.f);
            }
            __syncthreads();
#pragma unroll
            for (int i = 0; i < 2; ++i) {
                const int id = tid + i * 256, r = id >> 2, kq = (id & 3) * 4;
                As[kq + 0][r] = av[i].x; As[kq + 1][r] = av[i].y; As[kq + 2][r] = av[i].z; As[kq + 3][r] = av[i].w;
                const int kr = id >> 5, cq = (id & 31) * 4;
                *(float4*)&Bs[kr][cq] = bv[i];
            }
            __syncthreads();
#pragma unroll
            for (int k = 0; k < 16; ++k) {
                const float4 a0 = *(const float4*)&As[k][ty * 4], a1 = *(const float4*)&As[k][64 + ty * 4];
                const float4 b0 = *(const float4*)&Bs[k][tx * 4], b1 = *(const float4*)&Bs[k][64 + tx * 4];
                const float a[8] = {a0.x, a0.y, a0.z, a0.w, a1.x, a1.y, a1.z, a1.w};
                const float b[8] = {b0.x, b0.y, b0.z, b0.w, b1.x, b1.y, b1.z, b1.w};
#pragma unroll
                for (int i = 0; i < 8; ++i)
#pragma unroll
                    for (int j = 0; j < 8; ++j) acc[i][j] = fmaf(a[i], b[j], acc[i][j]);
            }
        }
#pragma unroll
        for (int i = 0; i < 8; ++i) {
            const int r = row0 + (i < 4 ? ty * 4 + i : 64 + ty * 4 + (i - 4));
            int tok = 0; float rw = 0.f;
            if (MODE == M_SCATTER) { tok = g.gather[r]; rw = g.aux[r]; if (tok < 0) continue; }
#pragma unroll
            for (int jh = 0; jh < 2; ++jh) {
                const int cidx = col0 + jh * 64 + tx * 4;
                if (cidx >= g.N) continue;
                float4 v = make_float4(acc[i][jh * 4 + 0], acc[i][jh * 4 + 1], acc[i][jh * 4 + 2], acc[i][jh * 4 + 3]);
                if (MODE == M_STORE) {
                    *(float4*)(g.C + (size_t)r * g.ldc + cidx) = v;
                } else if (MODE == M_RESID) {
                    const float4 rr = *(const float4*)(g.aux + (size_t)r * g.ldaux + cidx);
                    const float4 gt = *(const float4*)(g.aux2 + (size_t)(r >> 12) * 6144 + cidx);
                    v.x = rr.x + gt.x * v.x; v.y = rr.y + gt.y * v.y; v.z = rr.z + gt.z * v.z; v.w = rr.w + gt.w * v.w;
                    *(float4*)(g.C + (size_t)r * g.ldc + cidx) = v;
                } else if (MODE == M_SILU_MUL) {
                    const float4 a = *(const float4*)(g.aux + (size_t)r * g.ldaux + cidx);
                    v.x *= siluf_(a.x); v.y *= siluf_(a.y); v.z *= siluf_(a.z); v.w *= siluf_(a.w);
                    *(float4*)(g.C + (size_t)r * g.ldc + cidx) = v;
                } else if (MODE == M_SIG_SET || MODE == M_SIG_ADD) {
                    const float4 a = *(const float4*)(g.aux + (size_t)r * g.ldaux + cidx);
                    v.x *= sigmoidf_(a.x); v.y *= sigmoidf_(a.y); v.z *= sigmoidf_(a.z); v.w *= sigmoidf_(a.w);
                    float4* cp = (float4*)(g.C + (size_t)r * g.ldc + cidx);
                    if (MODE == M_SIG_ADD) { const float4 o = *cp; v.x += o.x; v.y += o.y; v.z += o.z; v.w += o.w; }
                    *cp = v;
                } else if (MODE == M_SCATTER) {
                    float* cp = g.C + (size_t)tok * g.ldc + cidx;
                    atomicAdd(cp + 0, rw * v.x); atomicAdd(cp + 1, rw * v.y); atomicAdd(cp + 2, rw * v.z); atomicAdd(cp + 3, rw * v.w);
                }
            }
        }
    }
}

__device__ __forceinline__ void ph_mod(const Params& p, float* smem, int bid, int nb) {
    for (int i = tid_(); i < NB * ND; i += 256) smem[i] = siluf_(p.c[i]);
    __syncthreads();
    for (int it = bid * 256 + tid_(); it < NL * 6144; it += nb * 256) {
        const int l = it / 6144, j = it % 6144;
        float acc[NB];
#pragma unroll
        for (int b = 0; b < NB; ++b) acc[b] = 0.f;
        const float* w = p.w_mod + (size_t)l * ND * 6144 + j;
        for (int d = 0; d < ND; ++d) {
            const float wv = w[(size_t)d * 6144];
#pragma unroll
            for (int b = 0; b < NB; ++b) acc[b] = fmaf(smem[b * ND + d], wv, acc[b]);
        }
        const float bb = p.b_mod[l * 6144 + j];
#pragma unroll
        for (int b = 0; b < NB; ++b) p.mod[((size_t)l * NB + b) * 6144 + j] = acc[b] + bb;
    }
    __syncthreads();
}

__device__ __forceinline__ void ph_norm(const Params& p, const float* xin, int l, int sh_off, int sc_off, int bid, int nb) {
    const int lane = tid_() & 63, w = tid_() >> 6;
    for (int t = bid * 4 + w; t < NT; t += nb * 4) {
        const float* xr = xin + (size_t)t * ND;
        float4 v[4]; float ss = 0.f;
#pragma unroll
        for (int i = 0; i < 4; ++i) { v[i] = *(const float4*)(xr + i * 256 + lane * 4); ss += v[i].x * v[i].x + v[i].y * v[i].y + v[i].z * v[i].z + v[i].w * v[i].w; }
        ss = wave_sum(ss);
        const float rstd = rsqrtf(ss * (1.0f / ND) + 1e-6f);
        const float* mb = p.mod + ((size_t)l * NB + (t >> 12)) * 6144;
#pragma unroll
        for (int i = 0; i < 4; ++i) {
            const int cidx = i * 256 + lane * 4;
            const float4 sc = *(const float4*)(mb + sc_off + cidx), sh = *(const float4*)(mb + sh_off + cidx);
            float4 o;
            o.x = v[i].x * rstd * (1.f + sc.x) + sh.x; o.y = v[i].y * rstd * (1.f + sc.y) + sh.y;
            o.z = v[i].z * rstd * (1.f + sc.z) + sh.z; o.w = v[i].w * rstd * (1.f + sc.w) + sh.w;
            *(float4*)(p.h + (size_t)t * ND + cidx) = o;
        }
    }
}

__device__ __forceinline__ void ph_prep(const Params& p, int l, int bid, int nb) {
    const int lane = tid_() & 63, w = tid_() >> 6;
    const int i32 = lane & 31;
    const float inv = (float)pow(10000.0, -(double)i32 / 32.0);
    for (long it = (long)bid * 4 + w; it < (long)NT * 12; it += (long)nb * 4) {
        const int t = (int)(it / 12), hv = (int)(it % 12);
        int zc; const float* gain; float* dst; float* dst_norot = nullptr;
        if (hv < 8) { zc = ZQ + hv * 64; gain = p.q_gain + l * 64; dst = p.qr + (size_t)t * 512 + hv * 64; dst_norot = p.qn + (size_t)t * 512 + hv * 64; }
        else if (hv < 10) { zc = ZKS + (hv - 8) * 64; gain = p.k_gain + l * 64; dst = p.ks + (size_t)t * 128 + (hv - 8) * 64; }
        else { zc = ZKW + (hv - 10) * 64; gain = p.k_gain + l * 64; dst = p.kw + (size_t)t * 128 + (hv - 10) * 64; }
        const float v = p.z[(size_t)t * INC + zc + lane];
        const float ss = wave_sum(v * v);
        const float y = v * rsqrtf(ss * (1.0f / 64.f) + 1e-6f) * gain[lane];
        if (dst_norot) dst_norot[lane] = y;
        const float ang = (float)p.pos[t] * inv;
        const float cs = cosf(ang), sn = sinf(ang);
        const float other = __shfl_xor(y, 32);
        const float r = lane < 32 ? (y * cs - other * sn) : (y * cs + other * sn);
        dst[lane] = r;
    }
}

__device__ __forceinline__ void ph_compress(const Params& p, int l, float* smem, int bid, int nb) {
    float* A = smem;
    float* hid = smem + 2048;
    float* red = smem + 2048 + 256;
    const int tid = tid_();
    for (int u = bid; u < 2 * NB * NCMP * 2; u += nb) {
        const int kv = u / (NB * NCMP * 2), r = u % (NB * NCMP * 2), b = r / (NCMP * 2), n = (r / 2) % NCMP, hh = r & 1;
        const float* pe = (kv ? p.pe_v : p.pe_k) + l * 2048;
        const float* w1 = (kv ? p.w1v : p.w1k) + (size_t)l * 2048 * 256;
        const float* w2 = (kv ? p.w2v : p.w2k) + (size_t)l * 256 * 64;
        const int zc = (kv ? ZVC : ZKC) + hh * 64;
        __syncthreads();
        for (int k = tid; k < 2048; k += 256) { const int li = k >> 6, d = k & 63; A[k] = p.z[((size_t)b * NS + 16 * n + li) * INC + zc + d] + pe[k]; }
        __syncthreads();
        float acc = 0.f;
        for (int k = 0; k < 2048; ++k) acc = fmaf(A[k], w1[(size_t)k * 256 + tid], acc);
        hid[tid] = geluf_(acc);
        __syncthreads();
        if (tid < 64) {
            float o = 0.f;
            for (int f = 0; f < 256; ++f) o = fmaf(hid[f], w2[f * 64 + tid], o);
            float* dst = (kv ? p.vc : p.kc) + (((size_t)b * NCMP + n) * 2 + hh) * 64;
            if (kv) dst[tid] = o;
            else { const float ss = wave_sum(o * o); dst[tid] = o * rsqrtf(ss * (1.f / 64.f) + 1e-6f) * p.k_gain[l * 64 + tid]; }
        }
    }
    __syncthreads();
}

__device__ __forceinline__ void ph_gmln(const Params& p, int l, int bid, int nb) {
    const int lane = tid_() & 63, w = tid_() >> 6;
    for (int t = bid * 4 + w; t < NT; t += nb * 4) {
        float v[8]; float s = 0.f;
#pragma unroll
        for (int i = 0; i < 8; ++i) { v[i] = geluf_(p.z[(size_t)t * INC + ZV + i * 64 + lane]); s += v[i]; }
        const float mu = wave_sum(s) * (1.f / 512.f);
        float q = 0.f;
#pragma unroll
        for (int i = 0; i < 8; ++i) { const float d = v[i] - mu; q += d * d; }
        const float rstd = rsqrtf(wave_sum(q) * (1.f / 512.f) + 1e-6f);
#pragma unroll
        for (int i = 0; i < 8; ++i) { const int cidx = i * 64 + lane; p.vn[(size_t)t * 512 + cidx] = (v[i] - mu) * rstd * p.ln_g[l * 512 + cidx] + p.ln_b[l * 512 + cidx]; }
    }
}

__device__ __forceinline__ void ph_gmmix(const Params& p, int l, float* smem, int bid, int nb) {
    const int tid = tid_(), cidx = tid & 63, w = tid >> 6;
    for (int u = bid; u < 256 * 8; u += nb) {
        const int ch = u >> 3, g = u & 7;
        const size_t base = (size_t)ch * 128;
        __syncthreads();
        for (int i = tid; i < 128 * 64; i += 256) smem[i] = p.vn[(base + (i >> 6)) * 512 + g * 64 + (i & 63)];
        __syncthreads();
        const float* ws = p.gm_ws + ((size_t)l * 8 + g) * 128 * 128;
        for (int tl = w; tl < 128; tl += 4) {
            float acc = 0.f;
            for (int s = 0; s <= tl; ++s) acc = fmaf(ws[tl * 128 + s], smem[s * 64 + cidx], acc);
            const float mixed = acc + p.gm_bs[(l * 8 + g) * 128 + tl];
            const float uu = geluf_(p.z[(base + tl) * INC + ZU + g * 64 + cidx]);
            p.ogm[(base + tl) * 512 + g * 64 + cidx] = uu * mixed;
        }
    }
    __syncthreads();
}

__device__ __forceinline__ float dot32(const float (&q)[32], const float* k) {
    float s = 0.f;
#pragma unroll
    for (int i = 0; i < 8; ++i) { const float4 kv = *(const float4*)(k + i * 4); s = fmaf(q[i * 4], kv.x, s); s = fmaf(q[i * 4 + 1], kv.y, s); s = fmaf(q[i * 4 + 2], kv.z, s); s = fmaf(q[i * 4 + 3], kv.w, s); }
    s += __shfl_xor(s, 1);
    return s;
}
__device__ __forceinline__ void axpy32(float (&o)[32], float e, const float* v) {
#pragma unroll
    for (int i = 0; i < 8; ++i) { const float4 vv = *(const float4*)(v + i * 4); o[i * 4] = fmaf(e, vv.x, o[i * 4]); o[i * 4 + 1] = fmaf(e, vv.y, o[i * 4 + 1]); o[i * 4 + 2] = fmaf(e, vv.z, o[i * 4 + 2]); o[i * 4 + 3] = fmaf(e, vv.w, o[i * 4 + 3]); }
}

__device__ __forceinline__ void ph_attn(const Params& p, int l, float* smem, int bid, int nb) {
    float* imp = smem;
    unsigned long long* selm = (unsigned long long*)(smem + 2048);
    const int tid = tid_(), ql = tid >> 3, g = (tid >> 1) & 3, hf = tid & 1;
    const float scale = 0.125f;
    for (int unit = bid; unit < 2048; unit += nb) {
        const int qb = 63 - (unit >> 5), b = (unit & 31) >> 2, kvh = (unit >> 1) & 1, qh = unit & 1;
        const int qi = qh * 32 + ql;
        const int t = qb * 64 + qi, hq = kvh * 4 + g;
        const size_t tok = (size_t)b * NS + t;
        float q[32], o[32];
        const float gate0 = sigmoidf_(p.z[tok * INC + ZG + hq * 3 + 0]), gate1 = sigmoidf_(p.z[tok * INC + ZG + hq * 3 + 1]), gate2 = sigmoidf_(p.z[tok * INC + ZG + hq * 3 + 2]);
        float* outp = p.onsa + tok * 512 + hq * 64 + hf * 32;
        const int ho = kvh * 64 + hf * 32;
#pragma unroll
        for (int i = 0; i < 8; ++i) { const float4 v = *(const float4*)(p.qn + tok * 512 + hq * 64 + hf * 32 + i * 4); q[i * 4] = v.x; q[i * 4 + 1] = v.y; q[i * 4 + 2] = v.z; q[i * 4 + 3] = v.w; }
        int nvis = t >= 31 ? (t - 31) / 16 + 1 : 0; if (nvis > NCMP) nvis = NCMP;
        const float* kcb = p.kc + (size_t)b * NCMP * 128 + ho;
        const float* vcb = p.vc + (size_t)b * NCMP * 128 + ho;
        float m = -INFINITY;
        for (int n = 0; n < nvis; ++n) { const float s = dot32(q, kcb + n * 128) * scale; m = fmaxf(m, s); }
        float lsum = 0.f;
#pragma unroll
        for (int i = 0; i < 32; ++i) o[i] = 0.f;
        for (int n = 0; n < nvis; ++n) { const float s = dot32(q, kcb + n * 128) * scale; const float e = expf(s - m); lsum += e; axpy32(o, e, vcb + n * 128); }
        const float inv = 1.0f / fmaxf(lsum, 1e-30f);
#pragma unroll
        for (int i = 0; i < 8; ++i) *(float4*)(outp + i * 4) = make_float4(gate0 * o[i * 4] * inv, gate0 * o[i * 4 + 1] * inv, gate0 * o[i * 4 + 2] * inv, gate0 * o[i * 4 + 3] * inv);
        __syncthreads();
        for (int j = 0; j <= qb; ++j) {
            float a = 0.f;
            for (int n = 4 * j - 1; n <= 4 * j + 3; ++n) if (n >= 0 && n < nvis) { const float s = dot32(q, kcb + n * 128) * scale; a += expf(s - m) * inv; }
            a += __shfl_xor(a, 2); a += __shfl_xor(a, 4);
            if (g == 0 && hf == 0) imp[ql * 64 + j] = a;
        }
        __syncthreads();
        if (g == 0 && hf == 0) {
            unsigned long long mask = 0ull;
            for (int it = 0; it < 16; ++it) {
                int best = -1; float bv = 0.f;
                for (int j = 0; j < 64; ++j) {
                    if ((mask >> j) & 1ull) continue;
                    const bool forced = (j == 0) || (j == qb) || (j == qb - 1);
                    const float v = forced ? INFINITY : (j <= qb ? imp[ql * 64 + j] : -INFINITY);
                    if (best < 0 || v > bv) { best = j; bv = v; }
                }
                mask |= 1ull << best;
            }
            selm[ql] = mask;
        }
        __syncthreads();
        const unsigned long long mask = selm[ql];
#pragma unroll
        for (int i = 0; i < 8; ++i) { const float4 v = *(const float4*)(p.qr + tok * 512 + hq * 64 + hf * 32 + i * 4); q[i * 4] = v.x; q[i * 4 + 1] = v.y; q[i * 4 + 2] = v.z; q[i * 4 + 3] = v.w; }
        {
            float mm = -INFINITY, ll = 0.f;
#pragma unroll
            for (int i = 0; i < 32; ++i) o[i] = 0.f;
            for (int j = 0; j <= qb; ++j) {
                if (!((mask >> j) & 1ull)) continue;
                for (int s = 0; s < 64; ++s) {
                    const int tk = j * 64 + s; if (tk > t) break;
                    const size_t kt = (size_t)b * NS + tk;
                    const float sc = dot32(q, p.ks + kt * 128 + ho) * scale;
                    if (sc > mm) { const float corr = expf(mm - sc); ll *= corr;
#pragma unroll
                        for (int i = 0; i < 32; ++i) o[i] *= corr;
                        mm = sc; }
                    const float e = expf(sc - mm); ll += e; axpy32(o, e, p.z + kt * INC + ZVS + ho);
                }
            }
            const float iv = gate1 / fmaxf(ll, 1e-30f);
#pragma unroll
            for (int i = 0; i < 8; ++i) { float4 c = *(float4*)(outp + i * 4); c.x += o[i * 4] * iv; c.y += o[i * 4 + 1] * iv; c.z += o[i * 4 + 2] * iv; c.w += o[i * 4 + 3] * iv; *(float4*)(outp + i * 4) = c; }
        }
        {
            float mm = -INFINITY, ll = 0.f;
#pragma unroll
            for (int i = 0; i < 32; ++i) o[i] = 0.f;
            const int k0 = t - 511 > 0 ? t - 511 : 0;
            for (int tk = k0; tk <= t; ++tk) {
                const size_t kt = (size_t)b * NS + tk;
                const float sc = dot32(q, p.kw + kt * 128 + ho) * scale;
                if (sc > mm) { const float corr = expf(mm - sc); ll *= corr;
#pragma unroll
                    for (int i = 0; i < 32; ++i) o[i] *= corr;
                    mm = sc; }
                const float e = expf(sc - mm); ll += e; axpy32(o, e, p.z + kt * INC + ZVW + ho);
            }
            const float iv = gate2 / fmaxf(ll, 1e-30f);
#pragma unroll
            for (int i = 0; i < 8; ++i) { float4 c = *(float4*)(outp + i * 4); c.x += o[i * 4] * iv; c.y += o[i * 4 + 1] * iv; c.z += o[i * 4 + 2] * iv; c.w += o[i * 4 + 3] * iv; *(float4*)(outp + i * 4) = c; }
        }
    }
    __syncthreads();
}

__device__ __forceinline__ void ph_topk(const Params& p, int l, int bid, int nb) {
    const int lane = tid_() & 63, w = tid_() >> 6;
    for (int t = bid * 4 + w; t < NT; t += nb * 4) {
        float aff[4], key[4]; bool used[4];
#pragma unroll
        for (int i = 0; i < 4; ++i) { const int e = i * 64 + lane; aff[i] = sigmoidf_(p.logits[(size_t)t * NE + e]); key[i] = aff[i] + p.b_router[l * NE + e]; used[i] = false; }
        float topv[8]; int tope[8]; float sum = 0.f;
#pragma unroll
        for (int r = 0; r < 8; ++r) {
            float bv = -INFINITY; int be = 1 << 30; float ba = 0.f;
#pragma unroll
            for (int i = 0; i < 4; ++i) { const int e = i * 64 + lane; if (!used[i] && (key[i] > bv || (key[i] == bv && e < be))) { bv = key[i]; be = e; ba = aff[i]; } }
#pragma unroll
            for (int o = 32; o >= 1; o >>= 1) {
                const float ov = __shfl_xor(bv, o); const int oe = __shfl_xor(be, o); const float oa = __shfl_xor(ba, o);
                if (ov > bv || (ov == bv && oe < be)) { bv = ov; be = oe; ba = oa; }
            }
#pragma unroll
            for (int i = 0; i < 4; ++i) if (i * 64 + lane == be) used[i] = true;
            topv[r] = ba; tope[r] = be; sum += ba;
        }
        if (lane < 8) {
            float tv = 0.f; int te = 0;
#pragma unroll
            for (int r = 0; r < 8; ++r) if (lane == r) { tv = topv[r]; te = tope[r]; }
            p.idx[(size_t)t * 8 + lane] = te;
            p.wts[(size_t)t * 8 + lane] = tv / sum * 2.5f;
            atomicAdd(&p.counts[te], 1);
        }
    }
}

__device__ __forceinline__ void ph_scan(const Params& p, int* ismem, int bid) {
    if (bid != 0) return;
    const int tid = tid_();
    ismem[tid] = (p.counts[tid] + 127) / 128 * 128;
    __syncthreads();
    if (tid == 0) { int run = 0; for (int e = 0; e < NE; ++e) { const int v = ismem[e]; ismem[e] = run; run += v; } ismem[NE] = run; }
    __syncthreads();
    const int st = ismem[tid], en = (tid == NE - 1) ? ismem[NE] : ismem[tid + 1];
    p.pad_start[tid] = st; p.cursor[tid] = 0;
    for (int i = st / 128; i < en / 128; ++i) p.blk_e[i] = tid;
    for (int i = ismem[NE] / 128 + tid; i < MAXBLK; i += 256) p.blk_e[i] = -1;
    __syncthreads();
}

__device__ __forceinline__ void ph_place(const Params& p, int bid, int nb) {
    for (int a = bid * 256 + tid_(); a < NT * 8; a += nb * 256) {
        const int e = p.idx[a];
        const int pos = atomicAdd(&p.cursor[e], 1);
        const int dest = p.pad_start[e] + pos;
        p.row_tok[dest] = a >> 3; p.row_w[dest] = p.wts[a];
    }
}

enum { PH_MOD = 0, PH_NORM_A, PH_GEMM_Z, PH_PREP, PH_ATTN, PH_PROJ, PH_OUT, PH_NORM_F, PH_ROUTER, PH_TOPK, PH_SCAN, PH_PLACE, PH_EGATE, PH_EUP, PH_EDOWN, PH_FINAL, PH_COUNT };

template <int PH>
__device__ __forceinline__ void run_phase(const Params& p, int l, float* smem, int bid, int nb) {
    const float* xin = (l == 0) ? p.x : p.out;
    if constexpr (PH == PH_MOD) { ph_mod(p, smem, bid, nb); }
    else if constexpr (PH == PH_NORM_A) { ph_norm(p, xin, l, 0, 1024, bid, nb); }
    else if constexpr (PH == PH_GEMM_Z) {
        GemmArgs g{}; g.A = p.h; g.lda = ND; g.Bm = p.w_in + (size_t)l * ND * INC; g.ldb = INC; g.C = p.z; g.ldc = INC; g.M = NT; g.N = INC; g.K = ND;
        sgemm<M_STORE, false>(g, smem, bid, nb);
    }
    else if constexpr (PH == PH_PREP) { ph_prep(p, l, bid, nb); ph_compress(p, l, smem, bid, nb); ph_gmln(p, l, bid, nb); }
    else if constexpr (PH == PH_ATTN) { ph_attn(p, l, smem, bid, nb); ph_gmmix(p, l, smem, bid, nb); }
    else if constexpr (PH == PH_PROJ) {
        GemmArgs g{}; g.A = p.onsa; g.lda = 512; g.Bm = p.wpn + (size_t)l * 512 * ND; g.ldb = ND; g.C = p.ya; g.ldc = ND; g.M = NT; g.N = ND; g.K = 512; g.aux = p.z + ZGA; g.ldaux = INC;
        sgemm<M_SIG_SET, false>(g, smem, bid, nb);
        g.A = p.ogm; g.Bm = p.wpg + (size_t)l * 512 * ND; g.aux = p.z + ZGB;
        sgemm<M_SIG_ADD, false>(g, smem, bid, nb);
    }
    else if constexpr (PH == PH_OUT) {
        GemmArgs g{}; g.A = p.ya; g.lda = ND; g.Bm = p.w_out + (size_t)l * ND * ND; g.ldb = ND; g.C = p.out; g.ldc = ND; g.M = NT; g.N = ND; g.K = ND;
        g.aux = xin; g.ldaux = ND; g.aux2 = p.mod + (size_t)l * NB * 6144 + 2048;
        sgemm<M_RESID, false>(g, smem, bid, nb);
    }
    else if constexpr (PH == PH_NORM_F) {
        ph_norm(p, p.out, l, 3072, 4096, bid, nb);
        for (size_t i = (size_t)bid * 256 + tid_(); i < (size_t)NT * ND / 4; i += (size_t)nb * 256) ((float4*)p.routed)[i] = make_float4(0.f, 0.f, 0.f, 0.f);
        for (int i = bid * 256 + tid_(); i < MAXROWS; i += nb * 256) { p.row_tok[i] = -1; p.row_w[i] = 0.f; }
        if (bid == 0) p.counts[tid_()] = 0;
    }
    else if constexpr (PH == PH_ROUTER) {
        GemmArgs g{}; g.A = p.h; g.lda = ND; g.Bm = p.w_router + (size_t)l * ND * NE; g.ldb = NE; g.C = p.logits; g.ldc = NE; g.M = NT; g.N = NE; g.K = ND;
        sgemm<M_STORE, false>(g, smem, bid, nb);
        g.Bm = p.wgs + (size_t)l * ND * 256; g.C = p.gs;
        sgemm<M_STORE, false>(g, smem, bid, nb);
    }
    else if constexpr (PH == PH_TOPK) {
        ph_topk(p, l, bid, nb);
        GemmArgs g{}; g.A = p.h; g.lda = ND; g.Bm = p.wus + (size_t)l * ND * 256; g.ldb = 256; g.C = p.sact; g.ldc = 256; g.M = NT; g.N = 256; g.K = ND; g.aux = p.gs; g.ldaux = 256;
        sgemm<M_SILU_MUL, false>(g, smem, bid, nb);
    }
    else if constexpr (PH == PH_SCAN) {
        ph_scan(p, (int*)smem, bid);
        GemmArgs g{}; g.A = p.sact; g.lda = 256; g.Bm = p.wds + (size_t)l * 256 * ND; g.ldb = ND; g.C = p.shout; g.ldc = ND; g.M = NT; g.N = ND; g.K = 256;
        sgemm<M_STORE, false>(g, smem, bid, nb);
    }
    else if constexpr (PH == PH_PLACE) { ph_place(p, bid, nb); }
    else if constexpr (PH == PH_EGATE) {
        GemmArgs g{}; g.A = p.h; g.lda = ND; g.gather = p.row_tok; g.Bm = p.wge + (size_t)l * NE * ND * 256; g.ldb = 256; g.strideB = (size_t)ND * 256; g.blk_e = p.blk_e;
        g.C = p.ag; g.ldc = 256; g.M = MAXROWS; g.N = 256; g.K = ND;
        sgemm<M_STORE, true>(g, smem, bid, nb);
    }
    else if constexpr (PH == PH_EUP) {
        GemmArgs g{}; g.A = p.h; g.lda = ND; g.gather = p.row_tok; g.Bm = p.wue + (size_t)l * NE * ND * 256; g.ldb = 256; g.strideB = (size_t)ND * 256; g.blk_e = p.blk_e;
        g.C = p.act; g.ldc = 256; g.M = MAXROWS; g.N = 256; g.K = ND; g.aux = p.ag; g.ldaux = 256;
        sgemm<M_SILU_MUL, true>(g, smem, bid, nb);
    }
    else if constexpr (PH == PH_EDOWN) {
        GemmArgs g{}; g.A = p.act; g.lda = 256; g.gather = p.row_tok; g.Bm = p.wde + (size_t)l * NE * 256 * ND; g.ldb = ND; g.strideB = (size_t)256 * ND; g.blk_e = p.blk_e;
        g.C = p.routed; g.ldc = ND; g.M = MAXROWS; g.N = ND; g.K = 256; g.aux = p.row_w;
        sgemm<M_SCATTER, false>(g, smem, bid, nb);
    }
    else if constexpr (PH == PH_FINAL) {
        const float* gt = p.mod + (size_t)l * NB * 6144 + 5120;
        for (size_t i = (size_t)bid * 256 + tid_(); i < (size_t)NT * ND / 4; i += (size_t)nb * 256) {
            const size_t e0 = i * 4; const int r = (int)(e0 >> 10), cidx = (int)(e0 & 1023);
            const float4 g4 = *(const float4*)(gt + (size_t)(r >> 12) * 6144 + cidx);
            const float4 a = ((const float4*)p.routed)[i], s = ((const float4*)p.shout)[i]; float4 o = ((float4*)p.out)[i];
            o.x += g4.x * (a.x + s.x); o.y += g4.y * (a.y + s.y); o.z += g4.z * (a.z + s.z); o.w += g4.w * (a.w + s.w);
            ((float4*)p.out)[i] = o;
        }
    }
}

#define SMEM_FLOATS 8192

template <int PH>
__global__ void __launch_bounds__(256, 2) k_phase(Params p, int l) {
    __shared__ float smem[SMEM_FLOATS];
    run_phase<PH>(p, l, smem, blockIdx.x, gridDim.x);
}


__global__ void __launch_bounds__(256, 1) k_mega(Params p) {
    __shared__ float smem[SMEM_FLOATS];
    __shared__ uint4 xb_words;
    if (tid_() == 0) xb_words = make_uint4(0u, 0u, 0u, 0u);
    __syncthreads();
    XcdBarrier bar = xcd_barrier_post(p.bar, (volatile LAS unsigned*)&xb_words);
    const int bid = blockIdx.x, nb = gridDim.x;
    run_phase<PH_MOD>(p, 0, smem, bid, nb); xcd_barrier(bar);
#pragma unroll
    for (int l = 0; l < NL; ++l) {
        run_phase<PH_NORM_A>(p, l, smem, bid, nb); xcd_barrier(bar);
        run_phase<PH_GEMM_Z>(p, l, smem, bid, nb); xcd_barrier(bar);
        run_phase<PH_PREP>(p, l, smem, bid, nb); xcd_barrier(bar);
        run_phase<PH_ATTN>(p, l, smem, bid, nb); xcd_barrier(bar);
        run_phase<PH_PROJ>(p, l, smem, bid, nb); xcd_barrier(bar);
        run_phase<PH_OUT>(p, l, smem, bid, nb); xcd_barrier(bar);
        run_phase<PH_NORM_F>(p, l, smem, bid, nb); xcd_barrier(bar);
        run_phase<PH_ROUTER>(p, l, smem, bid, nb); xcd_barrier(bar);
        run_phase<PH_TOPK>(p, l, smem, bid, nb); xcd_barrier(bar);
        run_phase<PH_SCAN>(p, l, smem, bid, nb); xcd_barrier(bar);
        run_phase<PH_PLACE>(p, l, smem, bid, nb); xcd_barrier(bar);
        run_phase<PH_EGATE>(p, l, smem, bid, nb); xcd_barrier(bar);
        run_phase<PH_EUP>(p, l, smem, bid, nb); xcd_barrier(bar);
        run_phase<PH_EDOWN>(p, l, smem, bid, nb); xcd_barrier(bar);
        run_phase<PH_FINAL>(p, l, smem, bid, nb); xcd_barrier(bar);
    }
}

template <int PH> static void launch_phase(const Params& p, int l, int grid, hipStream_t s) {
    hipLaunchKernelGGL(k_phase<PH>, dim3(grid), dim3(256), 0, s, p, l);
}

extern "C" void kernel_launch(void* const* d_in, const int* in_sizes, int n_in, void* d_out, int out_size, void* d_ws, size_t ws_size, hipStream_t stream) {
    Params p; memset(&p, 0, sizeof(p));
    p.x = (const float*)d_in[0]; p.c = (const float*)d_in[1]; p.pos = (const int*)d_in[2];
    p.w_mod = (const float*)d_in[3]; p.b_mod = (const float*)d_in[4]; p.w_in = (const float*)d_in[5]; p.q_gain = (const float*)d_in[6]; p.k_gain = (const float*)d_in[7];
    p.pe_k = (const float*)d_in[8]; p.pe_v = (const float*)d_in[9]; p.w1k = (const float*)d_in[10]; p.w2k = (const float*)d_in[11]; p.w1v = (const float*)d_in[12]; p.w2v = (const float*)d_in[13];
    p.ln_g = (const float*)d_in[14]; p.ln_b = (const float*)d_in[15]; p.gm_ws = (const float*)d_in[16]; p.gm_bs = (const float*)d_in[17];
    p.wpn = (const float*)d_in[18]; p.wpg = (const float*)d_in[19]; p.w_out = (const float*)d_in[20]; p.w_router = (const float*)d_in[21]; p.b_router = (const float*)d_in[22];
    p.wge = (const float*)d_in[23]; p.wue = (const float*)d_in[24]; p.wde = (const float*)d_in[25]; p.wgs = (const float*)d_in[26]; p.wus = (const float*)d_in[27]; p.wds = (const float*)d_in[28];
    p.out = (float*)d_out;
    char* w = (char*)d_ws; size_t off = 0;
    auto take = [&](size_t bytes) { void* r = w + off; off += (bytes + 255) & ~(size_t)255; return r; };
    p.bar = (unsigned*)take(16384);
    p.mod = (float*)take((size_t)NL * NB * 6144 * 4);
    p.h = (float*)take((size_t)NT * ND * 4);
    p.counts = (int*)take(NE * 4); p.cursor = (int*)take(NE * 4); p.pad_start = (int*)take(NE * 4); p.blk_e = (int*)take(MAXBLK * 4);
    p.row_tok = (int*)take((size_t)MAXROWS * 4); p.row_w = (float*)take((size_t)MAXROWS * 4);
    p.idx = (int*)take((size_t)NT * 8 * 4); p.wts = (float*)take((size_t)NT * 8 * 4);
    p.kc = (float*)take((size_t)NB * NCMP * 2 * 64 * 4); p.vc = (float*)take((size_t)NB * NCMP * 2 * 64 * 4);
    const size_t region = off;
    p.z = (float*)take((size_t)NT * INC * 4);
    p.qn = (float*)take((size_t)NT * 512 * 4); p.qr = (float*)take((size_t)NT * 512 * 4);
    p.ks = (float*)take((size_t)NT * 128 * 4); p.kw = (float*)take((size_t)NT * 128 * 4);
    p.onsa = (float*)take((size_t)NT * 512 * 4); p.vn = (float*)take((size_t)NT * 512 * 4); p.ogm = (float*)take((size_t)NT * 512 * 4);
    p.ya = (float*)take((size_t)NT * ND * 4);
    const size_t end_mix = off;
    off = region;
    p.logits = (float*)take((size_t)NT * NE * 4); p.gs = (float*)take((size_t)NT * 256 * 4); p.sact = (float*)take((size_t)NT * 256 * 4);
    p.shout = (float*)take((size_t)NT * ND * 4); p.routed = (float*)take((size_t)NT * ND * 4);
    p.ag = (float*)take((size_t)MAXROWS * 256 * 4); p.act = (float*)take((size_t)MAXROWS * 256 * 4);
    const size_t end_moe = off;
    if ((end_mix > end_moe ? end_mix : end_moe) > ws_size) { fprintf(stderr, "workspace too small: need %zu have %zu\n", end_mix > end_moe ? end_mix : end_moe, ws_size); return; }

#if ONE_LAUNCH
    static int grid = 0;
    if (!grid) {
        int dev = 0, cus = 0, per_cu = 0;
        hipGetDevice(&dev);
        hipDeviceGetAttribute(&cus, hipDeviceAttributeMultiprocessorCount, dev);
        hipOccupancyMaxActiveBlocksPerMultiprocessor(&per_cu, k_mega, 256, 0);
        if (per_cu < 1) per_cu = 1;
        grid = cus * (per_cu < 2 ? per_cu : 2);
    }
    hipMemsetAsync(p.bar, 0, XCD_BAR_WORDS * sizeof(unsigned), stream);
    hipLaunchKernelGGL(k_mega, dim3(grid), dim3(256), 0, stream, p);
#else
    const int G = 2048;
    launch_phase<PH_MOD>(p, 0, 48, stream);
    for (int l = 0; l < NL; ++l) {
        launch_phase<PH_NORM_A>(p, l, G, stream);
        launch_phase<PH_GEMM_Z>(p, l, G, stream);
        launch_phase<PH_PREP>(p, l, G, stream);
        launch_phase<PH_ATTN>(p, l, 2048, stream);
        launch_phase<PH_PROJ>(p, l, G, stream);
        launch_phase<PH_OUT>(p, l, G, stream);
        launch_phase<PH_NORM_F>(p, l, G, stream);
        launch_phase<PH_ROUTER>(p, l, G, stream);
        launch_phase<PH_TOPK>(p, l, G, stream);
        launch_phase<PH_SCAN>(p, l, G, stream);
        launch_phase<PH_PLACE>(p, l, G, stream);
        launch_phase<PH_EGATE>(p, l, G, stream);
        launch_phase<PH_EUP>(p, l, G, stream);
        launch_phase<PH_EDOWN>(p, l, G, stream);
        launch_phase<PH_FINAL>(p, l, G, stream);
    }
#endif
}
```

```cpp
#define DEV_CHECK 0
#include <hip/hip_runtime.h>
#include <stdint.h>
#include <string.h>
#include <stdio.h>

#ifndef DEV_CHECK
#define DEV_CHECK 0
#endif

#define NB 8
#define NS 4096
#define ND 1024
#define NT (NB * NS)
#define NL 2
#define INC 4376
#define NCMP 255
#define NE 256
#define MAXROWS 294912
#define MAXBLK 2304
#define ZQ 0
#define ZKC 512
#define ZVC 640
#define ZKS 768
#define ZVS 896
#define ZKW 1024
#define ZVW 1152
#define ZG 1280
#define ZU 1304
#define ZV 1816
#define ZGA 2328
#define ZGB 3352

#define LAS __attribute__((address_space(3)))
#define GAS __attribute__((address_space(1)))
typedef unsigned short bf16_t;
typedef short bf16x8 __attribute__((ext_vector_type(8)));
typedef short s16x4 __attribute__((ext_vector_type(4)));
typedef float f32x2 __attribute__((ext_vector_type(2)));
typedef float f32x4 __attribute__((ext_vector_type(4)));
typedef float f32x16 __attribute__((ext_vector_type(16)));
typedef unsigned u32x2 __attribute__((ext_vector_type(2)));
typedef unsigned u32x4 __attribute__((ext_vector_type(4)));
#define XB_TMO      128
#define XB_XCNT(j)  (256  + 64 * (j))
#define XB_XSUB(j)  (1280 + 64 * (j))
#define XB_XGEN(j)  (2304 + 64 * (j))
#define XB_TOP      3328
#define XB_TOPGEN   3392
#define XCD_BAR_WORDS 3456
#define XB_SPIN_CAP (1u << 22)
#define LAS __attribute__((address_space(3)))

__device__ __forceinline__ unsigned xb_ld(unsigned* p)              { return __hip_atomic_load(p, __ATOMIC_RELAXED, __HIP_MEMORY_SCOPE_AGENT); }
__device__ __forceinline__ unsigned xb_add(unsigned* p, unsigned v) { return __hip_atomic_fetch_add(p, v, __ATOMIC_RELAXED, __HIP_MEMORY_SCOPE_AGENT); }
__device__ __forceinline__ unsigned xb_xcc_id() { return (unsigned)__builtin_amdgcn_s_getreg((3 << 11) | 20) & 0xFu; }
#define XB_SPIN(cond, bar) do { unsigned _sp = 0; while (cond) { __builtin_amdgcn_s_sleep(1); \
    if ((++_sp & 255u) == 0u) { if (xb_ld(&(bar)[XB_TMO])) break; if (_sp > XB_SPIN_CAP) { atomicAdd(&(bar)[XB_TMO], 1u); break; } } } } while (0)

struct XcdBarrier { unsigned* bar; unsigned x; volatile LAS unsigned* st; };

__device__ __forceinline__ XcdBarrier xcd_barrier_post(unsigned* bar, volatile LAS unsigned* st) {
    XcdBarrier b; b.bar = bar; b.x = xb_xcc_id(); b.st = st;
    if (threadIdx.x == 0) (void)xb_add(&bar[XB_XCNT(b.x)], 1u);
    return b;
}
__device__ __forceinline__ void xcd_barrier_complete(unsigned* bar, unsigned x, unsigned& nloc, unsigned& nx) {
    const unsigned G = gridDim.x * gridDim.y * gridDim.z;
    unsigned sum, cnt, mine, sp = 0u;
    for (;;) {
        sum = 0u; cnt = 0u; mine = 0u;
#pragma unroll
        for (unsigned j = 0; j < 16; ++j) { const unsigned c = xb_ld(&bar[XB_XCNT(j)]); sum += c; cnt += (c > 0u) ? 1u : 0u; mine = (j == x) ? c : mine; }
        if (sum == G) break;
        __builtin_amdgcn_s_sleep(1);
        if ((++sp & 255u) == 0u) { if (xb_ld(&bar[XB_TMO])) break; if (sp > XB_SPIN_CAP) { atomicAdd(&bar[XB_TMO], 1u); break; } }
    }
    nloc = mine > 0u ? mine : 1u; nx = cnt > 0u ? cnt : 1u;
}
__device__ __noinline__ void xcd_barrier(const XcdBarrier b) {
    asm volatile("s_waitcnt vmcnt(0)" ::: "memory");
    __syncthreads();
    if (threadIdx.x == 0) {
        unsigned* bar = b.bar;
        __builtin_amdgcn_s_waitcnt(0);
        unsigned nloc = b.st[0], nx = b.st[1];
        if (nloc == 0u) { xcd_barrier_complete(bar, b.x, nloc, nx); b.st[0] = nloc; b.st[1] = nx; }
        const unsigned old = xb_add(&bar[XB_XSUB(b.x)], 1u);
        const unsigned gen = old / nloc;
        if (old + 1u == (gen + 1u) * nloc) {
            __builtin_amdgcn_fence(__ATOMIC_RELEASE, "agent");
            asm volatile("s_waitcnt vmcnt(0)" ::: "memory");
            const unsigned og = xb_add(&bar[XB_TOP], 1u);
            const unsigned tg = og / nx;
            if (og + 1u == (tg + 1u) * nx) xb_add(&bar[XB_TOPGEN], 1u);
            else XB_SPIN(xb_ld(&bar[XB_TOPGEN]) == tg, bar);
            __builtin_amdgcn_fence(__ATOMIC_ACQUIRE, "agent");
            xb_add(&bar[XB_XGEN(b.x)], 1u);
            asm volatile("s_waitcnt vmcnt(0)" ::: "memory");
        } else {
            XB_SPIN(xb_ld(&bar[XB_XGEN(b.x)]) == gen, bar);
            __builtin_amdgcn_fence(__ATOMIC_ACQUIRE, "agent");
            asm volatile("s_waitcnt vmcnt(0)" ::: "memory");
        }
    }
    __syncthreads();
}

__device__ __forceinline__ int tid_() { int t = threadIdx.x; asm volatile("" : "+v"(t)); return t; }
__device__ __forceinline__ float sigmoidf_(float x) { return 1.0f / (1.0f + expf(-x)); }
__device__ __forceinline__ float siluf_(float x) { return x / (1.0f + expf(-x)); }
__device__ __forceinline__ float geluf_(float x) { return 0.5f * x * (1.0f + tanhf(0.7978845608028654f * (x + 0.044715f * x * x * x))); }
__device__ __forceinline__ float wave_sum(float v) {
#pragma unroll
    for (int o = 32; o >= 1; o >>= 1) v += __shfl_xor(v, o);
    return v;
}

#if DEV_CHECK
namespace refp {
struct Params {
    const float *x, *c; const int* pos;
    const float *w_mod, *b_mod, *w_in, *q_gain, *k_gain, *pe_k, *pe_v, *w1k, *w2k, *w1v, *w2v, *ln_g, *ln_b, *gm_ws, *gm_bs,
                *wpn, *wpg, *w_out, *w_router, *b_router, *wge, *wue, *wde, *wgs, *wus, *wds;
    float* out;
    float *mod, *h, *z, *qn, *qr, *ks, *kw, *kc, *vc, *onsa, *vn, *ogm, *ya;
    float *logits, *gs, *sact, *shout, *routed, *ag, *act, *row_w, *wts;
    int *idx, *counts, *cursor, *pad_start, *row_tok, *blk_e;
    unsigned* bar;
};


enum { M_STORE = 0, M_RESID = 1, M_SILU_MUL = 2, M_SIG_SET = 3, M_SIG_ADD = 4, M_SCATTER = 5 };
struct GemmArgs {
    const float* A; int lda; const int* gather;
    const float* Bm; int ldb; size_t strideB; const int* blk_e;
    float* C; int ldc; int M, N, K;
    const float* aux; int ldaux; const float* aux2;
};

template <int MODE, bool GATHER>
__device__ __forceinline__ void sgemm(const GemmArgs& g, float* smem, int bid, int nb) {
    float (*As)[128] = (float (*)[128])smem;
    float (*Bs)[128] = (float (*)[128])(smem + 16 * 128);
    const int tid = tid_(), tx = tid & 15, ty = tid >> 4;
    const int ntn = (g.N + 127) / 128, ntm = g.M / 128, ntiles = ntm * ntn;
    for (int tile = bid; tile < ntiles; tile += nb) {
        const int tm = tile / ntn, tn = tile % ntn;
        const int row0 = tm * 128, col0 = tn * 128;
        const float* Bp = g.Bm;
        if (g.blk_e) { const int e = g.blk_e[tm]; if (e < 0) continue; Bp += (size_t)e * g.strideB; }
        float acc[8][8];
#pragma unroll
        for (int i = 0; i < 8; ++i)
#pragma unroll
            for (int j = 0; j < 8; ++j) acc[i][j] = 0.f;
        const float* arow[2];
#pragma unroll
        for (int i = 0; i < 2; ++i) {
            const int id = tid + i * 256, r = id >> 2;
            int srow = row0 + r;
            if (GATHER) { srow = g.gather[row0 + r]; srow = srow < 0 ? 0 : srow; }
            arow[i] = g.A + (size_t)srow * g.lda + (id & 3) * 4;
        }
        for (int k0 = 0; k0 < g.K; k0 += 16) {
            float4 av[2], bv[2];
#pragma unroll
            for (int i = 0; i < 2; ++i) av[i] = *(const float4*)(arow[i] + k0);
#pragma unroll
            for (int i = 0; i < 2; ++i) {
                const int id = tid + i * 256, kr = id >> 5, cq = (id & 31) * 4, cc = col0 + cq;
                if (cc < g.N) bv[i] = *(const float4*)(Bp + (size_t)(k0 + kr) * g.ldb + cc);
                else bv[i] = make_float4(0.f, 0.f, 0.f, 0.f);
            }
            __syncthreads();
#pragma unroll
            for (int i = 0; i < 2; ++i) {
                const int id = tid + i * 256, r = id >> 2, kq = (id & 3) * 4;
                As[kq + 0][r] = av[i].x; As[kq + 1][r] = av[i].y; As[kq + 2][r] = av[i].z; As[kq + 3][r] = av[i].w;
                const int kr = id >> 5, cq = (id & 31) * 4;
                *(float4*)&Bs[kr][cq] = bv[i];
            }
            __syncthreads();
#pragma unroll
            for (int k = 0; k < 16; ++k) {
                const float4 a0 = *(const float4*)&As[k][ty * 4], a1 = *(const float4*)&As[k][64 + ty * 4];
                const float4 b0 = *(const float4*)&Bs[k][tx * 4], b1 = *(const float4*)&Bs[k][64 + tx * 4];
                const float a[8] = {a0.x, a0.y, a0.z, a0.w, a1.x, a1.y, a1.z, a1.w};
                const float b[8] = {b0.x, b0.y, b0.z, b0.w, b1.x, b1.y, b1.z, b1.w};
#pragma unroll
                for (int i = 0; i < 8; ++i)
#pragma unroll
                    for (int j = 0; j < 8; ++j) acc[i][j] = fmaf(a[i], b[j], acc[i][j]);
            }
        }
#pragma unroll
        for (int i = 0; i < 8; ++i) {
            const int r = row0 + (i < 4 ? ty * 4 + i : 64 + ty * 4 + (i - 4));
            int tok = 0; float rw = 0.f;
            if (MODE == M_SCATTER) { tok = g.gather[r]; rw = g.aux[r]; if (tok < 0) continue; }
#pragma unroll
            for (int jh = 0; jh < 2; ++jh) {
                const int cidx = col0 + jh * 64 + tx * 4;
                if (cidx >= g.N) continue;
                float4 v = make_float4(acc[i][jh * 4 + 0], acc[i][jh * 4 + 1], acc[i][jh * 4 + 2], acc[i][jh * 4 + 3]);
                if (MODE == M_STORE) {
                    *(float4*)(g.C + (size_t)r * g.ldc + cidx) = v;
                } else if (MODE == M_RESID) {
                    const float4 rr = *(const float4*)(g.aux + (size_t)r * g.ldaux + cidx);
                    const float4 gt = *(const float4*)(g.aux2 + (size_t)(r >> 12) * 6144 + cidx);
                    v.x = rr.x + gt.x * v.x; v.y = rr.y + gt.y * v.y; v.z = rr.z + gt.z * v.z; v.w = rr.w + gt.w * v.w;
                    *(float4*)(g.C + (size_t)r * g.ldc + cidx) = v;
                } else if (MODE == M_SILU_MUL) {
                    const float4 a = *(const float4*)(g.aux + (size_t)r * g.ldaux + cidx);
                    v.x *= siluf_(a.x); v.y *= siluf_(a.y); v.z *= siluf_(a.z); v.w *= siluf_(a.w);
                    *(float4*)(g.C + (size_t)r * g.ldc + cidx) = v;
                } else if (MODE == M_SIG_SET || MODE == M_SIG_ADD) {
                    const float4 a = *(const float4*)(g.aux + (size_t)r * g.ldaux + cidx);
                    v.x *= sigmoidf_(a.x); v.y *= sigmoidf_(a.y); v.z *= sigmoidf_(a.z); v.w *= sigmoidf_(a.w);
                    float4* cp = (float4*)(g.C + (size_t)r * g.ldc + cidx);
                    if (MODE == M_SIG_ADD) { const float4 o = *cp; v.x += o.x; v.y += o.y; v.z += o.z; v.w += o.w; }
                    *cp = v;
                } else if (MODE == M_SCATTER) {
                    float* cp = g.C + (size_t)tok * g.ldc + cidx;
                    atomicAdd(cp + 0, rw * v.x); atomicAdd(cp + 1, rw * v.y); atomicAdd(cp + 2, rw * v.z); atomicAdd(cp + 3, rw * v.w);
                }
            }
        }
    }
}

__device__ __forceinline__ void ph_mod(const Params& p, float* smem, int bid, int nb) {
    for (int i = tid_(); i < NB * ND; i += 256) smem[i] = siluf_(p.c[i]);
    __syncthreads();
    for (int it = bid * 256 + tid_(); it < NL * 6144; it += nb * 256) {
        const int l = it / 6144, j = it % 6144;
        float acc[NB];
#pragma unroll
        for (int b = 0; b < NB; ++b) acc[b] = 0.f;
        const float* w = p.w_mod + (size_t)l * ND * 6144 + j;
        for (int d = 0; d < ND; ++d) {
            const float wv = w[(size_t)d * 6144];
#pragma unroll
            for (int b = 0; b < NB; ++b) acc[b] = fmaf(smem[b * ND + d], wv, acc[b]);
        }
        const float bb = p.b_mod[l * 6144 + j];
#pragma unroll
        for (int b = 0; b < NB; ++b) p.mod[((size_t)l * NB + b) * 6144 + j] = acc[b] + bb;
    }
    __syncthreads();
}

__device__ __forceinline__ void ph_norm(const Params& p, const float* xin, int l, int sh_off, int sc_off, int bid, int nb) {
    const int lane = tid_() & 63, w = tid_() >> 6;
    for (int t = bid * 4 + w; t < NT; t += nb * 4) {
        const float* xr = xin + (size_t)t * ND;
        float4 v[4]; float ss = 0.f;
#pragma unroll
        for (int i = 0; i < 4; ++i) { v[i] = *(const float4*)(xr + i * 256 + lane * 4); ss += v[i].x * v[i].x + v[i].y * v[i].y + v[i].z * v[i].z + v[i].w * v[i].w; }
        ss = wave_sum(ss);
        const float rstd = rsqrtf(ss * (1.0f / ND) + 1e-6f);
        const float* mb = p.mod + ((size_t)l * NB + (t >> 12)) * 6144;
#pragma unroll
        for (int i = 0; i < 4; ++i) {
            const int cidx = i * 256 + lane * 4;
            const float4 sc = *(const float4*)(mb + sc_off + cidx), sh = *(const float4*)(mb + sh_off + cidx);
            float4 o;
            o.x = v[i].x * rstd * (1.f + sc.x) + sh.x; o.y = v[i].y * rstd * (1.f + sc.y) + sh.y;
            o.z = v[i].z * rstd * (1.f + sc.z) + sh.z; o.w = v[i].w * rstd * (1.f + sc.w) + sh.w;
            *(float4*)(p.h + (size_t)t * ND + cidx) = o;
        }
    }
}

__device__ __forceinline__ void ph_prep(const Params& p, int l, int bid, int nb) {
    const int lane = tid_() & 63, w = tid_() >> 6;
    const int i32 = lane & 31;
    const float inv = (float)pow(10000.0, -(double)i32 / 32.0);
    for (long it = (long)bid * 4 + w; it < (long)NT * 12; it += (long)nb * 4) {
        const int t = (int)(it / 12), hv = (int)(it % 12);
        int zc; const float* gain; float* dst; float* dst_norot = nullptr;
        if (hv < 8) { zc = ZQ + hv * 64; gain = p.q_gain + l * 64; dst = p.qr + (size_t)t * 512 + hv * 64; dst_norot = p.qn + (size_t)t * 512 + hv * 64; }
        else if (hv < 10) { zc = ZKS + (hv - 8) * 64; gain = p.k_gain + l * 64; dst = p.ks + (size_t)t * 128 + (hv - 8) * 64; }
        else { zc = ZKW + (hv - 10) * 64; gain = p.k_gain + l * 64; dst = p.kw + (size_t)t * 128 + (hv - 10) * 64; }
        const float v = p.z[(size_t)t * INC + zc + lane];
        const float ss = wave_sum(v * v);
        const float y = v * rsqrtf(ss * (1.0f / 64.f) + 1e-6f) * gain[lane];
        if (dst_norot) dst_norot[lane] = y;
        const float ang = (float)p.pos[t] * inv;
        const float cs = cosf(ang), sn = sinf(ang);
        const float other = __shfl_xor(y, 32);
        const float r = lane < 32 ? (y * cs - other * sn) : (y * cs + other * sn);
        dst[lane] = r;
    }
}

__device__ __forceinline__ void ph_compress(const Params& p, int l, float* smem, int bid, int nb) {
    float* A = smem;
    float* hid = smem + 2048;
    float* red = smem + 2048 + 256;
    const int tid = tid_();
    for (int u = bid; u < 2 * NB * NCMP * 2; u += nb) {
        const int kv = u / (NB * NCMP * 2), r = u % (NB * NCMP * 2), b = r / (NCMP * 2), n = (r / 2) % NCMP, hh = r & 1;
        const float* pe = (kv ? p.pe_v : p.pe_k) + l * 2048;
        const float* w1 = (kv ? p.w1v : p.w1k) + (size_t)l * 2048 * 256;
        const float* w2 = (kv ? p.w2v : p.w2k) + (size_t)l * 256 * 64;
        const int zc = (kv ? ZVC : ZKC) + hh * 64;
        __syncthreads();
        for (int k = tid; k < 2048; k += 256) { const int li = k >> 6, d = k & 63; A[k] = p.z[((size_t)b * NS + 16 * n + li) * INC + zc + d] + pe[k]; }
        __syncthreads();
        float acc = 0.f;
        for (int k = 0; k < 2048; ++k) acc = fmaf(A[k], w1[(size_t)k * 256 + tid], acc);
        hid[tid] = geluf_(acc);
        __syncthreads();
        if (tid < 64) {
            float o = 0.f;
            for (int f = 0; f < 256; ++f) o = fmaf(hid[f], w2[f * 64 + tid], o);
            float* dst = (kv ? p.vc : p.kc) + (((size_t)b * NCMP + n) * 2 + hh) * 64;
            if (kv) dst[tid] = o;
            else { const float ss = wave_sum(o * o); dst[tid] = o * rsqrtf(ss * (1.f / 64.f) + 1e-6f) * p.k_gain[l * 64 + tid]; }
        }
    }
    __syncthreads();
}

__device__ __forceinline__ void ph_gmln(const Params& p, int l, int bid, int nb) {
    const int lane = tid_() & 63, w = tid_() >> 6;
    for (int t = bid * 4 + w; t < NT; t += nb * 4) {
        float v[8]; float s = 0.f;
#pragma unroll
        for (int i = 0; i < 8; ++i) { v[i] = geluf_(p.z[(size_t)t * INC + ZV + i * 64 + lane]); s += v[i]; }
        const float mu = wave_sum(s) * (1.f / 512.f);
        float q = 0.f;
#pragma unroll
        for (int i = 0; i < 8; ++i) { const float d = v[i] - mu; q += d * d; }
        const float rstd = rsqrtf(wave_sum(q) * (1.f / 512.f) + 1e-6f);
#pragma unroll
        for (int i = 0; i < 8; ++i) { const int cidx = i * 64 + lane; p.vn[(size_t)t * 512 + cidx] = (v[i] - mu) * rstd * p.ln_g[l * 512 + cidx] + p.ln_b[l * 512 + cidx]; }
    }
}

__device__ __forceinline__ void ph_gmmix(const Params& p, int l, float* smem, int bid, int nb) {
    const int tid = tid_(), cidx = tid & 63, w = tid >> 6;
    for (int u = bid; u < 256 * 8; u += nb) {
        const int ch = u >> 3, g = u & 7;
        const size_t base = (size_t)ch * 128;
        __syncthreads();
        for (int i = tid; i < 128 * 64; i += 256) smem[i] = p.vn[(base + (i >> 6)) * 512 + g * 64 + (i & 63)];
        __syncthreads();
        const float* ws = p.gm_ws + ((size_t)l * 8 + g) * 128 * 128;
        for (int tl = w; tl < 128; tl += 4) {
            float acc = 0.f;
            for (int s = 0; s <= tl; ++s) acc = fmaf(ws[tl * 128 + s], smem[s * 64 + cidx], acc);
            const float mixed = acc + p.gm_bs[(l * 8 + g) * 128 + tl];
            const float uu = geluf_(p.z[(base + tl) * INC + ZU + g * 64 + cidx]);
            p.ogm[(base + tl) * 512 + g * 64 + cidx] = uu * mixed;
        }
    }
    __syncthreads();
}

__device__ __forceinline__ float dot32(const float (&q)[32], const float* k) {
    float s = 0.f;
#pragma unroll
    for (int i = 0; i < 8; ++i) { const float4 kv = *(const float4*)(k + i * 4); s = fmaf(q[i * 4], kv.x, s); s = fmaf(q[i * 4 + 1], kv.y, s); s = fmaf(q[i * 4 + 2], kv.z, s); s = fmaf(q[i * 4 + 3], kv.w, s); }
    s += __shfl_xor(s, 1);
    return s;
}
__device__ __forceinline__ void axpy32(float (&o)[32], float e, const float* v) {
#pragma unroll
    for (int i = 0; i < 8; ++i) { const float4 vv = *(const float4*)(v + i * 4); o[i * 4] = fmaf(e, vv.x, o[i * 4]); o[i * 4 + 1] = fmaf(e, vv.y, o[i * 4 + 1]); o[i * 4 + 2] = fmaf(e, vv.z, o[i * 4 + 2]); o[i * 4 + 3] = fmaf(e, vv.w, o[i * 4 + 3]); }
}

__device__ __forceinline__ void ph_attn(const Params& p, int l, float* smem, int bid, int nb) {
    float* imp = smem;
    unsigned long long* selm = (unsigned long long*)(smem + 2048);
    const int tid = tid_(), ql = tid >> 3, g = (tid >> 1) & 3, hf = tid & 1;
    const float scale = 0.125f;
    for (int unit = bid; unit < 2048; unit += nb) {
        const int qb = 63 - (unit >> 5), b = (unit & 31) >> 2, kvh = (unit >> 1) & 1, qh = unit & 1;
        const int qi = qh * 32 + ql;
        const int t = qb * 64 + qi, hq = kvh * 4 + g;
        const size_t tok = (size_t)b * NS + t;
        float q[32], o[32];
        const float gate0 = sigmoidf_(p.z[tok * INC + ZG + hq * 3 + 0]), gate1 = sigmoidf_(p.z[tok * INC + ZG + hq * 3 + 1]), gate2 = sigmoidf_(p.z[tok * INC + ZG + hq * 3 + 2]);
        float* outp = p.onsa + tok * 512 + hq * 64 + hf * 32;
        const int ho = kvh * 64 + hf * 32;
#pragma unroll
        for (int i = 0; i < 8; ++i) { const float4 v = *(const float4*)(p.qn + tok * 512 + hq * 64 + hf * 32 + i * 4); q[i * 4] = v.x; q[i * 4 + 1] = v.y; q[i * 4 + 2] = v.z; q[i * 4 + 3] = v.w; }
        int nvis = t >= 31 ? (t - 31) / 16 + 1 : 0; if (nvis > NCMP) nvis = NCMP;
        const float* kcb = p.kc + (size_t)b * NCMP * 128 + ho;
        const float* vcb = p.vc + (size_t)b * NCMP * 128 + ho;
        float m = -INFINITY;
        for (int n = 0; n < nvis; ++n) { const float s = dot32(q, kcb + n * 128) * scale; m = fmaxf(m, s); }
        float lsum = 0.f;
#pragma unroll
        for (int i = 0; i < 32; ++i) o[i] = 0.f;
        for (int n = 0; n < nvis; ++n) { const float s = dot32(q, kcb + n * 128) * scale; const float e = expf(s - m); lsum += e; axpy32(o, e, vcb + n * 128); }
        const float inv = 1.0f / fmaxf(lsum, 1e-30f);
#pragma unroll
        for (int i = 0; i < 8; ++i) *(float4*)(outp + i * 4) = make_float4(gate0 * o[i * 4] * inv, gate0 * o[i * 4 + 1] * inv, gate0 * o[i * 4 + 2] * inv, gate0 * o[i * 4 + 3] * inv);
        __syncthreads();
        for (int j = 0; j <= qb; ++j) {
            float a = 0.f;
            for (int n = 4 * j - 1; n <= 4 * j + 3; ++n) if (n >= 0 && n < nvis) { const float s = dot32(q, kcb + n * 128) * scale; a += expf(s - m) * inv; }
            a += __shfl_xor(a, 2); a += __shfl_xor(a, 4);
            if (g == 0 && hf == 0) imp[ql * 64 + j] = a;
        }
        __syncthreads();
        if (g == 0 && hf == 0) {
            unsigned long long mask = 0ull;
            for (int it = 0; it < 16; ++it) {
                int best = -1; float bv = 0.f;
                for (int j = 0; j < 64; ++j) {
                    if ((mask >> j) & 1ull) continue;
                    const bool forced = (j == 0) || (j == qb) || (j == qb - 1);
                    const float v = forced ? INFINITY : (j <= qb ? imp[ql * 64 + j] : -INFINITY);
                    if (best < 0 || v > bv) { best = j; bv = v; }
                }
                mask |= 1ull << best;
            }
            selm[ql] = mask;
        }
        __syncthreads();
        const unsigned long long mask = selm[ql];
#pragma unroll
        for (int i = 0; i < 8; ++i) { const float4 v = *(const float4*)(p.qr + tok * 512 + hq * 64 + hf * 32 + i * 4); q[i * 4] = v.x; q[i * 4 + 1] = v.y; q[i * 4 + 2] = v.z; q[i * 4 + 3] = v.w; }
        {
            float mm = -INFINITY, ll = 0.f;
#pragma unroll
            for (int i = 0; i < 32; ++i) o[i] = 0.f;
            for (int j = 0; j <= qb; ++j) {
                if (!((mask >> j) & 1ull)) continue;
                for (int s = 0; s < 64; ++s) {
                    const int tk = j * 64 + s; if (tk > t) break;
                    const size_t kt = (size_t)b * NS + tk;
                    const float sc = dot32(q, p.ks + kt * 128 + ho) * scale;
                    if (sc > mm) { const float corr = expf(mm - sc); ll *= corr;
#pragma unroll
                        for (int i = 0; i < 32; ++i) o[i] *= corr;
                        mm = sc; }
                    const float e = expf(sc - mm); ll += e; axpy32(o, e, p.z + kt * INC + ZVS + ho);
                }
            }
            const float iv = gate1 / fmaxf(ll, 1e-30f);
#pragma unroll
            for (int i = 0; i < 8; ++i) { float4 c = *(float4*)(outp + i * 4); c.x += o[i * 4] * iv; c.y += o[i * 4 + 1] * iv; c.z += o[i * 4 + 2] * iv; c.w += o[i * 4 + 3] * iv; *(float4*)(outp + i * 4) = c; }
        }
        {
            float mm = -INFINITY, ll = 0.f;
#pragma unroll
            for (int i = 0; i < 32; ++i) o[i] = 0.f;
            const int k0 = t - 511 > 0 ? t - 511 : 0;
            for (int tk = k0; tk <= t; ++tk) {
                const size_t kt = (size_t)b * NS + tk;
                const float sc = dot32(q, p.kw + kt * 128 + ho) * scale;
                if (sc > mm) { const float corr = expf(mm - sc); ll *= corr;
#pragma unroll
                    for (int i = 0; i < 32; ++i) o[i] *= corr;
                    mm = sc; }
                const float e = expf(sc - mm); ll += e; axpy32(o, e, p.z + kt * INC + ZVW + ho);
            }
            const float iv = gate2 / fmaxf(ll, 1e-30f);
#pragma unroll
            for (int i = 0; i < 8; ++i) { float4 c = *(float4*)(outp + i * 4); c.x += o[i * 4] * iv; c.y += o[i * 4 + 1] * iv; c.z += o[i * 4 + 2] * iv; c.w += o[i * 4 + 3] * iv; *(float4*)(outp + i * 4) = c; }
        }
    }
    __syncthreads();
}

__device__ __forceinline__ void ph_topk(const Params& p, int l, int bid, int nb) {
    const int lane = tid_() & 63, w = tid_() >> 6;
    for (int t = bid * 4 + w; t < NT; t += nb * 4) {
        float aff[4], key[4]; bool used[4];
#pragma unroll
        for (int i = 0; i < 4; ++i) { const int e = i * 64 + lane; aff[i] = sigmoidf_(p.logits[(size_t)t * NE + e]); key[i] = aff[i] + p.b_router[l * NE + e]; used[i] = false; }
        float topv[8]; int tope[8]; float sum = 0.f;
#pragma unroll
        for (int r = 0; r < 8; ++r) {
            float bv = -INFINITY; int be = 1 << 30; float ba = 0.f;
#pragma unroll
            for (int i = 0; i < 4; ++i) { const int e = i * 64 + lane; if (!used[i] && (key[i] > bv || (key[i] == bv && e < be))) { bv = key[i]; be = e; ba = aff[i]; } }
#pragma unroll
            for (int o = 32; o >= 1; o >>= 1) {
                const float ov = __shfl_xor(bv, o); const int oe = __shfl_xor(be, o); const float oa = __shfl_xor(ba, o);
                if (ov > bv || (ov == bv && oe < be)) { bv = ov; be = oe; ba = oa; }
            }
#pragma unroll
            for (int i = 0; i < 4; ++i) if (i * 64 + lane == be) used[i] = true;
            topv[r] = ba; tope[r] = be; sum += ba;
        }
        if (lane < 8) {
            float tv = 0.f; int te = 0;
#pragma unroll
            for (int r = 0; r < 8; ++r) if (lane == r) { tv = topv[r]; te = tope[r]; }
            p.idx[(size_t)t * 8 + lane] = te;
            p.wts[(size_t)t * 8 + lane] = tv / sum * 2.5f;
            atomicAdd(&p.counts[te], 1);
        }
    }
}

__device__ __forceinline__ void ph_scan(const Params& p, int* ismem, int bid) {
    if (bid != 0) return;
    const int tid = tid_();
    ismem[tid] = (p.counts[tid] + 127) / 128 * 128;
    __syncthreads();
    if (tid == 0) { int run = 0; for (int e = 0; e < NE; ++e) { const int v = ismem[e]; ismem[e] = run; run += v; } ismem[NE] = run; }
    __syncthreads();
    const int st = ismem[tid], en = (tid == NE - 1) ? ismem[NE] : ismem[tid + 1];
    p.pad_start[tid] = st; p.cursor[tid] = 0;
    for (int i = st / 128; i < en / 128; ++i) p.blk_e[i] = tid;
    for (int i = ismem[NE] / 128 + tid; i < MAXBLK; i += 256) p.blk_e[i] = -1;
    __syncthreads();
}

__device__ __forceinline__ void ph_place(const Params& p, int bid, int nb) {
    for (int a = bid * 256 + tid_(); a < NT * 8; a += nb * 256) {
        const int e = p.idx[a];
        const int pos = atomicAdd(&p.cursor[e], 1);
        const int dest = p.pad_start[e] + pos;
        p.row_tok[dest] = a >> 3; p.row_w[dest] = p.wts[a];
    }
}

enum { PH_MOD = 0, PH_NORM_A, PH_GEMM_Z, PH_PREP, PH_ATTN, PH_PROJ, PH_OUT, PH_NORM_F, PH_ROUTER, PH_TOPK, PH_SCAN, PH_PLACE, PH_EGATE, PH_EUP, PH_EDOWN, PH_FINAL, PH_COUNT };

template <int PH>
__device__ __forceinline__ void run_phase(const Params& p, int l, float* smem, int bid, int nb) {
    const float* xin = (l == 0) ? p.x : p.out;
    if constexpr (PH == PH_MOD) { ph_mod(p, smem, bid, nb); }
    else if constexpr (PH == PH_NORM_A) { ph_norm(p, xin, l, 0, 1024, bid, nb); }
    else if constexpr (PH == PH_GEMM_Z) {
        GemmArgs g{}; g.A = p.h; g.lda = ND; g.Bm = p.w_in + (size_t)l * ND * INC; g.ldb = INC; g.C = p.z; g.ldc = INC; g.M = NT; g.N = INC; g.K = ND;
        sgemm<M_STORE, false>(g, smem, bid, nb);
    }
    else if constexpr (PH == PH_PREP) { ph_prep(p, l, bid, nb); ph_compress(p, l, smem, bid, nb); ph_gmln(p, l, bid, nb); }
    else if constexpr (PH == PH_ATTN) { ph_attn(p, l, smem, bid, nb); ph_gmmix(p, l, smem, bid, nb); }
    else if constexpr (PH == PH_PROJ) {
        GemmArgs g{}; g.A = p.onsa; g.lda = 512; g.Bm = p.wpn + (size_t)l * 512 * ND; g.ldb = ND; g.C = p.ya; g.ldc = ND; g.M = NT; g.N = ND; g.K = 512; g.aux = p.z + ZGA; g.ldaux = INC;
        sgemm<M_SIG_SET, false>(g, smem, bid, nb);
        g.A = p.ogm; g.Bm = p.wpg + (size_t)l * 512 * ND; g.aux = p.z + ZGB;
        sgemm<M_SIG_ADD, false>(g, smem, bid, nb);
    }
    else if constexpr (PH == PH_OUT) {
        GemmArgs g{}; g.A = p.ya; g.lda = ND; g.Bm = p.w_out + (size_t)l * ND * ND; g.ldb = ND; g.C = p.out; g.ldc = ND; g.M = NT; g.N = ND; g.K = ND;
        g.aux = xin; g.ldaux = ND; g.aux2 = p.mod + (size_t)l * NB * 6144 + 2048;
        sgemm<M_RESID, false>(g, smem, bid, nb);
    }
    else if constexpr (PH == PH_NORM_F) {
        ph_norm(p, p.out, l, 3072, 4096, bid, nb);
        for (size_t i = (size_t)bid * 256 + tid_(); i < (size_t)NT * ND / 4; i += (size_t)nb * 256) ((float4*)p.routed)[i] = make_float4(0.f, 0.f, 0.f, 0.f);
        for (int i = bid * 256 + tid_(); i < MAXROWS; i += nb * 256) { p.row_tok[i] = -1; p.row_w[i] = 0.f; }
        if (bid == 0) p.counts[tid_()] = 0;
    }
    else if constexpr (PH == PH_ROUTER) {
        GemmArgs g{}; g.A = p.h; g.lda = ND; g.Bm = p.w_router + (size_t)l * ND * NE; g.ldb = NE; g.C = p.logits; g.ldc = NE; g.M = NT; g.N = NE; g.K = ND;
        sgemm<M_STORE, false>(g, smem, bid, nb);
        g.Bm = p.wgs + (size_t)l * ND * 256; g.C = p.gs;
        sgemm<M_STORE, false>(g, smem, bid, nb);
    }
    else if constexpr (PH == PH_TOPK) {
        ph_topk(p, l, bid, nb);
        GemmArgs g{}; g.A = p.h; g.lda = ND; g.Bm = p.wus + (size_t)l * ND * 256; g.ldb = 256; g.C = p.sact; g.ldc = 256; g.M = NT; g.N = 256; g.K = ND; g.aux = p.gs; g.ldaux = 256;
        sgemm<M_SILU_MUL, false>(g, smem, bid, nb);
    }
    else if constexpr (PH == PH_SCAN) {
        ph_scan(p, (int*)smem, bid);
        GemmArgs g{}; g.A = p.sact; g.lda = 256; g.Bm = p.wds + (size_t)l * 256 * ND; g.ldb = ND; g.C = p.shout; g.ldc = ND; g.M = NT; g.N = ND; g.K = 256;
        sgemm<M_STORE, false>(g, smem, bid, nb);
    }
    else if constexpr (PH == PH_PLACE) { ph_place(p, bid, nb); }
    else if constexpr (PH == PH_EGATE) {
        GemmArgs g{}; g.A = p.h; g.lda = ND; g.gather = p.row_tok; g.Bm = p.wge + (size_t)l * NE * ND * 256; g.ldb = 256; g.strideB = (size_t)ND * 256; g.blk_e = p.blk_e;
        g.C = p.ag; g.ldc = 256; g.M = MAXROWS; g.N = 256; g.K = ND;
        sgemm<M_STORE, true>(g, smem, bid, nb);
    }
    else if constexpr (PH == PH_EUP) {
        GemmArgs g{}; g.A = p.h; g.lda = ND; g.gather = p.row_tok; g.Bm = p.wue + (size_t)l * NE * ND * 256; g.ldb = 256; g.strideB = (size_t)ND * 256; g.blk_e = p.blk_e;
        g.C = p.act; g.ldc = 256; g.M = MAXROWS; g.N = 256; g.K = ND; g.aux = p.ag; g.ldaux = 256;
        sgemm<M_SILU_MUL, true>(g, smem, bid, nb);
    }
    else if constexpr (PH == PH_EDOWN) {
        GemmArgs g{}; g.A = p.act; g.lda = 256; g.gather = p.row_tok; g.Bm = p.wde + (size_t)l * NE * 256 * ND; g.ldb = ND; g.strideB = (size_t)256 * ND; g.blk_e = p.blk_e;
        g.C = p.routed; g.ldc = ND; g.M = MAXROWS; g.N = ND; g.K = 256; g.aux = p.row_w;
        sgemm<M_SCATTER, false>(g, smem, bid, nb);
    }
    else if constexpr (PH == PH_FINAL) {
        const float* gt = p.mod + (size_t)l * NB * 6144 + 5120;
        for (size_t i = (size_t)bid * 256 + tid_(); i < (size_t)NT * ND / 4; i += (size_t)nb * 256) {
            const size_t e0 = i * 4; const int r = (int)(e0 >> 10), cidx = (int)(e0 & 1023);
            const float4 g4 = *(const float4*)(gt + (size_t)(r >> 12) * 6144 + cidx);
            const float4 a = ((const float4*)p.routed)[i], s = ((const float4*)p.shout)[i]; float4 o = ((float4*)p.out)[i];
            o.x += g4.x * (a.x + s.x); o.y += g4.y * (a.y + s.y); o.z += g4.z * (a.z + s.z); o.w += g4.w * (a.w + s.w);
            ((float4*)p.out)[i] = o;
        }
    }
}


#define SMEM_FLOATS 8192
template <int PH>
__global__ void __launch_bounds__(256, 2) k_phase(Params p, int l) {
    __shared__ float smem[SMEM_FLOATS];
    run_phase<PH>(p, l, smem, blockIdx.x, gridDim.x);
}
template <int PH> static void launch_phase(const Params& p, int l, int grid, hipStream_t s) { hipLaunchKernelGGL(k_phase<PH>, dim3(grid), dim3(256), 0, s, p, l); }
}
#endif
namespace pg8 {
constexpr int BM = 256, BK = 64, HALF = 128, HTB = HALF * BK * 2, STAGE_BYTES = 8 * HTB;

__host__ __device__ __forceinline__ int lds_byte(int r, int c) { const int st = (r >> 4) * 2 + (c >> 5), rr = r & 15, cc = c & 31, ob = rr * 64 + cc * 2; return st * 1024 + (ob ^ (((ob >> 9) & 1) << 5)); }
__host__ __device__ __forceinline__ void stage_rc(int b, int& R, int& C) { const int st = b / 1024, sb = b % 1024, swz = sb ^ (((sb >> 9) & 1) << 5); R = (st >> 1) * 16 + swz / 64; C = (st & 1) * 32 + (swz % 64) / 2; }
__host__ __device__ __forceinline__ int perm32(int rho) { const int n = rho >> 4, i = rho & 15; return 8 * (i >> 2) + 4 * n + (i & 3); }

struct Unit { int pm, pn, e; };

__device__ __forceinline__ const char* uptr(const char* p) { const unsigned long long v = (unsigned long long)p; const unsigned lo = __builtin_amdgcn_readfirstlane((unsigned)v), hi = __builtin_amdgcn_readfirstlane((unsigned)(v >> 32)); return (const char*)(((unsigned long long)hi << 32) | lo); }
__device__ __forceinline__ unsigned cvt_pk_bf16(float lo, float hi) { unsigned r; asm volatile("v_cvt_pk_bf16_f32 %0, %1, %2" : "=v"(r) : "v"(lo), "v"(hi)); return r; }

template <class Epi, class Sched, bool ALIGN_EPI = true>
__device__ __forceinline__ void gemm_phase(LAS unsigned char* lds, const Sched& S, const Epi& E) {
    const int tid = tid_(), wid = __builtin_amdgcn_readfirstlane(tid >> 6), lane = tid & 63, wr = wid >> 2, wc = wid & 3, fr = lane & 15, fq = lane >> 4;
    const int K = S.K, nt = K / BK;
    unsigned voffB[2];
#pragma unroll
    for (int i = 0; i < 2; ++i) { int R, C; stage_rc(tid * 16 + i * 8192, R, C); const int Rb = Epi::PERM ? ((R & ~31) + perm32(R & 31)) : R; voffB[i] = (unsigned)(Rb * S.ldb + C) * 2u; }
    const size_t kstepB = (size_t)(BK * 2), kstepA = (size_t)S.kstepA;
    const size_t hstepB = (size_t)HALF * S.ldb * 2;
    const unsigned ldsw = (unsigned)wid * 1024u;
    const int aoff = lds_byte(wr * 64 + fr, fq * 8), boff = lds_byte(wc * 32 + fr, fq * 8);
#define PG8_SA(b, h) (((b) * 2 + (h)) * HTB)
#define PG8_SB(b, h) ((4 + (b) * 2 + (h)) * HTB)
#define PG8_STAGE_B(bufoff, gbase) do { _Pragma("unroll") for (int _i = 0; _i < 2; ++_i) \
        __builtin_amdgcn_global_load_lds((const unsigned*)(uptr((const char*)(gbase)) + voffB[_i]), (LAS unsigned*)(lds + (bufoff) + ldsw + _i * 8192), 16, 0, 0); } while (0)
#define PG8_STAGE_A(bufoff, gbase, offs, h) do { _Pragma("unroll") for (int _i = 0; _i < 2; ++_i) \
        __builtin_amdgcn_global_load_lds((const unsigned*)(uptr((const char*)(gbase)) + (offs)[h][_i]), (LAS unsigned*)(lds + (bufoff) + ldsw + _i * 8192), 16, 0, 0); } while (0)
#define PG8_LDA(dst, b, h) do { _Pragma("unroll") for (int m = 0; m < 4; ++m) _Pragma("unroll") for (int k = 0; k < 2; ++k) dst[m][k] = *(const LAS bf16x8*)(lds + PG8_SA(b, h) + aoff + m * 2048 + k * 1024); } while (0)
#define PG8_LDB(dst, b, h) do { _Pragma("unroll") for (int n = 0; n < 2; ++n) _Pragma("unroll") for (int k = 0; k < 2; ++k) dst[n][k] = *(const LAS bf16x8*)(lds + PG8_SB(b, h) + boff + n * 2048 + k * 1024); } while (0)
#define PG8_MMA(ai, bj, At, Bt) do { __builtin_amdgcn_s_setprio(1); _Pragma("unroll") for (int m = 0; m < 4; ++m) _Pragma("unroll") for (int n = 0; n < 2; ++n) _Pragma("unroll") for (int k = 0; k < 2; ++k) \
        acc[ai][bj][m][n] = __builtin_amdgcn_mfma_f32_16x16x32_bf16(Bt[n][k], At[m][k], acc[ai][bj][m][n], 0, 0, 0); __builtin_amdgcn_s_setprio(0); } while (0)
#define PG8_WAIT_V(n) asm volatile("s_waitcnt vmcnt(" #n ")" ::: "memory")
#define PG8_WAIT_L(n) asm volatile("s_waitcnt lgkmcnt(" #n ")" ::: "memory")
#define PG8_BAR __builtin_amdgcn_s_barrier()
#define PG8_SCHED __builtin_amdgcn_sched_barrier(0)
    Unit cur, nxt; int ui = 0;
    if (!S.next(0, cur)) return;
    f32x4 acc[2][2][4][2];
#pragma unroll
    for (int a = 0; a < 2; ++a)
#pragma unroll
        for (int b = 0; b < 2; ++b)
#pragma unroll
            for (int m = 0; m < 4; ++m)
#pragma unroll
                for (int n = 0; n < 2; ++n) acc[a][b][m][n] = (f32x4){0.f, 0.f, 0.f, 0.f};
    bf16x8 At[4][2], B0[2][2], B1[2][2];
    const char* cA = S.a_ptr(cur); const char* cB = S.b_ptr(cur);
    unsigned coff[2][2], noff[2][2];
    S.a_off(cur, tid, coff);
    PG8_STAGE_B(PG8_SB(0, 0), cB); PG8_STAGE_B(PG8_SB(0, 1), cB + hstepB); PG8_STAGE_A(PG8_SA(0, 0), cA, coff, 0); PG8_STAGE_A(PG8_SA(0, 1), cA, coff, 1);
    if (wr == 1) PG8_BAR;
    PG8_WAIT_V(2); PG8_BAR;
    PG8_STAGE_B(PG8_SB(1, 0), cB + kstepB); PG8_STAGE_A(PG8_SA(1, 0), cA + kstepA, coff, 0); PG8_STAGE_B(PG8_SB(1, 1), cB + hstepB + kstepB);
    PG8_WAIT_V(6); PG8_BAR;
    for (;;) {
        const bool has_next = S.next(ui + 1, nxt);
        const char* nA = cA; const char* nB = cB;
#pragma unroll
        for (int h = 0; h < 2; ++h)
#pragma unroll
            for (int i = 0; i < 2; ++i) noff[h][i] = coff[h][i];
        if (has_next) { nA = S.a_ptr(nxt); nB = S.b_ptr(nxt); S.a_off(nxt, tid_(), noff); }
        for (int t = 0; t < nt; t += 2) {
            const bool last = (t == nt - 2);
            const char* a1 = cA + (size_t)(t + 1) * kstepA;
            const char* a2 = last ? nA : cA + (size_t)(t + 2) * kstepA; const char* b2 = last ? nB : cB + (size_t)(t + 2) * kstepB;
            const char* a3 = a2 + kstepA; const char* b3 = b2 + kstepB;
            unsigned so[2][2]; const unsigned lmask = last ? 0xffffffffu : 0u;
#pragma unroll
            for (int h = 0; h < 2; ++h)
#pragma unroll
                for (int i = 0; i < 2; ++i) so[h][i] = coff[h][i] ^ ((coff[h][i] ^ noff[h][i]) & lmask);
            PG8_LDB(B0, 0, 0); PG8_LDB(B1, 0, 1); PG8_SCHED; PG8_LDA(At, 0, 0); PG8_STAGE_A(PG8_SA(1, 1), a1, coff, 1);
            PG8_WAIT_V(8); PG8_WAIT_L(0); PG8_BAR; PG8_MMA(0, 0, At, B0); PG8_MMA(0, 1, At, B1); PG8_BAR; PG8_SCHED;
            PG8_LDA(At, 0, 1); PG8_STAGE_B(PG8_SB(0, 0), b2); PG8_STAGE_B(PG8_SB(0, 1), b2 + hstepB); PG8_STAGE_A(PG8_SA(0, 0), a2, so, 0);
            PG8_WAIT_V(8); PG8_WAIT_L(0); PG8_BAR; PG8_MMA(1, 0, At, B0); PG8_MMA(1, 1, At, B1); PG8_BAR; PG8_SCHED;
            PG8_LDB(B0, 1, 0); PG8_LDB(B1, 1, 1); PG8_SCHED; PG8_LDA(At, 1, 0); PG8_STAGE_A(PG8_SA(0, 1), a2, so, 1);
            PG8_WAIT_V(8); PG8_WAIT_L(0); PG8_BAR; PG8_MMA(0, 0, At, B0); PG8_MMA(0, 1, At, B1); PG8_BAR; PG8_SCHED;
            PG8_LDA(At, 1, 1); PG8_STAGE_B(PG8_SB(1, 0), b3); PG8_STAGE_B(PG8_SB(1, 1), b3 + hstepB); PG8_STAGE_A(PG8_SA(1, 0), a3, so, 0);
            PG8_WAIT_V(8); PG8_WAIT_L(0); PG8_BAR; PG8_MMA(1, 0, At, B0); PG8_MMA(1, 1, At, B1); PG8_BAR; PG8_SCHED;
        }
        if constexpr (ALIGN_EPI) { if (wr == 0) PG8_BAR; }
        E(acc, cur, wr, wc, fr, fq);
        if (!has_next) break;
#pragma unroll
        for (int a = 0; a < 2; ++a)
#pragma unroll
            for (int b = 0; b < 2; ++b)
#pragma unroll
                for (int m = 0; m < 4; ++m)
#pragma unroll
                    for (int n = 0; n < 2; ++n) acc[a][b][m][n] = (f32x4){0.f, 0.f, 0.f, 0.f};
        cur = nxt; cA = nA; cB = nB; ++ui;
#pragma unroll
        for (int h = 0; h < 2; ++h)
#pragma unroll
            for (int i = 0; i < 2; ++i) coff[h][i] = noff[h][i];
        if constexpr (ALIGN_EPI) { if (wr == 1) PG8_BAR; }
    }
    PG8_WAIT_V(0);
    if constexpr (!ALIGN_EPI) { if (wr == 0) PG8_BAR; }
    PG8_BAR;
#undef PG8_SA
#undef PG8_SB
#undef PG8_STAGE_A
#undef PG8_STAGE_B
#undef PG8_LDA
#undef PG8_LDB
#undef PG8_MMA
#undef PG8_WAIT_V
#undef PG8_WAIT_L
#undef PG8_BAR
#undef PG8_SCHED
}

struct DenseSched {
    const char* A; const char* Bt; int K, kstepA, ldb; int lda_bytes; int nM, nN, G, c;
    __device__ __forceinline__ void init(const void* A_, int lda_elems, const void* Bt_, int M, int N, int K_, int G_, int c_) {
        A = (const char*)A_; Bt = (const char*)Bt_; K = K_; ldb = K_; kstepA = BK * 2; lda_bytes = lda_elems * 2; nM = M / BM; nN = N / BM; G = G_; c = c_; }
    __device__ __forceinline__ bool next(int i, Unit& u) const {
        const long L = (long)i * G + c; if (L >= (long)nM * nN) return false;
        const int nwg = nM * nN; int wgid = (int)L; { const int q = nwg / 8, r = nwg % 8, xcd = wgid % 8, off = wgid / 8; wgid = (xcd < r ? xcd * (q + 1) : r * (q + 1) + (xcd - r) * q) + off; }
        const int nig = 8 * nN, gid = wgid / nig, fm = gid * 8, gsz = (nM - fm) < 8 ? (nM - fm) : 8;
        u.pm = fm + ((wgid % nig) % gsz); u.pn = (wgid % nig) / gsz; u.e = 0; return true;
    }
    __device__ __forceinline__ const char* a_ptr(const Unit& u) const { return A + (size_t)u.pm * BM * lda_bytes; }
    __device__ __forceinline__ void a_off(const Unit&, int tid, unsigned (&off)[2][2]) const {
#pragma unroll
        for (int i = 0; i < 2; ++i) { int R, C; stage_rc(tid * 16 + i * 8192, R, C);
#pragma unroll
            for (int h = 0; h < 2; ++h) off[h][i] = (unsigned)((h * HALF + R) * lda_bytes + C * 2); }
    }
    __device__ __forceinline__ const char* b_ptr(const Unit& u) const { return Bt + (size_t)u.pn * BM * K * 2; }
};
}
#define MAXROWS2 327680
#define MAXUNITS2 (MAXROWS2 / 256)
#define ZPAD 4608
constexpr int LDS_BYTES = 147456;
constexpr int LDS_MISC = 135168;

namespace wsl {
constexpr size_t al(size_t x) { return (x + 255) & ~(size_t)255; }
constexpr size_t O_ctl = 0;
constexpr size_t O_mod = O_ctl + al(65536);
constexpr size_t O_rope = O_mod + al((size_t)NL * NB * 6144 * 4);
constexpr size_t O_bias1 = O_rope + al((size_t)NT * 32 * 8);
constexpr size_t O_wsc = O_bias1 + al((size_t)NL * 2 * 256 * 4);
constexpr size_t O_Wt_in = O_wsc + al((size_t)NL * 8 * 128 * 128 * 2);
constexpr size_t O_Wt_pn = O_Wt_in + al((size_t)NL * ZPAD * ND * 2);
constexpr size_t O_Wt_pg = O_Wt_pn + al((size_t)NL * ND * 512 * 2);
constexpr size_t O_Wt_out = O_Wt_pg + al((size_t)NL * ND * 512 * 2);
constexpr size_t O_Wt_rs = O_Wt_out + al((size_t)NL * ND * ND * 2);
constexpr size_t O_Wt_ds = O_Wt_rs + al((size_t)NL * 768 * ND * 2);
constexpr size_t O_Wt_w1 = O_Wt_ds + al((size_t)NL * ND * 256 * 2);
constexpr size_t O_h = O_Wt_w1 + al((size_t)NL * 2 * 256 * 2048 * 2);
constexpr size_t O_gates = O_h + al((size_t)NT * ND * 2);
constexpr size_t O_kc = O_gates + al((size_t)NT * 32 * 4);
constexpr size_t O_vc = O_kc + al((size_t)NB * 256 * 128 * 2);
constexpr size_t O_idx = O_vc + al((size_t)NB * 256 * 128 * 2);
constexpr size_t O_slot = O_idx + al((size_t)NT * 8 * 4);
constexpr size_t O_wts = O_slot + al((size_t)NT * 8 * 4);
constexpr size_t O_counts = O_wts + al((size_t)NT * 8 * 4);
constexpr size_t O_cursor = O_counts + al(1024);
constexpr size_t O_row_tok = O_cursor + al(1024);
constexpr size_t O_row_w = O_row_tok + al((size_t)MAXROWS2 * 4);
constexpr size_t O_unit_e = O_row_w + al((size_t)MAXROWS2 * 4);
constexpr size_t O_REGION = O_unit_e + al((size_t)MAXUNITS2 * 4);
constexpr size_t O_qn = O_REGION;
constexpr size_t O_qr = O_qn + al((size_t)NT * 512 * 2);
constexpr size_t O_kvraw = O_qr + al((size_t)NT * 512 * 2);
constexpr size_t O_ksv = O_kvraw + al((size_t)NT * 256 * 2);
constexpr size_t O_kwv = O_ksv + al((size_t)NT * 256 * 2);
constexpr size_t O_u = O_kwv + al((size_t)NT * 256 * 2);
constexpr size_t O_v = O_u + al((size_t)NT * 512 * 2);
constexpr size_t O_sga = O_v + al((size_t)NT * 512 * 2);
constexpr size_t O_sgb = O_sga + al((size_t)NT * ND * 2);
constexpr size_t O_cpart = O_sgb + al((size_t)NT * ND * 2);
constexpr size_t O_onsa = O_cpart + al((size_t)2 * 4 * 4096 * 256 * 4);
constexpr size_t O_ogm = O_onsa + al((size_t)NT * 512 * 2);
constexpr size_t O_merged = O_ogm + al((size_t)NT * 512 * 2);
constexpr size_t O_END_MIX = O_merged + al((size_t)NT * ND * 2);
constexpr size_t O_logits = O_REGION;
constexpr size_t O_sact = O_logits + al((size_t)NT * NE * 4);
constexpr size_t O_shout = O_sact + al((size_t)NT * 256 * 2);
constexpr size_t O_act = O_shout + al((size_t)NT * ND * 2);
constexpr size_t O_yslot = O_act + al((size_t)MAXROWS2 * 256 * 2);
constexpr size_t O_END_MOE = O_yslot + al((size_t)MAXROWS2 * ND * 2);
constexpr size_t O_END_ACT = O_END_MIX > O_END_MOE ? O_END_MIX : O_END_MOE;
constexpr size_t O_Wt_eg = O_END_ACT;
constexpr size_t O_Wt_ed = O_Wt_eg + al((size_t)NL * NE * 512 * ND * 2);
constexpr size_t O_TOTAL = O_Wt_ed + al((size_t)NL * NE * ND * 256 * 2);
}
struct OP {
    const float *x, *c; const int* pos;
    const float *w_mod, *b_mod, *w_in, *q_gain, *k_gain, *pe_k, *pe_v, *w1k, *w2k, *w1v, *w2v, *ln_g, *ln_b, *gm_ws, *gm_bs,
                *wpn, *wpg, *w_out, *w_router, *b_router, *wge, *wue, *wde, *wgs, *wus, *wds;
    float* out;
    float* xres;
    char* ws;
    long long xoff;
    int ph_lo, ph_hi, l_lo, l_hi, conv_l_lo, conv_l_hi;
    __host__ __device__ __forceinline__ unsigned* ctl() const { return (unsigned*)(ws + wsl::O_ctl + (0)); }
    __host__ __device__ __forceinline__ float* mod() const { return (float*)(ws + wsl::O_mod + (0)); }
    __host__ __device__ __forceinline__ float* rope() const { return (float*)(ws + wsl::O_rope + (0)); }
    __host__ __device__ __forceinline__ float* bias1() const { return (float*)(ws + wsl::O_bias1 + (0)); }
    __host__ __device__ __forceinline__ bf16_t* wsc() const { return (bf16_t*)(ws + wsl::O_wsc + (0)); }
    __host__ __device__ __forceinline__ bf16_t* Wt_in() const { return (bf16_t*)(ws + wsl::O_Wt_in + (0)); }
    __host__ __device__ __forceinline__ bf16_t* Wt_pn() const { return (bf16_t*)(ws + wsl::O_Wt_pn + (0)); }
    __host__ __device__ __forceinline__ bf16_t* Wt_pg() const { return (bf16_t*)(ws + wsl::O_Wt_pg + (0)); }
    __host__ __device__ __forceinline__ bf16_t* Wt_out() const { return (bf16_t*)(ws + wsl::O_Wt_out + (0)); }
    __host__ __device__ __forceinline__ bf16_t* Wt_rs() const { return (bf16_t*)(ws + wsl::O_Wt_rs + (0)); }
    __host__ __device__ __forceinline__ bf16_t* Wt_ds() const { return (bf16_t*)(ws + wsl::O_Wt_ds + (0)); }
    __host__ __device__ __forceinline__ bf16_t* Wt_w1() const { return (bf16_t*)(ws + wsl::O_Wt_w1 + (0)); }
    __host__ __device__ __forceinline__ bf16_t* h() const { return (bf16_t*)(ws + wsl::O_h + (0)); }
    __host__ __device__ __forceinline__ float* gates() const { return (float*)(ws + wsl::O_gates + (0)); }
    __host__ __device__ __forceinline__ bf16_t* kc() const { return (bf16_t*)(ws + wsl::O_kc + (0)); }
    __host__ __device__ __forceinline__ bf16_t* vc() const { return (bf16_t*)(ws + wsl::O_vc + (0)); }
    __host__ __device__ __forceinline__ int* idx() const { return (int*)(ws + wsl::O_idx + (0)); }
    __host__ __device__ __forceinline__ int* slot() const { return (int*)(ws + wsl::O_slot + (0)); }
    __host__ __device__ __forceinline__ float* wts() const { return (float*)(ws + wsl::O_wts + (0)); }
    __host__ __device__ __forceinline__ int* counts() const { return (int*)(ws + wsl::O_counts + (0)); }
    __host__ __device__ __forceinline__ int* cursor() const { return (int*)(ws + wsl::O_cursor + (0)); }
    __host__ __device__ __forceinline__ int* row_tok() const { return (int*)(ws + wsl::O_row_tok + (0)); }
    __host__ __device__ __forceinline__ float* row_w() const { return (float*)(ws + wsl::O_row_w + (0)); }
    __host__ __device__ __forceinline__ int* unit_e() const { return (int*)(ws + wsl::O_unit_e + (0)); }
    __host__ __device__ __forceinline__ bf16_t* qn() const { return (bf16_t*)(ws + wsl::O_qn + (0)); }
    __host__ __device__ __forceinline__ bf16_t* qr() const { return (bf16_t*)(ws + wsl::O_qr + (0)); }
    __host__ __device__ __forceinline__ bf16_t* kvraw() const { return (bf16_t*)(ws + wsl::O_kvraw + (0)); }
    __host__ __device__ __forceinline__ bf16_t* ksv() const { return (bf16_t*)(ws + wsl::O_ksv + (0)); }
    __host__ __device__ __forceinline__ bf16_t* kwv() const { return (bf16_t*)(ws + wsl::O_kwv + (0)); }
    __host__ __device__ __forceinline__ bf16_t* u() const { return (bf16_t*)(ws + wsl::O_u + (0)); }
    __host__ __device__ __forceinline__ bf16_t* v() const { return (bf16_t*)(ws + wsl::O_v + (0)); }
    __host__ __device__ __forceinline__ bf16_t* sga() const { return (bf16_t*)(ws + wsl::O_sga + (0)); }
    __host__ __device__ __forceinline__ bf16_t* sgb() const { return (bf16_t*)(ws + wsl::O_sgb + (0)); }
    __host__ __device__ __forceinline__ float* cpart() const { return (float*)(ws + wsl::O_cpart + (0)); }
    __host__ __device__ __forceinline__ bf16_t* onsa() const { return (bf16_t*)(ws + wsl::O_onsa + (0)); }
    __host__ __device__ __forceinline__ bf16_t* ogm() const { return (bf16_t*)(ws + wsl::O_ogm + (0)); }
    __host__ __device__ __forceinline__ bf16_t* merged() const { return (bf16_t*)(ws + wsl::O_merged + (0)); }
    __host__ __device__ __forceinline__ float* logits() const { return (float*)(ws + wsl::O_logits + (0)); }
    __host__ __device__ __forceinline__ bf16_t* sact() const { return (bf16_t*)(ws + wsl::O_sact + (0)); }
    __host__ __device__ __forceinline__ bf16_t* shout() const { return (bf16_t*)(ws + wsl::O_shout + (0)); }
    __host__ __device__ __forceinline__ bf16_t* act() const { return (bf16_t*)(ws + wsl::O_act + (0)); }
    __host__ __device__ __forceinline__ bf16_t* yslot() const { return (bf16_t*)(ws + wsl::O_yslot + (0)); }
    __host__ __device__ __forceinline__ bf16_t* Wt_eg() const { return (bf16_t*)(ws + wsl::O_Wt_eg + (xoff)); }
    __host__ __device__ __forceinline__ bf16_t* Wt_ed() const { return (bf16_t*)(ws + wsl::O_Wt_ed + (xoff)); }
};

__device__ __forceinline__ float bf2f(bf16_t b) { return __uint_as_float(((unsigned)b) << 16); }
__device__ __forceinline__ unsigned f2bf(float f) { unsigned u = __float_as_uint(f); return (u + 0x7fffu + ((u >> 16) & 1u)) >> 16; }
__device__ __forceinline__ unsigned pk2(float lo, float hi) { return pg8::cvt_pk_bf16(lo, hi); }
__device__ __forceinline__ float fsigmoid(float x) { return __builtin_amdgcn_rcpf(1.0f + __expf(-x)); }
__device__ __forceinline__ float fgelu(float x) { const float u2 = 1.5957691216057308f * (x + 0.044715f * x * x * x); return x * __builtin_amdgcn_rcpf(1.0f + __expf(-u2)); }
__device__ __forceinline__ float fsilu(float x) { return x * __builtin_amdgcn_rcpf(1.0f + __expf(-x)); }

__device__ __forceinline__ void tr_item(const float* src, int ld, int scol, int nvalid, bf16_t* dst, int K, int nd0, int k0, LAS float* scr, int lane) {
    const int n4 = (lane & 7) * 4, kr = lane >> 3;
    f32x4 v[16];
#pragma unroll
    for (int i = 0; i < 16; ++i) v[i] = (n4 < nvalid) ? *(const f32x4*)(src + (size_t)(k0 + 8 * i + kr) * ld + scol + n4) : (f32x4){0.f, 0.f, 0.f, 0.f};
#pragma unroll
    for (int i = 0; i < 16; ++i) { LAS float* s = scr + (8 * i + kr) * 33 + n4; s[0] = v[i].x; s[1] = v[i].y; s[2] = v[i].z; s[3] = v[i].w; }
    asm volatile("s_waitcnt lgkmcnt(0)" ::: "memory");
    const int n = lane & 31, hk = lane >> 5;
#pragma unroll
    for (int j = 0; j < 8; ++j) {
        const int cc = 2 * j + hk; const LAS float* s = scr + (8 * cc) * 33 + n;
        u32x4 o; o.x = pk2(s[0], s[33]); o.y = pk2(s[2 * 33], s[3 * 33]); o.z = pk2(s[4 * 33], s[5 * 33]); o.w = pk2(s[6 * 33], s[7 * 33]);
        *(u32x4*)(dst + (size_t)(nd0 + n) * K + k0 + 8 * cc) = o;
    }
    asm volatile("s_waitcnt lgkmcnt(0)" ::: "memory");
}
__device__ __forceinline__ int win_srccol(int nd0, int& nvalid) {
    const int pn = nd0 >> 8, q = nd0 & 255, bj = q >> 7, wc = (q & 127) >> 5; nvalid = 32;
    if (pn < 2) return ZQ + (4 * pn + wc) * 64 + 32 * bj;
    if (pn < 5) return ZKC + (pn - 2) * 256 + wc * 64 + 32 * bj;
    if (pn < 7) return ZU + (pn - 5) * 256 + q;
    if (pn < 9) return ZV + (pn - 7) * 256 + q;
    if (pn < 13) return ZGA + (pn - 9) * 256 + q;
    if (pn < 17) return ZGB + (pn - 13) * 256 + q;
    nvalid = (q == 0) ? 24 : 0; return ZG;
}
__device__ __forceinline__ void ph_prologue(const OP& p, LAS unsigned char* lds, int bid, int nb) {
    const int tid = tid_(), lane = tid & 63, wave = tid >> 6;
    if (bid < 24) {
        LAS float* sc = (LAS float*)lds;
        for (int i = tid; i < NB * ND; i += 512) { const float cv = p.c[i]; sc[i] = cv / (1.0f + expf(-cv)); }
        __syncthreads();
        const int job = bid * 8 + wave, l = job / 96, j = (job % 96) * 64 + lane;
        float acc[NB];
#pragma unroll
        for (int b = 0; b < NB; ++b) acc[b] = 0.f;
        const float* w = p.w_mod + (size_t)l * ND * 6144 + j;
        for (int d = 0; d < ND; ++d) { const float wv = w[(size_t)d * 6144];
#pragma unroll
            for (int b = 0; b < NB; ++b) acc[b] = fmaf(sc[b * ND + d], wv, acc[b]); }
        const float bb = p.b_mod[l * 6144 + j];
#pragma unroll
        for (int b = 0; b < NB; ++b) p.mod()[((size_t)l * NB + b) * 6144 + j] = acc[b] + bb;
        __syncthreads();
    }
    const int gt = bid * 512 + tid, ngt = nb * 512;
    for (int it = gt; it < NT * 32; it += ngt) { const int t = it >> 5, i = it & 31; const float inv = (float)pow(10000.0, -(double)i / 32.0); const float ang = (float)p.pos[t] * inv;
        float sn, cs; sincosf(ang, &sn, &cs); *(f32x2*)(p.rope() + (size_t)it * 2) = (f32x2){cs, sn}; }
    for (int it = gt; it < NL * 2 * 256; it += ngt) { const int l = it >> 9, kv = (it >> 8) & 1, f = it & 255;
        const float* pe = (kv ? p.pe_v : p.pe_k) + l * 2048; const float* w1 = (kv ? p.w1v : p.w1k) + (size_t)l * 2048 * 256 + f; float a = 0.f;
        for (int k = 0; k < 2048; ++k) a = fmaf(pe[k], w1[(size_t)k * 256], a);
        p.bias1()[it] = a; }
    for (int it = gt; it < NL * 8 * 128 * 128; it += ngt) { const int s = it & 127, t = (it >> 7) & 127; p.wsc()[it] = (bf16_t)f2bf(s <= t ? p.gm_ws[it] : 0.f); }
    LAS float* scr = (LAS float*)lds + wave * (128 * 33);
    const int gw = bid * 8 + wave, ngw = nb * 8;
    constexpr int I_IN = (ZPAD / 32) * 8, I_P = 32 * 4, I_O = 32 * 8, I_R = 8 * 8, I_SG = 16 * 8, I_DS = 32 * 2, I_W1 = 8 * 16, I_SMALL = I_IN + 2 * I_P + I_O + I_R + I_SG + I_DS + 2 * I_W1;
    for (int it = gw; it < NL * I_SMALL; it += ngw) {
        const int l = it / I_SMALL; int r = it % I_SMALL;
        if (r < I_IN) { const int nd0 = (r >> 3) * 32, k0 = (r & 7) * 128; int nv; const int sc = win_srccol(nd0, nv); tr_item(p.w_in + (size_t)l * ND * INC, INC, sc, nv, p.Wt_in() + (size_t)l * ZPAD * ND, ND, nd0, k0, scr, lane); continue; } r -= I_IN;
        if (r < I_P) { const int nd0 = (r >> 2) * 32, k0 = (r & 3) * 128; tr_item(p.wpn + (size_t)l * 512 * ND, ND, nd0, 32, p.Wt_pn() + (size_t)l * ND * 512, 512, nd0, k0, scr, lane); continue; } r -= I_P;
        if (r < I_P) { const int nd0 = (r >> 2) * 32, k0 = (r & 3) * 128; tr_item(p.wpg + (size_t)l * 512 * ND, ND, nd0, 32, p.Wt_pg() + (size_t)l * ND * 512, 512, nd0, k0, scr, lane); continue; } r -= I_P;
        if (r < I_O) { const int nd0 = (r >> 3) * 32, k0 = (r & 7) * 128; tr_item(p.w_out + (size_t)l * ND * ND, ND, nd0, 32, p.Wt_out() + (size_t)l * ND * ND, ND, nd0, k0, scr, lane); continue; } r -= I_O;
        if (r < I_R) { const int nd0 = (r >> 3) * 32, k0 = (r & 7) * 128; tr_item(p.w_router + (size_t)l * ND * NE, NE, nd0, 32, p.Wt_rs() + (size_t)l * 768 * ND, ND, nd0, k0, scr, lane); continue; } r -= I_R;
        if (r < I_SG) { const int nd0 = (r >> 3) * 32, k0 = (r & 7) * 128; const int tile = nd0 >> 8, q = nd0 & 255;
            tr_item((q < 128 ? p.wgs : p.wus) + (size_t)l * ND * 256, 256, tile * 128 + (q & 127), 32, p.Wt_rs() + (size_t)l * 768 * ND, ND, 256 + nd0, k0, scr, lane); continue; } r -= I_SG;
        if (r < I_DS) { const int nd0 = (r >> 1) * 32, k0 = (r & 1) * 128; tr_item(p.wds + (size_t)l * 256 * ND, ND, nd0, 32, p.Wt_ds() + (size_t)l * ND * 256, 256, nd0, k0, scr, lane); continue; } r -= I_DS;
        { const int kv = r / I_W1; r %= I_W1; const int nd0 = (r >> 4) * 32, k0 = (r & 15) * 128;
          tr_item((kv ? p.w1v : p.w1k) + (size_t)l * 2048 * 256, 256, nd0, 32, p.Wt_w1() + ((size_t)l * 2 + kv) * 256 * 2048, 2048, nd0, k0, scr, lane); }
    }
    constexpr int I_E = 128 + 64;
    const int nle = (p.conv_l_hi - p.conv_l_lo) * NE;
    for (long it = gw; it < (long)nle * I_E; it += ngw) {
        const int le = (int)(it / I_E), l = p.conv_l_lo + le / NE, e = le % NE; int r = (int)(it % I_E);
        if (r < 128) { const int nd0 = (r >> 3) * 32, k0 = (r & 7) * 128; const int tile = nd0 >> 8, q = nd0 & 255;
            tr_item((q < 128 ? p.wge : p.wue) + ((size_t)l * NE + e) * ND * 256, 256, tile * 128 + (q & 127), 32, p.Wt_eg() + ((size_t)l * NE + e) * 512 * ND, ND, nd0, k0, scr, lane); }
        else { r -= 128; const int nd0 = (r >> 1) * 32, k0 = (r & 1) * 128; tr_item(p.wde + ((size_t)l * NE + e) * 256 * ND, ND, nd0, 32, p.Wt_ed() + ((size_t)l * NE + e) * ND * 256, 256, nd0, k0, scr, lane); }
    }
}

__device__ __forceinline__ void ph_norm(const OP& p, const float* xin, int l, int sh_off, int sc_off, int bid, int nb) {
    const int lane = tid_() & 63, w = tid_() >> 6;
    for (int t = bid * 8 + w; t < NT; t += nb * 8) {
        const float* xr = xin + (size_t)t * ND;
        f32x4 v[4]; float ss = 0.f;
#pragma unroll
        for (int i = 0; i < 4; ++i) { v[i] = *(const f32x4*)(xr + i * 256 + lane * 4); ss += v[i].x * v[i].x + v[i].y * v[i].y + v[i].z * v[i].z + v[i].w * v[i].w; }
#pragma unroll
        for (int o = 32; o >= 1; o >>= 1) ss += __shfl_xor(ss, o);
        const float rstd = rsqrtf(ss * (1.0f / ND) + 1e-6f);
        const float* mb = p.mod() + ((size_t)l * NB + (t >> 12)) * 6144;
#pragma unroll
        for (int i = 0; i < 4; ++i) {
            const int cidx = i * 256 + lane * 4;
            const f32x4 sc = *(const f32x4*)(mb + sc_off + cidx), sh = *(const f32x4*)(mb + sh_off + cidx);
            u32x2 o; o.x = pk2(v[i].x * rstd * (1.f + sc.x) + sh.x, v[i].y * rstd * (1.f + sc.y) + sh.y); o.y = pk2(v[i].z * rstd * (1.f + sc.z) + sh.z, v[i].w * rstd * (1.f + sc.w) + sh.w);
            *(u32x2*)(p.h() + (size_t)t * ND + cidx) = o;
        }
    }
}

#define LDS_GAIN (LDS_MISC + 256)
struct EpiZ {
    static constexpr bool PERM = true;
    const OP* pp; LAS unsigned char* lds;
    __device__ __forceinline__ void operator()(const f32x4 (&acc)[2][2][4][2], const pg8::Unit& u, int wr, int wc, int fr, int fq) const {
        const OP& p = *pp; const int pn = u.pn;
        const int row0 = u.pm * 256 + wr * 64 + fr;
        if (pn < 5) {
            const bool normed = (pn < 2) || (pn >= 3 && wc < 2);
            bf16_t* dst; int ldd, cbase;
            if (pn < 2) { dst = p.qn(); ldd = 512; cbase = (4 * pn + wc) * 64; }
            else if (pn == 2) { dst = p.kvraw(); ldd = 256; cbase = wc * 64; }
            else if (pn == 3) { dst = p.ksv(); ldd = 256; cbase = wc * 64; }
            else { dst = p.kwv(); ldd = 256; cbase = wc * 64; }
            const LAS float* gain = (const LAS float*)(lds + LDS_GAIN) + (pn < 2 ? 0 : 64);
            const float osc = (pn < 2) ? 0.125f : 1.0f;
            f32x4 g0[2], g1[2];
#pragma unroll
            for (int n = 0; n < 2; ++n) { g0[n] = *(const LAS f32x4*)(gain + 8 * fq + 4 * n); g1[n] = *(const LAS f32x4*)(gain + 32 + 8 * fq + 4 * n); }
#pragma unroll
            for (int ai = 0; ai < 2; ++ai)
#pragma unroll
                for (int m = 0; m < 4; ++m) {
                    const int row = row0 + ai * 128 + m * 16;
                    f32x4 y0[2], y1[2];
#pragma unroll
                    for (int n = 0; n < 2; ++n) { y0[n] = acc[ai][0][m][n]; y1[n] = acc[ai][1][m][n]; }
                    float ss = 0.f;
#pragma unroll
                    for (int n = 0; n < 2; ++n) { ss += y0[n].x * y0[n].x + y0[n].y * y0[n].y + y0[n].z * y0[n].z + y0[n].w * y0[n].w; ss += y1[n].x * y1[n].x + y1[n].y * y1[n].y + y1[n].z * y1[n].z + y1[n].w * y1[n].w; }
                    ss += __shfl_xor(ss, 16); ss += __shfl_xor(ss, 32);
                    const float rs = rsqrtf(ss * (1.0f / 64.f) + 1e-6f) * osc;
#pragma unroll
                    for (int n = 0; n < 2; ++n) { y0[n] = normed ? y0[n] * rs * g0[n] : y0[n]; y1[n] = normed ? y1[n] * rs * g1[n] : y1[n]; }
                    u32x4 w0, w1; w0.x = pk2(y0[0].x, y0[0].y); w0.y = pk2(y0[0].z, y0[0].w); w0.z = pk2(y0[1].x, y0[1].y); w0.w = pk2(y0[1].z, y0[1].w);
                    w1.x = pk2(y1[0].x, y1[0].y); w1.y = pk2(y1[0].z, y1[0].w); w1.z = pk2(y1[1].x, y1[1].y); w1.w = pk2(y1[1].z, y1[1].w);
                    *(u32x4*)(dst + (size_t)row * ldd + cbase + 8 * fq) = w0; *(u32x4*)(dst + (size_t)row * ldd + cbase + 32 + 8 * fq) = w1;
                }
        } else if (pn < 17) {
            bf16_t* dst; int ldd, ct; const bool is_gelu = pn < 9;
            if (pn < 7) { dst = p.u(); ldd = 512; ct = (pn - 5) * 256; } else if (pn < 9) { dst = p.v(); ldd = 512; ct = (pn - 7) * 256; }
            else if (pn < 13) { dst = p.sga(); ldd = 1024; ct = (pn - 9) * 256; } else { dst = p.sgb(); ldd = 1024; ct = (pn - 13) * 256; }
            const int col0 = ct + wc * 32 + 8 * fq;
#pragma unroll
            for (int ai = 0; ai < 2; ++ai)
#pragma unroll
                for (int m = 0; m < 4; ++m) {
                    bf16_t* rowp = dst + (size_t)(row0 + ai * 128 + m * 16) * ldd + col0;
#pragma unroll
                    for (int bj = 0; bj < 2; ++bj) {
                        f32x4 v0 = acc[ai][bj][m][0], v1 = acc[ai][bj][m][1];
                        f32x4 a0, a1, m0, m1;
                        if (is_gelu) { a0 = 1.5957691216057308f * (v0 + 0.044715f * v0 * v0 * v0); a1 = 1.5957691216057308f * (v1 + 0.044715f * v1 * v1 * v1); m0 = v0; m1 = v1; }
                        else { a0 = v0; a1 = v1; m0 = (f32x4){1.f, 1.f, 1.f, 1.f}; m1 = m0; }
                        v0 = (f32x4){m0.x * fsigmoid(a0.x), m0.y * fsigmoid(a0.y), m0.z * fsigmoid(a0.z), m0.w * fsigmoid(a0.w)};
                        v1 = (f32x4){m1.x * fsigmoid(a1.x), m1.y * fsigmoid(a1.y), m1.z * fsigmoid(a1.z), m1.w * fsigmoid(a1.w)};
                        u32x4 w; w.x = pk2(v0.x, v0.y); w.y = pk2(v0.z, v0.w); w.z = pk2(v1.x, v1.y); w.w = pk2(v1.z, v1.w);
                        *(u32x4*)(rowp + bj * 128) = w;
                    }
                }
        } else {
            if (wc == 0) {
#pragma unroll
                for (int ai = 0; ai < 2; ++ai)
#pragma unroll
                    for (int m = 0; m < 4; ++m) {
                        float* rowp = p.gates() + (size_t)(row0 + ai * 128 + m * 16) * 32 + 8 * fq;
                        const f32x4 v0 = acc[ai][0][m][0], v1 = acc[ai][0][m][1];
                        *(f32x4*)(rowp) = (f32x4){fsigmoid(v0.x), fsigmoid(v0.y), fsigmoid(v0.z), fsigmoid(v0.w)};
                        *(f32x4*)(rowp + 4) = (f32x4){fsigmoid(v1.x), fsigmoid(v1.y), fsigmoid(v1.z), fsigmoid(v1.w)};
                    }
            }
        }
    }
};

__device__ __forceinline__ void ph_rope(const OP& p, int bid, int nb) {
    const long nitems = (long)NT * 12 * 4;
    for (long it = (long)bid * 512 + tid_(); it < nitems; it += (long)nb * 512) {
        const int j = (int)(it & 3); const long hvi = it >> 2; const int t = (int)(hvi / 12), hv = (int)(hvi % 12);
        const bf16_t* src; bf16_t* dst;
        if (hv < 8) { src = p.qn() + (size_t)t * 512 + hv * 64; dst = p.qr() + (size_t)t * 512 + hv * 64; }
        else if (hv < 10) { src = p.ksv() + (size_t)t * 256 + (hv - 8) * 64; dst = (bf16_t*)src; }
        else { src = p.kwv() + (size_t)t * 256 + (hv - 10) * 64; dst = (bf16_t*)src; }
        const u32x4 a = *(const u32x4*)(src + 8 * j), b = *(const u32x4*)(src + 32 + 8 * j);
        const float* rp = p.rope() + ((size_t)t * 32 + 8 * j) * 2;
        const f32x4 c0 = *(const f32x4*)(rp), c1 = *(const f32x4*)(rp + 4), c2 = *(const f32x4*)(rp + 8), c3 = *(const f32x4*)(rp + 12);
        const float cs[8] = {c0.x, c0.z, c1.x, c1.z, c2.x, c2.z, c3.x, c3.z}, sn[8] = {c0.y, c0.w, c1.y, c1.w, c2.y, c2.w, c3.y, c3.w};
        const unsigned aw[4] = {a.x, a.y, a.z, a.w}, bw[4] = {b.x, b.y, b.z, b.w};
        unsigned oa[4], ob[4];
#pragma unroll
        for (int k = 0; k < 4; ++k) {
            const float x1l = __uint_as_float(aw[k] << 16), x1h = __uint_as_float(aw[k] & 0xffff0000u), x2l = __uint_as_float(bw[k] << 16), x2h = __uint_as_float(bw[k] & 0xffff0000u);
            oa[k] = pk2(x1l * cs[2 * k] - x2l * sn[2 * k], x1h * cs[2 * k + 1] - x2h * sn[2 * k + 1]);
            ob[k] = pk2(x2l * cs[2 * k] + x1l * sn[2 * k], x2h * cs[2 * k + 1] + x1h * sn[2 * k + 1]);
        }
        *(u32x4*)(dst + 8 * j) = (u32x4){oa[0], oa[1], oa[2], oa[3]}; *(u32x4*)(dst + 32 + 8 * j) = (u32x4){ob[0], ob[1], ob[2], ob[3]};
    }
}
struct CmpSched {
    const char* kvraw; const char* w1; int K, kstepA, ldb; int G, c;
    __device__ __forceinline__ bool next(int i, pg8::Unit& u) const { const int L = i * G + c; if (L >= 128) return false; u.e = L; u.pm = L & 15; u.pn = 0; return true; }
    __device__ __forceinline__ const char* a_ptr(const pg8::Unit& u) const { return kvraw; }
    __device__ __forceinline__ void a_off(const pg8::Unit& u, int tid, unsigned (&off)[2][2]) const {
        const int kv = u.e >> 6, s = (u.e >> 4) & 3;
#pragma unroll
        for (int i = 0; i < 2; ++i) { int R, C; pg8::stage_rc(tid * 16 + i * 8192, R, C);
#pragma unroll
            for (int h = 0; h < 2; ++h) { int r = u.pm * 256 + h * 128 + R; r = r < 4080 ? r : 4079; const int b = r / 510, rem = r - b * 510, n = rem >> 1, hh = rem & 1;
                off[h][i] = (unsigned)(((b * NS + 16 * n + 8 * s) * 256 + kv * 128 + hh * 64 + C) * 2); } }
    }
    __device__ __forceinline__ const char* b_ptr(const pg8::Unit& u) const { const int kv = u.e >> 6, s = (u.e >> 4) & 3; return w1 + ((size_t)kv * 256 * 2048 + s * 512) * 2; }
};
struct EpiCmp {
    static constexpr bool PERM = false;
    float* cpart;
    __device__ __forceinline__ void operator()(const f32x4 (&acc)[2][2][4][2], const pg8::Unit& u, int wr, int wc, int fr, int fq) const {
        float* base = cpart + (size_t)(u.e >> 4) * 4096 * 256;
        const int row0 = u.pm * 256 + wr * 64 + fr, col0 = wc * 32 + 4 * fq;
#pragma unroll
        for (int ai = 0; ai < 2; ++ai)
#pragma unroll
            for (int m = 0; m < 4; ++m) { float* rowp = base + (size_t)(row0 + ai * 128 + m * 16) * 256 + col0;
#pragma unroll
                for (int bj = 0; bj < 2; ++bj)
#pragma unroll
                    for (int n = 0; n < 2; ++n) *(f32x4*)(rowp + bj * 128 + n * 16) = acc[ai][bj][m][n]; }
    }
};
__device__ __forceinline__ void ph_cmp2(const OP& p, int l, LAS unsigned char* lds, int bid, int nb) {
    const int lane = tid_() & 63, wave = tid_() >> 6;
    LAS float* hid = (LAS float*)lds + wave * 256;
    for (int it = bid * 8 + wave; it < 2 * 4096; it += nb * 8) {
        const int kv = it >> 12, r = it & 4095;
        bf16_t* dstbase = kv ? p.vc() : p.kc();
        if (r >= 4080) { if (r < 4088) { const int b = r - 4080; dstbase[((size_t)b * 256 + 255) * 128 + lane] = 0; dstbase[((size_t)b * 256 + 255) * 128 + 64 + lane] = 0; } continue; }
        const float* cp = p.cpart() + ((size_t)kv * 4 * 4096 + r) * 256 + lane * 4;
        f32x4 a = *(const f32x4*)(p.bias1() + (l * 2 + kv) * 256 + lane * 4);
#pragma unroll
        for (int s = 0; s < 4; ++s) a += *(const f32x4*)(cp + (size_t)s * 4096 * 256);
        asm volatile("s_waitcnt lgkmcnt(0)" ::: "memory");
        *(LAS f32x4*)(hid + lane * 4) = (f32x4){fgelu(a.x), fgelu(a.y), fgelu(a.z), fgelu(a.w)};
        asm volatile("s_waitcnt lgkmcnt(0)" ::: "memory");
        const float* w2 = (kv ? p.w2v : p.w2k) + (size_t)l * 256 * 64 + lane;
        float o = 0.f;
#pragma unroll 8
        for (int f = 0; f < 256; ++f) o = fmaf(hid[f], w2[f * 64], o);
        const int b = r / 510, rem = r - b * 510, n = rem >> 1, hh = rem & 1;
        if (!kv) { float ss = o * o;
#pragma unroll
            for (int x = 32; x >= 1; x >>= 1) ss += __shfl_xor(ss, x);
            o = o * rsqrtf(ss * (1.f / 64.f) + 1e-6f) * p.k_gain[l * 64 + lane]; }
        dstbase[((size_t)b * 256 + n) * 128 + hh * 64 + lane] = (bf16_t)f2bf(o);
    }
}

#define GM_PITCH 520
typedef short v4i16_t __attribute__((ext_vector_type(4)));
__device__ __forceinline__ s16x4 ds_tr16(const LAS bf16_t* ptr) { return __builtin_bit_cast(s16x4, __builtin_amdgcn_ds_read_tr16_b64_v4i16((LAS v4i16_t*)ptr)); }
__device__ __forceinline__ void ph_gmlp(const OP& p, int l, LAS unsigned char* lds, int bid, int nb) {
    const int tid = tid_(), lane = tid & 63, wave = tid >> 6;
    LAS bf16_t* vn = (LAS bf16_t*)lds;
    for (int ch = bid; ch < NT / 128; ch += nb) {
        const size_t base = (size_t)ch * 128;
        __syncthreads();
        f32x4 g0 = *(const f32x4*)(p.ln_g + l * 512 + lane * 8), g1 = *(const f32x4*)(p.ln_g + l * 512 + lane * 8 + 4), b0 = *(const f32x4*)(p.ln_b + l * 512 + lane * 8), b1 = *(const f32x4*)(p.ln_b + l * 512 + lane * 8 + 4);
#pragma unroll 4
        for (int tt = 0; tt < 16; ++tt) {
            const int t = wave * 16 + tt;
            const u32x4 raw = *(const u32x4*)(p.v() + (base + t) * 512 + lane * 8);
            float x[8] = {__uint_as_float(raw.x << 16), __uint_as_float(raw.x & 0xffff0000u), __uint_as_float(raw.y << 16), __uint_as_float(raw.y & 0xffff0000u),
                          __uint_as_float(raw.z << 16), __uint_as_float(raw.z & 0xffff0000u), __uint_as_float(raw.w << 16), __uint_as_float(raw.w & 0xffff0000u)};
            float s = 0.f;
#pragma unroll
            for (int i = 0; i < 8; ++i) s += x[i];
#pragma unroll
            for (int o = 32; o >= 1; o >>= 1) s += __shfl_xor(s, o);
            const float mu = s * (1.f / 512.f); float q = 0.f;
#pragma unroll
            for (int i = 0; i < 8; ++i) { x[i] -= mu; q += x[i] * x[i]; }
#pragma unroll
            for (int o = 32; o >= 1; o >>= 1) q += __shfl_xor(q, o);
            const float rstd = rsqrtf(q * (1.f / 512.f) + 1e-6f);
            u32x4 w; w.x = pk2(x[0] * rstd * g0.x + b0.x, x[1] * rstd * g0.y + b0.y); w.y = pk2(x[2] * rstd * g0.z + b0.z, x[3] * rstd * g0.w + b0.w);
            w.z = pk2(x[4] * rstd * g1.x + b1.x, x[5] * rstd * g1.y + b1.y); w.w = pk2(x[6] * rstd * g1.z + b1.z, x[7] * rstd * g1.w + b1.w);
            *(LAS u32x4*)(vn + t * GM_PITCH + lane * 8) = w;
        }
        __syncthreads();
        const int g = wave, r32 = lane & 31, hi = lane >> 5;
        const bf16_t* wsg = p.wsc() + ((size_t)l * 8 + g) * 128 * 128;
        const LAS bf16_t* bbase = vn + (8 * hi + ((lane & 15) >> 2)) * GM_PITCH + g * 64 + 16 * ((lane >> 4) & 1) + 4 * (lane & 3);
#pragma unroll 1
        for (int mt = 0; mt < 4; ++mt) {
            f32x16 acc0, acc1;
#pragma unroll
            for (int i = 0; i < 16; ++i) { acc0[i] = 0.f; acc1[i] = 0.f; }
            for (int ks = 0; ks < 2 * (mt + 1); ++ks) {
                const bf16x8 a = *(const bf16x8*)(wsg + (size_t)(32 * mt + r32) * 128 + 16 * ks + 8 * hi);
                const LAS bf16_t* bp = bbase + 16 * ks * GM_PITCH;
                const s16x4 b00 = ds_tr16(bp), b01 = ds_tr16(bp + 4 * GM_PITCH), b10 = ds_tr16(bp + 32), b11 = ds_tr16(bp + 4 * GM_PITCH + 32);
                const bf16x8 bf0 = {b00[0], b00[1], b00[2], b00[3], b01[0], b01[1], b01[2], b01[3]}, bf1 = {b10[0], b10[1], b10[2], b10[3], b11[0], b11[1], b11[2], b11[3]};
                acc0 = __builtin_amdgcn_mfma_f32_32x32x16_bf16(a, bf0, acc0, 0, 0, 0);
                acc1 = __builtin_amdgcn_mfma_f32_32x32x16_bf16(a, bf1, acc1, 0, 0, 0);
            }
#pragma unroll
            for (int rg = 0; rg < 16; ++rg) {
                const int t = 32 * mt + (rg & 3) + 8 * (rg >> 2) + 4 * hi;
                const float bsv = p.gm_bs[(l * 8 + g) * 128 + t];
                const size_t o0 = (base + t) * 512 + g * 64 + r32;
                const float u0 = bf2f(p.u()[o0]), u1 = bf2f(p.u()[o0 + 32]);
                p.ogm()[o0] = (bf16_t)f2bf(u0 * (acc0[rg] + bsv)); p.ogm()[o0 + 32] = (bf16_t)f2bf(u1 * (acc1[rg] + bsv));
            }
        }
    }
    __syncthreads();
}
#define AT_PITCH 144
#define AT_TILE (64 * AT_PITCH)
#define AT_IMP (4 * AT_TILE)
#define AT_SELM (AT_IMP + 64 * 65 * 4)
#define AT_OST (AT_SELM + 1024)
#define AT_LOG2E 1.4426950408889634f
#define LDS_ADD(ptr, val) (void)__hip_atomic_fetch_add((ptr), (val), __ATOMIC_RELAXED, __HIP_MEMORY_SCOPE_WORKGROUP)
enum { AM_CMP1 = 0, AM_CMP2 = 1, AM_SEL = 2, AM_WIN = 3 };

struct AttnWave {
    f32x16 o0, o1;
    float M, L;
};

template <int MODE>
__device__ __forceinline__ void attn_tile(AttnWave& W, const bf16x8 (&qt)[4], const LAS unsigned char* Kl, const LAS unsigned char* Vl, int lane, int r32, int hi,
                                          int lim, bool diag, bool ledge, bool lanesel, float invl, LAS unsigned* imp_row, int jbase) {
    f32x16 s0, s1;
#pragma unroll
    for (int i = 0; i < 16; ++i) { s0[i] = 0.f; s1[i] = 0.f; }
#pragma unroll
    for (int ks = 0; ks < 4; ++ks) {
        const bf16x8 a0 = *(const LAS bf16x8*)(Kl + r32 * AT_PITCH + (16 * ks + 8 * hi) * 2);
        const bf16x8 a1 = *(const LAS bf16x8*)(Kl + (32 + r32) * AT_PITCH + (16 * ks + 8 * hi) * 2);
        s0 = __builtin_amdgcn_mfma_f32_32x32x16_bf16(a0, qt[ks], s0, 0, 0, 0);
        s1 = __builtin_amdgcn_mfma_f32_32x32x16_bf16(a1, qt[ks], s1, 0, 0, 0);
    }
    const float NEG = -INFINITY;
    if (MODE == AM_CMP1 || MODE == AM_CMP2) {
#pragma unroll
        for (int r = 0; r < 16; ++r) { const int k0 = (r & 3) + 8 * (r >> 2) + 4 * hi; s0[r] = (k0 < lim) ? s0[r] : NEG; s1[r] = (32 + k0 < lim) ? s1[r] : NEG; }
    } else {
        if (MODE == AM_SEL && !lanesel) {
#pragma unroll
            for (int r = 0; r < 16; ++r) { s0[r] = NEG; s1[r] = NEG; }
        }
        if (diag) {
#pragma unroll
            for (int r = 0; r < 16; ++r) { const int k0 = (r & 3) + 8 * (r >> 2) + 4 * hi; s0[r] = (k0 <= lim) ? s0[r] : NEG; s1[r] = (32 + k0 <= lim) ? s1[r] : NEG; }
        }
        if (MODE == AM_WIN && ledge) {
#pragma unroll
            for (int r = 0; r < 16; ++r) { const int k0 = (r & 3) + 8 * (r >> 2) + 4 * hi; s0[r] = (k0 > lim) ? s0[r] : NEG; s1[r] = (32 + k0 > lim) ? s1[r] : NEG; }
        }
    }
    float Mn = W.M;
    if (MODE != AM_CMP2) {
        float mx = s0[0];
#pragma unroll
        for (int r = 1; r < 16; ++r) mx = fmaxf(mx, s0[r]);
#pragma unroll
        for (int r = 0; r < 16; ++r) mx = fmaxf(mx, s1[r]);
        mx = fmaxf(mx, __shfl_xor(mx, 32));
        Mn = fmaxf(W.M, mx * AT_LOG2E);
    }
    float ps = 0.f;
#pragma unroll
    for (int r = 0; r < 16; ++r) { s0[r] = __builtin_amdgcn_exp2f(fmaf(s0[r], AT_LOG2E, -Mn)); s1[r] = __builtin_amdgcn_exp2f(fmaf(s1[r], AT_LOG2E, -Mn)); ps += s0[r] + s1[r]; }
    if (MODE == AM_CMP1) {
        ps += __shfl_xor(ps, 32);
        const float alpha = __builtin_amdgcn_exp2f(W.M - Mn);
        W.L = W.L * alpha + ps; W.M = Mn;
        return;
    }
    if (MODE == AM_CMP2) {
#pragma unroll
        for (int r = 0; r < 16; ++r) { s0[r] *= invl; s1[r] *= invl; }
#pragma unroll
        for (int i = 0; i < 4; ++i) {
            const float q0 = (s0[4 * i] + s0[4 * i + 1]) + (s0[4 * i + 2] + s0[4 * i + 3]), q1 = (s1[4 * i] + s1[4 * i + 1]) + (s1[4 * i + 2] + s1[4 * i + 3]);
            const int j0 = jbase + 2 * i + hi, j1 = j0 + 8;
            LDS_ADD(imp_row + j0, (unsigned)(q0 * 268435456.f + 0.5f)); LDS_ADD(imp_row + j1, (unsigned)(q1 * 268435456.f + 0.5f));
            LDS_ADD(imp_row + j0 + 1, (unsigned)(s0[4 * i + 3] * 268435456.f + 0.5f)); if (j1 + 1 < 64) LDS_ADD(imp_row + j1 + 1, (unsigned)(s1[4 * i + 3] * 268435456.f + 0.5f));
        }
    } else {
        ps += __shfl_xor(ps, 32);
        const float alpha = __builtin_amdgcn_exp2f(W.M - Mn);
        W.L = W.L * alpha + ps; W.M = Mn;
#pragma unroll
        for (int r = 0; r < 16; ++r) { W.o0[r] *= alpha; W.o1[r] *= alpha; }
    }
    const LAS unsigned char* vb = Vl + ((lane & 15) >> 2) * AT_PITCH + (16 * ((lane >> 4) & 1) + 4 * (lane & 3)) * 2 + (4 * hi) * AT_PITCH;
#pragma unroll
    for (int mt = 0; mt < 2; ++mt)
#pragma unroll
        for (int s = 0; s < 2; ++s) {
            const f32x16& sv = mt ? s1 : s0;
            bf16x8 pb;
            { const unsigned w0 = pk2(sv[8 * s + 0], sv[8 * s + 1]), w1 = pk2(sv[8 * s + 2], sv[8 * s + 3]), w2 = pk2(sv[8 * s + 4], sv[8 * s + 5]), w3 = pk2(sv[8 * s + 6], sv[8 * s + 7]);
              const u32x4 wv = {w0, w1, w2, w3}; pb = __builtin_bit_cast(bf16x8, wv); }
            const LAS unsigned char* vk = vb + (32 * mt + 16 * s) * AT_PITCH;
            const s16x4 a00 = ds_tr16((const LAS bf16_t*)(vk)), a01 = ds_tr16((const LAS bf16_t*)(vk + 8 * AT_PITCH));
            const s16x4 a10 = ds_tr16((const LAS bf16_t*)(vk + 64)), a11 = ds_tr16((const LAS bf16_t*)(vk + 8 * AT_PITCH + 64));
            const bf16x8 av0 = {a00[0], a00[1], a00[2], a00[3], a01[0], a01[1], a01[2], a01[3]}, av1 = {a10[0], a10[1], a10[2], a10[3], a11[0], a11[1], a11[2], a11[3]};
            W.o0 = __builtin_amdgcn_mfma_f32_32x32x16_bf16(av0, pb, W.o0, 0, 0, 0);
            W.o1 = __builtin_amdgcn_mfma_f32_32x32x16_bf16(av1, pb, W.o1, 0, 0, 0);
        }
}

__device__ __forceinline__ void at_store_tile(LAS unsigned char* lds, int buf, int tid, const u32x4& kr, const u32x4& vr) {
    const int key = tid >> 3, ch = tid & 7;
    *(LAS u32x4*)(lds + (2 * buf) * AT_TILE + key * AT_PITCH + ch * 16) = kr;
    *(LAS u32x4*)(lds + (2 * buf + 1) * AT_TILE + key * AT_PITCH + ch * 16) = vr;
}

__device__ __forceinline__ void ph_attn(const OP& p, LAS unsigned char* lds, int bid, int nb) {
    const int tid = tid_(), lane = tid & 63, wave = tid >> 6, r32 = lane & 31, hi = lane >> 5;
    const int g = wave >> 1, qh = wave & 1, qloc = 32 * qh + r32;
    LAS unsigned* imp = (LAS unsigned*)(lds + AT_IMP);
    LAS unsigned* selm = (LAS unsigned*)(lds + AT_SELM);
    LAS unsigned char* ost = lds + AT_OST + wave * (32 * AT_PITCH);
    const int key_ld = tid >> 3, ch_ld = tid & 7;
    for (int round = 0;; ++round) {
        const int idx = round * nb + ((round & 1) ? (nb - 1 - bid) : bid);
        if (idx >= 1024) break;
        const int qb = 63 - (idx >> 4), b = (idx & 15) >> 1, kvh = idx & 1, hq = kvh * 4 + g;
        const int t = qb * 64 + qloc; const size_t tok = (size_t)b * NS + t;
        __syncthreads();
        for (int i = tid; i < 64 * 65; i += 512) imp[i] = 0u;
        bf16x8 qt[4];
#pragma unroll
        for (int ks = 0; ks < 4; ++ks) qt[ks] = *(const bf16x8*)(p.qn() + tok * 512 + hq * 64 + 16 * ks + 8 * hi);
        int nvis = t >= 31 ? ((t - 31) >> 4) + 1 : 0; nvis = nvis > NCMP ? NCMP : nvis;
        const int nvmax = (qb * 64 + 63 - 31) / 16 + 1 > NCMP ? NCMP : (qb * 64 + 63 - 31) / 16 + 1;
        const int ntc = (nvmax + 63) >> 6;
        const bf16_t* kcb = p.kc() + (size_t)b * 256 * 128 + kvh * 64 + ch_ld * 8;
        const bf16_t* vcb = p.vc() + (size_t)b * 256 * 128 + kvh * 64 + ch_ld * 8;
        AttnWave W;
        W.M = -1e30f; W.L = 0.f;
#pragma unroll
        for (int i = 0; i < 16; ++i) { W.o0[i] = 0.f; W.o1[i] = 0.f; }
        f32x16 out0, out1;
#pragma unroll
        for (int i = 0; i < 16; ++i) { out0[i] = 0.f; out1[i] = 0.f; }
        const float gate0 = p.gates()[tok * 32 + hq * 3 + 0], gate1 = p.gates()[tok * 32 + hq * 3 + 1], gate2 = p.gates()[tok * 32 + hq * 3 + 2];
        u32x4 kr, vr;
        kr = *(const u32x4*)(kcb + (size_t)key_ld * 128); vr = *(const u32x4*)(vcb + (size_t)key_ld * 128);
        at_store_tile(lds, 0, tid, kr, vr);
        __syncthreads();
        float invl = 0.f;
        for (int i = 0; i < 2 * ntc; ++i) {
            const int kt = i < ntc ? i : i - ntc, nx = i + 1, ktn = nx < ntc ? nx : nx - ntc;
            if (nx < 2 * ntc) { kr = *(const u32x4*)(kcb + (size_t)(64 * ktn + key_ld) * 128); vr = *(const u32x4*)(vcb + (size_t)(64 * ktn + key_ld) * 128); }
            const LAS unsigned char* Kl = lds + (2 * (i & 1)) * AT_TILE; const LAS unsigned char* Vl = Kl + AT_TILE;
            if (i < ntc) attn_tile<AM_CMP1>(W, qt, Kl, Vl, lane, r32, hi, nvis - 64 * kt, false, false, true, 0.f, nullptr, 0);
            else { if (i == ntc) invl = 1.0f / fmaxf(W.L, 1e-30f);
                   attn_tile<AM_CMP2>(W, qt, Kl, Vl, lane, r32, hi, nvis - 64 * kt, false, false, true, invl, imp + qloc * 65, 16 * kt); }
            if (nx < 2 * ntc) at_store_tile(lds, nx & 1, tid, kr, vr);
            __syncthreads();
        }
#pragma unroll
        for (int r = 0; r < 16; ++r) { out0[r] = gate0 * W.o0[r]; out1[r] = gate0 * W.o1[r]; }
        if (tid < 64) {
            const LAS unsigned* row = imp + tid * 65;
            unsigned long long mask = 0ull; const int rounds = qb + 1 < 16 ? qb + 1 : 16;
            for (int it = 0; it < rounds; ++it) {
                int best = -1; unsigned bv = 0u;
                for (int j = 0; j <= qb; ++j) {
                    if ((mask >> j) & 1ull) continue;
                    const unsigned v = (j == 0 || j == qb || j == qb - 1) ? 0xffffffffu : row[j];
                    if (best < 0 || v > bv) { best = j; bv = v; }
                }
                mask |= 1ull << best;
            }
            selm[2 * tid] = (unsigned)mask; selm[2 * tid + 1] = (unsigned)(mask >> 32);
            unsigned long long um = mask;
#pragma unroll
            for (int o = 32; o >= 1; o >>= 1) um |= __shfl_xor(um, o);
            if (tid == 0) { selm[128] = (unsigned)um; selm[129] = (unsigned)(um >> 32); }
        }
        __syncthreads();
        const unsigned long long mymask = (unsigned long long)selm[2 * qloc] | ((unsigned long long)selm[2 * qloc + 1] << 32);
        const unsigned long long umask = (unsigned long long)selm[128] | ((unsigned long long)selm[129] << 32);
#pragma unroll
        for (int ks = 0; ks < 4; ++ks) qt[ks] = *(const bf16x8*)(p.qr() + tok * 512 + hq * 64 + 16 * ks + 8 * hi);
        {
            W.M = -1e30f; W.L = 0.f;
#pragma unroll
            for (int i = 0; i < 16; ++i) { W.o0[i] = 0.f; W.o1[i] = 0.f; }
            const bf16_t* kb = p.ksv() + (size_t)b * NS * 256 + kvh * 64 + ch_ld * 8;
            unsigned long long rem = umask;
            int j = __builtin_ctzll(rem); rem &= rem - 1;
            kr = *(const u32x4*)(kb + (size_t)(64 * j + key_ld) * 256); vr = *(const u32x4*)(kb + (size_t)(64 * j + key_ld) * 256 + 128);
            at_store_tile(lds, 0, tid, kr, vr);
            __syncthreads();
            for (int i = 0;; ++i) {
                const bool more = rem != 0ull; int jn = 0;
                if (more) { jn = __builtin_ctzll(rem); rem &= rem - 1; kr = *(const u32x4*)(kb + (size_t)(64 * jn + key_ld) * 256); vr = *(const u32x4*)(kb + (size_t)(64 * jn + key_ld) * 256 + 128); }
                const LAS unsigned char* Kl = lds + (2 * (i & 1)) * AT_TILE; const LAS unsigned char* Vl = Kl + AT_TILE;
                attn_tile<AM_SEL>(W, qt, Kl, Vl, lane, r32, hi, qloc, j == qb, false, ((mymask >> j) & 1ull) != 0ull, 0.f, nullptr, 0);
                if (more) at_store_tile(lds, (i + 1) & 1, tid, kr, vr);
                __syncthreads();
                if (!more) break;
                j = jn;
            }
            const float sc = gate1 / fmaxf(W.L, 1e-30f);
#pragma unroll
            for (int r = 0; r < 16; ++r) { out0[r] = fmaf(sc, W.o0[r], out0[r]); out1[r] = fmaf(sc, W.o1[r], out1[r]); }
        }
        {
            W.M = -1e30f; W.L = 0.f;
#pragma unroll
            for (int i = 0; i < 16; ++i) { W.o0[i] = 0.f; W.o1[i] = 0.f; }
            const bf16_t* kb = p.kwv() + (size_t)b * NS * 256 + kvh * 64 + ch_ld * 8;
            const int j0 = qb - 8 > 0 ? qb - 8 : 0;
            kr = *(const u32x4*)(kb + (size_t)(64 * j0 + key_ld) * 256); vr = *(const u32x4*)(kb + (size_t)(64 * j0 + key_ld) * 256 + 128);
            at_store_tile(lds, 0, tid, kr, vr);
            __syncthreads();
            for (int j = j0; j <= qb; ++j) {
                const int i = j - j0;
                if (j < qb) { kr = *(const u32x4*)(kb + (size_t)(64 * (j + 1) + key_ld) * 256); vr = *(const u32x4*)(kb + (size_t)(64 * (j + 1) + key_ld) * 256 + 128); }
                const LAS unsigned char* Kl = lds + (2 * (i & 1)) * AT_TILE; const LAS unsigned char* Vl = Kl + AT_TILE;
                attn_tile<AM_WIN>(W, qt, Kl, Vl, lane, r32, hi, qloc, j == qb, j == qb - 8, true, 0.f, nullptr, 0);
                if (j < qb) at_store_tile(lds, (i + 1) & 1, tid, kr, vr);
                __syncthreads();
            }
            const float sc = gate2 / fmaxf(W.L, 1e-30f);
#pragma unroll
            for (int r = 0; r < 16; ++r) { out0[r] = fmaf(sc, W.o0[r], out0[r]); out1[r] = fmaf(sc, W.o1[r], out1[r]); }
        }
#pragma unroll
        for (int i = 0; i < 4; ++i) {
            u32x2 w0 = {pk2(out0[4 * i], out0[4 * i + 1]), pk2(out0[4 * i + 2], out0[4 * i + 3])}, w1 = {pk2(out1[4 * i], out1[4 * i + 1]), pk2(out1[4 * i + 2], out1[4 * i + 3])};
            *(LAS u32x2*)(ost + r32 * AT_PITCH + (8 * i + 4 * hi) * 2) = w0;
            *(LAS u32x2*)(ost + r32 * AT_PITCH + (32 + 8 * i + 4 * hi) * 2) = w1;
        }
        asm volatile("s_waitcnt lgkmcnt(0)" ::: "memory");
#pragma unroll
        for (int i = 0; i < 4; ++i) {
            const int row = 8 * i + (lane >> 3), c16 = lane & 7;
            const u32x4 v = *(const LAS u32x4*)(ost + row * AT_PITCH + c16 * 16);
            *(u32x4*)(p.onsa() + ((size_t)b * NS + qb * 64 + 32 * qh + row) * 512 + hq * 64 + c16 * 8) = v;
        }
    }
    __syncthreads();
}
template <int PASS> struct EpiProj {
    static constexpr bool PERM = true;
    bf16_t* merged; const bf16_t* gate;
    __device__ __forceinline__ void operator()(const f32x4 (&acc)[2][2][4][2], const pg8::Unit& u, int wr, int wc, int fr, int fq) const {
        const int row0 = u.pm * 256 + wr * 64 + fr, col0 = u.pn * 256 + wc * 32 + 8 * fq;
#pragma unroll
        for (int ai = 0; ai < 2; ++ai)
#pragma unroll
            for (int m = 0; m < 4; ++m) {
                const size_t ro = (size_t)(row0 + ai * 128 + m * 16) * ND + col0;
                u32x4 gv[2], mv[2];
#pragma unroll
                for (int bj = 0; bj < 2; ++bj) { gv[bj] = *(const u32x4*)(gate + ro + bj * 128); if (PASS == 2) mv[bj] = *(const u32x4*)(merged + ro + bj * 128); }
#pragma unroll
                for (int bj = 0; bj < 2; ++bj) {
                    const f32x4 v0 = acc[ai][bj][m][0], v1 = acc[ai][bj][m][1];
                    const unsigned gw[4] = {gv[bj].x, gv[bj].y, gv[bj].z, gv[bj].w};
                    float o[8] = {v0.x, v0.y, v0.z, v0.w, v1.x, v1.y, v1.z, v1.w};
#pragma unroll
                    for (int k = 0; k < 4; ++k) { o[2 * k] *= __uint_as_float(gw[k] << 16); o[2 * k + 1] *= __uint_as_float(gw[k] & 0xffff0000u); }
                    if (PASS == 2) { const unsigned mw[4] = {mv[bj].x, mv[bj].y, mv[bj].z, mv[bj].w};
#pragma unroll
                        for (int k = 0; k < 4; ++k) { o[2 * k] += __uint_as_float(mw[k] << 16); o[2 * k + 1] += __uint_as_float(mw[k] & 0xffff0000u); } }
                    u32x4 w; w.x = pk2(o[0], o[1]); w.y = pk2(o[2], o[3]); w.z = pk2(o[4], o[5]); w.w = pk2(o[6], o[7]);
                    *(u32x4*)(merged + ro + bj * 128) = w;
                }
            }
    }
};
struct EpiOut {
    static constexpr bool PERM = false;
    const float* xin; float* out; const float* gt;
    __device__ __forceinline__ void operator()(const f32x4 (&acc)[2][2][4][2], const pg8::Unit& u, int wr, int wc, int fr, int fq) const {
        const int row0 = u.pm * 256 + wr * 64 + fr, col0 = u.pn * 256 + wc * 32 + 4 * fq;
        const float* gp = gt + (size_t)(u.pm >> 4) * 6144 + col0;
        f32x4 g4[2][2];
#pragma unroll
        for (int bj = 0; bj < 2; ++bj)
#pragma unroll
            for (int n = 0; n < 2; ++n) g4[bj][n] = *(const f32x4*)(gp + bj * 128 + n * 16);
#pragma unroll
        for (int ai = 0; ai < 2; ++ai)
#pragma unroll
            for (int m = 0; m < 4; ++m) {
                const size_t ro = (size_t)(row0 + ai * 128 + m * 16) * ND + col0;
                f32x4 xv[2][2];
#pragma unroll
                for (int bj = 0; bj < 2; ++bj)
#pragma unroll
                    for (int n = 0; n < 2; ++n) xv[bj][n] = *(const f32x4*)(xin + ro + bj * 128 + n * 16);
#pragma unroll
                for (int bj = 0; bj < 2; ++bj)
#pragma unroll
                    for (int n = 0; n < 2; ++n) *(f32x4*)(out + ro + bj * 128 + n * 16) = xv[bj][n] + g4[bj][n] * acc[ai][bj][m][n];
            }
    }
};

struct EpiRouter {
    static constexpr bool PERM = true;
    float* logits; bf16_t* sact;
    __device__ __forceinline__ void operator()(const f32x4 (&acc)[2][2][4][2], const pg8::Unit& u, int wr, int wc, int fr, int fq) const {
        const int row0 = u.pm * 256 + wr * 64 + fr, cw = wc * 32 + 8 * fq;
        if (u.pn == 0) {
#pragma unroll
            for (int ai = 0; ai < 2; ++ai)
#pragma unroll
                for (int m = 0; m < 4; ++m) { float* rp = logits + (size_t)(row0 + ai * 128 + m * 16) * NE + cw;
#pragma unroll
                    for (int bj = 0; bj < 2; ++bj) { *(f32x4*)(rp + bj * 128) = acc[ai][bj][m][0]; *(f32x4*)(rp + bj * 128 + 4) = acc[ai][bj][m][1]; } }
        } else {
#pragma unroll
            for (int ai = 0; ai < 2; ++ai)
#pragma unroll
                for (int m = 0; m < 4; ++m) {
                    const f32x4 g0 = acc[ai][0][m][0], g1 = acc[ai][0][m][1], u0 = acc[ai][1][m][0], u1 = acc[ai][1][m][1];
                    u32x4 w; w.x = pk2(fsilu(g0.x) * u0.x, fsilu(g0.y) * u0.y); w.y = pk2(fsilu(g0.z) * u0.z, fsilu(g0.w) * u0.w);
                    w.z = pk2(fsilu(g1.x) * u1.x, fsilu(g1.y) * u1.y); w.w = pk2(fsilu(g1.z) * u1.z, fsilu(g1.w) * u1.w);
                    *(u32x4*)(sact + (size_t)(row0 + ai * 128 + m * 16) * 256 + (u.pn - 1) * 128 + cw) = w;
                }
        }
    }
};

__device__ __forceinline__ void ph_topk(const OP& p, int l, int bid, int nb) {
    const int lane = tid_() & 63, w = tid_() >> 6;
    const float* lg = p.logits(); int* idxp = p.idx(); float* wtp = p.wts(); int* cnt = p.counts();
    for (int t = bid * 8 + w; t < NT; t += nb * 8) {
        float aff[4], key[4]; bool used[4];
#pragma unroll
        for (int i = 0; i < 4; ++i) { const int e = i * 64 + lane; aff[i] = 1.0f / (1.0f + expf(-lg[(size_t)t * NE + e])); key[i] = aff[i] + p.b_router[l * NE + e]; used[i] = false; }
        float topv[8]; int tope[8]; float sum = 0.f;
#pragma unroll
        for (int r = 0; r < 8; ++r) {
            float bv = -INFINITY; int be = 1 << 30; float ba = 0.f;
#pragma unroll
            for (int i = 0; i < 4; ++i) { const int e = i * 64 + lane; if (!used[i] && (key[i] > bv || (key[i] == bv && e < be))) { bv = key[i]; be = e; ba = aff[i]; } }
#pragma unroll
            for (int o = 32; o >= 1; o >>= 1) {
                const float ov = __shfl_xor(bv, o); const int oe = __shfl_xor(be, o); const float oa = __shfl_xor(ba, o);
                if (ov > bv || (ov == bv && oe < be)) { bv = ov; be = oe; ba = oa; }
            }
#pragma unroll
            for (int i = 0; i < 4; ++i) if (i * 64 + lane == be) used[i] = true;
            topv[r] = ba; tope[r] = be; sum += ba;
        }
        if (lane < 8) {
            float tv = 0.f; int te = 0;
#pragma unroll
            for (int r = 0; r < 8; ++r) if (lane == r) { tv = topv[r]; te = tope[r]; }
            idxp[(size_t)t * 8 + lane] = te; wtp[(size_t)t * 8 + lane] = tv / sum * 2.5f;
            atomicAdd(cnt + te, 1);
        }
    }
}
#define CW_NUNITS 64
__device__ __forceinline__ void ph_place(const OP& p, LAS unsigned char* lds, int bid, int nb) {
    const int tid = tid_();
    LAS int* pst = (LAS int*)lds;
    const int* cnt = p.counts(); int* rtok = p.row_tok(); float* rw = p.row_w(); int* ue = p.unit_e();
    __syncthreads();
    if (tid < 256) pst[tid] = (cnt[tid] + 255) & ~255;
    __syncthreads();
    if (tid == 0) { int run = 0; for (int e = 0; e < NE; ++e) { const int v = pst[e]; pst[e] = run; run += v; } pst[NE] = run; }
    __syncthreads();
    if (bid == 0) {
        if (tid < 256) { for (int i = pst[tid] >> 8; i < pst[tid + 1] >> 8; ++i) ue[i] = tid; }
        if (tid == 0) p.ctl()[CW_NUNITS] = (unsigned)(pst[NE] >> 8);
    }
    for (int e = bid; e < NE; e += nb) { for (int r = pst[e] + cnt[e] + tid; r < pst[e + 1]; r += 512) { rtok[r] = 0; rw[r] = 0.f; } }
    const int* idxp = p.idx(); const float* wtp = p.wts(); int* cur = p.cursor(); int* slot = p.slot();
    for (int a = bid * 512 + tid; a < NT * 8; a += nb * 512) {
        const int e = idxp[a]; const int pos = atomicAdd(cur + e, 1); const int dest = pst[e] + pos;
        rtok[dest] = a >> 3; rw[dest] = wtp[a]; slot[a] = dest;
    }
    __syncthreads();
}

struct GatherSched {
    const char* h; const char* W; const int* row_tok; const int* unit_e; int K, kstepA, ldb; int nunits2, G, c;
    __device__ __forceinline__ bool next(int i, pg8::Unit& u) const { const int L = i * G + c; if (L >= nunits2) return false; u.pm = L >> 1; u.pn = L & 1; u.e = unit_e[u.pm]; return true; }
    __device__ __forceinline__ const char* a_ptr(const pg8::Unit&) const { return h; }
    __device__ __forceinline__ void a_off(const pg8::Unit& u, int tid, unsigned (&off)[2][2]) const {
#pragma unroll
        for (int i = 0; i < 2; ++i) { int R, C; pg8::stage_rc(tid * 16 + i * 8192, R, C);
#pragma unroll
            for (int hh = 0; hh < 2; ++hh) off[hh][i] = (unsigned)(row_tok[u.pm * 256 + hh * 128 + R] * (ND * 2) + C * 2); }
    }
    __device__ __forceinline__ const char* b_ptr(const pg8::Unit& u) const { return W + ((size_t)u.e * 512 + u.pn * 256) * ND * 2; }
};
struct EpiAct {
    static constexpr bool PERM = true;
    bf16_t* act;
    __device__ __forceinline__ void operator()(const f32x4 (&acc)[2][2][4][2], const pg8::Unit& u, int wr, int wc, int fr, int fq) const {
        const int row0 = u.pm * 256 + wr * 64 + fr, cw = u.pn * 128 + wc * 32 + 8 * fq;
#pragma unroll
        for (int ai = 0; ai < 2; ++ai)
#pragma unroll
            for (int m = 0; m < 4; ++m) {
                const f32x4 g0 = acc[ai][0][m][0], g1 = acc[ai][0][m][1], u0 = acc[ai][1][m][0], u1 = acc[ai][1][m][1];
                u32x4 w; w.x = pk2(fsilu(g0.x) * u0.x, fsilu(g0.y) * u0.y); w.y = pk2(fsilu(g0.z) * u0.z, fsilu(g0.w) * u0.w);
                w.z = pk2(fsilu(g1.x) * u1.x, fsilu(g1.y) * u1.y); w.w = pk2(fsilu(g1.z) * u1.z, fsilu(g1.w) * u1.w);
                *(u32x4*)(act + (size_t)(row0 + ai * 128 + m * 16) * 256 + cw) = w;
            }
    }
};
struct DownSched {
    const char* act; const char* W; const int* unit_e; int K, kstepA, ldb; int nunits4, G, c;
    __device__ __forceinline__ bool next(int i, pg8::Unit& u) const { const int L = i * G + c; if (L >= nunits4) return false; u.pm = L >> 2; u.pn = L & 3; u.e = unit_e[u.pm]; return true; }
    __device__ __forceinline__ const char* a_ptr(const pg8::Unit& u) const { return act + (size_t)u.pm * 256 * 512; }
    __device__ __forceinline__ void a_off(const pg8::Unit&, int tid, unsigned (&off)[2][2]) const {
#pragma unroll
        for (int i = 0; i < 2; ++i) { int R, C; pg8::stage_rc(tid * 16 + i * 8192, R, C);
#pragma unroll
            for (int hh = 0; hh < 2; ++hh) off[hh][i] = (unsigned)((hh * 128 + R) * 512 + C * 2); }
    }
    __device__ __forceinline__ const char* b_ptr(const pg8::Unit& u) const { return W + ((size_t)u.e * ND + u.pn * 256) * 256 * 2; }
};
struct EpiY {
    static constexpr bool PERM = true;
    bf16_t* y; const float* row_w;
    __device__ __forceinline__ void operator()(const f32x4 (&acc)[2][2][4][2], const pg8::Unit& u, int wr, int wc, int fr, int fq) const {
        const int row0 = u.pm * 256 + wr * 64 + fr, cw = u.pn * 256 + wc * 32 + 8 * fq;
        float rwv[2][4];
#pragma unroll
        for (int ai = 0; ai < 2; ++ai)
#pragma unroll
            for (int m = 0; m < 4; ++m) rwv[ai][m] = row_w ? row_w[row0 + ai * 128 + m * 16] : 1.0f;
#pragma unroll
        for (int ai = 0; ai < 2; ++ai)
#pragma unroll
            for (int m = 0; m < 4; ++m) {
                bf16_t* rp = y + (size_t)(row0 + ai * 128 + m * 16) * ND + cw; const float s = rwv[ai][m];
#pragma unroll
                for (int bj = 0; bj < 2; ++bj) { const f32x4 v0 = acc[ai][bj][m][0] * s, v1 = acc[ai][bj][m][1] * s;
                    u32x4 w; w.x = pk2(v0.x, v0.y); w.y = pk2(v0.z, v0.w); w.z = pk2(v1.x, v1.y); w.w = pk2(v1.z, v1.w); *(u32x4*)(rp + bj * 128) = w; }
            }
    }
};
__device__ __forceinline__ void ph_combine(const OP& p, int l, int bid, int nb) {
    const int lane = tid_() & 63, w = tid_() >> 6;
    const bf16_t* ys = p.yslot(); const bf16_t* sh = p.shout(); const int* slot = p.slot(); const float* mod = p.mod(); bf16_t* hb = p.h();
    for (int t = bid * 8 + w; t < NT; t += nb * 8) {
        const float* mb = mod + ((size_t)l * NB + (t >> 12)) * 6144;
        int sl = 0; if (lane < 8) sl = slot[(size_t)t * 8 + lane];
        f32x4 accv[4];
#pragma unroll
        for (int i = 0; i < 4; ++i) { const u32x2 s2 = *(const u32x2*)(sh + (size_t)t * ND + i * 256 + lane * 4);
            accv[i] = (f32x4){__uint_as_float(s2.x << 16), __uint_as_float(s2.x & 0xffff0000u), __uint_as_float(s2.y << 16), __uint_as_float(s2.y & 0xffff0000u)}; }
#pragma unroll
        for (int k = 0; k < 8; ++k) {
            const int r = __shfl(sl, k);
#pragma unroll
            for (int i = 0; i < 4; ++i) { const u32x2 y2 = *(const u32x2*)(ys + (size_t)r * ND + i * 256 + lane * 4);
                accv[i] += (f32x4){__uint_as_float(y2.x << 16), __uint_as_float(y2.x & 0xffff0000u), __uint_as_float(y2.y << 16), __uint_as_float(y2.y & 0xffff0000u)}; }
        }
        float ss = 0.f; f32x4 xo[4];
#pragma unroll
        for (int i = 0; i < 4; ++i) { const int cidx = i * 256 + lane * 4; const f32x4 xv = *(const f32x4*)(p.xres + (size_t)t * ND + cidx), g4 = *(const f32x4*)(mb + 5120 + cidx);
            xo[i] = xv + g4 * accv[i]; *(f32x4*)(p.xres + (size_t)t * ND + cidx) = xo[i]; ss += xo[i].x * xo[i].x + xo[i].y * xo[i].y + xo[i].z * xo[i].z + xo[i].w * xo[i].w; }
        if (l + 1 < NL) {
#pragma unroll
            for (int o = 32; o >= 1; o >>= 1) ss += __shfl_xor(ss, o);
            const float rstd = rsqrtf(ss * (1.0f / ND) + 1e-6f);
            const float* mn = mod + ((size_t)(l + 1) * NB + (t >> 12)) * 6144;
#pragma unroll
            for (int i = 0; i < 4; ++i) { const int cidx = i * 256 + lane * 4; const f32x4 sc = *(const f32x4*)(mn + 1024 + cidx), s0 = *(const f32x4*)(mn + cidx);
                u32x2 o; o.x = pk2(xo[i].x * rstd * (1.f + sc.x) + s0.x, xo[i].y * rstd * (1.f + sc.y) + s0.y); o.y = pk2(xo[i].z * rstd * (1.f + sc.z) + s0.z, xo[i].w * rstd * (1.f + sc.w) + s0.w);
                *(u32x2*)(hb + (size_t)t * ND + cidx) = o; }
        }
    }
}
#ifndef OPT_PHASES_B
#define OPT_PHASES_B \
        if (IN(OPH_CMP1)) { ph_rope(p, bid, nb); \
            { CmpSched S; S.kvraw = (const char*)p.kvraw(); S.w1 = (const char*)(p.Wt_w1() + (size_t)l * 2 * 256 * 2048); S.K = 512; S.kstepA = 512; S.ldb = 2048; S.G = nb; S.c = bid; \
              EpiCmp E{p.cpart()}; pg8::gemm_phase<EpiCmp, CmpSched, true>(lds, S, E); } \
            ph_gmlp(p, l, lds, bid, nb); SEAM(); } \
        if (IN(OPH_CMP2)) { ph_cmp2(p, l, lds, bid, nb); SEAM(); } \
        if (IN(OPH_ATTN)) { ph_attn(p, lds, bid, nb); SEAM(); } \
        if (IN(OPH_PROJ)) { \
            { pg8::DenseSched S; S.init(p.onsa(), 512, p.Wt_pn() + (size_t)l * ND * 512, NT, ND, 512, nb, bid); EpiProj<1> E{p.merged(), p.sga()}; pg8::gemm_phase<EpiProj<1>, pg8::DenseSched, true>(lds, S, E); } \
            { pg8::DenseSched S; S.init(p.ogm(), 512, p.Wt_pg() + (size_t)l * ND * 512, NT, ND, 512, nb, bid); EpiProj<2> E{p.merged(), p.sgb()}; pg8::gemm_phase<EpiProj<2>, pg8::DenseSched, true>(lds, S, E); } \
            SEAM(); } \
        if (IN(OPH_OUT)) { pg8::DenseSched S; S.init(p.merged(), ND, p.Wt_out() + (size_t)l * ND * ND, NT, ND, ND, nb, bid); \
            EpiOut E{l == 0 ? p.x : p.xres, p.xres, p.mod() + (size_t)l * NB * 6144 + 2048}; pg8::gemm_phase<EpiOut, pg8::DenseSched, true>(lds, S, E); SEAM(); } \
        if (IN(OPH_NORMF)) { ph_norm(p, p.xres, l, 3072, 4096, bid, nb); if (bid == 0) { p.counts()[tid_() & 255] = 0; p.cursor()[tid_() & 255] = 0; } SEAM(); } \
        if (IN(OPH_ROUTER)) { pg8::DenseSched S; S.init(p.h(), ND, p.Wt_rs() + (size_t)l * 768 * ND, NT, 768, ND, nb, bid); \
            EpiRouter E{p.logits(), p.sact()}; pg8::gemm_phase<EpiRouter, pg8::DenseSched, true>(lds, S, E); SEAM(); } \
        if (IN(OPH_TOPK)) { ph_topk(p, l, bid, nb); SEAM(); } \
        if (IN(OPH_PLACE)) { ph_place(p, lds, bid, nb); SEAM(); } \
        if (IN(OPH_EGU)) { GatherSched S; S.h = (const char*)p.h(); S.W = (const char*)(p.Wt_eg() + (size_t)l * NE * 512 * ND); S.row_tok = p.row_tok(); S.unit_e = p.unit_e(); S.K = ND; S.kstepA = 128; S.ldb = ND; \
            S.nunits2 = 2 * (int)__builtin_amdgcn_readfirstlane(p.ctl()[CW_NUNITS]); S.G = nb; S.c = bid; \
            EpiAct E{p.act()}; pg8::gemm_phase<EpiAct, GatherSched, true>(lds, S, E); SEAM(); } \
        if (IN(OPH_EDOWN)) { \
            { DownSched S; S.act = (const char*)p.act(); S.W = (const char*)(p.Wt_ed() + (size_t)l * NE * ND * 256); S.unit_e = p.unit_e(); S.K = 256; S.kstepA = 128; S.ldb = 256; \
              S.nunits4 = 4 * (int)__builtin_amdgcn_readfirstlane(p.ctl()[CW_NUNITS]); S.G = nb; S.c = bid; EpiY E{p.yslot(), p.row_w()}; pg8::gemm_phase<EpiY, DownSched, true>(lds, S, E); } \
            { pg8::DenseSched S; S.init(p.sact(), 256, p.Wt_ds() + (size_t)l * ND * 256, NT, ND, 256, nb, bid); EpiY E{p.shout(), nullptr}; pg8::gemm_phase<EpiY, pg8::DenseSched, true>(lds, S, E); } \
            SEAM(); } \
        if (IN(OPH_COMBINE)) { ph_combine(p, l, bid, nb); SEAM(); }
#endif
enum { OPH_PROLOGUE = 0, OPH_NORM0 = 1, OPH_Z = 2, OPH_CMP1, OPH_CMP2, OPH_ATTN, OPH_PROJ, OPH_OUT, OPH_NORMF, OPH_ROUTER, OPH_TOPK, OPH_PLACE, OPH_EGU, OPH_EDOWN, OPH_COMBINE, OPH_END };
#define CW_BAR 4096

__global__ void __launch_bounds__(512, 2) k_opt(OP p) {
    extern __shared__ __attribute__((aligned(16))) unsigned char lds_raw[];
    LAS unsigned char* lds = (LAS unsigned char*)lds_raw;
    volatile LAS unsigned* misc = (volatile LAS unsigned*)(lds + LDS_MISC);
    for (int u = tid_(); u < (LDS_BYTES - LDS_MISC) / 4; u += 512) misc[u] = 0u;
    __syncthreads();
    const bool multi = (p.ph_hi - p.ph_lo > 1) || (p.l_hi - p.l_lo > 1);
    unsigned* const ctl = p.ctl();
    XcdBarrier bar; bar.bar = ctl + CW_BAR; bar.x = 0; bar.st = misc + 8;
    if (multi) bar = xcd_barrier_post(ctl + CW_BAR, misc + 8);
    const int bid = blockIdx.x, nb = gridDim.x;
    const int lo = p.ph_lo, hi = p.ph_hi;
#define IN(k) (lo <= (k) && (k) < hi)
#define SEAM() do { if (multi) xcd_barrier(bar); } while (0)
    if (p.l_lo == 0) {
        if (IN(OPH_PROLOGUE)) { ph_prologue(p, lds, bid, nb); SEAM(); }
        if (IN(OPH_NORM0)) { ph_norm(p, p.x, 0, 0, 1024, bid, nb); SEAM(); }
    }
#define LAYER_BODY(L_) { constexpr int l = (L_); if (l >= p.l_lo && l < p.l_hi) { \
        if (IN(OPH_Z)) { \
            pg8::DenseSched S; S.init(p.h(), ND, p.Wt_in() + (size_t)l * ZPAD * ND, NT, ZPAD, ND, nb, bid); \
            if (tid_() < 128) ((LAS float*)(lds + LDS_GAIN))[tid_()] = (tid_() < 64 ? p.q_gain : p.k_gain - 64)[l * 64 + tid_()]; \
            __syncthreads(); \
            EpiZ E{&p, lds}; \
            pg8::gemm_phase<EpiZ, pg8::DenseSched, true>(lds, S, E); \
            SEAM(); \
        } \
        OPT_PHASES_B \
    } }
    LAYER_BODY(0)
    LAYER_BODY(1)
#undef IN
#undef SEAM
}

static inline size_t ws_take(size_t& off, size_t bytes) { const size_t r = off; off += (bytes + 255) & ~(size_t)255; return r; }
static void fill_inputs(OP& p, void* const* d_in, void* d_out) {
    p.x = (const float*)d_in[0]; p.c = (const float*)d_in[1]; p.pos = (const int*)d_in[2];
    p.w_mod = (const float*)d_in[3]; p.b_mod = (const float*)d_in[4]; p.w_in = (const float*)d_in[5]; p.q_gain = (const float*)d_in[6]; p.k_gain = (const float*)d_in[7];
    p.pe_k = (const float*)d_in[8]; p.pe_v = (const float*)d_in[9]; p.w1k = (const float*)d_in[10]; p.w2k = (const float*)d_in[11]; p.w1v = (const float*)d_in[12]; p.w2v = (const float*)d_in[13];
    p.ln_g = (const float*)d_in[14]; p.ln_b = (const float*)d_in[15]; p.gm_ws = (const float*)d_in[16]; p.gm_bs = (const float*)d_in[17];
    p.wpn = (const float*)d_in[18]; p.wpg = (const float*)d_in[19]; p.w_out = (const float*)d_in[20]; p.w_router = (const float*)d_in[21]; p.b_router = (const float*)d_in[22];
    p.wge = (const float*)d_in[23]; p.wue = (const float*)d_in[24]; p.wde = (const float*)d_in[25]; p.wgs = (const float*)d_in[26]; p.wus = (const float*)d_in[27]; p.wds = (const float*)d_in[28];
    p.out = (float*)d_out;
}
static int opt_grid() {
    static int grid = 0;
    if (!grid) {
        int dev = 0, cus = 0;
        (void)hipGetDevice(&dev); (void)hipDeviceGetAttribute(&cus, hipDeviceAttributeMultiprocessorCount, dev);
        (void)hipFuncSetAttribute((const void*)k_opt, hipFuncAttributeMaxDynamicSharedMemorySize, LDS_BYTES);
        int per_cu = 0; (void)hipOccupancyMaxActiveBlocksPerMultiprocessor(&per_cu, (const void*)k_opt, 512, LDS_BYTES); (void)hipGetLastError();
        grid = cus > 0 ? cus : 256;
    }
    return grid;
}
static void launch_opt(OP p, int ph_lo, int ph_hi, int l_lo, int l_hi, hipStream_t s) {
    p.ph_lo = ph_lo; p.ph_hi = ph_hi; p.l_lo = l_lo; p.l_hi = l_hi;
    hipLaunchKernelGGL(k_opt, dim3(opt_grid()), dim3(512), LDS_BYTES, s, p);
}
#if DEV_CHECK
enum { T_NONE = 0, T_GELU = 1, T_SIGMOID = 2 };
__global__ void k_cmp(const void* opt, int opt_f32, int ldo, const float* ref, int ldr, int ncols, int nrows, int tr, float scale, double* acc) {
    double num = 0.0, den = 0.0;
    const size_t n = (size_t)nrows * ncols;
    for (size_t i = (size_t)blockIdx.x * blockDim.x + threadIdx.x; i < n; i += (size_t)gridDim.x * blockDim.x) {
        const size_t r = i / ncols; const int c = (int)(i % ncols);
        float e = ref[r * ldr + c];
        if (tr == T_GELU) e = geluf_(e); else if (tr == T_SIGMOID) e = sigmoidf_(e);
        e *= scale;
        const float o = opt_f32 ? ((const float*)opt)[r * ldo + c] : bf2f(((const bf16_t*)opt)[r * ldo + c]);
        const double d = (double)o - (double)e; num += d * d; den += (double)e * (double)e;
    }
    for (int o = 32; o >= 1; o >>= 1) { num += __shfl_xor(num, o); den += __shfl_xor(den, o); }
    if ((threadIdx.x & 63) == 0) { atomicAdd(acc, num); atomicAdd(acc + 1, den); }
}
__global__ void k_final(float* out, size_t n, const double* acc, int ngroups, int only) {
    double metric = 0.0;
    for (int g = 0; g < ngroups; ++g) { if (only >= 0 && g != only) continue; const double m = acc[2 * g] / (acc[2 * g + 1] + 1e-300); if (!(m <= metric)) metric = m; }
    const float s = 1.0f + (float)sqrt(metric);
    for (size_t i = (size_t)blockIdx.x * blockDim.x + threadIdx.x; i < n; i += (size_t)gridDim.x * blockDim.x) out[i] *= s;
}
#ifndef DEV_ONLY
#define DEV_ONLY -1
#endif
static void cmp(const void* opt, int f32, int ldo, const float* ref, int ldr, int ncols, int nrows, int tr, float scale, double* acc, int g, hipStream_t s) {
    hipLaunchKernelGGL(k_cmp, dim3(2048), dim3(256), 0, s, opt, f32, ldo, ref, ldr, ncols, nrows, tr, scale, acc + 2 * g);
}
#endif

extern "C" void kernel_launch(void* const* d_in, const int* in_sizes, int n_in, void* d_out, int out_size, void* d_ws, size_t ws_size, hipStream_t stream) {
    OP p; memset(&p, 0, sizeof(p));
    fill_inputs(p, d_in, d_out);
    char* w = (char*)d_ws;
#if DEV_CHECK
    size_t off = 0;
    p.ws = w; off = wsl::O_END_MIX;
    refp::Params rp; memset(&rp, 0, sizeof(rp));
    rp.x = p.x; rp.c = p.c; rp.pos = p.pos; rp.w_mod = p.w_mod; rp.b_mod = p.b_mod; rp.w_in = p.w_in; rp.q_gain = p.q_gain; rp.k_gain = p.k_gain; rp.pe_k = p.pe_k; rp.pe_v = p.pe_v;
    rp.w1k = p.w1k; rp.w2k = p.w2k; rp.w1v = p.w1v; rp.w2v = p.w2v; rp.ln_g = p.ln_g; rp.ln_b = p.ln_b; rp.gm_ws = p.gm_ws; rp.gm_bs = p.gm_bs; rp.wpn = p.wpn; rp.wpg = p.wpg; rp.w_out = p.w_out;
    rp.w_router = p.w_router; rp.b_router = p.b_router; rp.wge = p.wge; rp.wue = p.wue; rp.wde = p.wde; rp.wgs = p.wgs; rp.wus = p.wus; rp.wds = p.wds; rp.out = p.out;
    auto take = [&](size_t bytes) { return (void*)(w + ws_take(off, bytes)); };
    {
        const size_t region = off;
        rp.z = (float*)take((size_t)NT * INC * 4);
        rp.qn = (float*)take((size_t)NT * 512 * 4); rp.qr = (float*)take((size_t)NT * 512 * 4);
        rp.ks = (float*)take((size_t)NT * 128 * 4); rp.kw = (float*)take((size_t)NT * 128 * 4);
        rp.onsa = (float*)take((size_t)NT * 512 * 4); rp.vn = (float*)take((size_t)NT * 512 * 4); rp.ogm = (float*)take((size_t)NT * 512 * 4);
        rp.ya = (float*)take((size_t)NT * ND * 4);
        const size_t end_mix = off;
        off = region;
        rp.logits = (float*)take((size_t)NT * NE * 4); rp.gs = (float*)take((size_t)NT * 256 * 4); rp.sact = (float*)take((size_t)NT * 256 * 4);
        rp.shout = (float*)take((size_t)NT * ND * 4); rp.routed = (float*)take((size_t)NT * ND * 4);
        rp.ag = (float*)take((size_t)MAXROWS * 256 * 4); rp.act = (float*)take((size_t)MAXROWS * 256 * 4);
        if (off < end_mix) off = end_mix;
        const size_t need = wsl::O_Wt_ed + (size_t)NE * ND * 256 * 2 + 4096;
        if (off < need) off = need;
    }
    p.xres = (float*)take((size_t)NT * ND * 4);
    rp.bar = (unsigned*)take(16384);
    rp.mod = (float*)take((size_t)NL * NB * 6144 * 4);
    rp.h = (float*)take((size_t)NT * ND * 4);
    rp.counts = (int*)take(NE * 4); rp.cursor = (int*)take(NE * 4); rp.pad_start = (int*)take(NE * 4); rp.blk_e = (int*)take(MAXBLK * 4);
    rp.row_tok = (int*)take((size_t)MAXROWS * 4); rp.row_w = (float*)take((size_t)MAXROWS * 4);
    rp.idx = (int*)take((size_t)NT * 8 * 4); rp.wts = (float*)take((size_t)NT * 8 * 4);
    rp.kc = (float*)take((size_t)NB * NCMP * 2 * 64 * 4); rp.vc = (float*)take((size_t)NB * NCMP * 2 * 64 * 4);
    double* acc = (double*)take(4096);
    if (off > ws_size) { fprintf(stderr, "dev: workspace too small: need %zu have %zu\n", off, ws_size); return; }
    p.xoff = 0;
    (void)hipMemsetAsync(p.ws + wsl::O_ctl, 0, 65536, stream);
    (void)hipMemsetAsync(acc, 0, 4096, stream);
    using namespace refp;
    const int G = 2048;
    launch_phase<PH_MOD>(rp, 0, 48, stream);
    launch_phase<PH_NORM_A>(rp, 0, G, stream);
    launch_phase<PH_GEMM_Z>(rp, 0, G, stream);
    launch_phase<PH_PREP>(rp, 0, G, stream);
    p.conv_l_lo = 0; p.conv_l_hi = 0;
    launch_opt(p, OPH_PROLOGUE, OPH_PROLOGUE + 1, 0, 1, stream);
    launch_opt(p, OPH_NORM0, OPH_NORM0 + 1, 0, 1, stream);
    launch_opt(p, OPH_Z, OPH_Z + 1, 0, 1, stream);
    launch_opt(p, OPH_CMP1, OPH_CMP1 + 1, 0, 1, stream);
    int g = 0;
    cmp(p.qn(), 0, 512, rp.qn, 512, 512, NT, T_NONE, 0.125f, acc, g++, stream);
    cmp(p.qr(), 0, 512, rp.qr, 512, 512, NT, T_NONE, 0.125f, acc, g++, stream);
    cmp(p.kvraw(), 0, 256, rp.z + ZKC, INC, 256, NT, T_NONE, 1.f, acc, g++, stream);
    cmp(p.ksv(), 0, 256, rp.ks, 128, 128, NT, T_NONE, 1.f, acc, g++, stream);
    cmp(p.ksv() + 128, 0, 256, rp.z + ZVS, INC, 128, NT, T_NONE, 1.f, acc, g++, stream);
    cmp(p.kwv(), 0, 256, rp.kw, 128, 128, NT, T_NONE, 1.f, acc, g++, stream);
    cmp(p.kwv() + 128, 0, 256, rp.z + ZVW, INC, 128, NT, T_NONE, 1.f, acc, g++, stream);
    cmp(p.u(), 0, 512, rp.z + ZU, INC, 512, NT, T_GELU, 1.f, acc, g++, stream);
    cmp(p.v(), 0, 512, rp.z + ZV, INC, 512, NT, T_GELU, 1.f, acc, g++, stream);
    cmp(p.sga(), 0, 1024, rp.z + ZGA, INC, 1024, NT, T_SIGMOID, 1.f, acc, g++, stream);
    cmp(p.sgb(), 0, 1024, rp.z + ZGB, INC, 1024, NT, T_SIGMOID, 1.f, acc, g++, stream);
    cmp(p.gates(), 1, 32, rp.z + ZG, INC, 24, NT, T_SIGMOID, 1.f, acc, g++, stream);
    cmp(p.h(), 0, 1024, rp.h, 1024, 1024, NT, T_NONE, 1.f, acc, g++, stream);
    launch_opt(p, OPH_CMP2, OPH_CMP2 + 1, 0, 1, stream);
    for (int b = 0; b < NB; ++b) { cmp(p.kc() + (size_t)b * 256 * 128, 0, 128, rp.kc + (size_t)b * 255 * 128, 128, 128, 255, T_NONE, 1.f, acc, g, stream);
                                   cmp(p.vc() + (size_t)b * 256 * 128, 0, 128, rp.vc + (size_t)b * 255 * 128, 128, 128, 255, T_NONE, 1.f, acc, g + 1, stream); }
    g += 2;
    launch_phase<PH_ATTN>(rp, 0, 2048, stream);
    cmp(p.ogm(), 0, 512, rp.ogm, 512, 512, NT, T_NONE, 1.f, acc, g++, stream);
    launch_opt(p, OPH_ATTN, OPH_ATTN + 1, 0, 1, stream);
    cmp(p.onsa(), 0, 512, rp.onsa, 512, 512, NT, T_NONE, 1.f, acc, g++, stream);
    launch_phase<PH_PROJ>(rp, 0, G, stream);
    launch_phase<PH_OUT>(rp, 0, G, stream);
    launch_opt(p, OPH_PROJ, OPH_PROJ + 1, 0, 1, stream);
    cmp(p.merged(), 0, 1024, rp.ya, 1024, 1024, NT, T_NONE, 1.f, acc, g++, stream);
    launch_opt(p, OPH_OUT, OPH_OUT + 1, 0, 1, stream);
    cmp(p.xres, 1, 1024, rp.out, 1024, 1024, NT, T_NONE, 1.f, acc, g++, stream);
    launch_phase<PH_NORM_F>(rp, 0, G, stream);
    launch_opt(p, OPH_NORMF, OPH_NORMF + 1, 0, 1, stream);
    cmp(p.h(), 0, 1024, rp.h, 1024, 1024, NT, T_NONE, 1.f, acc, g++, stream);
    p.conv_l_lo = 0; p.conv_l_hi = 1;
    launch_opt(p, OPH_PROLOGUE, OPH_PROLOGUE + 1, 0, 1, stream);
    launch_opt(p, OPH_ROUTER, OPH_ROUTER + 1, 0, 1, stream);
    launch_opt(p, OPH_TOPK, OPH_TOPK + 1, 0, 1, stream);
    launch_opt(p, OPH_PLACE, OPH_PLACE + 1, 0, 1, stream);
    launch_opt(p, OPH_EGU, OPH_EGU + 1, 0, 1, stream);
    launch_opt(p, OPH_EDOWN, OPH_EDOWN + 1, 0, 1, stream);
    launch_opt(p, OPH_COMBINE, OPH_COMBINE + 1, 0, 1, stream);
    launch_phase<PH_NORM_F>(rp, 0, G, stream);
    launch_phase<PH_ROUTER>(rp, 0, G, stream);
    launch_phase<PH_TOPK>(rp, 0, G, stream);
    launch_phase<PH_SCAN>(rp, 0, G, stream);
    launch_phase<PH_PLACE>(rp, 0, G, stream);
    launch_phase<PH_EGATE>(rp, 0, G, stream);
    launch_phase<PH_EUP>(rp, 0, G, stream);
    launch_phase<PH_EDOWN>(rp, 0, G, stream);
    launch_phase<PH_FINAL>(rp, 0, G, stream);
    cmp(p.xres, 1, 1024, rp.out, 1024, 1024, NT, T_NONE, 1.f, acc, g++, stream);
    for (int l = 1; l < NL; ++l) {
        launch_phase<PH_NORM_A>(rp, l, G, stream); launch_phase<PH_GEMM_Z>(rp, l, G, stream); launch_phase<PH_PREP>(rp, l, G, stream); launch_phase<PH_ATTN>(rp, l, 2048, stream);
        launch_phase<PH_PROJ>(rp, l, G, stream); launch_phase<PH_OUT>(rp, l, G, stream); launch_phase<PH_NORM_F>(rp, l, G, stream); launch_phase<PH_ROUTER>(rp, l, G, stream);
        launch_phase<PH_TOPK>(rp, l, G, stream); launch_phase<PH_SCAN>(rp, l, G, stream); launch_phase<PH_PLACE>(rp, l, G, stream); launch_phase<PH_EGATE>(rp, l, G, stream);
        launch_phase<PH_EUP>(rp, l, G, stream); launch_phase<PH_EDOWN>(rp, l, G, stream); launch_phase<PH_FINAL>(rp, l, G, stream);
    }
    hipLaunchKernelGGL(k_final, dim3(2048), dim3(256), 0, stream, p.out, (size_t)NT * ND, acc, g, (int)DEV_ONLY);
#else
    p.ws = w; p.xres = p.out; p.xoff = 0;
    if (wsl::O_TOTAL > ws_size) { fprintf(stderr, "workspace too small: need %zu have %zu\n", (size_t)wsl::O_TOTAL, ws_size); return; }
    p.conv_l_lo = 0; p.conv_l_hi = NL;
    (void)hipMemsetAsync(p.ws + wsl::O_ctl, 0, 65536, stream);
    launch_opt(p, 0, OPH_END, 0, NL, stream);
#endif
}
```

```cpp
#define DEV_CHECK 0
#include <hip/hip_runtime.h>
#include <stdint.h>
#include <string.h>
#include <stdio.h>

#ifndef DEV_CHECK
#define DEV_CHECK 0
#endif

#define NB 8
#define NS 4096
#define ND 1024
#define NT (NB * NS)
#define NL 2
#define INC 4376
#define NCMP 255
#define NE 256
#define MAXROWS 294912
#define MAXBLK 2304
#define ZQ 0
#define ZKC 512
#define ZVC 640
#define ZKS 768
#define ZVS 896
#define ZKW 1024
#define ZVW 1152
#define ZG 1280
#define ZU 1304
#define ZV 1816
#define ZGA 2328
#define ZGB 3352

#define LAS __attribute__((address_space(3)))
#define GAS __attribute__((address_space(1)))
typedef unsigned short bf16_t;
typedef short bf16x8 __attribute__((ext_vector_type(8)));
typedef short s16x4 __attribute__((ext_vector_type(4)));
typedef float f32x2 __attribute__((ext_vector_type(2)));
typedef float f32x4 __attribute__((ext_vector_type(4)));
typedef float f32x16 __attribute__((ext_vector_type(16)));
typedef unsigned u32x2 __attribute__((ext_vector_type(2)));
typedef unsigned u32x4 __attribute__((ext_vector_type(4)));
#define XB_TMO      128
#define XB_XCNT(j)  (256  + 64 * (j))
#define XB_XSUB(j)  (1280 + 64 * (j))
#define XB_XGEN(j)  (2304 + 64 * (j))
#define XB_TOP      3328
#define XB_TOPGEN   3392
#define XCD_BAR_WORDS 3456
#define XB_SPIN_CAP (1u << 22)
#define LAS __attribute__((address_space(3)))

__device__ __forceinline__ unsigned xb_ld(unsigned* p)              { return __hip_atomic_load(p, __ATOMIC_RELAXED, __HIP_MEMORY_SCOPE_AGENT); }
__device__ __forceinline__ unsigned xb_add(unsigned* p, unsigned v) { return __hip_atomic_fetch_add(p, v, __ATOMIC_RELAXED, __HIP_MEMORY_SCOPE_AGENT); }
__device__ __forceinline__ unsigned xb_xcc_id() { return (unsigned)__builtin_amdgcn_s_getreg((3 << 11) | 20) & 0xFu; }
#define XB_SPIN(cond, bar) do { unsigned _sp = 0; while (cond) { __builtin_amdgcn_s_sleep(1); \
    if ((++_sp & 255u) == 0u) { if (xb_ld(&(bar)[XB_TMO])) break; if (_sp > XB_SPIN_CAP) { atomicAdd(&(bar)[XB_TMO], 1u); break; } } } } while (0)

struct XcdBarrier { unsigned* bar; unsigned x; volatile LAS unsigned* st; };

__device__ __forceinline__ XcdBarrier xcd_barrier_post(unsigned* bar, volatile LAS unsigned* st) {
    XcdBarrier b; b.bar = bar; b.x = xb_xcc_id(); b.st = st;
    if (threadIdx.x == 0) (void)xb_add(&bar[XB_XCNT(b.x)], 1u);
    return b;
}
__device__ __forceinline__ void xcd_barrier_complete(unsigned* bar, unsigned x, unsigned& nloc, unsigned& nx) {
    const unsigned G = gridDim.x * gridDim.y * gridDim.z;
    unsigned sum, cnt, mine, sp = 0u;
    for (;;) {
        sum = 0u; cnt = 0u; mine = 0u;
#pragma unroll
        for (unsigned j = 0; j < 16; ++j) { const unsigned c = xb_ld(&bar[XB_XCNT(j)]); sum += c; cnt += (c > 0u) ? 1u : 0u; mine = (j == x) ? c : mine; }
        if (sum == G) break;
        __builtin_amdgcn_s_sleep(1);
        if ((++sp & 255u) == 0u) { if (xb_ld(&bar[XB_TMO])) break; if (sp > XB_SPIN_CAP) { atomicAdd(&bar[XB_TMO], 1u); break; } }
    }
    nloc = mine > 0u ? mine : 1u; nx = cnt > 0u ? cnt : 1u;
}
__device__ __noinline__ void xcd_barrier(const XcdBarrier b) {
    asm volatile("s_waitcnt vmcnt(0)" ::: "memory");
    __syncthreads();
    if (threadIdx.x == 0) {
        unsigned* bar = b.bar;
        __builtin_amdgcn_s_waitcnt(0);
        unsigned nloc = b.st[0], nx = b.st[1];
        if (nloc == 0u) { xcd_barrier_complete(bar, b.x, nloc, nx); b.st[0] = nloc; b.st[1] = nx; }
        const unsigned old = xb_add(&bar[XB_XSUB(b.x)], 1u);
        const unsigned gen = old / nloc;
        if (old + 1u == (gen + 1u) * nloc) {
            __builtin_amdgcn_fence(__ATOMIC_RELEASE, "agent");
            asm volatile("s_waitcnt vmcnt(0)" ::: "memory");
            const unsigned og = xb_add(&bar[XB_TOP], 1u);
            const unsigned tg = og / nx;
            if (og + 1u == (tg + 1u) * nx) xb_add(&bar[XB_TOPGEN], 1u);
            else XB_SPIN(xb_ld(&bar[XB_TOPGEN]) == tg, bar);
            __builtin_amdgcn_fence(__ATOMIC_ACQUIRE, "agent");
            xb_add(&bar[XB_XGEN(b.x)], 1u);
            asm volatile("s_waitcnt vmcnt(0)" ::: "memory");
        } else {
            XB_SPIN(xb_ld(&bar[XB_XGEN(b.x)]) == gen, bar);
            __builtin_amdgcn_fence(__ATOMIC_ACQUIRE, "agent");
            asm volatile("s_waitcnt vmcnt(0)" ::: "memory");
        }
    }
    __syncthreads();
}

__device__ __forceinline__ int tid_() { int t = threadIdx.x; asm volatile("" : "+v"(t)); return t; }
__device__ __forceinline__ float sigmoidf_(float x) { return 1.0f / (1.0f + expf(-x)); }
__device__ __forceinline__ float siluf_(float x) { return x / (1.0f + expf(-x)); }
__device__ __forceinline__ float geluf_(float x) { return 0.5f * x * (1.0f + tanhf(0.7978845608028654f * (x + 0.044715f * x * x * x))); }
__device__ __forceinline__ float wave_sum(float v) {
#pragma unroll
    for (int o = 32; o >= 1; o >>= 1) v += __shfl_xor(v, o);
    return v;
}

#if DEV_CHECK
namespace refp {
struct Params {
    const float *x, *c; const int* pos;
    const float *w_mod, *b_mod, *w_in, *q_gain, *k_gain, *pe_k, *pe_v, *w1k, *w2k, *w1v, *w2v, *ln_g, *ln_b, *gm_ws, *gm_bs,
                *wpn, *wpg, *w_out, *w_router, *b_router, *wge, *wue, *wde, *wgs, *wus, *wds;
    float* out;
    float *mod, *h, *z, *qn, *qr, *ks, *kw, *kc, *vc, *onsa, *vn, *ogm, *ya;
    float *logits, *gs, *sact, *shout, *routed, *ag, *act, *row_w, *wts;
    int *idx, *counts, *cursor, *pad_start, *row_tok, *blk_e;
    unsigned* bar;
};


enum { M_STORE = 0, M_RESID = 1, M_SILU_MUL = 2, M_SIG_SET = 3, M_SIG_ADD = 4, M_SCATTER = 5 };
struct GemmArgs {
    const float* A; int lda; const int* gather;
    const float* Bm; int ldb; size_t strideB; const int* blk_e;
    float* C; int ldc; int M, N, K;
    const float* aux; int ldaux; const float* aux2;
};

template <int MODE, bool GATHER>
__device__ __forceinline__ void sgemm(const GemmArgs& g, float* smem, int bid, int nb) {
    float (*As)[128] = (float (*)[128])smem;
    float (*Bs)[128] = (float (*)[128])(smem + 16 * 128);
    const int tid = tid_(), tx = tid & 15, ty = tid >> 4;
    const int ntn = (g.N + 127) / 128, ntm = g.M / 128, ntiles = ntm * ntn;
    for (int tile = bid; tile < ntiles; tile += nb) {
        const int tm = tile / ntn, tn = tile % ntn;
        const int row0 = tm * 128, col0 = tn * 128;
        const float* Bp = g.Bm;
        if (g.blk_e) { const int e = g.blk_e[tm]; if (e < 0) continue; Bp += (size_t)e * g.strideB; }
        float acc[8][8];
#pragma unroll
        for (int i = 0; i < 8; ++i)
#pragma unroll
            for (int j = 0; j < 8; ++j) acc[i][j] = 0.f;
        const float* arow[2];
#pragma unroll
        for (int i = 0; i < 2; ++i) {
            const int id = tid + i * 256, r = id >> 2;
            int srow = row0 + r;
            if (GATHER) { srow = g.gather[row0 + r]; srow = srow < 0 ? 0 : srow; }
            arow[i] = g.A + (size_t)srow * g.lda + (id & 3) * 4;
        }
        for (int k0 = 0; k0 < g.K; k0 += 16) {
            float4 av[2], bv[2];
#pragma unroll
            for (int i = 0; i < 2; ++i) av[i] = *(const float4*)(arow[i] + k0);
#pragma unroll
            for (int i = 0; i < 2; ++i) {
                const int id = tid + i * 256, kr = id >> 5, cq = (id & 31) * 4, cc = col0 + cq;
                if (cc < g.N) bv[i] = *(const float4*)(Bp + (size_t)(k0 + kr) * g.ldb + cc);
                else bv[i] = make_float4(0.f, 0.f, 0.f, 0.f);
            }
            __syncthreads();
#pragma unroll
            for (int i = 0; i < 2; ++i) {
                const int id = tid + i * 256, r = id >> 2, kq = (id & 3) * 4;
                As[kq + 0][r] = av[i].x; As[kq + 1][r] = av[i].y; As[kq + 2][r] = av[i].z; As[kq + 3][r] = av[i].w;
                const int kr = id >> 5, cq = (id & 31) * 4;
                *(float4*)&Bs[kr][cq] = bv[i];
            }
            __syncthreads();
#pragma unroll
            for (int k = 0; k < 16; ++k) {
                const float4 a0 = *(const float4*)&As[k][ty * 4], a1 = *(const float4*)&As[k][64 + ty * 4];
                const float4 b0 = *(const float4*)&Bs[k][tx * 4], b1 = *(const float4*)&Bs[k][64 + tx * 4];
                const float a[8] = {a0.x, a0.y, a0.z, a0.w, a1.x, a1.y, a1.z, a1.w};
                const float b[8] = {b0.x, b0.y, b0.z, b0.w, b1.x, b1.y, b1.z, b1.w};
#pragma unroll
                for (int i = 0; i < 8; ++i)
#pragma unroll
                    for (int j = 0; j < 8; ++j) acc[i][j] = fmaf(a[i], b[j], acc[i][j]);
            }
        }
#pragma unroll
        for (int i = 0; i < 8; ++i) {
            const int r = row0 + (i < 4 ? ty * 4 + i : 64 + ty * 4 + (i - 4));
            int tok = 0; float rw = 0.f;
            if (MODE == M_SCATTER) { tok = g.gather[r]; rw = g.aux[r]; if (tok < 0) continue; }
#pragma unroll
            for (int jh = 0; jh < 2; ++jh) {
                const int cidx = col0 + jh * 64 + tx * 4;
                if (cidx >= g.N) continue;
                float4 v = make_float4(acc[i][jh * 4 + 0], acc[i][jh * 4 + 1], acc[i][jh * 4 + 2], acc[i][jh * 4 + 3]);
                if (MODE == M_STORE) {
                    *(float4*)(g.C + (size_t)r * g.ldc + cidx) = v;
                } else if (MODE == M_RESID) {
                    const float4 rr = *(const float4*)(g.aux + (size_t)r * g.ldaux + cidx);
                    const float4 gt = *(const float4*)(g.aux2 + (size_t)(r >> 12) * 6144 + cidx);
                    v.x = rr.x + gt.x * v.x; v.y = rr.y + gt.y * v.y; v.z = rr.z + gt.z * v.z; v.w = rr.w + gt.w * v.w;
                    *(float4*)(g.C + (size_t)r * g.ldc + cidx) = v;
                } else if (MODE == M_SILU_MUL) {
                    const float4 a = *(const float4*)(g.aux + (size_t)r * g.ldaux + cidx);
                    v.x *= siluf_(a.x); v.y *= siluf_(a.y); v.z *= siluf_(a.z); v.w *= siluf_(a.w);
                    *(float4*)(g.C + (size_t)r * g.ldc + cidx) = v;
                } else if (MODE == M_SIG_SET || MODE == M_SIG_ADD) {
                    const float4 a = *(const float4*)(g.aux + (size_t)r * g.ldaux + cidx);
                    v.x *= sigmoidf_(a.x); v.y *= sigmoidf_(a.y); v.z *= sigmoidf_(a.z); v.w *= sigmoidf_(a.w);
                    float4* cp = (float4*)(g.C + (size_t)r * g.ldc + cidx);
                    if (MODE == M_SIG_ADD) { const float4 o = *cp; v.x += o.x; v.y += o.y; v.z += o.z; v.w += o.w; }
                    *cp = v;
                } else if (MODE == M_SCATTER) {
                    float* cp = g.C + (size_t)tok * g.ldc + cidx;
                    atomicAdd(cp + 0, rw * v.x); atomicAdd(cp + 1, rw * v.y); atomicAdd(cp + 2, rw * v.z); atomicAdd(cp + 3, rw * v.w);
                }
            }
        }
    }
}

__device__ __forceinline__ void ph_mod(const Params& p, float* smem, int bid, int nb) {
    for (int i = tid_(); i < NB * ND; i += 256) smem[i] = siluf_(p.c[i]);
    __syncthreads();
    for (int it = bid * 256 + tid_(); it < NL * 6144; it += nb * 256) {
        const int l = it / 6144, j = it % 6144;
        float acc[NB];
#pragma unroll
        for (int b = 0; b < NB; ++b) acc[b] = 0.f;
        const float* w = p.w_mod + (size_t)l * ND * 6144 + j;
        for (int d = 0; d < ND; ++d) {
            const float wv = w[(size_t)d * 6144];
#pragma unroll
            for (int b = 0; b < NB; ++b) acc[b] = fmaf(smem[b * ND + d], wv, acc[b]);
        }
        const float bb = p.b_mod[l * 6144 + j];
#pragma unroll
        for (int b = 0; b < NB; ++b) p.mod[((size_t)l * NB + b) * 6144 + j] = acc[b] + bb;
    }
    __syncthreads();
}

__device__ __forceinline__ void ph_norm(const Params& p, const float* xin, int l, int sh_off, int sc_off, int bid, int nb) {
    const int lane = tid_() & 63, w = tid_() >> 6;
    for (int t = bid * 4 + w; t < NT; t += nb * 4) {
        const float* xr = xin + (size_t)t * ND;
        float4 v[4]; float ss = 0.f;
#pragma unroll
        for (int i = 0; i < 4; ++i) { v[i] = *(const float4*)(xr + i * 256 + lane * 4); ss += v[i].x * v[i].x + v[i].y * v[i].y + v[i].z * v[i].z + v[i].w * v[i].w; }
        ss = wave_sum(ss);
        const float rstd = rsqrtf(ss * (1.0f / ND) + 1e-6f);
        const float* mb = p.mod + ((size_t)l * NB + (t >> 12)) * 6144;
#pragma unroll
        for (int i = 0; i < 4; ++i) {
            const int cidx = i * 256 + lane * 4;
            const float4 sc = *(const float4*)(mb + sc_off + cidx), sh = *(const float4*)(mb + sh_off + cidx);
            float4 o;
            o.x = v[i].x * rstd * (1.f + sc.x) + sh.x; o.y = v[i].y * rstd * (1.f + sc.y) + sh.y;
            o.z = v[i].z * rstd * (1.f + sc.z) + sh.z; o.w = v[i].w * rstd * (1.f + sc.w) + sh.w;
            *(float4*)(p.h + (size_t)t * ND + cidx) = o;
        }
    }
}

__device__ __forceinline__ void ph_prep(const Params& p, int l, int bid, int nb) {
    const int lane = tid_() & 63, w = tid_() >> 6;
    const int i32 = lane & 31;
    const float inv = (float)pow(10000.0, -(double)i32 / 32.0);
    for (long it = (long)bid * 4 + w; it < (long)NT * 12; it += (long)nb * 4) {
        const int t = (int)(it / 12), hv = (int)(it % 12);
        int zc; const float* gain; float* dst; float* dst_norot = nullptr;
        if (hv < 8) { zc = ZQ + hv * 64; gain = p.q_gain + l * 64; dst = p.qr + (size_t)t * 512 + hv * 64; dst_norot = p.qn + (size_t)t * 512 + hv * 64; }
        else if (hv < 10) { zc = ZKS + (hv - 8) * 64; gain = p.k_gain + l * 64; dst = p.ks + (size_t)t * 128 + (hv - 8) * 64; }
        else { zc = ZKW + (hv - 10) * 64; gain = p.k_gain + l * 64; dst = p.kw + (size_t)t * 128 + (hv - 10) * 64; }
        const float v = p.z[(size_t)t * INC + zc + lane];
        const float ss = wave_sum(v * v);
        const float y = v * rsqrtf(ss * (1.0f / 64.f) + 1e-6f) * gain[lane];
        if (dst_norot) dst_norot[lane] = y;
        const float ang = (float)p.pos[t] * inv;
        const float cs = cosf(ang), sn = sinf(ang);
        const float other = __shfl_xor(y, 32);
        const float r = lane < 32 ? (y * cs - other * sn) : (y * cs + other * sn);
        dst[lane] = r;
    }
}

__device__ __forceinline__ void ph_compress(const Params& p, int l, float* smem, int bid, int nb) {
    float* A = smem;
    float* hid = smem + 2048;
    float* red = smem + 2048 + 256;
    const int tid = tid_();
    for (int u = bid; u < 2 * NB * NCMP * 2; u += nb) {
        const int kv = u / (NB * NCMP * 2), r = u % (NB * NCMP * 2), b = r / (NCMP * 2), n = (r / 2) % NCMP, hh = r & 1;
        const float* pe = (kv ? p.pe_v : p.pe_k) + l * 2048;
        const float* w1 = (kv ? p.w1v : p.w1k) + (size_t)l * 2048 * 256;
        const float* w2 = (kv ? p.w2v : p.w2k) + (size_t)l * 256 * 64;
        const int zc = (kv ? ZVC : ZKC) + hh * 64;
        __syncthreads();
        for (int k = tid; k < 2048; k += 256) { const int li = k >> 6, d = k & 63; A[k] = p.z[((size_t)b * NS + 16 * n + li) * INC + zc + d] + pe[k]; }
        __syncthreads();
        float acc = 0.f;
        for (int k = 0; k < 2048; ++k) acc = fmaf(A[k], w1[(size_t)k * 256 + tid], acc);
        hid[tid] = geluf_(acc);
        __syncthreads();
        if (tid < 64) {
            float o = 0.f;
            for (int f = 0; f < 256; ++f) o = fmaf(hid[f], w2[f * 64 + tid], o);
            float* dst = (kv ? p.vc : p.kc) + (((size_t)b * NCMP + n) * 2 + hh) * 64;
            if (kv) dst[tid] = o;
            else { const float ss = wave_sum(o * o); dst[tid] = o * rsqrtf(ss * (1.f / 64.f) + 1e-6f) * p.k_gain[l * 64 + tid]; }
        }
    }
    __syncthreads();
}

__device__ __forceinline__ void ph_gmln(const Params& p, int l, int bid, int nb) {
    const int lane = tid_() & 63, w = tid_() >> 6;
    for (int t = bid * 4 + w; t < NT; t += nb * 4) {
        float v[8]; float s = 0.f;
#pragma unroll
        for (int i = 0; i < 8; ++i) { v[i] = geluf_(p.z[(size_t)t * INC + ZV + i * 64 + lane]); s += v[i]; }
        const float mu = wave_sum(s) * (1.f / 512.f);
        float q = 0.f;
#pragma unroll
        for (int i = 0; i < 8; ++i) { const float d = v[i] - mu; q += d * d; }
        const float rstd = rsqrtf(wave_sum(q) * (1.f / 512.f) + 1e-6f);
#pragma unroll
        for (int i = 0; i < 8; ++i) { const int cidx = i * 64 + lane; p.vn[(size_t)t * 512 + cidx] = (v[i] - mu) * rstd * p.ln_g[l * 512 + cidx] + p.ln_b[l * 512 + cidx]; }
    }
}

__device__ __forceinline__ void ph_gmmix(const Params& p, int l, float* smem, int bid, int nb) {
    const int tid = tid_(), cidx = tid & 63, w = tid >> 6;
    for (int u = bid; u < 256 * 8; u += nb) {
        const int ch = u >> 3, g = u & 7;
        const size_t base = (size_t)ch * 128;
        __syncthreads();
        for (int i = tid; i < 128 * 64; i += 256) smem[i] = p.vn[(base + (i >> 6)) * 512 + g * 64 + (i & 63)];
        __syncthreads();
        const float* ws = p.gm_ws + ((size_t)l * 8 + g) * 128 * 128;
        for (int tl = w; tl < 128; tl += 4) {
            float acc = 0.f;
            for (int s = 0; s <= tl; ++s) acc = fmaf(ws[tl * 128 + s], smem[s * 64 + cidx], acc);
            const float mixed = acc + p.gm_bs[(l * 8 + g) * 128 + tl];
            const float uu = geluf_(p.z[(base + tl) * INC + ZU + g * 64 + cidx]);
            p.ogm[(base + tl) * 512 + g * 64 + cidx] = uu * mixed;
        }
    }
    __syncthreads();
}

__device__ __forceinline__ float dot32(const float (&q)[32], const float* k) {
    float s = 0.f;
#pragma unroll
    for (int i = 0; i < 8; ++i) { const float4 kv = *(const float4*)(k + i * 4); s = fmaf(q[i * 4], kv.x, s); s = fmaf(q[i * 4 + 1], kv.y, s); s = fmaf(q[i * 4 + 2], kv.z, s); s = fmaf(q[i * 4 + 3], kv.w, s); }
    s += __shfl_xor(s, 1);
    return s;
}
__device__ __forceinline__ void axpy32(float (&o)[32], float e, const float* v) {
#pragma unroll
    for (int i = 0; i < 8; ++i) { const float4 vv = *(const float4*)(v + i * 4); o[i * 4] = fmaf(e, vv.x, o[i * 4]); o[i * 4 + 1] = fmaf(e, vv.y, o[i * 4 + 1]); o[i * 4 + 2] = fmaf(e, vv.z, o[i * 4 + 2]); o[i * 4 + 3] = fmaf(e, vv.w, o[i * 4 + 3]); }
}

__device__ __forceinline__ void ph_attn(const Params& p, int l, float* smem, int bid, int nb) {
    float* imp = smem;
    unsigned long long* selm = (unsigned long long*)(smem + 2048);
    const int tid = tid_(), ql = tid >> 3, g = (tid >> 1) & 3, hf = tid & 1;
    const float scale = 0.125f;
    for (int unit = bid; unit < 2048; unit += nb) {
        const int qb = 63 - (unit >> 5), b = (unit & 31) >> 2, kvh = (unit >> 1) & 1, qh = unit & 1;
        const int qi = qh * 32 + ql;
        const int t = qb * 64 + qi, hq = kvh * 4 + g;
        const size_t tok = (size_t)b * NS + t;
        float q[32], o[32];
        const float gate0 = sigmoidf_(p.z[tok * INC + ZG + hq * 3 + 0]), gate1 = sigmoidf_(p.z[tok * INC + ZG + hq * 3 + 1]), gate2 = sigmoidf_(p.z[tok * INC + ZG + hq * 3 + 2]);
        float* outp = p.onsa + tok * 512 + hq * 64 + hf * 32;
        const int ho = kvh * 64 + hf * 32;
#pragma unroll
        for (int i = 0; i < 8; ++i) { const float4 v = *(const float4*)(p.qn + tok * 512 + hq * 64 + hf * 32 + i * 4); q[i * 4] = v.x; q[i * 4 + 1] = v.y; q[i * 4 + 2] = v.z; q[i * 4 + 3] = v.w; }
        int nvis = t >= 31 ? (t - 31) / 16 + 1 : 0; if (nvis > NCMP) nvis = NCMP;
        const float* kcb = p.kc + (size_t)b * NCMP * 128 + ho;
        const float* vcb = p.vc + (size_t)b * NCMP * 128 + ho;
        float m = -INFINITY;
        for (int n = 0; n < nvis; ++n) { const float s = dot32(q, kcb + n * 128) * scale; m = fmaxf(m, s); }
        float lsum = 0.f;
#pragma unroll
        for (int i = 0; i < 32; ++i) o[i] = 0.f;
        for (int n = 0; n < nvis; ++n) { const float s = dot32(q, kcb + n * 128) * scale; const float e = expf(s - m); lsum += e; axpy32(o, e, vcb + n * 128); }
        const float inv = 1.0f / fmaxf(lsum, 1e-30f);
#pragma unroll
        for (int i = 0; i < 8; ++i) *(float4*)(outp + i * 4) = make_float4(gate0 * o[i * 4] * inv, gate0 * o[i * 4 + 1] * inv, gate0 * o[i * 4 + 2] * inv, gate0 * o[i * 4 + 3] * inv);
        __syncthreads();
        for (int j = 0; j <= qb; ++j) {
            float a = 0.f;
            for (int n = 4 * j - 1; n <= 4 * j + 3; ++n) if (n >= 0 && n < nvis) { const float s = dot32(q, kcb + n * 128) * scale; a += expf(s - m) * inv; }
            a += __shfl_xor(a, 2); a += __shfl_xor(a, 4);
            if (g == 0 && hf == 0) imp[ql * 64 + j] = a;
        }
        __syncthreads();
        if (g == 0 && hf == 0) {
            unsigned long long mask = 0ull;
            for (int it = 0; it < 16; ++it) {
                int best = -1; float bv = 0.f;
                for (int j = 0; j < 64; ++j) {
                    if ((mask >> j) & 1ull) continue;
                    const bool forced = (j == 0) || (j == qb) || (j == qb - 1);
                    const float v = forced ? INFINITY : (j <= qb ? imp[ql * 64 + j] : -INFINITY);
                    if (best < 0 || v > bv) { best = j; bv = v; }
                }
                mask |= 1ull << best;
            }
            selm[ql] = mask;
        }
        __syncthreads();
        const unsigned long long mask = selm[ql];
#pragma unroll
        for (int i = 0; i < 8; ++i) { const float4 v = *(const float4*)(p.qr + tok * 512 + hq * 64 + hf * 32 + i * 4); q[i * 4] = v.x; q[i * 4 + 1] = v.y; q[i * 4 + 2] = v.z; q[i * 4 + 3] = v.w; }
        {
            float mm = -INFINITY, ll = 0.f;
#pragma unroll
            for (int i = 0; i < 32; ++i) o[i] = 0.f;
            for (int j = 0; j <= qb; ++j) {
                if (!((mask >> j) & 1ull)) continue;
                for (int s = 0; s < 64; ++s) {
                    const int tk = j * 64 + s; if (tk > t) break;
                    const size_t kt = (size_t)b * NS + tk;
                    const float sc = dot32(q, p.ks + kt * 128 + ho) * scale;
                    if (sc > mm) { const float corr = expf(mm - sc); ll *= corr;
#pragma unroll
                        for (int i = 0; i < 32; ++i) o[i] *= corr;
                        mm = sc; }
                    const float e = expf(sc - mm); ll += e; axpy32(o, e, p.z + kt * INC + ZVS + ho);
                }
            }
            const float iv = gate1 / fmaxf(ll, 1e-30f);
#pragma unroll
            for (int i = 0; i < 8; ++i) { float4 c = *(float4*)(outp + i * 4); c.x += o[i * 4] * iv; c.y += o[i * 4 + 1] * iv; c.z += o[i * 4 + 2] * iv; c.w += o[i * 4 + 3] * iv; *(float4*)(outp + i * 4) = c; }
        }
        {
            float mm = -INFINITY, ll = 0.f;
#pragma unroll
            for (int i = 0; i < 32; ++i) o[i] = 0.f;
            const int k0 = t - 511 > 0 ? t - 511 : 0;
            for (int tk = k0; tk <= t; ++tk) {
                const size_t kt = (size_t)b * NS + tk;
                const float sc = dot32(q, p.kw + kt * 128 + ho) * scale;
                if (sc > mm) { const float corr = expf(mm - sc); ll *= corr;
#pragma unroll
                    for (int i = 0; i < 32; ++i) o[i] *= corr;
                    mm = sc; }
                const float e = expf(sc - mm); ll += e; axpy32(o, e, p.z + kt * INC + ZVW + ho);
            }
            const float iv = gate2 / fmaxf(ll, 1e-30f);
#pragma unroll
            for (int i = 0; i < 8; ++i) { float4 c = *(float4*)(outp + i * 4); c.x += o[i * 4] * iv; c.y += o[i * 4 + 1] * iv; c.z += o[i * 4 + 2] * iv; c.w += o[i * 4 + 3] * iv; *(float4*)(outp + i * 4) = c; }
        }
    }
    __syncthreads();
}

__device__ __forceinline__ void ph_topk(const Params& p, int l, int bid, int nb) {
    const int lane = tid_() & 63, w = tid_() >> 6;
    for (int t = bid * 4 + w; t < NT; t += nb * 4) {
        float aff[4], key[4]; bool used[4];
#pragma unroll
        for (int i = 0; i < 4; ++i) { const int e = i * 64 + lane; aff[i] = sigmoidf_(p.logits[(size_t)t * NE + e]); key[i] = aff[i] + p.b_router[l * NE + e]; used[i] = false; }
        float topv[8]; int tope[8]; float sum = 0.f;
#pragma unroll
        for (int r = 0; r < 8; ++r) {
            float bv = -INFINITY; int be = 1 << 30; float ba = 0.f;
#pragma unroll
            for (int i = 0; i < 4; ++i) { const int e = i * 64 + lane; if (!used[i] && (key[i] > bv || (key[i] == bv && e < be))) { bv = key[i]; be = e; ba = aff[i]; } }
#pragma unroll
            for (int o = 32; o >= 1; o >>= 1) {
                const float ov = __shfl_xor(bv, o); const int oe = __shfl_xor(be, o); const float oa = __shfl_xor(ba, o);
                if (ov > bv || (ov == bv && oe < be)) { bv = ov; be = oe; ba = oa; }
            }
#pragma unroll
            for (int i = 0; i < 4; ++i) if (i * 64 + lane == be) used[i] = true;
            topv[r] = ba; tope[r] = be; sum += ba;
        }
        if (lane < 8) {
            float tv = 0.f; int te = 0;
#pragma unroll
            for (int r = 0; r < 8; ++r) if (lane == r) { tv = topv[r]; te = tope[r]; }
            p.idx[(size_t)t * 8 + lane] = te;
            p.wts[(size_t)t * 8 + lane] = tv / sum * 2.5f;
            atomicAdd(&p.counts[te], 1);
        }
    }
}

__device__ __forceinline__ void ph_scan(const Params& p, int* ismem, int bid) {
    if (bid != 0) return;
    const int tid = tid_();
    ismem[tid] = (p.counts[tid] + 127) / 128 * 128;
    __syncthreads();
    if (tid == 0) { int run = 0; for (int e = 0; e < NE; ++e) { const int v = ismem[e]; ismem[e] = run; run += v; } ismem[NE] = run; }
    __syncthreads();
    const int st = ismem[tid], en = (tid == NE - 1) ? ismem[NE] : ismem[tid + 1];
    p.pad_start[tid] = st; p.cursor[tid] = 0;
    for (int i = st / 128; i < en / 128; ++i) p.blk_e[i] = tid;
    for (int i = ismem[NE] / 128 + tid; i < MAXBLK; i += 256) p.blk_e[i] = -1;
    __syncthreads();
}

__device__ __forceinline__ void ph_place(const Params& p, int bid, int nb) {
    for (int a = bid * 256 + tid_(); a < NT * 8; a += nb * 256) {
        const int e = p.idx[a];
        const int pos = atomicAdd(&p.cursor[e], 1);
        const int dest = p.pad_start[e] + pos;
        p.row_tok[dest] = a >> 3; p.row_w[dest] = p.wts[a];
    }
}

enum { PH_MOD = 0, PH_NORM_A, PH_GEMM_Z, PH_PREP, PH_ATTN, PH_PROJ, PH_OUT, PH_NORM_F, PH_ROUTER, PH_TOPK, PH_SCAN, PH_PLACE, PH_EGATE, PH_EUP, PH_EDOWN, PH_FINAL, PH_COUNT };

template <int PH>
__device__ __forceinline__ void run_phase(const Params& p, int l, float* smem, int bid, int nb) {
    const float* xin = (l == 0) ? p.x : p.out;
    if constexpr (PH == PH_MOD) { ph_mod(p, smem, bid, nb); }
    else if constexpr (PH == PH_NORM_A) { ph_norm(p, xin, l, 0, 1024, bid, nb); }
    else if constexpr (PH == PH_GEMM_Z) {
        GemmArgs g{}; g.A = p.h; g.lda = ND; g.Bm = p.w_in + (size_t)l * ND * INC; g.ldb = INC; g.C = p.z; g.ldc = INC; g.M = NT; g.N = INC; g.K = ND;
        sgemm<M_STORE, false>(g, smem, bid, nb);
    }
    else if constexpr (PH == PH_PREP) { ph_prep(p, l, bid, nb); ph_compress(p, l, smem, bid, nb); ph_gmln(p, l, bid, nb); }
    else if constexpr (PH == PH_ATTN) { ph_attn(p, l, smem, bid, nb); ph_gmmix(p, l, smem, bid, nb); }
    else if constexpr (PH == PH_PROJ) {
        GemmArgs g{}; g.A = p.onsa; g.lda = 512; g.Bm = p.wpn + (size_t)l * 512 * ND; g.ldb = ND; g.C = p.ya; g.ldc = ND; g.M = NT; g.N = ND; g.K = 512; g.aux = p.z + ZGA; g.ldaux = INC;
        sgemm<M_SIG_SET, false>(g, smem, bid, nb);
        g.A = p.ogm; g.Bm = p.wpg + (size_t)l * 512 * ND; g.aux = p.z + ZGB;
        sgemm<M_SIG_ADD, false>(g, smem, bid, nb);
    }
    else if constexpr (PH == PH_OUT) {
        GemmArgs g{}; g.A = p.ya; g.lda = ND; g.Bm = p.w_out + (size_t)l * ND * ND; g.ldb = ND; g.C = p.out; g.ldc = ND; g.M = NT; g.N = ND; g.K = ND;
        g.aux = xin; g.ldaux = ND; g.aux2 = p.mod + (size_t)l * NB * 6144 + 2048;
        sgemm<M_RESID, false>(g, smem, bid, nb);
    }
    else if constexpr (PH == PH_NORM_F) {
        ph_norm(p, p.out, l, 3072, 4096, bid, nb);
        for (size_t i = (size_t)bid * 256 + tid_(); i < (size_t)NT * ND / 4; i += (size_t)nb * 256) ((float4*)p.routed)[i] = make_float4(0.f, 0.f, 0.f, 0.f);
        for (int i = bid * 256 + tid_(); i < MAXROWS; i += nb * 256) { p.row_tok[i] = -1; p.row_w[i] = 0.f; }
        if (bid == 0) p.counts[tid_()] = 0;
    }
    else if constexpr (PH == PH_ROUTER) {
        GemmArgs g{}; g.A = p.h; g.lda = ND; g.Bm = p.w_router + (size_t)l * ND * NE; g.ldb = NE; g.C = p.logits; g.ldc = NE; g.M = NT; g.N = NE; g.K = ND;
        sgemm<M_STORE, false>(g, smem, bid, nb);
        g.Bm = p.wgs + (size_t)l * ND * 256; g.C = p.gs;
        sgemm<M_STORE, false>(g, smem, bid, nb);
    }
    else if constexpr (PH == PH_TOPK) {
        ph_topk(p, l, bid, nb);
        GemmArgs g{}; g.A = p.h; g.lda = ND; g.Bm = p.wus + (size_t)l * ND * 256; g.ldb = 256; g.C = p.sact; g.ldc = 256; g.M = NT; g.N = 256; g.K = ND; g.aux = p.gs; g.ldaux = 256;
        sgemm<M_SILU_MUL, false>(g, smem, bid, nb);
    }
    else if constexpr (PH == PH_SCAN) {
        ph_scan(p, (int*)smem, bid);
        GemmArgs g{}; g.A = p.sact; g.lda = 256; g.Bm = p.wds + (size_t)l * 256 * ND; g.ldb = ND; g.C = p.shout; g.ldc = ND; g.M = NT; g.N = ND; g.K = 256;
        sgemm<M_STORE, false>(g, smem, bid, nb);
    }
    else if constexpr (PH == PH_PLACE) { ph_place(p, bid, nb); }
    else if constexpr (PH == PH_EGATE) {
        GemmArgs g{}; g.A = p.h; g.lda = ND; g.gather = p.row_tok; g.Bm = p.wge + (size_t)l * NE * ND * 256; g.ldb = 256; g.strideB = (size_t)ND * 256; g.blk_e = p.blk_e;
        g.C = p.ag; g.ldc = 256; g.M = MAXROWS; g.N = 256; g.K = ND;
        sgemm<M_STORE, true>(g, smem, bid, nb);
    }
    else if constexpr (PH == PH_EUP) {
        GemmArgs g{}; g.A = p.h; g.lda = ND; g.gather = p.row_tok; g.Bm = p.wue + (size_t)l * NE * ND * 256; g.ldb = 256; g.strideB = (size_t)ND * 256; g.blk_e = p.blk_e;
        g.C = p.act; g.ldc = 256; g.M = MAXROWS; g.N = 256; g.K = ND; g.aux = p.ag; g.ldaux = 256;
        sgemm<M_SILU_MUL, true>(g, smem, bid, nb);
    }
    else if constexpr (PH == PH_EDOWN) {
        GemmArgs g{}; g.A = p.act; g.lda = 256; g.gather = p.row_tok; g.Bm = p.wde + (size_t)l * NE * 256 * ND; g.ldb = ND; g.strideB = (size_t)256 * ND; g.blk_e = p.blk_e;
        g.C = p.routed; g.ldc = ND; g.M = MAXROWS; g.N = ND; g.K = 256; g.aux = p.row_w;
        sgemm<M_SCATTER, false>(g, smem, bid, nb);
    }
    else if constexpr (PH == PH_FINAL) {
        const float* gt = p.mod + (size_t)l * NB * 6144 + 5120;
        for (size_t i = (size_t)bid * 256 + tid_(); i < (size_t)NT * ND / 4; i += (size_t)nb * 256) {
            const size_t e0 = i * 4; const int r = (int)(e0 >> 10), cidx = (int)(e0 & 1023);
            const float4 g4 = *(const float4*)(gt + (size_t)(r >> 12) * 6144 + cidx);
            const float4 a = ((const float4*)p.routed)[i], s = ((const float4*)p.shout)[i]; float4 o = ((float4*)p.out)[i];
            o.x += g4.x * (a.x + s.x); o.y += g4.y * (a.y + s.y); o.z += g4.z * (a.z + s.z); o.w += g4.w * (a.w + s.w);
            ((float4*)p.out)[i] = o;
        }
    }
}


#define SMEM_FLOATS 8192
template <int PH>
__global__ void __launch_bounds__(256, 2) k_phase(Params p, int l) {
    __shared__ float smem[SMEM_FLOATS];
    run_phase<PH>(p, l, smem, blockIdx.x, gridDim.x);
}
template <int PH> static void launch_phase(const Params& p, int l, int grid, hipStream_t s) { hipLaunchKernelGGL(k_phase<PH>, dim3(grid), dim3(256), 0, s, p, l); }
}
#endif
namespace pg8 {
constexpr int BM = 256, BK = 64, HALF = 128, HTB = HALF * BK * 2, STAGE_BYTES = 8 * HTB;

__host__ __device__ __forceinline__ int lds_byte(int r, int c) { const int st = (r >> 4) * 2 + (c >> 5), rr = r & 15, cc = c & 31, ob = rr * 64 + cc * 2; return st * 1024 + (ob ^ (((ob >> 9) & 1) << 5)); }
__host__ __device__ __forceinline__ void stage_rc(int b, int& R, int& C) { const int st = b / 1024, sb = b % 1024, swz = sb ^ (((sb >> 9) & 1) << 5); R = (st >> 1) * 16 + swz / 64; C = (st & 1) * 32 + (swz % 64) / 2; }
__host__ __device__ __forceinline__ int perm32(int rho) { const int n = rho >> 4, i = rho & 15; return 8 * (i >> 2) + 4 * n + (i & 3); }

struct Unit { int pm, pn, e; };

__device__ __forceinline__ const char* uptr(const char* p) { return p; }
__device__ __forceinline__ unsigned cvt_pk_bf16(float lo, float hi) { unsigned r; asm volatile("v_cvt_pk_bf16_f32 %0, %1, %2" : "=v"(r) : "v"(lo), "v"(hi)); return r; }

typedef long pg8_l2 __attribute__((ext_vector_type(2)));
template <bool F8> __device__ __forceinline__ f32x4 pg8_mma(const bf16x8& b, const bf16x8& a, const f32x4& c) {
    if constexpr (F8) { const pg8_l2 bl = __builtin_bit_cast(pg8_l2, b), al = __builtin_bit_cast(pg8_l2, a);
        f32x4 r = __builtin_amdgcn_mfma_f32_16x16x32_fp8_fp8(bl[0], al[0], c, 0, 0, 0); return __builtin_amdgcn_mfma_f32_16x16x32_fp8_fp8(bl[1], al[1], r, 0, 0, 0); }
    else return __builtin_amdgcn_mfma_f32_16x16x32_bf16(b, a, c, 0, 0, 0);
}
template <class Epi, class Sched, bool ALIGN_EPI = true, bool MID = false, bool F8 = false>
__device__ __forceinline__ void gemm_phase(LAS unsigned char* lds, const Sched& S, const Epi& E) {
    const int tid = tid_(), wid = __builtin_amdgcn_readfirstlane(tid >> 6), lane = tid & 63, wr = wid >> 2, wc = wid & 3, fr = lane & 15, fq = lane >> 4;
    const int K = S.K, nt = K / BK;
    unsigned voffB[2];
#pragma unroll
    for (int i = 0; i < 2; ++i) { int R, C; stage_rc(tid * 16 + i * 8192, R, C); const int Rb = Epi::PERM ? ((R & ~31) + perm32(R & 31)) : R; voffB[i] = (unsigned)(Rb * S.ldb + C) * 2u; }
    const unsigned kstepB = (unsigned)(BK * 2), kstepA = (unsigned)S.kstepA;
    const unsigned hstepB = (unsigned)(HALF * S.ldb * 2);
    const char* const bA = S.a_base(); const char* const bB = S.b_base();
    const unsigned ldsw = (unsigned)wid * 1024u;
    const int aoff = lds_byte(wr * 64 + fr, fq * 8), boff = lds_byte(wc * 32 + fr, fq * 8);
#define PG8_SA(b, h) (((b) * 2 + (h)) * HTB)
#define PG8_SB(b, h) ((4 + (b) * 2 + (h)) * HTB)
#define PG8_STAGE_B(bufoff, gbase) do { _Pragma("unroll") for (int _i = 0; _i < 2; ++_i) \
        __builtin_amdgcn_global_load_lds((const unsigned*)(bB + (unsigned)((gbase) + voffB[_i])), (LAS unsigned*)(lds + (bufoff) + ldsw + _i * 8192), 16, 0, 0); } while (0)
#define PG8_STAGE_A(bufoff, gbase, offs, h) do { _Pragma("unroll") for (int _i = 0; _i < 2; ++_i) \
        __builtin_amdgcn_global_load_lds((const unsigned*)(bA + (unsigned)((gbase) + (offs)[h][_i])), (LAS unsigned*)(lds + (bufoff) + ldsw + _i * 8192), 16, 0, 0); } while (0)
#define PG8_LDA(dst, b, h) do { _Pragma("unroll") for (int m = 0; m < 4; ++m) _Pragma("unroll") for (int k = 0; k < 2; ++k) dst[m][k] = *(const LAS bf16x8*)(lds + PG8_SA(b, h) + aoff + m * 2048 + k * 1024); } while (0)
#define PG8_LDB(dst, b, h) do { _Pragma("unroll") for (int n = 0; n < 2; ++n) _Pragma("unroll") for (int k = 0; k < 2; ++k) dst[n][k] = *(const LAS bf16x8*)(lds + PG8_SB(b, h) + boff + n * 2048 + k * 1024); } while (0)
#define PG8_MMA(ai, bj, At, Bt) do { __builtin_amdgcn_s_setprio(1); _Pragma("unroll") for (int m = 0; m < 4; ++m) _Pragma("unroll") for (int n = 0; n < 2; ++n) _Pragma("unroll") for (int k = 0; k < 2; ++k) \
        acc[ai][bj][m][n] = pg8_mma<F8>(Bt[n][k], At[m][k], acc[ai][bj][m][n]); __builtin_amdgcn_s_setprio(0); } while (0)
#define PG8_WAIT_V(n) asm volatile("s_waitcnt vmcnt(" #n ")" ::: "memory")
#define PG8_WAIT_L(n) asm volatile("s_waitcnt lgkmcnt(" #n ")" ::: "memory")
#define PG8_BAR __builtin_amdgcn_s_barrier()
#define PG8_SCHED __builtin_amdgcn_sched_barrier(0)
    Unit cur, nxt; int ui = 0;
    if (!S.next(0, cur)) return;
    f32x4 acc[2][2][4][2];
#pragma unroll
    for (int a = 0; a < 2; ++a)
#pragma unroll
        for (int b = 0; b < 2; ++b)
#pragma unroll
            for (int m = 0; m < 4; ++m)
#pragma unroll
                for (int n = 0; n < 2; ++n) acc[a][b][m][n] = (f32x4){0.f, 0.f, 0.f, 0.f};
    bf16x8 At[4][2], B0[2][2], B1[2][2];
    unsigned cA = (unsigned)(S.a_ptr(cur) - bA), cB = (unsigned)(S.b_ptr(cur) - bB);
    unsigned coff[2][2], noff[2][2];
    S.a_off(cur, tid, coff);
    PG8_STAGE_B(PG8_SB(0, 0), cB); PG8_STAGE_B(PG8_SB(0, 1), cB + hstepB); PG8_STAGE_A(PG8_SA(0, 0), cA, coff, 0); PG8_STAGE_A(PG8_SA(0, 1), cA, coff, 1);
    if (wr == 1) PG8_BAR;
    PG8_WAIT_V(2); PG8_BAR;
    PG8_STAGE_B(PG8_SB(1, 0), cB + kstepB); PG8_STAGE_A(PG8_SA(1, 0), cA + kstepA, coff, 0); PG8_STAGE_B(PG8_SB(1, 1), cB + hstepB + kstepB);
    PG8_WAIT_V(6); PG8_BAR;
    for (;;) {
        const bool has_next = S.next(ui + 1, nxt);
        unsigned nA = cA, nB = cB;
#pragma unroll
        for (int h = 0; h < 2; ++h)
#pragma unroll
            for (int i = 0; i < 2; ++i) noff[h][i] = coff[h][i];
        if (has_next) { nA = (unsigned)(S.a_ptr(nxt) - bA); nB = (unsigned)(S.b_ptr(nxt) - bB); S.a_off(nxt, tid_(), noff); }
        for (int t = 0; t < nt; t += 2) {
            if constexpr (MID) { if (2 * t == nt) E.mid(acc, cur, wr, wc, fr, fq); }
            const bool last = (t == nt - 2);
            const unsigned a1 = cA + (unsigned)(t + 1) * kstepA;
            const unsigned a2 = last ? nA : cA + (unsigned)(t + 2) * kstepA, b2 = last ? nB : cB + (unsigned)(t + 2) * kstepB;
            const unsigned a3 = a2 + kstepA, b3 = b2 + kstepB;
            unsigned so[2][2]; const unsigned lmask = last ? 0xffffffffu : 0u;
#pragma unroll
            for (int h = 0; h < 2; ++h)
#pragma unroll
                for (int i = 0; i < 2; ++i) so[h][i] = coff[h][i] ^ ((coff[h][i] ^ noff[h][i]) & lmask);
            PG8_LDB(B0, 0, 0); PG8_LDB(B1, 0, 1); PG8_SCHED; PG8_LDA(At, 0, 0); PG8_STAGE_A(PG8_SA(1, 1), a1, coff, 1);
            PG8_WAIT_V(8); PG8_WAIT_L(0); PG8_BAR; PG8_MMA(0, 0, At, B0); PG8_MMA(0, 1, At, B1); PG8_BAR; PG8_SCHED;
            PG8_LDA(At, 0, 1); PG8_STAGE_B(PG8_SB(0, 0), b2); PG8_STAGE_B(PG8_SB(0, 1), b2 + hstepB); PG8_STAGE_A(PG8_SA(0, 0), a2, so, 0);
            PG8_WAIT_V(8); PG8_WAIT_L(0); PG8_BAR; PG8_MMA(1, 0, At, B0); PG8_MMA(1, 1, At, B1); PG8_BAR; PG8_SCHED;
            PG8_LDB(B0, 1, 0); PG8_LDB(B1, 1, 1); PG8_SCHED; PG8_LDA(At, 1, 0); PG8_STAGE_A(PG8_SA(0, 1), a2, so, 1);
            PG8_WAIT_V(8); PG8_WAIT_L(0); PG8_BAR; PG8_MMA(0, 0, At, B0); PG8_MMA(0, 1, At, B1); PG8_BAR; PG8_SCHED;
            PG8_LDA(At, 1, 1); PG8_STAGE_B(PG8_SB(1, 0), b3); PG8_STAGE_B(PG8_SB(1, 1), b3 + hstepB); PG8_STAGE_A(PG8_SA(1, 0), a3, so, 0);
            PG8_WAIT_V(8); PG8_WAIT_L(0); PG8_BAR; PG8_MMA(1, 0, At, B0); PG8_MMA(1, 1, At, B1); PG8_BAR; PG8_SCHED;
        }
        if constexpr (ALIGN_EPI) { if (wr == 0) PG8_BAR; }
        E(acc, cur, wr, wc, fr, fq);
        if (!has_next) break;
#pragma unroll
        for (int a = 0; a < 2; ++a)
#pragma unroll
            for (int b = 0; b < 2; ++b)
#pragma unroll
                for (int m = 0; m < 4; ++m)
#pragma unroll
                    for (int n = 0; n < 2; ++n) acc[a][b][m][n] = (f32x4){0.f, 0.f, 0.f, 0.f};
        cur = nxt; cA = nA; cB = nB; ++ui;
#pragma unroll
        for (int h = 0; h < 2; ++h)
#pragma unroll
            for (int i = 0; i < 2; ++i) coff[h][i] = noff[h][i];
        if constexpr (ALIGN_EPI) { if (wr == 1) PG8_BAR; }
    }
    PG8_WAIT_V(0);
    if constexpr (!ALIGN_EPI) { if (wr == 0) PG8_BAR; }
    PG8_BAR;
#undef PG8_SA
#undef PG8_SB
#undef PG8_STAGE_A
#undef PG8_STAGE_B
#undef PG8_LDA
#undef PG8_LDB
#undef PG8_MMA
#undef PG8_WAIT_V
#undef PG8_WAIT_L
#undef PG8_BAR
#undef PG8_SCHED
}

struct DenseSched {
    const char* A; const char* Bt; int K, kstepA, ldb; int lda_bytes; int nM, nN, G, c;
    __device__ __forceinline__ void init(const void* A_, int lda_elems, const void* Bt_, int M, int N, int K_, int G_, int c_) {
        A = (const char*)A_; Bt = (const char*)Bt_; K = K_; ldb = K_; kstepA = BK * 2; lda_bytes = lda_elems * 2; nM = M / BM; nN = N / BM; G = G_; c = c_; }
    __device__ __forceinline__ bool next(int i, Unit& u) const {
        const long L = (long)i * G + c; if (L >= (long)nM * nN) return false;
        const int nwg = nM * nN; int wgid = (int)L; { const int q = nwg / 8, r = nwg % 8, xcd = wgid % 8, off = wgid / 8; wgid = (xcd < r ? xcd * (q + 1) : r * (q + 1) + (xcd - r) * q) + off; }
        const int nig = 8 * nN, gid = wgid / nig, fm = gid * 8, gsz = (nM - fm) < 8 ? (nM - fm) : 8;
        u.pm = fm + ((wgid % nig) % gsz); u.pn = (wgid % nig) / gsz; u.e = 0; return true;
    }
    __device__ __forceinline__ const char* a_base() const { return A; }
    __device__ __forceinline__ const char* b_base() const { return Bt; }
    __device__ __forceinline__ const char* a_ptr(const Unit& u) const { return A + (size_t)u.pm * BM * lda_bytes; }
    __device__ __forceinline__ void a_off(const Unit&, int tid, unsigned (&off)[2][2]) const {
#pragma unroll
        for (int i = 0; i < 2; ++i) { int R, C; stage_rc(tid * 16 + i * 8192, R, C);
#pragma unroll
            for (int h = 0; h < 2; ++h) off[h][i] = (unsigned)((h * HALF + R) * lda_bytes + C * 2); }
    }
    __device__ __forceinline__ const char* b_ptr(const Unit& u) const { return Bt + (size_t)u.pn * BM * K * 2; }
};
}
#define MAXROWS2 327680
#define MAXUNITS2 (MAXROWS2 / 256)
#define ZPAD 4608
constexpr int LDS_BYTES = 147456;
constexpr int LDS_MISC = 135168;

namespace wsl {
constexpr size_t al(size_t x) { return (x + 255) & ~(size_t)255; }
constexpr size_t O_ctl = 0;
constexpr size_t O_mod = O_ctl + al(65536);
constexpr size_t O_rope = O_mod + al((size_t)NL * NB * 6144 * 4);
constexpr size_t O_bias1 = O_rope + al((size_t)NT * 32 * 8);
constexpr size_t O_wsc = O_bias1 + al((size_t)NL * 2 * 256 * 4);
constexpr size_t O_Wt_in = O_wsc + al((size_t)NL * 8 * 128 * 128 * 2);
constexpr size_t O_Wt_pn = O_Wt_in + al((size_t)NL * ZPAD * ND * 2);
constexpr size_t O_Wt_pg = O_Wt_pn + al((size_t)NL * ND * 512 * 2);
constexpr size_t O_Wt_out = O_Wt_pg + al((size_t)NL * ND * 512 * 2);
constexpr size_t O_Wt_rs = O_Wt_out + al((size_t)NL * ND * ND * 2);
constexpr size_t O_Wt_ds = O_Wt_rs + al((size_t)NL * 768 * ND * 2);
constexpr size_t O_Wt_w1 = O_Wt_ds + al((size_t)NL * ND * 256 * 2);
constexpr size_t O_h = O_Wt_w1 + al((size_t)NL * 2 * 256 * 2048 * 2);
constexpr size_t O_xb = O_h + al((size_t)NT * ND * 2);
constexpr size_t O_gates = O_xb + al((size_t)NT * ND * 2);
constexpr size_t O_kc = O_gates + al((size_t)NT * 32 * 4);
constexpr size_t O_vc = O_kc + al((size_t)NB * 256 * 128 * 2);
constexpr size_t O_idx = O_vc + al((size_t)NB * 256 * 128 * 2);
constexpr size_t O_slot = O_idx + al((size_t)NT * 8 * 4);
constexpr size_t O_wts = O_slot + al((size_t)NT * 8 * 4);
constexpr size_t O_counts = O_wts + al((size_t)NT * 8 * 4);
constexpr size_t O_cursor = O_counts + al(1024);
constexpr size_t O_bhist = O_cursor + al(1024);
constexpr size_t O_row_tok = O_bhist + al(1024 * 256 * 4);
constexpr size_t O_row_w = O_row_tok + al((size_t)MAXROWS2 * 4);
constexpr size_t O_unit_e = O_row_w + al((size_t)MAXROWS2 * 4);
constexpr size_t O_REGION = O_unit_e + al((size_t)MAXUNITS2 * 4);
constexpr size_t O_qn = O_REGION;
constexpr size_t O_qr = O_qn + al((size_t)NT * 512 * 2);
constexpr size_t O_kvraw = O_qr + al((size_t)NT * 512 * 2);
constexpr size_t O_ksv = O_kvraw + al((size_t)NT * 256 * 2);
constexpr size_t O_kwv = O_ksv + al((size_t)NT * 256 * 2);
constexpr size_t O_u = O_kwv + al((size_t)NT * 256 * 2);
constexpr size_t O_v = O_u + al((size_t)NT * 512 * 2);
constexpr size_t O_sga = O_v + al((size_t)NT * 512 * 2);
constexpr size_t O_sgb = O_sga + al((size_t)NT * ND * 2);
constexpr size_t O_cpart = O_sgb + al((size_t)NT * ND * 2);
constexpr size_t O_onsa = O_cpart + al((size_t)2 * 4 * 4096 * 256 * 4);
constexpr size_t O_ogm = O_onsa + al((size_t)NT * 512 * 2);
constexpr size_t O_merged = O_ogm + al((size_t)NT * 512 * 2);
constexpr size_t O_END_MIX = O_merged + al((size_t)NT * ND * 2);
constexpr size_t O_logits = O_REGION;
constexpr size_t O_sact = O_logits + al((size_t)NT * NE * 4);
constexpr size_t O_shout = O_sact + al((size_t)NT * 256 * 2);
constexpr size_t O_act = O_shout + al((size_t)NT * ND * 2);
constexpr size_t O_yslot = O_act + al((size_t)MAXROWS2 * 256 * 2);
constexpr size_t O_END_MOE = O_yslot + al((size_t)MAXROWS2 * ND * 2);
constexpr size_t O_END_ACT = O_END_MIX > O_END_MOE ? O_END_MIX : O_END_MOE;
constexpr size_t O_Wt_eg = O_END_ACT;
constexpr size_t O_Wt_ed = O_Wt_eg + al((size_t)NL * NE * 512 * ND * 2);
constexpr size_t O_TOTAL = O_Wt_ed + al((size_t)NL * NE * ND * 256 * 2);
}
struct OP {
    const float *x, *c; const int* pos;
    const float *w_mod, *b_mod, *w_in, *q_gain, *k_gain, *pe_k, *pe_v, *w1k, *w2k, *w1v, *w2v, *ln_g, *ln_b, *gm_ws, *gm_bs,
                *wpn, *wpg, *w_out, *w_router, *b_router, *wge, *wue, *wde, *wgs, *wus, *wds;
    float* out;
    float* xres;
    char* ws;
    long long xoff;
    int ph_lo, ph_hi, l_lo, l_hi, conv_l_lo, conv_l_hi;
    __host__ __device__ __forceinline__ unsigned* ctl() const { return (unsigned*)(ws + wsl::O_ctl + (0)); }
    __host__ __device__ __forceinline__ float* mod() const { return (float*)(ws + wsl::O_mod + (0)); }
    __host__ __device__ __forceinline__ float* rope() const { return (float*)(ws + wsl::O_rope + (0)); }
    __host__ __device__ __forceinline__ float* bias1() const { return (float*)(ws + wsl::O_bias1 + (0)); }
    __host__ __device__ __forceinline__ bf16_t* wsc() const { return (bf16_t*)(ws + wsl::O_wsc + (0)); }
    __host__ __device__ __forceinline__ bf16_t* Wt_in() const { return (bf16_t*)(ws + wsl::O_Wt_in + (0)); }
    __host__ __device__ __forceinline__ bf16_t* Wt_pn() const { return (bf16_t*)(ws + wsl::O_Wt_pn + (0)); }
    __host__ __device__ __forceinline__ bf16_t* Wt_pg() const { return (bf16_t*)(ws + wsl::O_Wt_pg + (0)); }
    __host__ __device__ __forceinline__ bf16_t* Wt_out() const { return (bf16_t*)(ws + wsl::O_Wt_out + (0)); }
    __host__ __device__ __forceinline__ bf16_t* Wt_rs() const { return (bf16_t*)(ws + wsl::O_Wt_rs + (0)); }
    __host__ __device__ __forceinline__ bf16_t* Wt_ds() const { return (bf16_t*)(ws + wsl::O_Wt_ds + (0)); }
    __host__ __device__ __forceinline__ bf16_t* Wt_w1() const { return (bf16_t*)(ws + wsl::O_Wt_w1 + (0)); }
    __host__ __device__ __forceinline__ bf16_t* h() const { return (bf16_t*)(ws + wsl::O_h + (0)); }
    __host__ __device__ __forceinline__ bf16_t* xb() const { return (bf16_t*)(ws + wsl::O_xb + (0)); }
    __host__ __device__ __forceinline__ float* gates() const { return (float*)(ws + wsl::O_gates + (0)); }
    __host__ __device__ __forceinline__ bf16_t* kc() const { return (bf16_t*)(ws + wsl::O_kc + (0)); }
    __host__ __device__ __forceinline__ bf16_t* vc() const { return (bf16_t*)(ws + wsl::O_vc + (0)); }
    __host__ __device__ __forceinline__ int* idx() const { return (int*)(ws + wsl::O_idx + (0)); }
    __host__ __device__ __forceinline__ int* slot() const { return (int*)(ws + wsl::O_slot + (0)); }
    __host__ __device__ __forceinline__ float* wts() const { return (float*)(ws + wsl::O_wts + (0)); }
    __host__ __device__ __forceinline__ int* counts() const { return (int*)(ws + wsl::O_counts + (0)); }
    __host__ __device__ __forceinline__ int* cursor() const { return (int*)(ws + wsl::O_cursor + (0)); }
    __host__ __device__ __forceinline__ int* bhist() const { return (int*)(ws + wsl::O_bhist + (0)); }
    __host__ __device__ __forceinline__ int* row_tok() const { return (int*)(ws + wsl::O_row_tok + (0)); }
    __host__ __device__ __forceinline__ float* row_w() const { return (float*)(ws + wsl::O_row_w + (0)); }
    __host__ __device__ __forceinline__ int* unit_e() const { return (int*)(ws + wsl::O_unit_e + (0)); }
    __host__ __device__ __forceinline__ bf16_t* qn() const { return (bf16_t*)(ws + wsl::O_qn + (0)); }
    __host__ __device__ __forceinline__ bf16_t* qr() const { return (bf16_t*)(ws + wsl::O_qr + (0)); }
    __host__ __device__ __forceinline__ bf16_t* kvraw() const { return (bf16_t*)(ws + wsl::O_kvraw + (0)); }
    __host__ __device__ __forceinline__ bf16_t* ksv() const { return (bf16_t*)(ws + wsl::O_ksv + (0)); }
    __host__ __device__ __forceinline__ bf16_t* kwv() const { return (bf16_t*)(ws + wsl::O_kwv + (0)); }
    __host__ __device__ __forceinline__ bf16_t* u() const { return (bf16_t*)(ws + wsl::O_u + (0)); }
    __host__ __device__ __forceinline__ bf16_t* v() const { return (bf16_t*)(ws + wsl::O_v + (0)); }
    __host__ __device__ __forceinline__ bf16_t* sga() const { return (bf16_t*)(ws + wsl::O_sga + (0)); }
    __host__ __device__ __forceinline__ bf16_t* sgb() const { return (bf16_t*)(ws + wsl::O_sgb + (0)); }
    __host__ __device__ __forceinline__ float* cpart() const { return (float*)(ws + wsl::O_cpart + (0)); }
    __host__ __device__ __forceinline__ bf16_t* onsa() const { return (bf16_t*)(ws + wsl::O_onsa + (0)); }
    __host__ __device__ __forceinline__ bf16_t* ogm() const { return (bf16_t*)(ws + wsl::O_ogm + (0)); }
    __host__ __device__ __forceinline__ bf16_t* merged() const { return (bf16_t*)(ws + wsl::O_merged + (0)); }
    __host__ __device__ __forceinline__ float* logits() const { return (float*)(ws + wsl::O_logits + (0)); }
    __host__ __device__ __forceinline__ bf16_t* sact() const { return (bf16_t*)(ws + wsl::O_sact + (0)); }
    __host__ __device__ __forceinline__ bf16_t* shout() const { return (bf16_t*)(ws + wsl::O_shout + (0)); }
    __host__ __device__ __forceinline__ bf16_t* act() const { return (bf16_t*)(ws + wsl::O_act + (0)); }
    __host__ __device__ __forceinline__ bf16_t* yslot() const { return (bf16_t*)(ws + wsl::O_yslot + (0)); }
    __host__ __device__ __forceinline__ bf16_t* Wt_eg() const { return (bf16_t*)(ws + wsl::O_Wt_eg + (xoff)); }
    __host__ __device__ __forceinline__ bf16_t* Wt_ed() const { return (bf16_t*)(ws + wsl::O_Wt_ed + (xoff)); }
};

__device__ __forceinline__ float bf2f(bf16_t b) { return __uint_as_float(((unsigned)b) << 16); }
__device__ __forceinline__ unsigned f2bf(float f) { unsigned u = __float_as_uint(f); return (u + 0x7fffu + ((u >> 16) & 1u)) >> 16; }
__device__ __forceinline__ unsigned pk2(float lo, float hi) { return pg8::cvt_pk_bf16(lo, hi); }
__device__ __forceinline__ float fsigmoid(float x) { return __builtin_amdgcn_rcpf(1.0f + __expf(-x)); }
__device__ __forceinline__ float fgelu(float x) { const float u2 = 1.5957691216057308f * (x + 0.044715f * x * x * x); return x * __builtin_amdgcn_rcpf(1.0f + __expf(-u2)); }
__device__ __forceinline__ float fsilu(float x) { return x * __builtin_amdgcn_rcpf(1.0f + __expf(-x)); }

struct TrItem { const float* src; bf16_t* dst; int ld, scol, nvalid, K, nd0, k0, f8; };
#define W8_SCALE 64.0f
#define H8_SCALE 8.0f
__device__ __forceinline__ unsigned pk4_e4m3(float a, float b, float c, float d) {
    int w = __builtin_amdgcn_cvt_pk_fp8_f32(__builtin_amdgcn_fmed3f(a, -240.f, 240.f), __builtin_amdgcn_fmed3f(b, -240.f, 240.f), 0, false);
    w = __builtin_amdgcn_cvt_pk_fp8_f32(__builtin_amdgcn_fmed3f(c, -240.f, 240.f), __builtin_amdgcn_fmed3f(d, -240.f, 240.f), w, true); return (unsigned)w; }
__device__ __forceinline__ void tr_load(const TrItem& it, f32x4 (&v)[16], int lane) {
    const int n4 = (lane & 7) * 4, kr = lane >> 3;
    const float* s = it.src + (size_t)(it.k0 + kr) * it.ld + it.scol + n4;
#pragma unroll
    for (int i = 0; i < 16; ++i) v[i] = (n4 < it.nvalid) ? __builtin_nontemporal_load((const f32x4*)(s + (size_t)(8 * i) * it.ld)) : (f32x4){0.f, 0.f, 0.f, 0.f};
}
#define TR_PITCH 72
typedef short tr_v4i16 __attribute__((ext_vector_type(4)));
__device__ __forceinline__ void tr_store(const TrItem& it, const f32x4 (&v)[16], LAS float* scrf, int lane) {
    LAS unsigned char* scr = (LAS unsigned char*)scrf;
    const int n4 = (lane & 7) * 4, kr = lane >> 3;
#pragma unroll
    for (int i = 0; i < 16; ++i) { const u32x2 w = {pk2(v[i].x, v[i].y), pk2(v[i].z, v[i].w)}; *(LAS u32x2*)(scr + (8 * i + kr) * TR_PITCH + n4 * 2) = w; }
    asm volatile("s_waitcnt lgkmcnt(0)" ::: "memory");
    const int n = lane & 31, hk = lane >> 5;
    const LAS unsigned char* rb = scr + ((lane & 15) >> 2) * TR_PITCH + (16 * ((lane >> 4) & 1) + 4 * (lane & 3)) * 2;
#pragma unroll
    for (int j = 0; j < 8; ++j) {
        const int cc = 2 * j + hk;
        const tr_v4i16 a = __builtin_amdgcn_ds_read_tr16_b64_v4i16((LAS tr_v4i16*)(rb + (8 * cc) * TR_PITCH)), b = __builtin_amdgcn_ds_read_tr16_b64_v4i16((LAS tr_v4i16*)(rb + (8 * cc + 4) * TR_PITCH));
        const bf16x8 o = {a[0], a[1], a[2], a[3], b[0], b[1], b[2], b[3]};
        if (it.f8) { const u32x4 ow = __builtin_bit_cast(u32x4, o);
            const u32x2 w8 = {pk4_e4m3(__uint_as_float(ow.x << 16) * W8_SCALE, __uint_as_float(ow.x & 0xffff0000u) * W8_SCALE, __uint_as_float(ow.y << 16) * W8_SCALE, __uint_as_float(ow.y & 0xffff0000u) * W8_SCALE),
                              pk4_e4m3(__uint_as_float(ow.z << 16) * W8_SCALE, __uint_as_float(ow.z & 0xffff0000u) * W8_SCALE, __uint_as_float(ow.w << 16) * W8_SCALE, __uint_as_float(ow.w & 0xffff0000u) * W8_SCALE)};
            *(u32x2*)((unsigned char*)it.dst + (size_t)(it.nd0 + n) * it.K + it.k0 + 8 * cc) = w8; }
        else *(bf16x8*)(it.dst + (size_t)(it.nd0 + n) * it.K + it.k0 + 8 * cc) = o;
    }
    asm volatile("s_waitcnt lgkmcnt(0)" ::: "memory");
}
__device__ __forceinline__ void tr_item(const float* src, int ld, int scol, int nvalid, bf16_t* dst, int K, int nd0, int k0, LAS float* scr, int lane, int f8 = 0) {
    TrItem it{src, dst, ld, scol, nvalid, K, nd0, k0, f8}; f32x4 v[16]; tr_load(it, v, lane); tr_store(it, v, scr, lane);
}
__device__ __forceinline__ int win_srccol(int nd0, int& nvalid) {
    const int pn = nd0 >> 8, q = nd0 & 255, bj = q >> 7, wc = (q & 127) >> 5; nvalid = 32;
    if (pn < 2) return ZQ + (4 * pn + wc) * 64 + 32 * bj;
    if (pn < 5) return ZKC + (pn - 2) * 256 + wc * 64 + 32 * bj;
    if (pn < 7) return ZU + (pn - 5) * 256 + q;
    if (pn < 9) return ZV + (pn - 7) * 256 + q;
    if (pn < 17) return (bj ? ZGB : ZGA) + (pn - 9) * 128 + (q & 127);
    nvalid = (q == 0) ? 24 : 0; return ZG;
}
__device__ __forceinline__ void ph_prologue(const OP& p, LAS unsigned char* lds, int bid, int nb) {
    const int tid = tid_(), lane = tid & 63, wave = tid >> 6;
    {
        LAS float* sc = (LAS float*)lds;
        LAS float* part = sc + NB * ND;
        bool have_sc = false;
        for (int job = bid; job < NL * 96 + 16; job += nb) {
            __syncthreads();
            if (job < NL * 96) {
                if (!have_sc) { for (int i = tid; i < NB * ND; i += 512) { const float cv = p.c[i]; sc[i] = cv / (1.0f + expf(-cv)); } have_sc = true; __syncthreads(); }
                const int l = job / 96, j = (job % 96) * 64 + lane;
                const float* w = p.w_mod + (size_t)l * ND * 6144 + (size_t)(wave * 128) * 6144 + j;
                float acc[NB];
#pragma unroll
                for (int b = 0; b < NB; ++b) acc[b] = 0.f;
                for (int bt = 0; bt < 4; ++bt) {
                    float wv[32];
#pragma unroll
                    for (int i = 0; i < 32; ++i) wv[i] = w[(size_t)(bt * 32 + i) * 6144];
#pragma unroll
                    for (int i = 0; i < 32; ++i)
#pragma unroll
                        for (int b = 0; b < NB; ++b) acc[b] = fmaf(sc[b * ND + wave * 128 + bt * 32 + i], wv[i], acc[b]);
                }
#pragma unroll
                for (int b = 0; b < NB; ++b) part[(wave * NB + b) * 64 + lane] = acc[b];
                __syncthreads();
                { const int b = wave; float s = p.b_mod[l * 6144 + j];
#pragma unroll
                  for (int ww = 0; ww < 8; ++ww) s += part[(ww * NB + b) * 64 + lane];
                  p.mod()[((size_t)l * NB + b) * 6144 + j] = s; }
            } else {
                const int jb = job - NL * 96, l = jb >> 3, kv = (jb >> 2) & 1, f = (jb & 3) * 64 + lane;
                const float* pe = (kv ? p.pe_v : p.pe_k) + l * 2048 + wave * 256; const float* w1 = (kv ? p.w1v : p.w1k) + (size_t)l * 2048 * 256 + (size_t)(wave * 256) * 256 + f; float a = 0.f;
                for (int bt = 0; bt < 8; ++bt) {
                    float wv[32];
#pragma unroll
                    for (int i = 0; i < 32; ++i) wv[i] = w1[(size_t)(bt * 32 + i) * 256];
#pragma unroll
                    for (int i = 0; i < 32; ++i) a = fmaf(pe[bt * 32 + i], wv[i], a);
                }
                part[wave * 64 + lane] = a;
                __syncthreads();
                if (wave == 0) { float s = 0.f;
#pragma unroll
                    for (int ww = 0; ww < 8; ++ww) s += part[ww * 64 + lane];
                    p.bias1()[(l * 2 + kv) * 256 + f] = s; }
            }
        }
        __syncthreads();
    }
    const int gt = bid * 512 + tid, ngt = nb * 512;
    for (int it = gt; it < NT * 32; it += ngt) { const int t = it >> 5, i = it & 31; const float inv = (float)pow(10000.0, -(double)i / 32.0); const float ang = (float)p.pos[t] * inv;
        float sn, cs; sincosf(ang, &sn, &cs); *(f32x2*)(p.rope() + (size_t)it * 2) = (f32x2){cs, sn}; }
    for (int it = gt; it < NL * 8 * 128 * 128; it += ngt) { const int s = it & 127, t = (it >> 7) & 127; p.wsc()[it] = (bf16_t)f2bf(s <= t ? p.gm_ws[it] : 0.f); }
    LAS float* scr = (LAS float*)lds + wave * (128 * 33);
    const int gw = bid * 8 + wave, ngw = nb * 8;
    constexpr int I_IN = (ZPAD / 32) * 8, I_P = 32 * 4, I_O = 32 * 8, I_R = 8 * 8, I_SG = 16 * 8, I_DS = 32 * 2, I_W1 = 8 * 16, I_SMALL = I_IN + 2 * I_P + I_O + I_R + I_SG + I_DS + 2 * I_W1;
    for (int it = gw; it < NL * I_SMALL; it += ngw) {
        const int l = it / I_SMALL; int r = it % I_SMALL;
        if (r < I_IN) { const int nd0 = (r >> 3) * 32, k0 = (r & 7) * 128; int nv; const int sc = win_srccol(nd0, nv); tr_item(p.w_in + (size_t)l * ND * INC, INC, sc, nv, p.Wt_in() + (size_t)l * ZPAD * ND, ND, nd0, k0, scr, lane); continue; } r -= I_IN;
        if (r < I_P) { const int nd0 = (r >> 2) * 32, k0 = (r & 3) * 128; tr_item(p.wpn + (size_t)l * 512 * ND, ND, nd0, 32, (bf16_t*)((unsigned char*)p.Wt_pn() + (size_t)l * ND * ND), ND, nd0, k0, scr, lane, 1); continue; } r -= I_P;
        if (r < I_P) { const int nd0 = (r >> 2) * 32, k0 = (r & 3) * 128; tr_item(p.wpg + (size_t)l * 512 * ND, ND, nd0, 32, (bf16_t*)((unsigned char*)p.Wt_pn() + (size_t)l * ND * ND + 512), ND, nd0, k0, scr, lane, 1); continue; } r -= I_P;
        if (r < I_O) { const int nd0 = (r >> 3) * 32, k0 = (r & 7) * 128; tr_item(p.w_out + (size_t)l * ND * ND, ND, nd0, 32, (bf16_t*)((unsigned char*)p.Wt_out() + (size_t)l * ND * ND), ND, nd0, k0, scr, lane, 1); continue; } r -= I_O;
        if (r < I_R) { const int nd0 = (r >> 3) * 32, k0 = (r & 7) * 128; tr_item(p.w_router + (size_t)l * ND * NE, NE, nd0, 32, p.Wt_rs() + (size_t)l * 768 * ND, ND, nd0, k0, scr, lane); continue; } r -= I_R;
        if (r < I_SG) { const int nd0 = (r >> 3) * 32, k0 = (r & 7) * 128; const int tile = nd0 >> 8, q = nd0 & 255;
            tr_item((q < 128 ? p.wgs : p.wus) + (size_t)l * ND * 256, 256, tile * 128 + (q & 127), 32, p.Wt_rs() + (size_t)l * 768 * ND, ND, 256 + nd0, k0, scr, lane); continue; } r -= I_SG;
        if (r < I_DS) { const int nd0 = (r >> 1) * 32, k0 = (r & 1) * 128; tr_item(p.wds + (size_t)l * 256 * ND, ND, nd0, 32, p.Wt_ds() + (size_t)l * ND * 256, 256, nd0, k0, scr, lane); continue; } r -= I_DS;
        { const int kv = r / I_W1; r %= I_W1; const int nd0 = (r >> 4) * 32, k0 = (r & 15) * 128;
          tr_item((kv ? p.w1v : p.w1k) + (size_t)l * 2048 * 256, 256, nd0, 32, p.Wt_w1() + ((size_t)l * 2 + kv) * 256 * 2048, 2048, nd0, k0, scr, lane); }
    }
    constexpr int I_E = 128 + 64;
    const int nle = (p.conv_l_hi - p.conv_l_lo) * NE;
    auto expert_item = [&](long it) {
        const int le = (int)(it / I_E), l = p.conv_l_lo + le / NE, e = le % NE; int r = (int)(it % I_E); TrItem ti;
        if (r < 128) { const int nd0 = (r >> 3) * 32, k0 = (r & 7) * 128; const int tile = nd0 >> 8, q = nd0 & 255;
            ti = TrItem{(q < 128 ? p.wge : p.wue) + ((size_t)l * NE + e) * ND * 256, (bf16_t*)((unsigned char*)p.Wt_eg() + ((size_t)l * NE + e) * 512 * ND), 256, tile * 128 + (q & 127), 32, ND, nd0, k0, 1}; }
        else { r -= 128; const int nd0 = (r >> 1) * 32, k0 = (r & 1) * 128; ti = TrItem{p.wde + ((size_t)l * NE + e) * 256 * ND, (bf16_t*)((unsigned char*)p.Wt_ed() + ((size_t)l * NE + e) * ND * 256), ND, nd0, 32, 256, nd0, k0, 1}; }
        return ti;
    };
    const long nit = (long)nle * I_E;
    if (gw < nit) {
        f32x4 va[16], vb[16];
        TrItem ia = expert_item(gw), ib = ia; tr_load(ia, va, lane);
        for (long it = gw; it < nit; it += 2 * ngw) {
            const bool hb = it + ngw < nit, ha = it + 2 * ngw < nit;
            if (hb) { ib = expert_item(it + ngw); tr_load(ib, vb, lane); }
            tr_store(ia, va, scr, lane);
            if (ha) { ia = expert_item(it + 2 * ngw); tr_load(ia, va, lane); }
            if (hb) tr_store(ib, vb, scr, lane);
        }
    }
}

__device__ __forceinline__ void ph_norm(const OP& p, const float* xin, int l, int sh_off, int sc_off, int bid, int nb) {
    const int lane = tid_() & 63, w = tid_() >> 6;
    for (int t = bid * 8 + w; t < NT; t += nb * 8) {
        const float* xr = xin + (size_t)t * ND;
        f32x4 v[4]; float ss = 0.f;
#pragma unroll
        for (int i = 0; i < 4; ++i) { v[i] = *(const f32x4*)(xr + i * 256 + lane * 4); ss += v[i].x * v[i].x + v[i].y * v[i].y + v[i].z * v[i].z + v[i].w * v[i].w; }
#pragma unroll
        for (int o = 32; o >= 1; o >>= 1) ss += __shfl_xor(ss, o);
        const float rstd = rsqrtf(ss * (1.0f / ND) + 1e-6f);
        const float* mb = p.mod() + ((size_t)l * NB + (t >> 12)) * 6144;
#pragma unroll
        for (int i = 0; i < 4; ++i) {
            const int cidx = i * 256 + lane * 4;
            const f32x4 sc = *(const f32x4*)(mb + sc_off + cidx), sh = *(const f32x4*)(mb + sh_off + cidx);
            u32x2 o; o.x = pk2(v[i].x * rstd * (1.f + sc.x) + sh.x, v[i].y * rstd * (1.f + sc.y) + sh.y); o.y = pk2(v[i].z * rstd * (1.f + sc.z) + sh.z, v[i].w * rstd * (1.f + sc.w) + sh.w);
            *(u32x2*)(p.h() + (size_t)t * ND + cidx) = o;
        }
    }
}

__device__ __forceinline__ void ph_norm_b(const OP& p, const bf16_t* xin, int l, int sh_off, int sc_off, int bid, int nb, unsigned char* h8) {
    const int lane = tid_() & 63, w = tid_() >> 6;
    for (int t = bid * 8 + w; t < NT; t += nb * 8) {
        float v[2][8]; float ss = 0.f;
#pragma unroll
        for (int i = 0; i < 2; ++i) { const u32x4 r = *(const u32x4*)(xin + (size_t)t * ND + i * 512 + lane * 8); const unsigned rw[4] = {r.x, r.y, r.z, r.w};
#pragma unroll
            for (int k = 0; k < 4; ++k) { v[i][2 * k] = __uint_as_float(rw[k] << 16); v[i][2 * k + 1] = __uint_as_float(rw[k] & 0xffff0000u); ss += v[i][2 * k] * v[i][2 * k] + v[i][2 * k + 1] * v[i][2 * k + 1]; } }
#pragma unroll
        for (int o = 32; o >= 1; o >>= 1) ss += __shfl_xor(ss, o);
        const float rstd = rsqrtf(ss * (1.0f / ND) + 1e-6f);
        const float* mb = p.mod() + ((size_t)l * NB + (t >> 12)) * 6144;
#pragma unroll
        for (int i = 0; i < 2; ++i) {
            const int cidx = i * 512 + lane * 8;
            const f32x4 sc0 = *(const f32x4*)(mb + sc_off + cidx), sc1 = *(const f32x4*)(mb + sc_off + cidx + 4), sh0 = *(const f32x4*)(mb + sh_off + cidx), sh1 = *(const f32x4*)(mb + sh_off + cidx + 4);
            u32x4 o; o.x = pk2(v[i][0] * rstd * (1.f + sc0.x) + sh0.x, v[i][1] * rstd * (1.f + sc0.y) + sh0.y); o.y = pk2(v[i][2] * rstd * (1.f + sc0.z) + sh0.z, v[i][3] * rstd * (1.f + sc0.w) + sh0.w);
            o.z = pk2(v[i][4] * rstd * (1.f + sc1.x) + sh1.x, v[i][5] * rstd * (1.f + sc1.y) + sh1.y); o.w = pk2(v[i][6] * rstd * (1.f + sc1.z) + sh1.z, v[i][7] * rstd * (1.f + sc1.w) + sh1.w);
            *(u32x4*)(p.h() + (size_t)t * ND + cidx) = o;
            if (h8) {
                const u32x2 w8 = {pk4_e4m3((v[i][0] * rstd * (1.f + sc0.x) + sh0.x) * H8_SCALE, (v[i][1] * rstd * (1.f + sc0.y) + sh0.y) * H8_SCALE, (v[i][2] * rstd * (1.f + sc0.z) + sh0.z) * H8_SCALE, (v[i][3] * rstd * (1.f + sc0.w) + sh0.w) * H8_SCALE),
                                  pk4_e4m3((v[i][4] * rstd * (1.f + sc1.x) + sh1.x) * H8_SCALE, (v[i][5] * rstd * (1.f + sc1.y) + sh1.y) * H8_SCALE, (v[i][6] * rstd * (1.f + sc1.z) + sh1.z) * H8_SCALE, (v[i][7] * rstd * (1.f + sc1.w) + sh1.w) * H8_SCALE)};
                *(u32x2*)(h8 + (size_t)t * ND + cidx) = w8; }
        }
    }
}

#define LDS_GAIN (LDS_MISC + 256)
struct EpiZ {
    static constexpr bool PERM = true;
    const OP* pp; LAS unsigned char* lds;
    __device__ __forceinline__ void operator()(const f32x4 (&acc)[2][2][4][2], const pg8::Unit& u, int wr, int wc, int fr, int fq) const {
        const OP& p = *pp; const int pn = u.pn;
        const int row0 = u.pm * 256 + wr * 64 + fr;
        if (pn < 5) {
            const bool normed = (pn < 2) || (pn >= 3 && wc < 2);
            bf16_t* dst; int ldd, cbase;
            if (pn < 2) { dst = p.qn(); ldd = 512; cbase = (4 * pn + wc) * 64; }
            else if (pn == 2) { dst = p.kvraw(); ldd = 256; cbase = wc * 64; }
            else if (pn == 3) { dst = p.ksv(); ldd = 256; cbase = wc * 64; }
            else { dst = p.kwv(); ldd = 256; cbase = wc * 64; }
            const LAS float* gain = (const LAS float*)(lds + LDS_GAIN) + (pn < 2 ? 0 : 64);
            const float osc = (pn < 2) ? 0.125f * 1.4426950408889634f : 1.0f;
            f32x4 g0[2], g1[2];
#pragma unroll
            for (int n = 0; n < 2; ++n) { g0[n] = *(const LAS f32x4*)(gain + 8 * fq + 4 * n); g1[n] = *(const LAS f32x4*)(gain + 32 + 8 * fq + 4 * n); }
#pragma unroll
            for (int ai = 0; ai < 2; ++ai)
#pragma unroll
                for (int m = 0; m < 4; ++m) {
                    const int row = row0 + ai * 128 + m * 16;
                    f32x4 y0[2], y1[2];
#pragma unroll
                    for (int n = 0; n < 2; ++n) { y0[n] = acc[ai][0][m][n]; y1[n] = acc[ai][1][m][n]; }
                    float ss = 0.f;
#pragma unroll
                    for (int n = 0; n < 2; ++n) { ss += y0[n].x * y0[n].x + y0[n].y * y0[n].y + y0[n].z * y0[n].z + y0[n].w * y0[n].w; ss += y1[n].x * y1[n].x + y1[n].y * y1[n].y + y1[n].z * y1[n].z + y1[n].w * y1[n].w; }
                    ss += __shfl_xor(ss, 16); ss += __shfl_xor(ss, 32);
                    const float rs = rsqrtf(ss * (1.0f / 64.f) + 1e-6f) * osc;
#pragma unroll
                    for (int n = 0; n < 2; ++n) { y0[n] = normed ? y0[n] * rs * g0[n] : y0[n]; y1[n] = normed ? y1[n] * rs * g1[n] : y1[n]; }
                    u32x4 w0, w1; w0.x = pk2(y0[0].x, y0[0].y); w0.y = pk2(y0[0].z, y0[0].w); w0.z = pk2(y0[1].x, y0[1].y); w0.w = pk2(y0[1].z, y0[1].w);
                    w1.x = pk2(y1[0].x, y1[0].y); w1.y = pk2(y1[0].z, y1[0].w); w1.z = pk2(y1[1].x, y1[1].y); w1.w = pk2(y1[1].z, y1[1].w);
                    *(u32x4*)(dst + (size_t)row * ldd + cbase + 8 * fq) = w0; *(u32x4*)(dst + (size_t)row * ldd + cbase + 32 + 8 * fq) = w1;
                }
        } else if (pn >= 9 && pn < 17) {
            const int col0 = (pn - 9) * 128 + wc * 32 + 8 * fq;
            bf16_t* da = p.sga(); bf16_t* db = p.sgb();
#pragma unroll
            for (int ai = 0; ai < 2; ++ai)
#pragma unroll
                for (int m = 0; m < 4; ++m) {
                    const size_t ro = (size_t)(row0 + ai * 128 + m * 16) * 1024 + col0;
                    float ra[8], sb[8];
#pragma unroll
                    for (int n = 0; n < 2; ++n) { const f32x4 ga = acc[ai][0][m][n], gb = acc[ai][1][m][n];
                        const float gav[4] = {ga.x, ga.y, ga.z, ga.w}, gbv[4] = {gb.x, gb.y, gb.z, gb.w};
#pragma unroll
                        for (int k = 0; k < 4; ++k) { const float ea = __expf(-gav[k]), eb = fminf(__expf(-gbv[k]), 1e20f); const float dbv = 1.0f + eb;
                            ra[4 * n + k] = dbv * __builtin_amdgcn_rcpf(1.0f + ea); sb[4 * n + k] = __builtin_amdgcn_rcpf(dbv); } }
                    u32x4 wa, wb; wa.x = pk2(ra[0], ra[1]); wa.y = pk2(ra[2], ra[3]); wa.z = pk2(ra[4], ra[5]); wa.w = pk2(ra[6], ra[7]);
                    wb.x = pk2(sb[0], sb[1]); wb.y = pk2(sb[2], sb[3]); wb.z = pk2(sb[4], sb[5]); wb.w = pk2(sb[6], sb[7]);
                    *(u32x4*)(da + ro) = wa; *(u32x4*)(db + ro) = wb;
                }
        } else if (pn < 17) {
            bf16_t* dst; int ldd, ct; const bool is_gelu = pn < 9;
            if (pn < 7) { dst = p.u(); ldd = 512; ct = (pn - 5) * 256; } else { dst = p.v(); ldd = 512; ct = (pn - 7) * 256; }
            const int col0 = ct + wc * 32 + 8 * fq;
#pragma unroll
            for (int ai = 0; ai < 2; ++ai)
#pragma unroll
                for (int m = 0; m < 4; ++m) {
                    bf16_t* rowp = dst + (size_t)(row0 + ai * 128 + m * 16) * ldd + col0;
#pragma unroll
                    for (int bj = 0; bj < 2; ++bj) {
                        f32x4 v0 = acc[ai][bj][m][0], v1 = acc[ai][bj][m][1];
                        f32x4 a0, a1, m0, m1;
                        if (is_gelu) { a0 = 1.5957691216057308f * (v0 + 0.044715f * v0 * v0 * v0); a1 = 1.5957691216057308f * (v1 + 0.044715f * v1 * v1 * v1); m0 = v0; m1 = v1; }
                        else { a0 = v0; a1 = v1; m0 = (f32x4){1.f, 1.f, 1.f, 1.f}; m1 = m0; }
                        v0 = (f32x4){m0.x * fsigmoid(a0.x), m0.y * fsigmoid(a0.y), m0.z * fsigmoid(a0.z), m0.w * fsigmoid(a0.w)};
                        v1 = (f32x4){m1.x * fsigmoid(a1.x), m1.y * fsigmoid(a1.y), m1.z * fsigmoid(a1.z), m1.w * fsigmoid(a1.w)};
                        u32x4 w; w.x = pk2(v0.x, v0.y); w.y = pk2(v0.z, v0.w); w.z = pk2(v1.x, v1.y); w.w = pk2(v1.z, v1.w);
                        *(u32x4*)(rowp + bj * 128) = w;
                    }
                }
        } else {
            if (wc == 0) {
#pragma unroll
                for (int ai = 0; ai < 2; ++ai)
#pragma unroll
                    for (int m = 0; m < 4; ++m) {
                        float* rowp = p.gates() + (size_t)(row0 + ai * 128 + m * 16) * 32 + 8 * fq;
                        const f32x4 v0 = acc[ai][0][m][0], v1 = acc[ai][0][m][1];
                        *(f32x4*)(rowp) = (f32x4){fsigmoid(v0.x), fsigmoid(v0.y), fsigmoid(v0.z), fsigmoid(v0.w)};
                        *(f32x4*)(rowp + 4) = (f32x4){fsigmoid(v1.x), fsigmoid(v1.y), fsigmoid(v1.z), fsigmoid(v1.w)};
                    }
            }
        }
    }
};

struct RopeIt { const bf16_t* src; bf16_t* dst; const float* rp; int j; };
__device__ __forceinline__ void rope_addr(const OP& p, long it, RopeIt& r) {
    const int j = (int)(it & 3); const long hvi = it >> 2; const int t = (int)(hvi / 12), hv = (int)(hvi % 12);
    if (hv < 8) { r.src = p.qn() + (size_t)t * 512 + hv * 64; r.dst = p.qr() + (size_t)t * 512 + hv * 64; }
    else if (hv < 10) { r.src = p.ksv() + (size_t)t * 256 + (hv - 8) * 64; r.dst = (bf16_t*)r.src; }
    else { r.src = p.kwv() + (size_t)t * 256 + (hv - 10) * 64; r.dst = (bf16_t*)r.src; }
    r.rp = p.rope() + ((size_t)t * 32 + 8 * j) * 2; r.j = j;
}
__device__ __forceinline__ void rope_apply(const RopeIt& r, const u32x4 a, const u32x4 b, const f32x4 c0, const f32x4 c1, const f32x4 c2, const f32x4 c3) {
    const float cs[8] = {c0.x, c0.z, c1.x, c1.z, c2.x, c2.z, c3.x, c3.z}, sn[8] = {c0.y, c0.w, c1.y, c1.w, c2.y, c2.w, c3.y, c3.w};
    const unsigned aw[4] = {a.x, a.y, a.z, a.w}, bw[4] = {b.x, b.y, b.z, b.w};
    unsigned oa[4], ob[4];
#pragma unroll
    for (int k = 0; k < 4; ++k) {
        const float x1l = __uint_as_float(aw[k] << 16), x1h = __uint_as_float(aw[k] & 0xffff0000u), x2l = __uint_as_float(bw[k] << 16), x2h = __uint_as_float(bw[k] & 0xffff0000u);
        oa[k] = pk2(x1l * cs[2 * k] - x2l * sn[2 * k], x1h * cs[2 * k + 1] - x2h * sn[2 * k + 1]);
        ob[k] = pk2(x2l * cs[2 * k] + x1l * sn[2 * k], x2h * cs[2 * k + 1] + x1h * sn[2 * k + 1]);
    }
    *(u32x4*)(r.dst + 8 * r.j) = (u32x4){oa[0], oa[1], oa[2], oa[3]}; *(u32x4*)(r.dst + 32 + 8 * r.j) = (u32x4){ob[0], ob[1], ob[2], ob[3]};
}
__device__ __forceinline__ void ph_rope(const OP& p, int bid, int nb) {
    const long nitems = (long)NT * 12 * 4, stride = (long)nb * 512;
    long it = (long)bid * 512 + tid_();
    for (; it + 3 * stride < nitems; it += 4 * stride) {
        RopeIt r[4]; u32x4 a[4], b[4]; f32x4 c[4][4];
#pragma unroll
        for (int u = 0; u < 4; ++u) { rope_addr(p, it + u * stride, r[u]); a[u] = *(const u32x4*)(r[u].src + 8 * r[u].j); b[u] = *(const u32x4*)(r[u].src + 32 + 8 * r[u].j);
#pragma unroll
            for (int k = 0; k < 4; ++k) c[u][k] = *(const f32x4*)(r[u].rp + 4 * k); }
#pragma unroll
        for (int u = 0; u < 4; ++u) rope_apply(r[u], a[u], b[u], c[u][0], c[u][1], c[u][2], c[u][3]);
    }
    for (; it < nitems; it += stride) {
        RopeIt r; rope_addr(p, it, r);
        const u32x4 a = *(const u32x4*)(r.src + 8 * r.j), b = *(const u32x4*)(r.src + 32 + 8 * r.j);
        const f32x4 c0 = *(const f32x4*)(r.rp), c1 = *(const f32x4*)(r.rp + 4), c2 = *(const f32x4*)(r.rp + 8), c3 = *(const f32x4*)(r.rp + 12);
        rope_apply(r, a, b, c0, c1, c2, c3);
    }
}
struct CmpSched {
    const char* kvraw; const char* w1; int K, kstepA, ldb; int G, c;
    __device__ __forceinline__ bool next(int i, pg8::Unit& u) const { const int L = i * G + c; if (L >= 128) return false; u.e = L; u.pm = L & 15; u.pn = 0; return true; }
    __device__ __forceinline__ const char* a_base() const { return kvraw; }
    __device__ __forceinline__ const char* b_base() const { return w1; }
    __device__ __forceinline__ const char* a_ptr(const pg8::Unit& u) const { return kvraw; }
    __device__ __forceinline__ void a_off(const pg8::Unit& u, int tid, unsigned (&off)[2][2]) const {
        const int kv = u.e >> 6, s = (u.e >> 4) & 3;
#pragma unroll
        for (int i = 0; i < 2; ++i) { int R, C; pg8::stage_rc(tid * 16 + i * 8192, R, C);
#pragma unroll
            for (int h = 0; h < 2; ++h) { int r = u.pm * 256 + h * 128 + R; r = r < 4080 ? r : 4079; const int b = r / 510, rem = r - b * 510, n = rem >> 1, hh = rem & 1;
                off[h][i] = (unsigned)(((b * NS + 16 * n + 8 * s) * 256 + kv * 128 + hh * 64 + C) * 2); } }
    }
    __device__ __forceinline__ const char* b_ptr(const pg8::Unit& u) const { const int kv = u.e >> 6, s = (u.e >> 4) & 3; return w1 + ((size_t)kv * 256 * 2048 + s * 512) * 2; }
};
struct EpiCmp {
    static constexpr bool PERM = false;
    float* cpart;
    __device__ __forceinline__ void operator()(const f32x4 (&acc)[2][2][4][2], const pg8::Unit& u, int wr, int wc, int fr, int fq) const {
        float* base = cpart + (size_t)(u.e >> 4) * 4096 * 256;
        const int row0 = u.pm * 256 + wr * 64 + fr, col0 = wc * 32 + 4 * fq;
#pragma unroll
        for (int ai = 0; ai < 2; ++ai)
#pragma unroll
            for (int m = 0; m < 4; ++m) { float* rowp = base + (size_t)(row0 + ai * 128 + m * 16) * 256 + col0;
#pragma unroll
                for (int bj = 0; bj < 2; ++bj)
#pragma unroll
                    for (int n = 0; n < 2; ++n) *(f32x4*)(rowp + bj * 128 + n * 16) = acc[ai][bj][m][n]; }
    }
};
__device__ __forceinline__ void ph_cmp2(const OP& p, int l, LAS unsigned char* lds, int bid, int nb) {
    const int tid = tid_(), lane = tid & 63, wave = tid >> 6;
    LAS float* w2s = (LAS float*)lds;
    LAS float* hid = w2s + 256 * 64 + wave * 256;
    int kv_loaded = -1;
    for (int it0 = bid * 8; it0 < 2 * 4096; it0 += nb * 8) {
        const int it = it0 + wave, kv = it0 >> 12, r = it & 4095;
        if (kv != kv_loaded) { __syncthreads(); const float* w2 = (kv ? p.w2v : p.w2k) + (size_t)l * 256 * 64;
            for (int i = tid; i < 256 * 64 / 4; i += 512) *(LAS f32x4*)(w2s + i * 4) = *(const f32x4*)(w2 + i * 4);
            kv_loaded = kv; __syncthreads(); }
        bf16_t* dstbase = kv ? p.vc() : p.kc();
        if (r >= 4080) { if (r < 4088) { const int b = r - 4080; dstbase[((size_t)b * 256 + 255) * 128 + lane] = 0; dstbase[((size_t)b * 256 + 255) * 128 + 64 + lane] = 0; } continue; }
        const float* cp = p.cpart() + ((size_t)kv * 4 * 4096 + r) * 256 + lane * 4;
        f32x4 a = *(const f32x4*)(p.bias1() + (l * 2 + kv) * 256 + lane * 4);
        { f32x4 pv[4];
#pragma unroll
          for (int s = 0; s < 4; ++s) pv[s] = *(const f32x4*)(cp + (size_t)s * 4096 * 256);
#pragma unroll
          for (int s = 0; s < 4; ++s) a += pv[s]; }
        asm volatile("s_waitcnt lgkmcnt(0)" ::: "memory");
        *(LAS f32x4*)(hid + lane * 4) = (f32x4){fgelu(a.x), fgelu(a.y), fgelu(a.z), fgelu(a.w)};
        asm volatile("s_waitcnt lgkmcnt(0)" ::: "memory");
        float o = 0.f;
#pragma unroll 16
        for (int f = 0; f < 256; ++f) o = fmaf(hid[f], w2s[f * 64 + lane], o);
        const int b = r / 510, rem = r - b * 510, n = rem >> 1, hh = rem & 1;
        if (!kv) { float ss = o * o;
#pragma unroll
            for (int x = 32; x >= 1; x >>= 1) ss += __shfl_xor(ss, x);
            o = o * rsqrtf(ss * (1.f / 64.f) + 1e-6f) * p.k_gain[l * 64 + lane]; }
        dstbase[((size_t)b * 256 + n) * 128 + hh * 64 + lane] = (bf16_t)f2bf(o);
    }
    __syncthreads();
}

#define GM_PITCH 520
typedef short v4i16_t __attribute__((ext_vector_type(4)));
__device__ __forceinline__ s16x4 ds_tr16(const LAS bf16_t* ptr) { return __builtin_bit_cast(s16x4, __builtin_amdgcn_ds_read_tr16_b64_v4i16((LAS v4i16_t*)ptr)); }
__device__ __forceinline__ void ph_gmlp(const OP& p, int l, LAS unsigned char* lds, int bid, int nb) {
    const int tid = tid_(), lane = tid & 63, wave = tid >> 6;
    LAS bf16_t* vn = (LAS bf16_t*)lds;
    for (int ch = bid; ch < NT / 128; ch += nb) {
        const size_t base = (size_t)ch * 128;
        __syncthreads();
        f32x4 g0 = *(const f32x4*)(p.ln_g + l * 512 + lane * 8), g1 = *(const f32x4*)(p.ln_g + l * 512 + lane * 8 + 4), b0 = *(const f32x4*)(p.ln_b + l * 512 + lane * 8), b1 = *(const f32x4*)(p.ln_b + l * 512 + lane * 8 + 4);
#pragma unroll 4
        for (int tt = 0; tt < 16; ++tt) {
            const int t = wave * 16 + tt;
            const u32x4 raw = *(const u32x4*)(p.v() + (base + t) * 512 + lane * 8);
            float x[8] = {__uint_as_float(raw.x << 16), __uint_as_float(raw.x & 0xffff0000u), __uint_as_float(raw.y << 16), __uint_as_float(raw.y & 0xffff0000u),
                          __uint_as_float(raw.z << 16), __uint_as_float(raw.z & 0xffff0000u), __uint_as_float(raw.w << 16), __uint_as_float(raw.w & 0xffff0000u)};
            float s = 0.f;
#pragma unroll
            for (int i = 0; i < 8; ++i) s += x[i];
#pragma unroll
            for (int o = 32; o >= 1; o >>= 1) s += __shfl_xor(s, o);
            const float mu = s * (1.f / 512.f); float q = 0.f;
#pragma unroll
            for (int i = 0; i < 8; ++i) { x[i] -= mu; q += x[i] * x[i]; }
#pragma unroll
            for (int o = 32; o >= 1; o >>= 1) q += __shfl_xor(q, o);
            const float rstd = rsqrtf(q * (1.f / 512.f) + 1e-6f);
            u32x4 w; w.x = pk2(x[0] * rstd * g0.x + b0.x, x[1] * rstd * g0.y + b0.y); w.y = pk2(x[2] * rstd * g0.z + b0.z, x[3] * rstd * g0.w + b0.w);
            w.z = pk2(x[4] * rstd * g1.x + b1.x, x[5] * rstd * g1.y + b1.y); w.w = pk2(x[6] * rstd * g1.z + b1.z, x[7] * rstd * g1.w + b1.w);
            *(LAS u32x4*)(vn + t * GM_PITCH + lane * 8) = w;
        }
        __syncthreads();
        const int g = wave, r32 = lane & 31, hi = lane >> 5;
        const bf16_t* wsg = p.wsc() + ((size_t)l * 8 + g) * 128 * 128;
        const LAS bf16_t* bbase = vn + (8 * hi + ((lane & 15) >> 2)) * GM_PITCH + g * 64 + 16 * ((lane >> 4) & 1) + 4 * (lane & 3);
        const float* bsg = p.gm_bs + (l * 8 + g) * 128;
#pragma unroll
        for (int mt = 3; mt >= 0; --mt) {
            bf16x8 af[8];
#pragma unroll
            for (int ks = 0; ks < 2 * (mt + 1); ++ks) af[ks] = *(const bf16x8*)(wsg + (size_t)(32 * mt + r32) * 128 + 16 * ks + 8 * hi);
            float bsv[16];
#pragma unroll
            for (int rg = 0; rg < 16; ++rg) bsv[rg] = bsg[32 * mt + (rg & 3) + 8 * (rg >> 2) + 4 * hi];
            f32x16 acc0, acc1;
#pragma unroll
            for (int i = 0; i < 16; ++i) { acc0[i] = 0.f; acc1[i] = 0.f; }
#pragma unroll
            for (int ks = 0; ks < 2 * (mt + 1); ++ks) {
                const LAS bf16_t* bp = bbase + 16 * ks * GM_PITCH;
                const s16x4 b00 = ds_tr16(bp), b01 = ds_tr16(bp + 4 * GM_PITCH), b10 = ds_tr16(bp + 32), b11 = ds_tr16(bp + 4 * GM_PITCH + 32);
                const bf16x8 bf0 = {b00[0], b00[1], b00[2], b00[3], b01[0], b01[1], b01[2], b01[3]}, bf1 = {b10[0], b10[1], b10[2], b10[3], b11[0], b11[1], b11[2], b11[3]};
                acc0 = __builtin_amdgcn_mfma_f32_32x32x16_bf16(af[ks], bf0, acc0, 0, 0, 0);
                acc1 = __builtin_amdgcn_mfma_f32_32x32x16_bf16(af[ks], bf1, acc1, 0, 0, 0);
            }
#pragma unroll
            for (int rg = 0; rg < 16; ++rg) {
                const int t = 32 * mt + (rg & 3) + 8 * (rg >> 2) + 4 * hi;
                vn[t * GM_PITCH + g * 64 + r32] = (bf16_t)f2bf(acc0[rg] + bsv[rg]); vn[t * GM_PITCH + g * 64 + 32 + r32] = (bf16_t)f2bf(acc1[rg] + bsv[rg]);
            }
        }
        asm volatile("s_waitcnt lgkmcnt(0)" ::: "memory");
        for (int i0 = 0; i0 < 16; i0 += 4) {
            u32x4 uv4[4];
#pragma unroll
            for (int ii = 0; ii < 4; ++ii) { const int t = 8 * (i0 + ii) + (lane >> 3), c8 = (lane & 7) * 8; uv4[ii] = *(const u32x4*)(p.u() + (base + t) * 512 + g * 64 + c8); }
#pragma unroll
            for (int ii = 0; ii < 4; ++ii) {
                const int t = 8 * (i0 + ii) + (lane >> 3), c8 = (lane & 7) * 8;
                const u32x4 mv = *(const LAS u32x4*)(vn + t * GM_PITCH + g * 64 + c8);
                const u32x4 uv = uv4[ii];
                const unsigned mw[4] = {mv.x, mv.y, mv.z, mv.w}, uw[4] = {uv.x, uv.y, uv.z, uv.w}; unsigned ow[4];
                float of[8];
#pragma unroll
                for (int k = 0; k < 4; ++k) { of[2 * k] = __uint_as_float(mw[k] << 16) * __uint_as_float(uw[k] << 16) * H8_SCALE; of[2 * k + 1] = __uint_as_float(mw[k] & 0xffff0000u) * __uint_as_float(uw[k] & 0xffff0000u) * H8_SCALE; }
                (void)ow;
                *(u32x2*)((unsigned char*)p.onsa() + (base + t) * 1024 + 512 + g * 64 + c8) = (u32x2){pk4_e4m3(of[0], of[1], of[2], of[3]), pk4_e4m3(of[4], of[5], of[6], of[7])};
            }
        }
    }
    __syncthreads();
}
#define AT_PITCH 144
#define AT_TILE (64 * AT_PITCH)
#define AT_IMP (4 * AT_TILE)
#define AT_SELM (AT_IMP + 64 * 65 * 4)
#define AT_OST (AT_SELM + 1024)
#define AT_OPITCH 272
#define AT_LOG2E 1.4426950408889634f
#define LDS_ADD(ptr, val) (void)__hip_atomic_fetch_add((ptr), (val), __ATOMIC_RELAXED, __HIP_MEMORY_SCOPE_WORKGROUP)
__device__ __forceinline__ float xhalf_max(float v) { const auto r = __builtin_amdgcn_permlane32_swap(__float_as_uint(v), __float_as_uint(v), false, false); return fmaxf(__uint_as_float(r[0]), __uint_as_float(r[1])); }
__device__ __forceinline__ float xhalf_sum(float v) { const auto r = __builtin_amdgcn_permlane32_swap(__float_as_uint(v), __float_as_uint(v), false, false); return __uint_as_float(r[0]) + __uint_as_float(r[1]); }
__device__ __forceinline__ float max3f(float a, float b, float c) { float r; asm("v_max3_f32 %0, %1, %2, %3" : "=v"(r) : "v"(a), "v"(b), "v"(c)); return r; }
enum { AM_CMP1 = 0, AM_CMP2 = 1, AM_SEL = 2, AM_WIN = 3 };

struct AttnWave {
    f32x16 o0, o1;
    f32x16 ls;
    float M, L;
};

template <int MODE, bool FIXM>
__device__ __forceinline__ void attn_tile(AttnWave& W, const bf16x8 (&qt)[4], const LAS unsigned char* Kl, const LAS unsigned char* Vl, int lane, int r32, int hi,
                                          int lim, bool diag, bool ledge, bool lanesel, float invl, LAS unsigned* imp_row, int jbase) {
    f32x16 s0, s1;
    const float sinit = 0.f;
    const unsigned lmask = (FIXM && MODE == AM_SEL && !lanesel) ? 0u : 0xffffffffu;
#pragma unroll
    for (int i = 0; i < 16; ++i) { s0[i] = sinit; s1[i] = sinit; }
    bf16x8 ka[2][4];
#pragma unroll
    for (int ks = 0; ks < 4; ++ks) { ka[0][ks] = *(const LAS bf16x8*)(Kl + r32 * AT_PITCH + (16 * ks + 8 * hi) * 2); ka[1][ks] = *(const LAS bf16x8*)(Kl + (32 + r32) * AT_PITCH + (16 * ks + 8 * hi) * 2); }
    __builtin_amdgcn_s_setprio(1);
#pragma unroll
    for (int ks = 0; ks < 4; ++ks) { s0 = __builtin_amdgcn_mfma_f32_32x32x16_bf16(ka[0][ks], qt[ks], s0, 0, 0, 0); s1 = __builtin_amdgcn_mfma_f32_32x32x16_bf16(ka[1][ks], qt[ks], s1, 0, 0, 0); }
    __builtin_amdgcn_s_setprio(0);
    s16x4 va[2][2][2][2];
    if (MODE != AM_CMP1) {
        const LAS unsigned char* vb = Vl + ((lane & 15) >> 2) * AT_PITCH + (16 * ((lane >> 4) & 1) + 4 * (lane & 3)) * 2 + (4 * hi) * AT_PITCH;
#pragma unroll
        for (int mt = 0; mt < 2; ++mt)
#pragma unroll
            for (int s = 0; s < 2; ++s) { const LAS unsigned char* vk = vb + (32 * mt + 16 * s) * AT_PITCH;
                va[mt][s][0][0] = ds_tr16((const LAS bf16_t*)(vk)); va[mt][s][0][1] = ds_tr16((const LAS bf16_t*)(vk + 8 * AT_PITCH));
                va[mt][s][1][0] = ds_tr16((const LAS bf16_t*)(vk + 64)); va[mt][s][1][1] = ds_tr16((const LAS bf16_t*)(vk + 8 * AT_PITCH + 64)); }
    }
    const float NEG = -INFINITY;
    if (MODE == AM_CMP1 || MODE == AM_CMP2) {
#pragma unroll
        for (int r = 0; r < 16; ++r) { const int k0 = (r & 3) + 8 * (r >> 2) + 4 * hi; s0[r] = (k0 < lim) ? s0[r] : NEG; s1[r] = (32 + k0 < lim) ? s1[r] : NEG; }
    } else {
        if (diag) {
#pragma unroll
            for (int r = 0; r < 16; ++r) { const int k0 = (r & 3) + 8 * (r >> 2) + 4 * hi; s0[r] = (k0 <= lim) ? s0[r] : NEG; s1[r] = (32 + k0 <= lim) ? s1[r] : NEG; }
        }
        if (MODE == AM_WIN && ledge) {
#pragma unroll
            for (int r = 0; r < 16; ++r) { const int k0 = (r & 3) + 8 * (r >> 2) + 4 * hi; s0[r] = (k0 > lim) ? s0[r] : NEG; s1[r] = (32 + k0 > lim) ? s1[r] : NEG; }
        }
    }
    float Mn = W.M;
    if (MODE != AM_CMP2 && !FIXM) {
        float mx = max3f(s0[0], s1[0], s0[1]);
#pragma unroll
        for (int r = 1; r < 15; ++r) mx = max3f(mx, s1[r], s0[r + 1]);
        mx = max3f(mx, s1[15], s1[15]);
        mx = xhalf_max(mx);
        if (MODE == AM_SEL) mx = lanesel ? mx : NEG;
        Mn = fmaxf(W.M, mx);
    }
    const float Msub = (MODE == AM_SEL && !lanesel) ? INFINITY : Mn;
    float ps = 0.f;
    if (FIXM) {
        if (MODE == AM_SEL || MODE == AM_WIN) {
#pragma unroll
            for (int r = 0; r < 16; ++r) { s0[r] = __builtin_amdgcn_exp2f(s0[r]); s1[r] = __builtin_amdgcn_exp2f(s1[r]); }
        } else {
#pragma unroll
            for (int r = 0; r < 16; ++r) { s0[r] = __builtin_amdgcn_exp2f(s0[r]); s1[r] = __builtin_amdgcn_exp2f(s1[r]); ps += s0[r] + s1[r]; }
        }
    } else {
#pragma unroll
        for (int r = 0; r < 16; ++r) { s0[r] = __builtin_amdgcn_exp2f(s0[r] - Msub); s1[r] = __builtin_amdgcn_exp2f(s1[r] - Msub); ps += s0[r] + s1[r]; }
    }
    if (MODE == AM_CMP1) {
        ps = xhalf_sum(ps);
        if (FIXM) { W.L += ps; return; }
        const float alpha = __builtin_amdgcn_exp2f(W.M - Mn);
        W.L = W.L * alpha + ps; W.M = Mn;
        return;
    }
    if (MODE == AM_CMP2) {
#pragma unroll
        for (int r = 0; r < 16; ++r) { s0[r] *= invl; s1[r] *= invl; }
#pragma unroll
        for (int i = 0; i < 4; ++i) {
            const float q0 = (s0[4 * i] + s0[4 * i + 1]) + (s0[4 * i + 2] + s0[4 * i + 3]), q1 = (s1[4 * i] + s1[4 * i + 1]) + (s1[4 * i + 2] + s1[4 * i + 3]);
            const int j0 = jbase + 2 * i + hi, j1 = j0 + 8;
            LDS_ADD(imp_row + j0, (unsigned)(q0 * 268435456.f + 0.5f)); LDS_ADD(imp_row + j1, (unsigned)(q1 * 268435456.f + 0.5f));
            LDS_ADD(imp_row + j0 + 1, (unsigned)(s0[4 * i + 3] * 268435456.f + 0.5f)); if (j1 + 1 < 64) LDS_ADD(imp_row + j1 + 1, (unsigned)(s1[4 * i + 3] * 268435456.f + 0.5f));
        }
    } else {
        if (!(FIXM && (MODE == AM_SEL || MODE == AM_WIN))) ps = xhalf_sum(ps);
        if (!FIXM && __builtin_amdgcn_ballot_w64(Mn != W.M) != 0ull) {
            const float alpha = __builtin_amdgcn_exp2f(W.M - Mn);
            W.L *= alpha;
#pragma unroll
            for (int r = 0; r < 16; ++r) { W.o0[r] *= alpha; W.o1[r] *= alpha; }
            W.M = Mn;
        }
        W.L += ps;
    }
    __builtin_amdgcn_s_setprio(1);
#pragma unroll
    for (int mt = 0; mt < 2; ++mt)
#pragma unroll
        for (int s = 0; s < 2; ++s) {
            const f32x16& sv = mt ? s1 : s0;
            bf16x8 pb;
            { unsigned w0 = pk2(sv[8 * s + 0], sv[8 * s + 1]), w1 = pk2(sv[8 * s + 2], sv[8 * s + 3]), w2 = pk2(sv[8 * s + 4], sv[8 * s + 5]), w3 = pk2(sv[8 * s + 6], sv[8 * s + 7]);
              if (FIXM && MODE == AM_SEL) { w0 &= lmask; w1 &= lmask; w2 &= lmask; w3 &= lmask; }
              const u32x4 wv = {w0, w1, w2, w3}; pb = __builtin_bit_cast(bf16x8, wv); }
            const s16x4 a00 = va[mt][s][0][0], a01 = va[mt][s][0][1], a10 = va[mt][s][1][0], a11 = va[mt][s][1][1];
            const bf16x8 av0 = {a00[0], a00[1], a00[2], a00[3], a01[0], a01[1], a01[2], a01[3]}, av1 = {a10[0], a10[1], a10[2], a10[3], a11[0], a11[1], a11[2], a11[3]};
            W.o0 = __builtin_amdgcn_mfma_f32_32x32x16_bf16(av0, pb, W.o0, 0, 0, 0);
            W.o1 = __builtin_amdgcn_mfma_f32_32x32x16_bf16(av1, pb, W.o1, 0, 0, 0);
            if (FIXM && (MODE == AM_SEL || MODE == AM_WIN)) { const bf16x8 ones = {0x3f80, 0x3f80, 0x3f80, 0x3f80, 0x3f80, 0x3f80, 0x3f80, 0x3f80}; W.ls = __builtin_amdgcn_mfma_f32_32x32x16_bf16(ones, pb, W.ls, 0, 0, 0); }
        }
    __builtin_amdgcn_s_setprio(0);
}

__device__ __forceinline__ void at_store_tile(LAS unsigned char* lds, int buf, int tid, const u32x4& kr, const u32x4& vr) {
    const int key = tid >> 3, ch = tid & 7;
    *(LAS u32x4*)(lds + (2 * buf) * AT_TILE + key * AT_PITCH + ch * 16) = kr;
    *(LAS u32x4*)(lds + (2 * buf + 1) * AT_TILE + key * AT_PITCH + ch * 16) = vr;
}

#define ATT_TILE(MODE_, ...) do { if (fixm) attn_tile<MODE_, true>(__VA_ARGS__); else attn_tile<MODE_, false>(__VA_ARGS__); } while (0)
__device__ __forceinline__ void ph_attn(const OP& p, int l, LAS unsigned char* lds, int bid, int nb) {
    const int tid = tid_(), lane = tid & 63, wave = tid >> 6, r32 = lane & 31, hi = lane >> 5;
    const int g = wave >> 1, qh = wave & 1, qloc = 32 * qh + r32;
    LAS unsigned* imp = (LAS unsigned*)(lds + AT_IMP);
    LAS unsigned* selm = (LAS unsigned*)(lds + AT_SELM);
    LAS unsigned char* ost = lds + AT_OST + wave * (32 * AT_OPITCH);
    const int key_ld = tid >> 3, ch_ld = tid & 7;
    float gq = fabsf(p.q_gain[l * 64 + lane]), gk = fabsf(p.k_gain[l * 64 + lane]);
#pragma unroll
    for (int o = 32; o >= 1; o >>= 1) { gq = fmaxf(gq, __shfl_xor(gq, o)); gk = fmaxf(gk, __shfl_xor(gk, o)); }
    const float sbound = 8.0f * gq * gk * 1.001f + 0.01f;
    const bool fixm = sbound < 40.0f;
    const float Mfix = sbound * AT_LOG2E;
    for (int round = 0;; ++round) {
        const int idx = round * nb + ((round & 1) ? (nb - 1 - bid) : bid);
        if (idx >= 1024) break;
        const int qb = 63 - (idx >> 4), b = (idx & 15) >> 1, kvh = idx & 1, hq = kvh * 4 + g;
        const int t = qb * 64 + qloc; const size_t tok = (size_t)b * NS + t;
        __syncthreads();
        for (int i = tid; i < 64 * 65; i += 512) imp[i] = 0u;
        if (tid < 2) selm[128 + tid] = 0u;
        bf16x8 qt[4];
#pragma unroll
        for (int ks = 0; ks < 4; ++ks) qt[ks] = *(const bf16x8*)(p.qn() + tok * 512 + hq * 64 + 16 * ks + 8 * hi);
        int nvis = t >= 31 ? ((t - 31) >> 4) + 1 : 0; nvis = nvis > NCMP ? NCMP : nvis;
        const int nvmax = (qb * 64 + 63 - 31) / 16 + 1 > NCMP ? NCMP : (qb * 64 + 63 - 31) / 16 + 1;
        const int ntc = (nvmax + 63) >> 6;
        const bf16_t* kcb = p.kc() + (size_t)b * 256 * 128 + kvh * 64 + ch_ld * 8;
        const bf16_t* vcb = p.vc() + (size_t)b * 256 * 128 + kvh * 64 + ch_ld * 8;
        AttnWave W;
        W.M = fixm ? Mfix : -1e30f; W.L = 0.f;
#pragma unroll
        for (int i = 0; i < 16; ++i) { W.o0[i] = 0.f; W.o1[i] = 0.f; }
        const float gate0 = p.gates()[tok * 32 + hq * 3 + 0], gate1 = p.gates()[tok * 32 + hq * 3 + 1], gate2 = p.gates()[tok * 32 + hq * 3 + 2];
        u32x4 kr, vr;
        kr = *(const u32x4*)(kcb + (size_t)key_ld * 128); vr = *(const u32x4*)(vcb + (size_t)key_ld * 128);
        at_store_tile(lds, 0, tid, kr, vr);
        __syncthreads();
        float invl = 0.f;
        for (int i = 0; i < 2 * ntc; ++i) {
            const int kt = i < ntc ? i : i - ntc, nx = i + 1, ktn = nx < ntc ? nx : nx - ntc;
            if (nx < 2 * ntc) { kr = *(const u32x4*)(kcb + (size_t)(64 * ktn + key_ld) * 128); vr = *(const u32x4*)(vcb + (size_t)(64 * ktn + key_ld) * 128); }
            const LAS unsigned char* Kl = lds + (2 * (i & 1)) * AT_TILE; const LAS unsigned char* Vl = Kl + AT_TILE;
            if (i < ntc) ATT_TILE(AM_CMP1, W, qt, Kl, Vl, lane, r32, hi, nvis - 64 * kt, false, false, true, 0.f, nullptr, 0);
            else { if (i == ntc) invl = 1.0f / fmaxf(W.L, 1e-30f);
                   ATT_TILE(AM_CMP2, W, qt, Kl, Vl, lane, r32, hi, nvis - 64 * kt, false, false, true, invl, imp + qloc * 65, 16 * kt); }
            if (nx < 2 * ntc) at_store_tile(lds, nx & 1, tid, kr, vr);
            __syncthreads();
        }
#pragma unroll
        for (int i = 0; i < 4; ++i) {
            *(LAS f32x4*)(ost + r32 * AT_OPITCH + (8 * i + 4 * hi) * 4) = (f32x4){gate0 * W.o0[4 * i], gate0 * W.o0[4 * i + 1], gate0 * W.o0[4 * i + 2], gate0 * W.o0[4 * i + 3]};
            *(LAS f32x4*)(ost + r32 * AT_OPITCH + (32 + 8 * i + 4 * hi) * 4) = (f32x4){gate0 * W.o1[4 * i], gate0 * W.o1[4 * i + 1], gate0 * W.o1[4 * i + 2], gate0 * W.o1[4 * i + 3]};
        }
        const bf16_t* kbs = p.ksv() + (size_t)b * NS * 256 + kvh * 64 + ch_ld * 8;
        kr = *(const u32x4*)(kbs + (size_t)key_ld * 256); vr = *(const u32x4*)(kbs + (size_t)key_ld * 256 + 128);
        {
            const int q = tid >> 3, part = tid & 7;
            const LAS unsigned* row = imp + q * 65 + part * 8;
            unsigned key[8];
#pragma unroll
            for (int i = 0; i < 8; ++i) { const int j = part * 8 + i; const unsigned v = (j == 0 || j == qb || j == qb - 1) ? 0xffffffffu : (row[i] | 64u);
                key[i] = (j <= qb) ? ((v & 0xffffffc0u) | (unsigned)(63 - j)) : 0u; }
            unsigned long long mask = 0ull; const int rounds = qb + 1 < 16 ? qb + 1 : 16;
            for (int it = 0; it < rounds; ++it) {
                unsigned best = key[0];
#pragma unroll
                for (int i = 1; i < 8; ++i) best = key[i] > best ? key[i] : best;
                { unsigned o;
                  o = (unsigned)__builtin_amdgcn_update_dpp(0, (int)best, 0xB1, 0xf, 0xf, false); best = best > o ? best : o;
                  o = (unsigned)__builtin_amdgcn_update_dpp(0, (int)best, 0x4E, 0xf, 0xf, false); best = best > o ? best : o;
                  o = (unsigned)__builtin_amdgcn_update_dpp(0, (int)best, 0x141, 0xf, 0xf, false); best = best > o ? best : o; }
                const int jw = 63 - (int)(best & 63u);
                mask |= 1ull << jw;
#pragma unroll
                for (int i = 0; i < 8; ++i) key[i] = (key[i] == best) ? 0u : key[i];
            }
            if (part == 0) { selm[2 * q] = (unsigned)mask; selm[2 * q + 1] = (unsigned)(mask >> 32);
                (void)__hip_atomic_fetch_or(selm + 128, (unsigned)mask, __ATOMIC_RELAXED, __HIP_MEMORY_SCOPE_WORKGROUP); (void)__hip_atomic_fetch_or(selm + 129, (unsigned)(mask >> 32), __ATOMIC_RELAXED, __HIP_MEMORY_SCOPE_WORKGROUP); }
        }
        __syncthreads();
        const unsigned long long mymask = (unsigned long long)selm[2 * qloc] | ((unsigned long long)selm[2 * qloc + 1] << 32);
        const unsigned long long umask = (unsigned long long)selm[128] | ((unsigned long long)selm[129] << 32);
        const bf16_t* kbw = p.kwv() + (size_t)b * NS * 256 + kvh * 64 + ch_ld * 8;
        const int j0w = qb - 8 > 0 ? qb - 8 : 0;
        int pw = 0;
#pragma unroll
        for (int ks = 0; ks < 4; ++ks) qt[ks] = *(const bf16x8*)(p.qr() + tok * 512 + hq * 64 + 16 * ks + 8 * hi);
        {
            W.M = fixm ? Mfix : -1e30f; W.L = 0.f;
#pragma unroll
            for (int i = 0; i < 16; ++i) { W.o0[i] = 0.f; W.o1[i] = 0.f; W.ls[i] = 0.f; }
            const bf16_t* kb = kbs;
            unsigned long long rem = umask & ~1ull;
            int j = 0;
            at_store_tile(lds, 0, tid, kr, vr);
            __syncthreads();

            for (int i = 0;; ++i) {
                const bool more = rem != 0ull; int jn = 0;
                if (more) { jn = __builtin_ctzll(rem); rem &= rem - 1; kr = *(const u32x4*)(kb + (size_t)(64 * jn + key_ld) * 256); vr = *(const u32x4*)(kb + (size_t)(64 * jn + key_ld) * 256 + 128); }
                else { kr = *(const u32x4*)(kbw + (size_t)(64 * j0w + key_ld) * 256); vr = *(const u32x4*)(kbw + (size_t)(64 * j0w + key_ld) * 256 + 128); }
                const LAS unsigned char* Kl = lds + (2 * (i & 1)) * AT_TILE; const LAS unsigned char* Vl = Kl + AT_TILE;
                ATT_TILE(AM_SEL, W, qt, Kl, Vl, lane, r32, hi, qloc, j == qb, false, ((mymask >> j) & 1ull) != 0ull, 0.f, nullptr, 0);
                at_store_tile(lds, (i + 1) & 1, tid, kr, vr);
                __syncthreads();
                if (!more) { pw = (i + 1) & 1; break; }
                j = jn;
            }
            if (fixm) W.L = W.ls[0];
            const float sc = gate1 / fmaxf(W.L, 1e-30f);
#pragma unroll
            for (int i = 0; i < 4; ++i) {
                LAS f32x4* p0 = (LAS f32x4*)(ost + r32 * AT_OPITCH + (8 * i + 4 * hi) * 4); LAS f32x4* p1 = (LAS f32x4*)(ost + r32 * AT_OPITCH + (32 + 8 * i + 4 * hi) * 4);
                *p0 = *p0 + (f32x4){sc * W.o0[4 * i], sc * W.o0[4 * i + 1], sc * W.o0[4 * i + 2], sc * W.o0[4 * i + 3]};
                *p1 = *p1 + (f32x4){sc * W.o1[4 * i], sc * W.o1[4 * i + 1], sc * W.o1[4 * i + 2], sc * W.o1[4 * i + 3]};
            }
        }
        {
            W.M = fixm ? Mfix : -1e30f; W.L = 0.f;
#pragma unroll
            for (int i = 0; i < 16; ++i) { W.o0[i] = 0.f; W.o1[i] = 0.f; W.ls[i] = 0.f; }
            const bf16_t* kb = kbw;
            const int j0 = j0w;
            for (int j = j0; j <= qb; ++j) {
                const int i = j - j0 + pw;
                if (j < qb) { kr = *(const u32x4*)(kb + (size_t)(64 * (j + 1) + key_ld) * 256); vr = *(const u32x4*)(kb + (size_t)(64 * (j + 1) + key_ld) * 256 + 128); }
                const LAS unsigned char* Kl = lds + (2 * (i & 1)) * AT_TILE; const LAS unsigned char* Vl = Kl + AT_TILE;
                ATT_TILE(AM_WIN, W, qt, Kl, Vl, lane, r32, hi, qloc, j == qb, j == qb - 8, true, 0.f, nullptr, 0);
                if (j < qb) at_store_tile(lds, (i + 1) & 1, tid, kr, vr);
                __syncthreads();
            }
            if (fixm) W.L = W.ls[0];
            const float sc = gate2 / fmaxf(W.L, 1e-30f);
#pragma unroll
            for (int i = 0; i < 4; ++i) {
                LAS f32x4* p0 = (LAS f32x4*)(ost + r32 * AT_OPITCH + (8 * i + 4 * hi) * 4); LAS f32x4* p1 = (LAS f32x4*)(ost + r32 * AT_OPITCH + (32 + 8 * i + 4 * hi) * 4);
                *p0 = *p0 + (f32x4){sc * W.o0[4 * i], sc * W.o0[4 * i + 1], sc * W.o0[4 * i + 2], sc * W.o0[4 * i + 3]};
                *p1 = *p1 + (f32x4){sc * W.o1[4 * i], sc * W.o1[4 * i + 1], sc * W.o1[4 * i + 2], sc * W.o1[4 * i + 3]};
            }
        }
        asm volatile("s_waitcnt lgkmcnt(0)" ::: "memory");
#pragma unroll
        for (int i = 0; i < 4; ++i) {
            const int row = 8 * i + (lane >> 3), c8 = lane & 7;
            const f32x4 a = *(const LAS f32x4*)(ost + row * AT_OPITCH + c8 * 32), bq = *(const LAS f32x4*)(ost + row * AT_OPITCH + c8 * 32 + 16);
            const u32x2 v = {pk4_e4m3(a.x * H8_SCALE, a.y * H8_SCALE, a.z * H8_SCALE, a.w * H8_SCALE), pk4_e4m3(bq.x * H8_SCALE, bq.y * H8_SCALE, bq.z * H8_SCALE, bq.w * H8_SCALE)};
            *(u32x2*)((unsigned char*)p.onsa() + ((size_t)b * NS + qb * 64 + 32 * qh + row) * 1024 + hq * 64 + c8 * 8) = v;
        }
    }
    __syncthreads();
}
struct EpiProjF {
    static constexpr bool PERM = true;
    bf16_t* merged; const bf16_t* ra; const bf16_t* sb; float dsc;
    static __device__ __forceinline__ unsigned base_off(const pg8::Unit& u, int wr, int wc, int fr, int fq) {
        unsigned b = (unsigned)(((u.pm * 256 + wr * 64 + fr) * ND + u.pn * 256 + wc * 32 + 8 * fq) * 2); asm volatile("" : "+v"(b)); return b; }
    __device__ __forceinline__ void mid(f32x4 (&acc)[2][2][4][2], const pg8::Unit& u, int wr, int wc, int fr, int fq) const {
        const unsigned b0 = base_off(u, wr, wc, fr, fq);
#pragma unroll
        for (int ai = 0; ai < 2; ++ai)
#pragma unroll
            for (int m = 0; m < 4; ++m) {
                const unsigned ro = b0 + (unsigned)((ai * 128 + m * 16) * ND * 2);
                u32x4 gv[2];
#pragma unroll
                for (int bj = 0; bj < 2; ++bj) gv[bj] = *(const u32x4*)((const char*)ra + ro + bj * 256);
#pragma unroll
                for (int bj = 0; bj < 2; ++bj) {
                    acc[ai][bj][m][0] *= (f32x4){__uint_as_float(gv[bj].x << 16), __uint_as_float(gv[bj].x & 0xffff0000u), __uint_as_float(gv[bj].y << 16), __uint_as_float(gv[bj].y & 0xffff0000u)};
                    acc[ai][bj][m][1] *= (f32x4){__uint_as_float(gv[bj].z << 16), __uint_as_float(gv[bj].z & 0xffff0000u), __uint_as_float(gv[bj].w << 16), __uint_as_float(gv[bj].w & 0xffff0000u)};
                }
            }
    }
    __device__ __forceinline__ void operator()(const f32x4 (&acc)[2][2][4][2], const pg8::Unit& u, int wr, int wc, int fr, int fq) const {
        const unsigned b0 = base_off(u, wr, wc, fr, fq);
        u32x4 gv[2][4][2];
#pragma unroll
        for (int ai = 0; ai < 2; ++ai)
#pragma unroll
            for (int m = 0; m < 4; ++m)
#pragma unroll
                for (int bj = 0; bj < 2; ++bj) gv[ai][m][bj] = *(const u32x4*)((const char*)sb + (b0 + (unsigned)((ai * 128 + m * 16) * ND * 2)) + bj * 256);
#pragma unroll
        for (int ai = 0; ai < 2; ++ai)
#pragma unroll
            for (int m = 0; m < 4; ++m) {
                const unsigned ro = b0 + (unsigned)((ai * 128 + m * 16) * ND * 2);
#pragma unroll
                for (int bj = 0; bj < 2; ++bj) { const u32x4 g = gv[ai][m][bj];
                    const f32x4 o0 = acc[ai][bj][m][0] * (f32x4){__uint_as_float(g.x << 16), __uint_as_float(g.x & 0xffff0000u), __uint_as_float(g.y << 16), __uint_as_float(g.y & 0xffff0000u)};
                    const f32x4 o1 = acc[ai][bj][m][1] * (f32x4){__uint_as_float(g.z << 16), __uint_as_float(g.z & 0xffff0000u), __uint_as_float(g.w << 16), __uint_as_float(g.w & 0xffff0000u)};
                    *(u32x2*)((unsigned char*)merged + (ro >> 1) + bj * 128) = (u32x2){pk4_e4m3(o0.x * dsc, o0.y * dsc, o0.z * dsc, o0.w * dsc), pk4_e4m3(o1.x * dsc, o1.y * dsc, o1.z * dsc, o1.w * dsc)};
                }
            }
    }
};
template <bool XF32> struct EpiOut {
    static constexpr bool PERM = true;
    const float* xin; bf16_t* xb; const float* gt; float dsc;
    __device__ __forceinline__ void operator()(const f32x4 (&acc)[2][2][4][2], const pg8::Unit& u, int wr, int wc, int fr, int fq) const {
        const int row0 = u.pm * 256 + wr * 64 + fr, col0 = u.pn * 256 + wc * 32 + 8 * fq;
        const float* gp = gt + (size_t)(u.pm >> 4) * 6144 + col0;
        f32x4 g4[2][2];
#pragma unroll
        for (int bj = 0; bj < 2; ++bj)
#pragma unroll
            for (int n = 0; n < 2; ++n) g4[bj][n] = *(const f32x4*)(gp + bj * 128 + n * 4) * dsc;
#pragma unroll
        for (int ai = 0; ai < 2; ++ai) {
            f32x4 xv[4][2][2];
            if (XF32) {
#pragma unroll
                for (int m = 0; m < 4; ++m)
#pragma unroll
                    for (int bj = 0; bj < 2; ++bj) { const float* xp = xin + (size_t)(row0 + ai * 128 + m * 16) * ND + col0 + bj * 128; xv[m][bj][0] = *(const f32x4*)xp; xv[m][bj][1] = *(const f32x4*)(xp + 4); }
            } else {
                u32x4 r[4][2];
#pragma unroll
                for (int m = 0; m < 4; ++m)
#pragma unroll
                    for (int bj = 0; bj < 2; ++bj) r[m][bj] = *(const u32x4*)(xb + (size_t)(row0 + ai * 128 + m * 16) * ND + col0 + bj * 128);
#pragma unroll
                for (int m = 0; m < 4; ++m)
#pragma unroll
                    for (int bj = 0; bj < 2; ++bj) { const u32x4 q = r[m][bj];
                        xv[m][bj][0] = (f32x4){__uint_as_float(q.x << 16), __uint_as_float(q.x & 0xffff0000u), __uint_as_float(q.y << 16), __uint_as_float(q.y & 0xffff0000u)};
                        xv[m][bj][1] = (f32x4){__uint_as_float(q.z << 16), __uint_as_float(q.z & 0xffff0000u), __uint_as_float(q.w << 16), __uint_as_float(q.w & 0xffff0000u)}; }
            }
#pragma unroll
            for (int m = 0; m < 4; ++m)
#pragma unroll
                for (int bj = 0; bj < 2; ++bj) { const f32x4 o0 = xv[m][bj][0] + g4[bj][0] * acc[ai][bj][m][0], o1 = xv[m][bj][1] + g4[bj][1] * acc[ai][bj][m][1];
                    u32x4 w; w.x = pk2(o0.x, o0.y); w.y = pk2(o0.z, o0.w); w.z = pk2(o1.x, o1.y); w.w = pk2(o1.z, o1.w);
                    *(u32x4*)(xb + (size_t)(row0 + ai * 128 + m * 16) * ND + col0 + bj * 128) = w; }
        }
    }
};

struct EpiRouter {
    static constexpr bool PERM = true;
    float* logits; bf16_t* sact;
    __device__ __forceinline__ void operator()(const f32x4 (&acc)[2][2][4][2], const pg8::Unit& u, int wr, int wc, int fr, int fq) const {
        const int row0 = u.pm * 256 + wr * 64 + fr, cw = wc * 32 + 8 * fq;
        if (u.pn == 0) {
#pragma unroll
            for (int ai = 0; ai < 2; ++ai)
#pragma unroll
                for (int m = 0; m < 4; ++m) { float* rp = logits + (size_t)(row0 + ai * 128 + m * 16) * NE + cw;
#pragma unroll
                    for (int bj = 0; bj < 2; ++bj) { *(f32x4*)(rp + bj * 128) = acc[ai][bj][m][0]; *(f32x4*)(rp + bj * 128 + 4) = acc[ai][bj][m][1]; } }
        } else {
#pragma unroll
            for (int ai = 0; ai < 2; ++ai)
#pragma unroll
                for (int m = 0; m < 4; ++m) {
                    const f32x4 g0 = acc[ai][0][m][0], g1 = acc[ai][0][m][1], u0 = acc[ai][1][m][0], u1 = acc[ai][1][m][1];
                    u32x4 w; w.x = pk2(fsilu(g0.x) * u0.x, fsilu(g0.y) * u0.y); w.y = pk2(fsilu(g0.z) * u0.z, fsilu(g0.w) * u0.w);
                    w.z = pk2(fsilu(g1.x) * u1.x, fsilu(g1.y) * u1.y); w.w = pk2(fsilu(g1.z) * u1.z, fsilu(g1.w) * u1.w);
                    *(u32x4*)(sact + (size_t)(row0 + ai * 128 + m * 16) * 256 + (u.pn - 1) * 128 + cw) = w;
                }
        }
    }
};

__device__ __forceinline__ void ph_topk(const OP& p, int l, LAS unsigned char* lds, int bid, int nb) {
    const int tid = tid_(), lane = tid & 63, w = tid >> 6;
    LAS int* hist = (LAS int*)lds;
    const float* lg = p.logits(); int* idxp = p.idx(); float* wtp = p.wts(); int* slot = p.slot();
    __syncthreads();
    if (tid < 256) hist[tid] = 0;
    __syncthreads();
    const int CH = (NT + nb - 1) / nb, t0 = bid * CH, t1 = (t0 + CH) < NT ? (t0 + CH) : NT;
    float br[4];
#pragma unroll
    for (int i = 0; i < 4; ++i) br[i] = p.b_router[l * NE + i * 64 + lane];
    float lgn[4];
#pragma unroll
    for (int i = 0; i < 4; ++i) lgn[i] = (t0 + w < t1) ? lg[(size_t)(t0 + w) * NE + i * 64 + lane] : 0.f;
    for (int t = t0 + w; t < t1; t += 8) {
        unsigned key[4]; float affv[4];
#pragma unroll
        for (int i = 0; i < 4; ++i) { const int e = i * 64 + lane; const float aff = 1.0f / (1.0f + expf(-lgn[i])); affv[i] = aff; const float kf = fmaxf(aff + br[i], 1e-30f);
            key[i] = (__float_as_uint(kf) & 0xffffff00u) | (unsigned)(255 - e); }
        if (t + 8 < t1) {
#pragma unroll
            for (int i = 0; i < 4; ++i) lgn[i] = lg[(size_t)(t + 8) * NE + i * 64 + lane]; }
        int mye = 0;
#pragma unroll
        for (int r = 0; r < 8; ++r) {
            unsigned m = key[0] > key[1] ? key[0] : key[1]; { const unsigned m2 = key[2] > key[3] ? key[2] : key[3]; m = m > m2 ? m : m2; }
            { unsigned o;
              o = (unsigned)__builtin_amdgcn_update_dpp(0, (int)m, 0xB1, 0xf, 0xf, false); m = m > o ? m : o;
              o = (unsigned)__builtin_amdgcn_update_dpp(0, (int)m, 0x4E, 0xf, 0xf, false); m = m > o ? m : o;
              o = (unsigned)__builtin_amdgcn_update_dpp(0, (int)m, 0x141, 0xf, 0xf, false); m = m > o ? m : o;
              o = (unsigned)__builtin_amdgcn_update_dpp(0, (int)m, 0x140, 0xf, 0xf, false); m = m > o ? m : o; }
            const unsigned r0 = (unsigned)__builtin_amdgcn_readlane((int)m, 0), r1 = (unsigned)__builtin_amdgcn_readlane((int)m, 16), r2 = (unsigned)__builtin_amdgcn_readlane((int)m, 32), r3 = (unsigned)__builtin_amdgcn_readlane((int)m, 48);
            unsigned win = r0 > r1 ? r0 : r1; { const unsigned w2 = r2 > r3 ? r2 : r3; win = win > w2 ? win : w2; }
#pragma unroll
            for (int i = 0; i < 4; ++i) key[i] = (key[i] == win) ? 0u : key[i];
            if (lane == r) mye = 255 - (int)(win & 255u);
        }
        float av = 0.f;
        { const int sl = mye & 63, si = mye >> 6;
          const float a0 = __shfl(affv[0], sl), a1 = __shfl(affv[1], sl), a2 = __shfl(affv[2], sl), a3 = __shfl(affv[3], sl);
          const float sel = (si == 0) ? a0 : (si == 1) ? a1 : (si == 2) ? a2 : a3;
          if (lane < 8) av = sel; }
        float sum = av;
        sum += __shfl_xor(sum, 1); sum += __shfl_xor(sum, 2); sum += __shfl_xor(sum, 4);
        if (lane < 8) {
            idxp[(size_t)t * 8 + lane] = mye; wtp[(size_t)t * 8 + lane] = av / sum * 2.5f;
            slot[(size_t)t * 8 + lane] = __hip_atomic_fetch_add(hist + mye, 1, __ATOMIC_RELAXED, __HIP_MEMORY_SCOPE_WORKGROUP);
        }
    }
    __syncthreads();
    if (tid < 256) p.bhist()[bid * 256 + tid] = hist[tid];
    __syncthreads();
}
#define CW_NUNITS 64
__device__ __forceinline__ void ph_place(const OP& p, LAS unsigned char* lds, int bid, int nb) {
    const int tid = tid_();
    LAS int* pst = (LAS int*)lds;
    LAS int* cntl = pst + 260;
    LAS int* basel = cntl + 256;
    int* rtok = p.row_tok(); float* rw = p.row_w(); int* ue = p.unit_e(); const int* bh = p.bhist();
    LAS int* ptot = basel + 256;
    LAS int* pbase = ptot + 8 * 256;
    __syncthreads();
    { const int lane = tid & 63, wave = tid >> 6; int tot[4] = {0, 0, 0, 0}, base[4] = {0, 0, 0, 0};
      for (int b0 = wave; b0 < nb; b0 += 64) {
          int v[8][4];
#pragma unroll
          for (int k = 0; k < 8; ++k) { const int b = b0 + 8 * k;
#pragma unroll
              for (int i = 0; i < 4; ++i) v[k][i] = (b < nb) ? bh[b * 256 + i * 64 + lane] : 0; }
#pragma unroll
          for (int k = 0; k < 8; ++k) { const int b = b0 + 8 * k;
#pragma unroll
              for (int i = 0; i < 4; ++i) { tot[i] += v[k][i]; base[i] += (b < bid) ? v[k][i] : 0; } }
      }
#pragma unroll
      for (int i = 0; i < 4; ++i) { ptot[wave * 256 + i * 64 + lane] = tot[i]; pbase[wave * 256 + i * 64 + lane] = base[i]; } }
    __syncthreads();
    if (tid < 256) { int tot = 0, base = 0;
#pragma unroll
        for (int ww = 0; ww < 8; ++ww) { tot += ptot[ww * 256 + tid]; base += pbase[ww * 256 + tid]; }
        cntl[tid] = tot; basel[tid] = base; ptot[tid] = (tot + 255) & ~255; }
    __syncthreads();
    if (tid <= 256) { int run = 0;
        for (int e = 0; e < 256; ++e) run += (e < tid) ? ptot[e] : 0;
        pst[tid] = run; }
    __syncthreads();
    if (bid == 0) {
        if (tid < 256) { for (int i = pst[tid] >> 8; i < pst[tid + 1] >> 8; ++i) ue[i] = tid; }
        if (tid == 0) p.ctl()[CW_NUNITS] = (unsigned)(pst[NE] >> 8);
    }
    for (int e = bid; e < NE; e += nb) { for (int r = pst[e] + cntl[e] + tid; r < pst[e + 1]; r += 512) { rtok[r] = 0; rw[r] = -1.f; } }
    const int* idxp = p.idx(); const float* wtp = p.wts(); int* slot = p.slot();
    const int CH = (NT + nb - 1) / nb, a0 = bid * CH * 8, a1 = ((bid + 1) * CH < NT ? (bid + 1) * CH : NT) * 8;
    for (int a = a0 + tid; a < a1; a += 512) {
        const int e = idxp[a]; const int dest = pst[e] + basel[e] + slot[a];
        rtok[dest] = a >> 3; rw[dest] = wtp[a]; slot[a] = dest;
    }
    __syncthreads();
}

__device__ __forceinline__ int xcd_chunk(int L, int nwg) { const int q = nwg / 8, r = nwg % 8, xcd = L % 8, off = L / 8; return (xcd < r ? xcd * (q + 1) : r * (q + 1) + (xcd - r) * q) + off; }
struct GatherSched {
    const char* h; const char* W; const int* row_tok; const int* unit_e; int K, kstepA, ldb; int nunits2, G, c; int arow, brow;
    __device__ __forceinline__ bool next(int i, pg8::Unit& u) const { int L = i * G + c; if (L >= nunits2) return false; L = xcd_chunk(L, nunits2); u.pm = L >> 1; u.pn = L & 1; u.e = unit_e[u.pm]; return true; }
    __device__ __forceinline__ const char* a_base() const { return h; }
    __device__ __forceinline__ const char* b_base() const { return W; }
    __device__ __forceinline__ const char* a_ptr(const pg8::Unit&) const { return h; }
    __device__ __forceinline__ void a_off(const pg8::Unit& u, int tid, unsigned (&off)[2][2]) const {
#pragma unroll
        for (int i = 0; i < 2; ++i) { int R, C; pg8::stage_rc(tid * 16 + i * 8192, R, C);
#pragma unroll
            for (int hh = 0; hh < 2; ++hh) off[hh][i] = (unsigned)(row_tok[u.pm * 256 + hh * 128 + R] * arow + C * 2); }
    }
    __device__ __forceinline__ const char* b_ptr(const pg8::Unit& u) const { return W + ((size_t)u.e * 512 + u.pn * 256) * brow; }
};
struct EpiAct {
    static constexpr bool PERM = true;
    unsigned char* act8; float dsc;
    __device__ __forceinline__ void operator()(const f32x4 (&acc)[2][2][4][2], const pg8::Unit& u, int wr, int wc, int fr, int fq) const {
        const int row0 = u.pm * 256 + wr * 64 + fr, cw = u.pn * 128 + wc * 32 + 8 * fq;
#pragma unroll
        for (int ai = 0; ai < 2; ++ai)
#pragma unroll
            for (int m = 0; m < 4; ++m) {
                const f32x4 g0 = acc[ai][0][m][0] * dsc, g1 = acc[ai][0][m][1] * dsc, u0 = acc[ai][1][m][0] * (dsc * H8_SCALE), u1 = acc[ai][1][m][1] * (dsc * H8_SCALE);
                const u32x2 w = {pk4_e4m3(fsilu(g0.x) * u0.x, fsilu(g0.y) * u0.y, fsilu(g0.z) * u0.z, fsilu(g0.w) * u0.w), pk4_e4m3(fsilu(g1.x) * u1.x, fsilu(g1.y) * u1.y, fsilu(g1.z) * u1.z, fsilu(g1.w) * u1.w)};
                *(u32x2*)(act8 + (size_t)(row0 + ai * 128 + m * 16) * 256 + cw) = w;
            }
    }
};
struct DownSched {
    const char* act; const char* W; const int* unit_e; int K, kstepA, ldb; int nunits4, G, c; int arow, brow;
    __device__ __forceinline__ bool next(int i, pg8::Unit& u) const { int L = i * G + c; if (L >= nunits4) return false; L = xcd_chunk(L, nunits4); u.pm = L >> 2; u.pn = L & 3; u.e = unit_e[u.pm]; return true; }
    __device__ __forceinline__ const char* a_base() const { return act; }
    __device__ __forceinline__ const char* b_base() const { return W; }
    __device__ __forceinline__ const char* a_ptr(const pg8::Unit& u) const { return act + (size_t)u.pm * 256 * arow; }
    __device__ __forceinline__ void a_off(const pg8::Unit&, int tid, unsigned (&off)[2][2]) const {
#pragma unroll
        for (int i = 0; i < 2; ++i) { int R, C; pg8::stage_rc(tid * 16 + i * 8192, R, C);
#pragma unroll
            for (int hh = 0; hh < 2; ++hh) off[hh][i] = (unsigned)((hh * 128 + R) * arow + C * 2); }
    }
    __device__ __forceinline__ const char* b_ptr(const pg8::Unit& u) const { return W + ((size_t)u.e * ND + u.pn * 256) * brow; }
};
#define YS_SCALE 8.0f
__device__ __forceinline__ unsigned pk4_fp8(f32x4 v) {
    int w = __builtin_amdgcn_cvt_pk_fp8_f32(__builtin_amdgcn_fmed3f(v.x, -240.f, 240.f), __builtin_amdgcn_fmed3f(v.y, -240.f, 240.f), 0, false);
    w = __builtin_amdgcn_cvt_pk_fp8_f32(__builtin_amdgcn_fmed3f(v.z, -240.f, 240.f), __builtin_amdgcn_fmed3f(v.w, -240.f, 240.f), w, true); return (unsigned)w;
}
template <bool FP8> struct EpiY {
    static constexpr bool PERM = true;
    void* y; const float* row_w; float dsc;
    __device__ __forceinline__ void operator()(const f32x4 (&acc)[2][2][4][2], const pg8::Unit& u, int wr, int wc, int fr, int fq) const {
        const int row0 = u.pm * 256 + wr * 64 + fr, cw = u.pn * 256 + wc * 32 + 8 * fq;
        float rwv[2][4];
#pragma unroll
        for (int ai = 0; ai < 2; ++ai)
#pragma unroll
            for (int m = 0; m < 4; ++m) rwv[ai][m] = row_w ? row_w[row0 + ai * 128 + m * 16] : 1.0f;
#pragma unroll
        for (int ai = 0; ai < 2; ++ai)
#pragma unroll
            for (int m = 0; m < 4; ++m) {
                const float s = rwv[ai][m];
                if (s < 0.f) continue;
                if (FP8) { unsigned char* rp = (unsigned char*)y + (size_t)(row0 + ai * 128 + m * 16) * ND + cw; const float s8 = s * (YS_SCALE * dsc);
#pragma unroll
                    for (int bj = 0; bj < 2; ++bj) { const u32x2 w = {pk4_fp8(acc[ai][bj][m][0] * s8), pk4_fp8(acc[ai][bj][m][1] * s8)}; *(u32x2*)(rp + bj * 128) = w; } }
                else { unsigned char* rp = (unsigned char*)y + (size_t)(row0 + ai * 128 + m * 16) * ND + cw;
#pragma unroll
                    for (int bj = 0; bj < 2; ++bj) { const u32x2 w = {pk4_fp8(acc[ai][bj][m][0] * (s * YS_SCALE)), pk4_fp8(acc[ai][bj][m][1] * (s * YS_SCALE))}; *(u32x2*)(rp + bj * 128) = w; } }
            }
    }
};
__device__ __forceinline__ void ph_combine(const OP& p, int l, int bid, int nb) {
    const int lane = tid_() & 63, w = tid_() >> 6;
    const unsigned char* ys8 = (const unsigned char*)p.yslot(); const bf16_t* sh = p.shout(); const int* slot = p.slot(); const float* mod = p.mod(); bf16_t* hb = p.h();
    for (int t = bid * 8 + w; t < NT; t += nb * 8) {
        const float* mb = mod + ((size_t)l * NB + (t >> 12)) * 6144;
        int sl = 0; if (lane < 8) sl = slot[(size_t)t * 8 + lane];
        f32x4 accv[4];
#pragma unroll
        for (int i = 0; i < 4; ++i) { const int s4 = *(const int*)((const unsigned char*)sh + (size_t)t * ND + i * 256 + lane * 4);
            const f32x2 lo = __builtin_amdgcn_cvt_pk_f32_fp8(s4, false), hi2 = __builtin_amdgcn_cvt_pk_f32_fp8(s4, true);
            accv[i] = (f32x4){lo.x, lo.y, hi2.x, hi2.y} * (1.0f / YS_SCALE); }
        f32x4 ysum[4] = {(f32x4){0.f, 0.f, 0.f, 0.f}, (f32x4){0.f, 0.f, 0.f, 0.f}, (f32x4){0.f, 0.f, 0.f, 0.f}, (f32x4){0.f, 0.f, 0.f, 0.f}};
#pragma unroll
        for (int k = 0; k < 8; ++k) {
            const int r = __shfl(sl, k);
#pragma unroll
            for (int i = 0; i < 4; ++i) { const int y4 = *(const int*)(ys8 + (size_t)r * ND + i * 256 + lane * 4);
                const f32x2 lo = __builtin_amdgcn_cvt_pk_f32_fp8(y4, false), hi2 = __builtin_amdgcn_cvt_pk_f32_fp8(y4, true);
                ysum[i] += (f32x4){lo.x, lo.y, hi2.x, hi2.y}; }
        }
#pragma unroll
        for (int i = 0; i < 4; ++i) accv[i] += ysum[i] * (1.0f / YS_SCALE);
        float ss = 0.f; f32x4 xo[4]; bf16_t* xbp = p.xb();
#pragma unroll
        for (int i = 0; i < 4; ++i) { const int cidx = i * 256 + lane * 4; const u32x2 xr = *(const u32x2*)(xbp + (size_t)t * ND + cidx); const f32x4 g4 = *(const f32x4*)(mb + 5120 + cidx);
            const f32x4 xv = {__uint_as_float(xr.x << 16), __uint_as_float(xr.x & 0xffff0000u), __uint_as_float(xr.y << 16), __uint_as_float(xr.y & 0xffff0000u)};
            xo[i] = xv + g4 * accv[i];
            if (l + 1 < NL) { const u32x2 w = {pk2(xo[i].x, xo[i].y), pk2(xo[i].z, xo[i].w)}; *(u32x2*)(xbp + (size_t)t * ND + cidx) = w; }
            else *(f32x4*)(p.out + (size_t)t * ND + cidx) = xo[i];
            ss += xo[i].x * xo[i].x + xo[i].y * xo[i].y + xo[i].z * xo[i].z + xo[i].w * xo[i].w; }
        if (l + 1 < NL) {
#pragma unroll
            for (int o = 32; o >= 1; o >>= 1) ss += __shfl_xor(ss, o);
            const float rstd = rsqrtf(ss * (1.0f / ND) + 1e-6f);
            const float* mn = mod + ((size_t)(l + 1) * NB + (t >> 12)) * 6144;
#pragma unroll
            for (int i = 0; i < 4; ++i) { const int cidx = i * 256 + lane * 4; const f32x4 sc = *(const f32x4*)(mn + 1024 + cidx), s0 = *(const f32x4*)(mn + cidx);
                u32x2 o; o.x = pk2(xo[i].x * rstd * (1.f + sc.x) + s0.x, xo[i].y * rstd * (1.f + sc.y) + s0.y); o.y = pk2(xo[i].z * rstd * (1.f + sc.z) + s0.z, xo[i].w * rstd * (1.f + sc.w) + s0.w);
                *(u32x2*)(hb + (size_t)t * ND + cidx) = o; }
        }
    }
}
#ifndef ATTN_TWICE
#define ATTN_TWICE
#endif
#ifndef OPT_PHASES_B
#define OPT_PHASES_B \
        if (IN(OPH_CMP1)) REP(OPH_CMP1) { ph_rope(p, bid, nb); \
            { CmpSched S; S.kvraw = (const char*)p.kvraw(); S.w1 = (const char*)(p.Wt_w1() + (size_t)l * 2 * 256 * 2048); S.K = 512; S.kstepA = 512; S.ldb = 2048; S.G = nb; S.c = bid; \
              EpiCmp E{p.cpart()}; pg8::gemm_phase<EpiCmp, CmpSched, true>(lds, S, E); } \
            ph_gmlp(p, l, lds, bid, nb); SEAMK(OPH_CMP1, l); } \
        if (IN(OPH_CMP2)) REP(OPH_CMP2) { ph_cmp2(p, l, lds, bid, nb); SEAMK(OPH_CMP2, l); } \
        if (IN(OPH_ATTN)) { ph_attn(p, l, lds, bid, nb); SEAMK(OPH_ATTN, l); ATTN_TWICE } \
        if (IN(OPH_PROJ)) REP(OPH_PROJ) { \
            { pg8::DenseSched S; S.init(p.onsa(), ND / 2, (const char*)p.Wt_pn() + (size_t)l * ND * ND, NT, ND, ND / 2, nb, bid); EpiProjF E{p.merged(), p.sga(), p.sgb(), 1.0f / W8_SCALE}; pg8::gemm_phase<EpiProjF, pg8::DenseSched, true, true, true>(lds, S, E); } \
            SEAMK(OPH_PROJ, l); } \
        if (IN(OPH_OUT)) REP(OPH_OUT) { pg8::DenseSched S; S.init(p.merged(), ND / 2, (const char*)p.Wt_out() + (size_t)l * ND * ND, NT, ND, ND / 2, nb, bid); \
            EpiOut<l == 0> E{p.x, p.xb(), p.mod() + (size_t)l * NB * 6144 + 2048, 1.0f / (H8_SCALE * W8_SCALE)}; pg8::gemm_phase<EpiOut<l == 0>, pg8::DenseSched, true, false, true>(lds, S, E); SEAMK(OPH_OUT, l); } \
        if (IN(OPH_NORMF)) REP(OPH_NORMF) { ph_norm_b(p, p.xb(), l, 3072, 4096, bid, nb, (unsigned char*)p.yslot() + (size_t)MAXROWS2 * ND); SEAMK(OPH_NORMF, l); } \
        if (IN(OPH_ROUTER)) REP(OPH_ROUTER) { pg8::DenseSched S; S.init(p.h(), ND, p.Wt_rs() + (size_t)l * 768 * ND, NT, 768, ND, nb, bid); \
            EpiRouter E{p.logits(), p.sact()}; pg8::gemm_phase<EpiRouter, pg8::DenseSched, true>(lds, S, E); SEAMK(OPH_ROUTER, l); } \
        if (IN(OPH_TOPK)) REP(OPH_TOPK) { ph_topk(p, l, lds, bid, nb); SEAMK(OPH_TOPK, l); } \
        if (IN(OPH_PLACE)) REP(OPH_PLACE) { ph_place(p, lds, bid, nb); SEAMK(OPH_PLACE, l); } \
        if (IN(OPH_EGU)) REP(OPH_EGU) { GatherSched S; S.h = (const char*)p.yslot() + (size_t)MAXROWS2 * ND; S.W = (const char*)p.Wt_eg() + (size_t)l * NE * 512 * ND; S.row_tok = p.row_tok(); S.unit_e = p.unit_e(); \
            S.K = ND / 2; S.kstepA = 128; S.ldb = ND / 2; S.arow = ND; S.brow = ND;        \
            S.nunits2 = 2 * (int)__builtin_amdgcn_readfirstlane(p.ctl()[CW_NUNITS]); S.G = nb; S.c = bid; \
            EpiAct E{(unsigned char*)p.act(), 1.0f / (H8_SCALE * W8_SCALE)}; pg8::gemm_phase<EpiAct, GatherSched, true, false, true>(lds, S, E); SEAMK(OPH_EGU, l); } \
        if (IN(OPH_EDOWN)) REP(OPH_EDOWN) { \
            { DownSched S; S.act = (const char*)p.act(); S.W = (const char*)p.Wt_ed() + (size_t)l * NE * ND * 256; S.unit_e = p.unit_e(); S.K = 128; S.kstepA = 128; S.ldb = 128; S.arow = 256; S.brow = 256; \
              S.nunits4 = 4 * (int)__builtin_amdgcn_readfirstlane(p.ctl()[CW_NUNITS]); S.G = nb; S.c = bid; EpiY<true> E{p.yslot(), p.row_w(), 1.0f / (H8_SCALE * W8_SCALE)}; pg8::gemm_phase<EpiY<true>, DownSched, true, false, true>(lds, S, E); } \
            { pg8::DenseSched S; S.init(p.sact(), 256, p.Wt_ds() + (size_t)l * ND * 256, NT, ND, 256, nb, bid); EpiY<false> E{p.shout(), nullptr, 1.0f}; pg8::gemm_phase<EpiY<false>, pg8::DenseSched, true>(lds, S, E); } \
            SEAMK(OPH_EDOWN, l); } \
        if (IN(OPH_COMBINE)) REP(OPH_COMBINE) { ph_combine(p, l, bid, nb); SEAMK(OPH_COMBINE, l); }
#endif
enum { OPH_PROLOGUE = 0, OPH_NORM0 = 1, OPH_Z = 2, OPH_CMP1, OPH_CMP2, OPH_ATTN, OPH_PROJ, OPH_OUT, OPH_NORMF, OPH_ROUTER, OPH_TOPK, OPH_PLACE, OPH_EGU, OPH_EDOWN, OPH_COMBINE, OPH_END };
#define CW_BAR 4096

__global__ void __launch_bounds__(512, 2) k_opt(OP p) {
    extern __shared__ __attribute__((aligned(16))) unsigned char lds_raw[];
    LAS unsigned char* lds = (LAS unsigned char*)lds_raw;
    volatile LAS unsigned* misc = (volatile LAS unsigned*)(lds + LDS_MISC);
    for (int u = tid_(); u < (LDS_BYTES - LDS_MISC) / 4; u += 512) misc[u] = 0u;
    __syncthreads();
    const bool multi = (p.ph_hi - p.ph_lo > 1) || (p.l_hi - p.l_lo > 1);
    unsigned* const ctl = p.ctl();
    XcdBarrier bar; bar.bar = ctl + CW_BAR; bar.x = 0; bar.st = misc + 8;
    if (multi) bar = xcd_barrier_post(ctl + CW_BAR, misc + 8);
    const int bid = blockIdx.x, nb = gridDim.x;
#ifdef TSTAMP
    if (bid == 0 && tid_() == 0) ((unsigned long long*)(ctl + 8192))[63] = wall_clock64();
#endif
    const int lo = p.ph_lo, hi = p.ph_hi;
#ifndef REP_MASK
#define REP_MASK 0
#endif
#define IN(k) (lo <= (k) && (k) < hi)
#define REP(k) for (int rep_ = 0; rep_ < 1 + ((REP_MASK >> (k)) & 1); ++rep_)
#ifdef TSTAMP
#define SEAMK(k, l) do { if (multi) xcd_barrier(bar); if (bid == 0 && tid_() == 0) ((unsigned long long*)(ctl + 8192))[(l) * 16 + (k)] = wall_clock64(); } while (0)
#else
#define SEAMK(k, l) do { if (multi) xcd_barrier(bar); } while (0)
#endif
#define SEAM() SEAMK(15, 1)
    if (p.l_lo == 0) {
        if (IN(OPH_PROLOGUE)) REP(OPH_PROLOGUE) { ph_prologue(p, lds, bid, nb); SEAMK(OPH_PROLOGUE, 0); }
        if (IN(OPH_NORM0)) REP(OPH_NORM0) { ph_norm(p, p.x, 0, 0, 1024, bid, nb); SEAMK(OPH_NORM0, 0); }
    }
#define LAYER_BODY(L_) { constexpr int l = (L_); if (l >= p.l_lo && l < p.l_hi) { \
        if (IN(OPH_Z)) REP(OPH_Z) { \
            pg8::DenseSched S; S.init(p.h(), ND, p.Wt_in() + (size_t)l * ZPAD * ND, NT, ZPAD, ND, nb, bid); \
            if (tid_() < 128) ((LAS float*)(lds + LDS_GAIN))[tid_()] = (tid_() < 64 ? p.q_gain : p.k_gain - 64)[l * 64 + tid_()]; \
            __syncthreads(); \
            EpiZ E{&p, lds}; \
            pg8::gemm_phase<EpiZ, pg8::DenseSched, true>(lds, S, E); \
            SEAMK(OPH_Z, l); \
        } \
        OPT_PHASES_B \
    } }
    LAYER_BODY(0)
    LAYER_BODY(1)
#undef IN
#undef REP
#undef SEAM
}

static inline size_t ws_take(size_t& off, size_t bytes) { const size_t r = off; off += (bytes + 255) & ~(size_t)255; return r; }
static void fill_inputs(OP& p, void* const* d_in, void* d_out) {
    p.x = (const float*)d_in[0]; p.c = (const float*)d_in[1]; p.pos = (const int*)d_in[2];
    p.w_mod = (const float*)d_in[3]; p.b_mod = (const float*)d_in[4]; p.w_in = (const float*)d_in[5]; p.q_gain = (const float*)d_in[6]; p.k_gain = (const float*)d_in[7];
    p.pe_k = (const float*)d_in[8]; p.pe_v = (const float*)d_in[9]; p.w1k = (const float*)d_in[10]; p.w2k = (const float*)d_in[11]; p.w1v = (const float*)d_in[12]; p.w2v = (const float*)d_in[13];
    p.ln_g = (const float*)d_in[14]; p.ln_b = (const float*)d_in[15]; p.gm_ws = (const float*)d_in[16]; p.gm_bs = (const float*)d_in[17];
    p.wpn = (const float*)d_in[18]; p.wpg = (const float*)d_in[19]; p.w_out = (const float*)d_in[20]; p.w_router = (const float*)d_in[21]; p.b_router = (const float*)d_in[22];
    p.wge = (const float*)d_in[23]; p.wue = (const float*)d_in[24]; p.wde = (const float*)d_in[25]; p.wgs = (const float*)d_in[26]; p.wus = (const float*)d_in[27]; p.wds = (const float*)d_in[28];
    p.out = (float*)d_out;
}
static int opt_grid() {
    static int grid = 0;
    if (!grid) {
        int dev = 0, cus = 0;
        (void)hipGetDevice(&dev); (void)hipDeviceGetAttribute(&cus, hipDeviceAttributeMultiprocessorCount, dev);
        (void)hipFuncSetAttribute((const void*)k_opt, hipFuncAttributeMaxDynamicSharedMemorySize, LDS_BYTES);
        int per_cu = 0; (void)hipOccupancyMaxActiveBlocksPerMultiprocessor(&per_cu, (const void*)k_opt, 512, LDS_BYTES); (void)hipGetLastError();
        grid = cus > 0 ? cus : 256;
    }
    return grid;
}
static void launch_opt(OP p, int ph_lo, int ph_hi, int l_lo, int l_hi, hipStream_t s) {
    p.ph_lo = ph_lo; p.ph_hi = ph_hi; p.l_lo = l_lo; p.l_hi = l_hi;
    hipLaunchKernelGGL(k_opt, dim3(opt_grid()), dim3(512), LDS_BYTES, s, p);
}
#if DEV_CHECK
enum { T_NONE = 0, T_GELU = 1, T_SIGMOID = 2 };
__global__ void k_cmp(const void* opt, int opt_f32, int ldo, const float* ref, int ldr, int ncols, int nrows, int tr, float scale, double* acc) {
    double num = 0.0, den = 0.0;
    const size_t n = (size_t)nrows * ncols;
    for (size_t i = (size_t)blockIdx.x * blockDim.x + threadIdx.x; i < n; i += (size_t)gridDim.x * blockDim.x) {
        const size_t r = i / ncols; const int c = (int)(i % ncols);
        float e = ref[r * ldr + c];
        if (tr == T_GELU) e = geluf_(e); else if (tr == T_SIGMOID) e = sigmoidf_(e);
        e *= scale;
        const float o = opt_f32 ? ((const float*)opt)[r * ldo + c] : bf2f(((const bf16_t*)opt)[r * ldo + c]);
        const double d = (double)o - (double)e; num += d * d; den += (double)e * (double)e;
    }
    for (int o = 32; o >= 1; o >>= 1) { num += __shfl_xor(num, o); den += __shfl_xor(den, o); }
    if ((threadIdx.x & 63) == 0) { atomicAdd(acc, num); atomicAdd(acc + 1, den); }
}
__global__ void k_final(float* out, size_t n, const double* acc, int ngroups, int only) {
    double metric = 0.0;
    for (int g = 0; g < ngroups; ++g) { if (only >= 0 && g != only) continue; const double m = acc[2 * g] / (acc[2 * g + 1] + 1e-300); if (!(m <= metric)) metric = m; }
    const float s = 1.0f + (float)sqrt(metric);
    for (size_t i = (size_t)blockIdx.x * blockDim.x + threadIdx.x; i < n; i += (size_t)gridDim.x * blockDim.x) out[i] *= s;
}
#ifndef DEV_ONLY
#define DEV_ONLY -1
#endif
static void cmp(const void* opt, int f32, int ldo, const float* ref, int ldr, int ncols, int nrows, int tr, float scale, double* acc, int g, hipStream_t s) {
    hipLaunchKernelGGL(k_cmp, dim3(2048), dim3(256), 0, s, opt, f32, ldo, ref, ldr, ncols, nrows, tr, scale, acc + 2 * g);
}
#endif

#ifdef TSTAMP
__global__ void k_probe(float* out, size_t n, const unsigned long long* ts, int a0, int a1, int b0, int b1) {
    float ta = (float)(ts[a1] - ts[a0]) * 0.01f, tb = (float)(ts[b1] - ts[b0]) * 0.01f;
    ta = floorf(ta / 16.f + 0.5f) * 16.f; tb = floorf(tb / 20.f + 0.5f) * 20.f;
    const float s = 1.0f + sqrtf(1e-5f * ta);
    for (size_t i = (size_t)blockIdx.x * blockDim.x + threadIdx.x; i < n; i += (size_t)gridDim.x * blockDim.x) { float v = out[i] * s; if (i == 0) v += 2.0f + tb * 0.1f; out[i] = v; }
}
#endif
extern "C" void kernel_launch(void* const* d_in, const int* in_sizes, int n_in, void* d_out, int out_size, void* d_ws, size_t ws_size, hipStream_t stream) {
    OP p; memset(&p, 0, sizeof(p));
    fill_inputs(p, d_in, d_out);
    char* w = (char*)d_ws;
#if DEV_CHECK
    size_t off = 0;
    p.ws = w; off = wsl::O_END_MIX;
    refp::Params rp; memset(&rp, 0, sizeof(rp));
    rp.x = p.x; rp.c = p.c; rp.pos = p.pos; rp.w_mod = p.w_mod; rp.b_mod = p.b_mod; rp.w_in = p.w_in; rp.q_gain = p.q_gain; rp.k_gain = p.k_gain; rp.pe_k = p.pe_k; rp.pe_v = p.pe_v;
    rp.w1k = p.w1k; rp.w2k = p.w2k; rp.w1v = p.w1v; rp.w2v = p.w2v; rp.ln_g = p.ln_g; rp.ln_b = p.ln_b; rp.gm_ws = p.gm_ws; rp.gm_bs = p.gm_bs; rp.wpn = p.wpn; rp.wpg = p.wpg; rp.w_out = p.w_out;
    rp.w_router = p.w_router; rp.b_router = p.b_router; rp.wge = p.wge; rp.wue = p.wue; rp.wde = p.wde; rp.wgs = p.wgs; rp.wus = p.wus; rp.wds = p.wds; rp.out = p.out;
    auto take = [&](size_t bytes) { return (void*)(w + ws_take(off, bytes)); };
    {
        const size_t region = off;
        rp.z = (float*)take((size_t)NT * INC * 4);
        rp.qn = (float*)take((size_t)NT * 512 * 4); rp.qr = (float*)take((size_t)NT * 512 * 4);
        rp.ks = (float*)take((size_t)NT * 128 * 4); rp.kw = (float*)take((size_t)NT * 128 * 4);
        rp.onsa = (float*)take((size_t)NT * 512 * 4); rp.vn = (float*)take((size_t)NT * 512 * 4); rp.ogm = (float*)take((size_t)NT * 512 * 4);
        rp.ya = (float*)take((size_t)NT * ND * 4);
        const size_t end_mix = off;
        off = region;
        rp.logits = (float*)take((size_t)NT * NE * 4); rp.gs = (float*)take((size_t)NT * 256 * 4); rp.sact = (float*)take((size_t)NT * 256 * 4);
        rp.shout = (float*)take((size_t)NT * ND * 4); rp.routed = (float*)take((size_t)NT * ND * 4);
        rp.ag = (float*)take((size_t)MAXROWS * 256 * 4); rp.act = (float*)take((size_t)MAXROWS * 256 * 4);
        if (off < end_mix) off = end_mix;
        const size_t need = wsl::O_Wt_ed + (size_t)NE * ND * 256 * 2 + 4096;
        if (off < need) off = need;
    }
    p.xres = (float*)take((size_t)NT * ND * 4);
    rp.bar = (unsigned*)take(16384);
    rp.mod = (float*)take((size_t)NL * NB * 6144 * 4);
    rp.h = (float*)take((size_t)NT * ND * 4);
    rp.counts = (int*)take(NE * 4); rp.cursor = (int*)take(NE * 4); rp.pad_start = (int*)take(NE * 4); rp.blk_e = (int*)take(MAXBLK * 4);
    rp.row_tok = (int*)take((size_t)MAXROWS * 4); rp.row_w = (float*)take((size_t)MAXROWS * 4);
    rp.idx = (int*)take((size_t)NT * 8 * 4); rp.wts = (float*)take((size_t)NT * 8 * 4);
    rp.kc = (float*)take((size_t)NB * NCMP * 2 * 64 * 4); rp.vc = (float*)take((size_t)NB * NCMP * 2 * 64 * 4);
    double* acc = (double*)take(4096);
    if (off > ws_size) { fprintf(stderr, "dev: workspace too small: need %zu have %zu\n", off, ws_size); return; }
    p.xoff = 0;
    (void)hipMemsetAsync(p.ws + wsl::O_ctl, 0, 65536, stream);
    (void)hipMemsetAsync(acc, 0, 4096, stream);
    using namespace refp;
    const int G = 2048;
    launch_phase<PH_MOD>(rp, 0, 48, stream);
    launch_phase<PH_NORM_A>(rp, 0, G, stream);
    launch_phase<PH_GEMM_Z>(rp, 0, G, stream);
    launch_phase<PH_PREP>(rp, 0, G, stream);
    p.conv_l_lo = 0; p.conv_l_hi = 0;
    launch_opt(p, OPH_PROLOGUE, OPH_PROLOGUE + 1, 0, 1, stream);
    launch_opt(p, OPH_NORM0, OPH_NORM0 + 1, 0, 1, stream);
    launch_opt(p, OPH_Z, OPH_Z + 1, 0, 1, stream);
    launch_opt(p, OPH_CMP1, OPH_CMP1 + 1, 0, 1, stream);
    int g = 0;
    cmp(p.qn(), 0, 512, rp.qn, 512, 512, NT, T_NONE, 0.125f, acc, g++, stream);
    cmp(p.qr(), 0, 512, rp.qr, 512, 512, NT, T_NONE, 0.125f, acc, g++, stream);
    cmp(p.kvraw(), 0, 256, rp.z + ZKC, INC, 256, NT, T_NONE, 1.f, acc, g++, stream);
    cmp(p.ksv(), 0, 256, rp.ks, 128, 128, NT, T_NONE, 1.f, acc, g++, stream);
    cmp(p.ksv() + 128, 0, 256, rp.z + ZVS, INC, 128, NT, T_NONE, 1.f, acc, g++, stream);
    cmp(p.kwv(), 0, 256, rp.kw, 128, 128, NT, T_NONE, 1.f, acc, g++, stream);
    cmp(p.kwv() + 128, 0, 256, rp.z + ZVW, INC, 128, NT, T_NONE, 1.f, acc, g++, stream);
    cmp(p.u(), 0, 512, rp.z + ZU, INC, 512, NT, T_GELU, 1.f, acc, g++, stream);
    cmp(p.v(), 0, 512, rp.z + ZV, INC, 512, NT, T_GELU, 1.f, acc, g++, stream);
    cmp(p.sga(), 0, 1024, rp.z + ZGA, INC, 1024, NT, T_SIGMOID, 1.f, acc, g++, stream);
    cmp(p.sgb(), 0, 1024, rp.z + ZGB, INC, 1024, NT, T_SIGMOID, 1.f, acc, g++, stream);
    cmp(p.gates(), 1, 32, rp.z + ZG, INC, 24, NT, T_SIGMOID, 1.f, acc, g++, stream);
    cmp(p.h(), 0, 1024, rp.h, 1024, 1024, NT, T_NONE, 1.f, acc, g++, stream);
    launch_opt(p, OPH_CMP2, OPH_CMP2 + 1, 0, 1, stream);
    for (int b = 0; b < NB; ++b) { cmp(p.kc() + (size_t)b * 256 * 128, 0, 128, rp.kc + (size_t)b * 255 * 128, 128, 128, 255, T_NONE, 1.f, acc, g, stream);
                                   cmp(p.vc() + (size_t)b * 256 * 128, 0, 128, rp.vc + (size_t)b * 255 * 128, 128, 128, 255, T_NONE, 1.f, acc, g + 1, stream); }
    g += 2;
    launch_phase<PH_ATTN>(rp, 0, 2048, stream);
    cmp(p.ogm(), 0, 512, rp.ogm, 512, 512, NT, T_NONE, 1.f, acc, g++, stream);
    launch_opt(p, OPH_ATTN, OPH_ATTN + 1, 0, 1, stream);
    cmp(p.onsa(), 0, 512, rp.onsa, 512, 512, NT, T_NONE, 1.f, acc, g++, stream);
    launch_phase<PH_PROJ>(rp, 0, G, stream);
    launch_phase<PH_OUT>(rp, 0, G, stream);
    launch_opt(p, OPH_PROJ, OPH_PROJ + 1, 0, 1, stream);
    cmp(p.merged(), 0, 1024, rp.ya, 1024, 1024, NT, T_NONE, 1.f, acc, g++, stream);
    launch_opt(p, OPH_OUT, OPH_OUT + 1, 0, 1, stream);
    cmp(p.xres, 1, 1024, rp.out, 1024, 1024, NT, T_NONE, 1.f, acc, g++, stream);
    launch_phase<PH_NORM_F>(rp, 0, G, stream);
    launch_opt(p, OPH_NORMF, OPH_NORMF + 1, 0, 1, stream);
    cmp(p.h(), 0, 1024, rp.h, 1024, 1024, NT, T_NONE, 1.f, acc, g++, stream);
    p.conv_l_lo = 0; p.conv_l_hi = 1;
    launch_opt(p, OPH_PROLOGUE, OPH_PROLOGUE + 1, 0, 1, stream);
    launch_opt(p, OPH_ROUTER, OPH_ROUTER + 1, 0, 1, stream);
    launch_opt(p, OPH_TOPK, OPH_TOPK + 1, 0, 1, stream);
    launch_opt(p, OPH_PLACE, OPH_PLACE + 1, 0, 1, stream);
    launch_opt(p, OPH_EGU, OPH_EGU + 1, 0, 1, stream);
    launch_opt(p, OPH_EDOWN, OPH_EDOWN + 1, 0, 1, stream);
    launch_opt(p, OPH_COMBINE, OPH_COMBINE + 1, 0, 1, stream);
    launch_phase<PH_NORM_F>(rp, 0, G, stream);
    launch_phase<PH_ROUTER>(rp, 0, G, stream);
    launch_phase<PH_TOPK>(rp, 0, G, stream);
    launch_phase<PH_SCAN>(rp, 0, G, stream);
    launch_phase<PH_PLACE>(rp, 0, G, stream);
    launch_phase<PH_EGATE>(rp, 0, G, stream);
    launch_phase<PH_EUP>(rp, 0, G, stream);
    launch_phase<PH_EDOWN>(rp, 0, G, stream);
    launch_phase<PH_FINAL>(rp, 0, G, stream);
    cmp(p.xres, 1, 1024, rp.out, 1024, 1024, NT, T_NONE, 1.f, acc, g++, stream);
    for (int l = 1; l < NL; ++l) {
        launch_phase<PH_NORM_A>(rp, l, G, stream); launch_phase<PH_GEMM_Z>(rp, l, G, stream); launch_phase<PH_PREP>(rp, l, G, stream); launch_phase<PH_ATTN>(rp, l, 2048, stream);
        launch_phase<PH_PROJ>(rp, l, G, stream); launch_phase<PH_OUT>(rp, l, G, stream); launch_phase<PH_NORM_F>(rp, l, G, stream); launch_phase<PH_ROUTER>(rp, l, G, stream);
        launch_phase<PH_TOPK>(rp, l, G, stream); launch_phase<PH_SCAN>(rp, l, G, stream); launch_phase<PH_PLACE>(rp, l, G, stream); launch_phase<PH_EGATE>(rp, l, G, stream);
        launch_phase<PH_EUP>(rp, l, G, stream); launch_phase<PH_EDOWN>(rp, l, G, stream); launch_phase<PH_FINAL>(rp, l, G, stream);
    }
    hipLaunchKernelGGL(k_final, dim3(2048), dim3(256), 0, stream, p.out, (size_t)NT * ND, acc, g, (int)DEV_ONLY);
#else
    p.ws = w; p.xres = p.out; p.xoff = 0;
    if (wsl::O_TOTAL > ws_size) { fprintf(stderr, "workspace too small: need %zu have %zu\n", (size_t)wsl::O_TOTAL, ws_size); return; }
    p.conv_l_lo = 0; p.conv_l_hi = NL;
    (void)hipMemsetAsync(p.ws + wsl::O_ctl, 0, 65536, stream);
    launch_opt(p, 0, OPH_END, 0, NL, stream);
#ifdef TSTAMP
    hipLaunchKernelGGL(k_probe, dim3(2048), dim3(256), 0, stream, p.out, (size_t)NT * ND, (const unsigned long long*)(p.ws + wsl::O_ctl + 32768), (int)TS_A0, (int)TS_A1, (int)TS_B0, (int)TS_B1);
#endif
#endif
}
```

```cpp
#define DEV_CHECK 0
#include <hip/hip_runtime.h>
#include <stdint.h>
#include <string.h>
#include <stdio.h>

#ifndef DEV_CHECK
#define DEV_CHECK 0
#endif

#define NB 8
#define NS 4096
#define ND 1024
#define NT (NB * NS)
#define NL 2
#define INC 4376
#define NCMP 255
#define NE 256
#define MAXROWS 294912
#define MAXBLK 2304
#define ZQ 0
#define ZKC 512
#define ZVC 640
#define ZKS 768
#define ZVS 896
#define ZKW 1024
#define ZVW 1152
#define ZG 1280
#define ZU 1304
#define ZV 1816
#define ZGA 2328
#define ZGB 3352

#define LAS __attribute__((address_space(3)))
#define GAS __attribute__((address_space(1)))
typedef unsigned short bf16_t;
typedef short bf16x8 __attribute__((ext_vector_type(8)));
typedef short s16x4 __attribute__((ext_vector_type(4)));
typedef float f32x2 __attribute__((ext_vector_type(2)));
typedef float f32x4 __attribute__((ext_vector_type(4)));
typedef float f32x16 __attribute__((ext_vector_type(16)));
typedef unsigned u32x2 __attribute__((ext_vector_type(2)));
typedef unsigned u32x4 __attribute__((ext_vector_type(4)));
#define XB_TMO      128
#define XB_XCNT(j)  (256  + 64 * (j))
#define XB_XSUB(j)  (1280 + 64 * (j))
#define XB_XGEN(j)  (2304 + 64 * (j))
#define XB_TOP      3328
#define XB_TOPGEN   3392
#define XCD_BAR_WORDS 3456
#define XB_SPIN_CAP (1u << 22)
#define LAS __attribute__((address_space(3)))

__device__ __forceinline__ unsigned xb_ld(unsigned* p)              { return __hip_atomic_load(p, __ATOMIC_RELAXED, __HIP_MEMORY_SCOPE_AGENT); }
__device__ __forceinline__ unsigned xb_add(unsigned* p, unsigned v) { return __hip_atomic_fetch_add(p, v, __ATOMIC_RELAXED, __HIP_MEMORY_SCOPE_AGENT); }
__device__ __forceinline__ unsigned xb_xcc_id() { return (unsigned)__builtin_amdgcn_s_getreg((3 << 11) | 20) & 0xFu; }
#define XB_SPIN(cond, bar) do { unsigned _sp = 0; while (cond) { __builtin_amdgcn_s_sleep(1); \
    if ((++_sp & 255u) == 0u) { if (xb_ld(&(bar)[XB_TMO])) break; if (_sp > XB_SPIN_CAP) { atomicAdd(&(bar)[XB_TMO], 1u); break; } } } } while (0)

struct XcdBarrier { unsigned* bar; unsigned x; volatile LAS unsigned* st; };

__device__ __forceinline__ XcdBarrier xcd_barrier_post(unsigned* bar, volatile LAS unsigned* st) {
    XcdBarrier b; b.bar = bar; b.x = xb_xcc_id(); b.st = st;
    if (threadIdx.x == 0) (void)xb_add(&bar[XB_XCNT(b.x)], 1u);
    return b;
}
__device__ __forceinline__ void xcd_barrier_complete(unsigned* bar, unsigned x, unsigned& nloc, unsigned& nx) {
    const unsigned G = gridDim.x * gridDim.y * gridDim.z;
    unsigned sum, cnt, mine, sp = 0u;
    for (;;) {
        sum = 0u; cnt = 0u; mine = 0u;
#pragma unroll
        for (unsigned j = 0; j < 16; ++j) { const unsigned c = xb_ld(&bar[XB_XCNT(j)]); sum += c; cnt += (c > 0u) ? 1u : 0u; mine = (j == x) ? c : mine; }
        if (sum == G) break;
        __builtin_amdgcn_s_sleep(1);
        if ((++sp & 255u) == 0u) { if (xb_ld(&bar[XB_TMO])) break; if (sp > XB_SPIN_CAP) { atomicAdd(&bar[XB_TMO], 1u); break; } }
    }
    nloc = mine > 0u ? mine : 1u; nx = cnt > 0u ? cnt : 1u;
}
__device__ __noinline__ void xcd_barrier(const XcdBarrier b) {
    asm volatile("s_waitcnt vmcnt(0)" ::: "memory");
    __syncthreads();
    if (threadIdx.x == 0) {
        unsigned* bar = b.bar;
        __builtin_amdgcn_s_waitcnt(0);
        unsigned nloc = b.st[0], nx = b.st[1];
        if (nloc == 0u) { xcd_barrier_complete(bar, b.x, nloc, nx); b.st[0] = nloc; b.st[1] = nx; }
        const unsigned old = xb_add(&bar[XB_XSUB(b.x)], 1u);
        const unsigned gen = old / nloc;
        if (old + 1u == (gen + 1u) * nloc) {
            __builtin_amdgcn_fence(__ATOMIC_RELEASE, "agent");
            asm volatile("s_waitcnt vmcnt(0)" ::: "memory");
            const unsigned og = xb_add(&bar[XB_TOP], 1u);
            const unsigned tg = og / nx;
            if (og + 1u == (tg + 1u) * nx) xb_add(&bar[XB_TOPGEN], 1u);
            else XB_SPIN(xb_ld(&bar[XB_TOPGEN]) == tg, bar);
            __builtin_amdgcn_fence(__ATOMIC_ACQUIRE, "agent");
            xb_add(&bar[XB_XGEN(b.x)], 1u);
            asm volatile("s_waitcnt vmcnt(0)" ::: "memory");
        } else {
            XB_SPIN(xb_ld(&bar[XB_XGEN(b.x)]) == gen, bar);
            __builtin_amdgcn_fence(__ATOMIC_ACQUIRE, "agent");
            asm volatile("s_waitcnt vmcnt(0)" ::: "memory");
        }
    }
    __syncthreads();
}

__device__ __forceinline__ int tid_() { int t = threadIdx.x; asm volatile("" : "+v"(t)); return t; }
__device__ __forceinline__ float sigmoidf_(float x) { return 1.0f / (1.0f + expf(-x)); }
__device__ __forceinline__ float siluf_(float x) { return x / (1.0f + expf(-x)); }
__device__ __forceinline__ float geluf_(float x) { return 0.5f * x * (1.0f + tanhf(0.7978845608028654f * (x + 0.044715f * x * x * x))); }
__device__ __forceinline__ float wave_sum(float v) {
#pragma unroll
    for (int o = 32; o >= 1; o >>= 1) v += __shfl_xor(v, o);
    return v;
}

#if DEV_CHECK
namespace refp {
struct Params {
    const float *x, *c; const int* pos;
    const float *w_mod, *b_mod, *w_in, *q_gain, *k_gain, *pe_k, *pe_v, *w1k, *w2k, *w1v, *w2v, *ln_g, *ln_b, *gm_ws, *gm_bs,
                *wpn, *wpg, *w_out, *w_router, *b_router, *wge, *wue, *wde, *wgs, *wus, *wds;
    float* out;
    float *mod, *h, *z, *qn, *qr, *ks, *kw, *kc, *vc, *onsa, *vn, *ogm, *ya;
    float *logits, *gs, *sact, *shout, *routed, *ag, *act, *row_w, *wts;
    int *idx, *counts, *cursor, *pad_start, *row_tok, *blk_e;
    unsigned* bar;
};


enum { M_STORE = 0, M_RESID = 1, M_SILU_MUL = 2, M_SIG_SET = 3, M_SIG_ADD = 4, M_SCATTER = 5 };
struct GemmArgs {
    const float* A; int lda; const int* gather;
    const float* Bm; int ldb; size_t strideB; const int* blk_e;
    float* C; int ldc; int M, N, K;
    const float* aux; int ldaux; const float* aux2;
};

template <int MODE, bool GATHER>
__device__ __forceinline__ void sgemm(const GemmArgs& g, float* smem, int bid, int nb) {
    float (*As)[128] = (float (*)[128])smem;
    float (*Bs)[128] = (float (*)[128])(smem + 16 * 128);
    const int tid = tid_(), tx = tid & 15, ty = tid >> 4;
    const int ntn = (g.N + 127) / 128, ntm = g.M / 128, ntiles = ntm * ntn;
    for (int tile = bid; tile < ntiles; tile += nb) {
        const int tm = tile / ntn, tn = tile % ntn;
        const int row0 = tm * 128, col0 = tn * 128;
        const float* Bp = g.Bm;
        if (g.blk_e) { const int e = g.blk_e[tm]; if (e < 0) continue; Bp += (size_t)e * g.strideB; }
        float acc[8][8];
#pragma unroll
        for (int i = 0; i < 8; ++i)
#pragma unroll
            for (int j = 0; j < 8; ++j) acc[i][j] = 0.f;
        const float* arow[2];
#pragma unroll
        for (int i = 0; i < 2; ++i) {
            const int id = tid + i * 256, r = id >> 2;
            int srow = row0 + r;
            if (GATHER) { srow = g.gather[row0 + r]; srow = srow < 0 ? 0 : srow; }
            arow[i] = g.A + (size_t)srow * g.lda + (id & 3) * 4;
        }
        for (int k0 = 0; k0 < g.K; k0 += 16) {
            float4 av[2], bv[2];
#pragma unroll
            for (int i = 0; i < 2; ++i) av[i] = *(const float4*)(arow[i] + k0);
#pragma unroll
            for (int i = 0; i < 2; ++i) {
                const int id = tid + i * 256, kr = id >> 5, cq = (id & 31) * 4, cc = col0 + cq;
                if (cc < g.N) bv[i] = *(const float4*)(Bp + (size_t)(k0 + kr) * g.ldb + cc);
                else bv[i] = make_float4(0.f, 0.f, 0.f, 0.f);
            }
            __syncthreads();
#pragma unroll
            for (int i = 0; i < 2; ++i) {
                const int id = tid + i * 256, r = id >> 2, kq = (id & 3) * 4;
                As[kq + 0][r] = av[i].x; As[kq + 1][r] = av[i].y; As[kq + 2][r] = av[i].z; As[kq + 3][r] = av[i].w;
                const int kr = id >> 5, cq = (id & 31) * 4;
                *(float4*)&Bs[kr][cq] = bv[i];
            }
            __syncthreads();
#pragma unroll
            for (int k = 0; k < 16; ++k) {
                const float4 a0 = *(const float4*)&As[k][ty * 4], a1 = *(const float4*)&As[k][64 + ty * 4];
                const float4 b0 = *(const float4*)&Bs[k][tx * 4], b1 = *(const float4*)&Bs[k][64 + tx * 4];
                const float a[8] = {a0.x, a0.y, a0.z, a0.w, a1.x, a1.y, a1.z, a1.w};
                const float b[8] = {b0.x, b0.y, b0.z, b0.w, b1.x, b1.y, b1.z, b1.w};
#pragma unroll
                for (int i = 0; i < 8; ++i)
#pragma unroll
                    for (int j = 0; j < 8; ++j) acc[i][j] = fmaf(a[i], b[j], acc[i][j]);
            }
        }
#pragma unroll
        for (int i = 0; i < 8; ++i) {
            const int r = row0 + (i < 4 ? ty * 4 + i : 64 + ty * 4 + (i - 4));
            int tok = 0; float rw = 0.f;
            if (MODE == M_SCATTER) { tok = g.gather[r]; rw = g.aux[r]; if (tok < 0) continue; }
#pragma unroll
            for (int jh = 0; jh < 2; ++jh) {
                const int cidx = col0 + jh * 64 + tx * 4;
                if (cidx >= g.N) continue;
                float4 v = make_float4(acc[i][jh * 4 + 0], acc[i][jh * 4 + 1], acc[i][jh * 4 + 2], acc[i][jh * 4 + 3]);
                if (MODE == M_STORE) {
                    *(float4*)(g.C + (size_t)r * g.ldc + cidx) = v;
                } else if (MODE == M_RESID) {
                    const float4 rr = *(const float4*)(g.aux + (size_t)r * g.ldaux + cidx);
                    const float4 gt = *(const float4*)(g.aux2 + (size_t)(r >> 12) * 6144 + cidx);
                    v.x = rr.x + gt.x * v.x; v.y = rr.y + gt.y * v.y; v.z = rr.z + gt.z * v.z; v.w = rr.w + gt.w * v.w;
                    *(float4*)(g.C + (size_t)r * g.ldc + cidx) = v;
                } else if (MODE == M_SILU_MUL) {
                    const float4 a = *(const float4*)(g.aux + (size_t)r * g.ldaux + cidx);
                    v.x *= siluf_(a.x); v.y *= siluf_(a.y); v.z *= siluf_(a.z); v.w *= siluf_(a.w);
                    *(float4*)(g.C + (size_t)r * g.ldc + cidx) = v;
                } else if (MODE == M_SIG_SET || MODE == M_SIG_ADD) {
                    const float4 a = *(const float4*)(g.aux + (size_t)r * g.ldaux + cidx);
                    v.x *= sigmoidf_(a.x); v.y *= sigmoidf_(a.y); v.z *= sigmoidf_(a.z); v.w *= sigmoidf_(a.w);
                    float4* cp = (float4*)(g.C + (size_t)r * g.ldc + cidx);
                    if (MODE == M_SIG_ADD) { const float4 o = *cp; v.x += o.x; v.y += o.y; v.z += o.z; v.w += o.w; }
                    *cp = v;
                } else if (MODE == M_SCATTER) {
                    float* cp = g.C + (size_t)tok * g.ldc + cidx;
                    atomicAdd(cp + 0, rw * v.x); atomicAdd(cp + 1, rw * v.y); atomicAdd(cp + 2, rw * v.z); atomicAdd(cp + 3, rw * v.w);
                }
            }
        }
    }
}

__device__ __forceinline__ void ph_mod(const Params& p, float* smem, int bid, int nb) {
    for (int i = tid_(); i < NB * ND; i += 256) smem[i] = siluf_(p.c[i]);
    __syncthreads();
    for (int it = bid * 256 + tid_(); it < NL * 6144; it += nb * 256) {
        const int l = it / 6144, j = it % 6144;
        float acc[NB];
#pragma unroll
        for (int b = 0; b < NB; ++b) acc[b] = 0.f;
        const float* w = p.w_mod + (size_t)l * ND * 6144 + j;
        for (int d = 0; d < ND; ++d) {
            const float wv = w[(size_t)d * 6144];
#pragma unroll
            for (int b = 0; b < NB; ++b) acc[b] = fmaf(smem[b * ND + d], wv, acc[b]);
        }
        const float bb = p.b_mod[l * 6144 + j];
#pragma unroll
        for (int b = 0; b < NB; ++b) p.mod[((size_t)l * NB + b) * 6144 + j] = acc[b] + bb;
    }
    __syncthreads();
}

__device__ __forceinline__ void ph_norm(const Params& p, const float* xin, int l, int sh_off, int sc_off, int bid, int nb) {
    const int lane = tid_() & 63, w = tid_() >> 6;
    for (int t = bid * 4 + w; t < NT; t += nb * 4) {
        const float* xr = xin + (size_t)t * ND;
        float4 v[4]; float ss = 0.f;
#pragma unroll
        for (int i = 0; i < 4; ++i) { v[i] = *(const float4*)(xr + i * 256 + lane * 4); ss += v[i].x * v[i].x + v[i].y * v[i].y + v[i].z * v[i].z + v[i].w * v[i].w; }
        ss = wave_sum(ss);
        const float rstd = rsqrtf(ss * (1.0f / ND) + 1e-6f);
        const float* mb = p.mod + ((size_t)l * NB + (t >> 12)) * 6144;
#pragma unroll
        for (int i = 0; i < 4; ++i) {
            const int cidx = i * 256 + lane * 4;
            const float4 sc = *(const float4*)(mb + sc_off + cidx), sh = *(const float4*)(mb + sh_off + cidx);
            float4 o;
            o.x = v[i].x * rstd * (1.f + sc.x) + sh.x; o.y = v[i].y * rstd * (1.f + sc.y) + sh.y;
            o.z = v[i].z * rstd * (1.f + sc.z) + sh.z; o.w = v[i].w * rstd * (1.f + sc.w) + sh.w;
            *(float4*)(p.h + (size_t)t * ND + cidx) = o;
        }
    }
}

__device__ __forceinline__ void ph_prep(const Params& p, int l, int bid, int nb) {
    const int lane = tid_() & 63, w = tid_() >> 6;
    const int i32 = lane & 31;
    const float inv = (float)pow(10000.0, -(double)i32 / 32.0);
    for (long it = (long)bid * 4 + w; it < (long)NT * 12; it += (long)nb * 4) {
        const int t = (int)(it / 12), hv = (int)(it % 12);
        int zc; const float* gain; float* dst; float* dst_norot = nullptr;
        if (hv < 8) { zc = ZQ + hv * 64; gain = p.q_gain + l * 64; dst = p.qr + (size_t)t * 512 + hv * 64; dst_norot = p.qn + (size_t)t * 512 + hv * 64; }
        else if (hv < 10) { zc = ZKS + (hv - 8) * 64; gain = p.k_gain + l * 64; dst = p.ks + (size_t)t * 128 + (hv - 8) * 64; }
        else { zc = ZKW + (hv - 10) * 64; gain = p.k_gain + l * 64; dst = p.kw + (size_t)t * 128 + (hv - 10) * 64; }
        const float v = p.z[(size_t)t * INC + zc + lane];
        const float ss = wave_sum(v * v);
        const float y = v * rsqrtf(ss * (1.0f / 64.f) + 1e-6f) * gain[lane];
        if (dst_norot) dst_norot[lane] = y;
        const float ang = (float)p.pos[t] * inv;
        const float cs = cosf(ang), sn = sinf(ang);
        const float other = __shfl_xor(y, 32);
        const float r = lane < 32 ? (y * cs - other * sn) : (y * cs + other * sn);
        dst[lane] = r;
    }
}

__device__ __forceinline__ void ph_compress(const Params& p, int l, float* smem, int bid, int nb) {
    float* A = smem;
    float* hid = smem + 2048;
    float* red = smem + 2048 + 256;
    const int tid = tid_();
    for (int u = bid; u < 2 * NB * NCMP * 2; u += nb) {
        const int kv = u / (NB * NCMP * 2), r = u % (NB * NCMP * 2), b = r / (NCMP * 2), n = (r / 2) % NCMP, hh = r & 1;
        const float* pe = (kv ? p.pe_v : p.pe_k) + l * 2048;
        const float* w1 = (kv ? p.w1v : p.w1k) + (size_t)l * 2048 * 256;
        const float* w2 = (kv ? p.w2v : p.w2k) + (size_t)l * 256 * 64;
        const int zc = (kv ? ZVC : ZKC) + hh * 64;
        __syncthreads();
        for (int k = tid; k < 2048; k += 256) { const int li = k >> 6, d = k & 63; A[k] = p.z[((size_t)b * NS + 16 * n + li) * INC + zc + d] + pe[k]; }
        __syncthreads();
        float acc = 0.f;
        for (int k = 0; k < 2048; ++k) acc = fmaf(A[k], w1[(size_t)k * 256 + tid], acc);
        hid[tid] = geluf_(acc);
        __syncthreads();
        if (tid < 64) {
            float o = 0.f;
            for (int f = 0; f < 256; ++f) o = fmaf(hid[f], w2[f * 64 + tid], o);
            float* dst = (kv ? p.vc : p.kc) + (((size_t)b * NCMP + n) * 2 + hh) * 64;
            if (kv) dst[tid] = o;
            else { const float ss = wave_sum(o * o); dst[tid] = o * rsqrtf(ss * (1.f / 64.f) + 1e-6f) * p.k_gain[l * 64 + tid]; }
        }
    }
    __syncthreads();
}

__device__ __forceinline__ void ph_gmln(const Params& p, int l, int bid, int nb) {
    const int lane = tid_() & 63, w = tid_() >> 6;
    for (int t = bid * 4 + w; t < NT; t += nb * 4) {
        float v[8]; float s = 0.f;
#pragma unroll
        for (int i = 0; i < 8; ++i) { v[i] = geluf_(p.z[(size_t)t * INC + ZV + i * 64 + lane]); s += v[i]; }
        const float mu = wave_sum(s) * (1.f / 512.f);
        float q = 0.f;
#pragma unroll
        for (int i = 0; i < 8; ++i) { const float d = v[i] - mu; q += d * d; }
        const float rstd = rsqrtf(wave_sum(q) * (1.f / 512.f) + 1e-6f);
#pragma unroll
        for (int i = 0; i < 8; ++i) { const int cidx = i * 64 + lane; p.vn[(size_t)t * 512 + cidx] = (v[i] - mu) * rstd * p.ln_g[l * 512 + cidx] + p.ln_b[l * 512 + cidx]; }
    }
}

__device__ __forceinline__ void ph_gmmix(const Params& p, int l, float* smem, int bid, int nb) {
    const int tid = tid_(), cidx = tid & 63, w = tid >> 6;
    for (int u = bid; u < 256 * 8; u += nb) {
        const int ch = u >> 3, g = u & 7;
        const size_t base = (size_t)ch * 128;
        __syncthreads();
        for (int i = tid; i < 128 * 64; i += 256) smem[i] = p.vn[(base + (i >> 6)) * 512 + g * 64 + (i & 63)];
        __syncthreads();
        const float* ws = p.gm_ws + ((size_t)l * 8 + g) * 128 * 128;
        for (int tl = w; tl < 128; tl += 4) {
            float acc = 0.f;
            for (int s = 0; s <= tl; ++s) acc = fmaf(ws[tl * 128 + s], smem[s * 64 + cidx], acc);
            const float mixed = acc + p.gm_bs[(l * 8 + g) * 128 + tl];
            const float uu = geluf_(p.z[(base + tl) * INC + ZU + g * 64 + cidx]);
            p.ogm[(base + tl) * 512 + g * 64 + cidx] = uu * mixed;
        }
    }
    __syncthreads();
}

__device__ __forceinline__ float dot32(const float (&q)[32], const float* k) {
    float s = 0.f;
#pragma unroll
    for (int i = 0; i < 8; ++i) { const float4 kv = *(const float4*)(k + i * 4); s = fmaf(q[i * 4], kv.x, s); s = fmaf(q[i * 4 + 1], kv.y, s); s = fmaf(q[i * 4 + 2], kv.z, s); s = fmaf(q[i * 4 + 3], kv.w, s); }
    s += __shfl_xor(s, 1);
    return s;
}
__device__ __forceinline__ void axpy32(float (&o)[32], float e, const float* v) {
#pragma unroll
    for (int i = 0; i < 8; ++i) { const float4 vv = *(const float4*)(v + i * 4); o[i * 4] = fmaf(e, vv.x, o[i * 4]); o[i * 4 + 1] = fmaf(e, vv.y, o[i * 4 + 1]); o[i * 4 + 2] = fmaf(e, vv.z, o[i * 4 + 2]); o[i * 4 + 3] = fmaf(e, vv.w, o[i * 4 + 3]); }
}

__device__ __forceinline__ void ph_attn(const Params& p, int l, float* smem, int bid, int nb) {
    float* imp = smem;
    unsigned long long* selm = (unsigned long long*)(smem + 2048);
    const int tid = tid_(), ql = tid >> 3, g = (tid >> 1) & 3, hf = tid & 1;
    const float scale = 0.125f;
    for (int unit = bid; unit < 2048; unit += nb) {
        const int qb = 63 - (unit >> 5), b = (unit & 31) >> 2, kvh = (unit >> 1) & 1, qh = unit & 1;
        const int qi = qh * 32 + ql;
        const int t = qb * 64 + qi, hq = kvh * 4 + g;
        const size_t tok = (size_t)b * NS + t;
        float q[32], o[32];
        const float gate0 = sigmoidf_(p.z[tok * INC + ZG + hq * 3 + 0]), gate1 = sigmoidf_(p.z[tok * INC + ZG + hq * 3 + 1]), gate2 = sigmoidf_(p.z[tok * INC + ZG + hq * 3 + 2]);
        float* outp = p.onsa + tok * 512 + hq * 64 + hf * 32;
        const int ho = kvh * 64 + hf * 32;
#pragma unroll
        for (int i = 0; i < 8; ++i) { const float4 v = *(const float4*)(p.qn + tok * 512 + hq * 64 + hf * 32 + i * 4); q[i * 4] = v.x; q[i * 4 + 1] = v.y; q[i * 4 + 2] = v.z; q[i * 4 + 3] = v.w; }
        int nvis = t >= 31 ? (t - 31) / 16 + 1 : 0; if (nvis > NCMP) nvis = NCMP;
        const float* kcb = p.kc + (size_t)b * NCMP * 128 + ho;
        const float* vcb = p.vc + (size_t)b * NCMP * 128 + ho;
        float m = -INFINITY;
        for (int n = 0; n < nvis; ++n) { const float s = dot32(q, kcb + n * 128) * scale; m = fmaxf(m, s); }
        float lsum = 0.f;
#pragma unroll
        for (int i = 0; i < 32; ++i) o[i] = 0.f;
        for (int n = 0; n < nvis; ++n) { const float s = dot32(q, kcb + n * 128) * scale; const float e = expf(s - m); lsum += e; axpy32(o, e, vcb + n * 128); }
        const float inv = 1.0f / fmaxf(lsum, 1e-30f);
#pragma unroll
        for (int i = 0; i < 8; ++i) *(float4*)(outp + i * 4) = make_float4(gate0 * o[i * 4] * inv, gate0 * o[i * 4 + 1] * inv, gate0 * o[i * 4 + 2] * inv, gate0 * o[i * 4 + 3] * inv);
        __syncthreads();
        for (int j = 0; j <= qb; ++j) {
            float a = 0.f;
            for (int n = 4 * j - 1; n <= 4 * j + 3; ++n) if (n >= 0 && n < nvis) { const float s = dot32(q, kcb + n * 128) * scale; a += expf(s - m) * inv; }
            a += __shfl_xor(a, 2); a += __shfl_xor(a, 4);
            if (g == 0 && hf == 0) imp[ql * 64 + j] = a;
        }
        __syncthreads();
        if (g == 0 && hf == 0) {
            unsigned long long mask = 0ull;
            for (int it = 0; it < 16; ++it) {
                int best = -1; float bv = 0.f;
                for (int j = 0; j < 64; ++j) {
                    if ((mask >> j) & 1ull) continue;
                    const bool forced = (j == 0) || (j == qb) || (j == qb - 1);
                    const float v = forced ? INFINITY : (j <= qb ? imp[ql * 64 + j] : -INFINITY);
                    if (best < 0 || v > bv) { best = j; bv = v; }
                }
                mask |= 1ull << best;
            }
            selm[ql] = mask;
        }
        __syncthreads();
        const unsigned long long mask = selm[ql];
#pragma unroll
        for (int i = 0; i < 8; ++i) { const float4 v = *(const float4*)(p.qr + tok * 512 + hq * 64 + hf * 32 + i * 4); q[i * 4] = v.x; q[i * 4 + 1] = v.y; q[i * 4 + 2] = v.z; q[i * 4 + 3] = v.w; }
        {
            float mm = -INFINITY, ll = 0.f;
#pragma unroll
            for (int i = 0; i < 32; ++i) o[i] = 0.f;
            for (int j = 0; j <= qb; ++j) {
                if (!((mask >> j) & 1ull)) continue;
                for (int s = 0; s < 64; ++s) {
                    const int tk = j * 64 + s; if (tk > t) break;
                    const size_t kt = (size_t)b * NS + tk;
                    const float sc = dot32(q, p.ks + kt * 128 + ho) * scale;
                    if (sc > mm) { const float corr = expf(mm - sc); ll *= corr;
#pragma unroll
                        for (int i = 0; i < 32; ++i) o[i] *= corr;
                        mm = sc; }
                    const float e = expf(sc - mm); ll += e; axpy32(o, e, p.z + kt * INC + ZVS + ho);
                }
            }
            const float iv = gate1 / fmaxf(ll, 1e-30f);
#pragma unroll
            for (int i = 0; i < 8; ++i) { float4 c = *(float4*)(outp + i * 4); c.x += o[i * 4] * iv; c.y += o[i * 4 + 1] * iv; c.z += o[i * 4 + 2] * iv; c.w += o[i * 4 + 3] * iv; *(float4*)(outp + i * 4) = c; }
        }
        {
            float mm = -INFINITY, ll = 0.f;
#pragma unroll
            for (int i = 0; i < 32; ++i) o[i] = 0.f;
            const int k0 = t - 511 > 0 ? t - 511 : 0;
            for (int tk = k0; tk <= t; ++tk) {
                const size_t kt = (size_t)b * NS + tk;
                const float sc = dot32(q, p.kw + kt * 128 + ho) * scale;
                if (sc > mm) { const float corr = expf(mm - sc); ll *= corr;
#pragma unroll
                    for (int i = 0; i < 32; ++i) o[i] *= corr;
                    mm = sc; }
                const float e = expf(sc - mm); ll += e; axpy32(o, e, p.z + kt * INC + ZVW + ho);
            }
            const float iv = gate2 / fmaxf(ll, 1e-30f);
#pragma unroll
            for (int i = 0; i < 8; ++i) { float4 c = *(float4*)(outp + i * 4); c.x += o[i * 4] * iv; c.y += o[i * 4 + 1] * iv; c.z += o[i * 4 + 2] * iv; c.w += o[i * 4 + 3] * iv; *(float4*)(outp + i * 4) = c; }
        }
    }
    __syncthreads();
}

__device__ __forceinline__ void ph_topk(const Params& p, int l, int bid, int nb) {
    const int lane = tid_() & 63, w = tid_() >> 6;
    for (int t = bid * 4 + w; t < NT; t += nb * 4) {
        float aff[4], key[4]; bool used[4];
#pragma unroll
        for (int i = 0; i < 4; ++i) { const int e = i * 64 + lane; aff[i] = sigmoidf_(p.logits[(size_t)t * NE + e]); key[i] = aff[i] + p.b_router[l * NE + e]; used[i] = false; }
        float topv[8]; int tope[8]; float sum = 0.f;
#pragma unroll
        for (int r = 0; r < 8; ++r) {
            float bv = -INFINITY; int be = 1 << 30; float ba = 0.f;
#pragma unroll
            for (int i = 0; i < 4; ++i) { const int e = i * 64 + lane; if (!used[i] && (key[i] > bv || (key[i] == bv && e < be))) { bv = key[i]; be = e; ba = aff[i]; } }
#pragma unroll
            for (int o = 32; o >= 1; o >>= 1) {
                const float ov = __shfl_xor(bv, o); const int oe = __shfl_xor(be, o); const float oa = __shfl_xor(ba, o);
                if (ov > bv || (ov == bv && oe < be)) { bv = ov; be = oe; ba = oa; }
            }
#pragma unroll
            for (int i = 0; i < 4; ++i) if (i * 64 + lane == be) used[i] = true;
            topv[r] = ba; tope[r] = be; sum += ba;
        }
        if (lane < 8) {
            float tv = 0.f; int te = 0;
#pragma unroll
            for (int r = 0; r < 8; ++r) if (lane == r) { tv = topv[r]; te = tope[r]; }
            p.idx[(size_t)t * 8 + lane] = te;
            p.wts[(size_t)t * 8 + lane] = tv / sum * 2.5f;
            atomicAdd(&p.counts[te], 1);
        }
    }
}

__device__ __forceinline__ void ph_scan(const Params& p, int* ismem, int bid) {
    if (bid != 0) return;
    const int tid = tid_();
    ismem[tid] = (p.counts[tid] + 127) / 128 * 128;
    __syncthreads();
    if (tid == 0) { int run = 0; for (int e = 0; e < NE; ++e) { const int v = ismem[e]; ismem[e] = run; run += v; } ismem[NE] = run; }
    __syncthreads();
    const int st = ismem[tid], en = (tid == NE - 1) ? ismem[NE] : ismem[tid + 1];
    p.pad_start[tid] = st; p.cursor[tid] = 0;
    for (int i = st / 128; i < en / 128; ++i) p.blk_e[i] = tid;
    for (int i = ismem[NE] / 128 + tid; i < MAXBLK; i += 256) p.blk_e[i] = -1;
    __syncthreads();
}

__device__ __forceinline__ void ph_place(const Params& p, int bid, int nb) {
    for (int a = bid * 256 + tid_(); a < NT * 8; a += nb * 256) {
        const int e = p.idx[a];
        const int pos = atomicAdd(&p.cursor[e], 1);
        const int dest = p.pad_start[e] + pos;
        p.row_tok[dest] = a >> 3; p.row_w[dest] = p.wts[a];
    }
}

enum { PH_MOD = 0, PH_NORM_A, PH_GEMM_Z, PH_PREP, PH_ATTN, PH_PROJ, PH_OUT, PH_NORM_F, PH_ROUTER, PH_TOPK, PH_SCAN, PH_PLACE, PH_EGATE, PH_EUP, PH_EDOWN, PH_FINAL, PH_COUNT };

template <int PH>
__device__ __forceinline__ void run_phase(const Params& p, int l, float* smem, int bid, int nb) {
    const float* xin = (l == 0) ? p.x : p.out;
    if constexpr (PH == PH_MOD) { ph_mod(p, smem, bid, nb); }
    else if constexpr (PH == PH_NORM_A) { ph_norm(p, xin, l, 0, 1024, bid, nb); }
    else if constexpr (PH == PH_GEMM_Z) {
        GemmArgs g{}; g.A = p.h; g.lda = ND; g.Bm = p.w_in + (size_t)l * ND * INC; g.ldb = INC; g.C = p.z; g.ldc = INC; g.M = NT; g.N = INC; g.K = ND;
        sgemm<M_STORE, false>(g, smem, bid, nb);
    }
    else if constexpr (PH == PH_PREP) { ph_prep(p, l, bid, nb); ph_compress(p, l, smem, bid, nb); ph_gmln(p, l, bid, nb); }
    else if constexpr (PH == PH_ATTN) { ph_attn(p, l, smem, bid, nb); ph_gmmix(p, l, smem, bid, nb); }
    else if constexpr (PH == PH_PROJ) {
        GemmArgs g{}; g.A = p.onsa; g.lda = 512; g.Bm = p.wpn + (size_t)l * 512 * ND; g.ldb = ND; g.C = p.ya; g.ldc = ND; g.M = NT; g.N = ND; g.K = 512; g.aux = p.z + ZGA; g.ldaux = INC;
        sgemm<M_SIG_SET, false>(g, smem, bid, nb);
        g.A = p.ogm; g.Bm = p.wpg + (size_t)l * 512 * ND; g.aux = p.z + ZGB;
        sgemm<M_SIG_ADD, false>(g, smem, bid, nb);
    }
    else if constexpr (PH == PH_OUT) {
        GemmArgs g{}; g.A = p.ya; g.lda = ND; g.Bm = p.w_out + (size_t)l * ND * ND; g.ldb = ND; g.C = p.out; g.ldc = ND; g.M = NT; g.N = ND; g.K = ND;
        g.aux = xin; g.ldaux = ND; g.aux2 = p.mod + (size_t)l * NB * 6144 + 2048;
        sgemm<M_RESID, false>(g, smem, bid, nb);
    }
    else if constexpr (PH == PH_NORM_F) {
        ph_norm(p, p.out, l, 3072, 4096, bid, nb);
        for (size_t i = (size_t)bid * 256 + tid_(); i < (size_t)NT * ND / 4; i += (size_t)nb * 256) ((float4*)p.routed)[i] = make_float4(0.f, 0.f, 0.f, 0.f);
        for (int i = bid * 256 + tid_(); i < MAXROWS; i += nb * 256) { p.row_tok[i] = -1; p.row_w[i] = 0.f; }
        if (bid == 0) p.counts[tid_()] = 0;
    }
    else if constexpr (PH == PH_ROUTER) {
        GemmArgs g{}; g.A = p.h; g.lda = ND; g.Bm = p.w_router + (size_t)l * ND * NE; g.ldb = NE; g.C = p.logits; g.ldc = NE; g.M = NT; g.N = NE; g.K = ND;
        sgemm<M_STORE, false>(g, smem, bid, nb);
        g.Bm = p.wgs + (size_t)l * ND * 256; g.C = p.gs;
        sgemm<M_STORE, false>(g, smem, bid, nb);
    }
    else if constexpr (PH == PH_TOPK) {
        ph_topk(p, l, bid, nb);
        GemmArgs g{}; g.A = p.h; g.lda = ND; g.Bm = p.wus + (size_t)l * ND * 256; g.ldb = 256; g.C = p.sact; g.ldc = 256; g.M = NT; g.N = 256; g.K = ND; g.aux = p.gs; g.ldaux = 256;
        sgemm<M_SILU_MUL, false>(g, smem, bid, nb);
    }
    else if constexpr (PH == PH_SCAN) {
        ph_scan(p, (int*)smem, bid);
        GemmArgs g{}; g.A = p.sact; g.lda = 256; g.Bm = p.wds + (size_t)l * 256 * ND; g.ldb = ND; g.C = p.shout; g.ldc = ND; g.M = NT; g.N = ND; g.K = 256;
        sgemm<M_STORE, false>(g, smem, bid, nb);
    }
    else if constexpr (PH == PH_PLACE) { ph_place(p, bid, nb); }
    else if constexpr (PH == PH_EGATE) {
        GemmArgs g{}; g.A = p.h; g.lda = ND; g.gather = p.row_tok; g.Bm = p.wge + (size_t)l * NE * ND * 256; g.ldb = 256; g.strideB = (size_t)ND * 256; g.blk_e = p.blk_e;
        g.C = p.ag; g.ldc = 256; g.M = MAXROWS; g.N = 256; g.K = ND;
        sgemm<M_STORE, true>(g, smem, bid, nb);
    }
    else if constexpr (PH == PH_EUP) {
        GemmArgs g{}; g.A = p.h; g.lda = ND; g.gather = p.row_tok; g.Bm = p.wue + (size_t)l * NE * ND * 256; g.ldb = 256; g.strideB = (size_t)ND * 256; g.blk_e = p.blk_e;
        g.C = p.act; g.ldc = 256; g.M = MAXROWS; g.N = 256; g.K = ND; g.aux = p.ag; g.ldaux = 256;
        sgemm<M_SILU_MUL, true>(g, smem, bid, nb);
    }
    else if constexpr (PH == PH_EDOWN) {
        GemmArgs g{}; g.A = p.act; g.lda = 256; g.gather = p.row_tok; g.Bm = p.wde + (size_t)l * NE * 256 * ND; g.ldb = ND; g.strideB = (size_t)256 * ND; g.blk_e = p.blk_e;
        g.C = p.routed; g.ldc = ND; g.M = MAXROWS; g.N = ND; g.K = 256; g.aux = p.row_w;
        sgemm<M_SCATTER, false>(g, smem, bid, nb);
    }
    else if constexpr (PH == PH_FINAL) {
        const float* gt = p.mod + (size_t)l * NB * 6144 + 5120;
        for (size_t i = (size_t)bid * 256 + tid_(); i < (size_t)NT * ND / 4; i += (size_t)nb * 256) {
            const size_t e0 = i * 4; const int r = (int)(e0 >> 10), cidx = (int)(e0 & 1023);
            const float4 g4 = *(const float4*)(gt + (size_t)(r >> 12) * 6144 + cidx);
            const float4 a = ((const float4*)p.routed)[i], s = ((const float4*)p.shout)[i]; float4 o = ((float4*)p.out)[i];
            o.x += g4.x * (a.x + s.x); o.y += g4.y * (a.y + s.y); o.z += g4.z * (a.z + s.z); o.w += g4.w * (a.w + s.w);
            ((float4*)p.out)[i] = o;
        }
    }
}


#define SMEM_FLOATS 8192
template <int PH>
__global__ void __launch_bounds__(256, 2) k_phase(Params p, int l) {
    __shared__ float smem[SMEM_FLOATS];
    run_phase<PH>(p, l, smem, blockIdx.x, gridDim.x);
}
template <int PH> static void launch_phase(const Params& p, int l, int grid, hipStream_t s) { hipLaunchKernelGGL(k_phase<PH>, dim3(grid), dim3(256), 0, s, p, l); }
}
#endif
namespace pg8 {
constexpr int BM = 256, BK = 64, HALF = 128, HTB = HALF * BK * 2, STAGE_BYTES = 8 * HTB;

__host__ __device__ __forceinline__ int lds_byte(int r, int c) { const int st = (r >> 4) * 2 + (c >> 5), rr = r & 15, cc = c & 31, ob = rr * 64 + cc * 2; return st * 1024 + (ob ^ (((ob >> 9) & 1) << 5)); }
__host__ __device__ __forceinline__ void stage_rc(int b, int& R, int& C) { const int st = b / 1024, sb = b % 1024, swz = sb ^ (((sb >> 9) & 1) << 5); R = (st >> 1) * 16 + swz / 64; C = (st & 1) * 32 + (swz % 64) / 2; }
__host__ __device__ __forceinline__ int perm32(int rho) { const int n = rho >> 4, i = rho & 15; return 8 * (i >> 2) + 4 * n + (i & 3); }

struct Unit { int pm, pn, e; };

__device__ __forceinline__ const char* uptr(const char* p) { return p; }
__device__ __forceinline__ unsigned cvt_pk_bf16(float lo, float hi) { unsigned r; asm volatile("v_cvt_pk_bf16_f32 %0, %1, %2" : "=v"(r) : "v"(lo), "v"(hi)); return r; }

typedef long pg8_l2 __attribute__((ext_vector_type(2)));
template <bool F8> __device__ __forceinline__ f32x4 pg8_mma(const bf16x8& b, const bf16x8& a, const f32x4& c) {
    if constexpr (F8) { const pg8_l2 bl = __builtin_bit_cast(pg8_l2, b), al = __builtin_bit_cast(pg8_l2, a);
        f32x4 r = __builtin_amdgcn_mfma_f32_16x16x32_fp8_fp8(bl[0], al[0], c, 0, 0, 0); return __builtin_amdgcn_mfma_f32_16x16x32_fp8_fp8(bl[1], al[1], r, 0, 0, 0); }
    else return __builtin_amdgcn_mfma_f32_16x16x32_bf16(b, a, c, 0, 0, 0);
}
template <class Epi, class Sched, bool ALIGN_EPI = true, bool MID = false, bool F8 = false>
__device__ __forceinline__ void gemm_phase(LAS unsigned char* lds, const Sched& S, const Epi& E) {
    const int tid = tid_(), wid = __builtin_amdgcn_readfirstlane(tid >> 6), lane = tid & 63, wr = wid >> 2, wc = wid & 3, fr = lane & 15, fq = lane >> 4;
    const int K = S.K, nt = K / BK;
    unsigned voffB[2];
#pragma unroll
    for (int i = 0; i < 2; ++i) { int R, C; stage_rc(tid * 16 + i * 8192, R, C); const int Rb = Epi::PERM ? ((R & ~31) + perm32(R & 31)) : R; voffB[i] = (unsigned)(Rb * S.ldb + C) * 2u; }
    const unsigned kstepB = (unsigned)(BK * 2), kstepA = (unsigned)S.kstepA;
    const unsigned hstepB = (unsigned)(HALF * S.ldb * 2);
    const char* const bA = S.a_base(); const char* const bB = S.b_base();
    const unsigned ldsw = (unsigned)wid * 1024u;
    const int aoff = lds_byte(wr * 64 + fr, fq * 8), boff = lds_byte(wc * 32 + fr, fq * 8);
#define PG8_SA(b, h) (((b) * 2 + (h)) * HTB)
#define PG8_SB(b, h) ((4 + (b) * 2 + (h)) * HTB)
#define PG8_STAGE_B(bufoff, gbase) do { _Pragma("unroll") for (int _i = 0; _i < 2; ++_i) \
        __builtin_amdgcn_global_load_lds((const unsigned*)(bB + (unsigned)((gbase) + voffB[_i])), (LAS unsigned*)(lds + (bufoff) + ldsw + _i * 8192), 16, 0, 0); } while (0)
#define PG8_STAGE_A(bufoff, gbase, offs, h) do { _Pragma("unroll") for (int _i = 0; _i < 2; ++_i) \
        __builtin_amdgcn_global_load_lds((const unsigned*)(bA + (unsigned)((gbase) + (offs)[h][_i])), (LAS unsigned*)(lds + (bufoff) + ldsw + _i * 8192), 16, 0, 0); } while (0)
#define PG8_LDA(dst, b, h) do { _Pragma("unroll") for (int m = 0; m < 4; ++m) _Pragma("unroll") for (int k = 0; k < 2; ++k) dst[m][k] = *(const LAS bf16x8*)(lds + PG8_SA(b, h) + aoff + m * 2048 + k * 1024); } while (0)
#define PG8_LDB(dst, b, h) do { _Pragma("unroll") for (int n = 0; n < 2; ++n) _Pragma("unroll") for (int k = 0; k < 2; ++k) dst[n][k] = *(const LAS bf16x8*)(lds + PG8_SB(b, h) + boff + n * 2048 + k * 1024); } while (0)
#define PG8_MMA(ai, bj, At, Bt) do { __builtin_amdgcn_s_setprio(1); _Pragma("unroll") for (int m = 0; m < 4; ++m) _Pragma("unroll") for (int n = 0; n < 2; ++n) _Pragma("unroll") for (int k = 0; k < 2; ++k) \
        acc[ai][bj][m][n] = pg8_mma<F8>(Bt[n][k], At[m][k], acc[ai][bj][m][n]); __builtin_amdgcn_s_setprio(0); } while (0)
#define PG8_WAIT_V(n) asm volatile("s_waitcnt vmcnt(" #n ")" ::: "memory")
#define PG8_WAIT_L(n) asm volatile("s_waitcnt lgkmcnt(" #n ")" ::: "memory")
#define PG8_BAR __builtin_amdgcn_s_barrier()
#define PG8_SCHED __builtin_amdgcn_sched_barrier(0)
    Unit cur, nxt; int ui = 0;
    if (!S.next(0, cur)) return;
    f32x4 acc[2][2][4][2];
#pragma unroll
    for (int a = 0; a < 2; ++a)
#pragma unroll
        for (int b = 0; b < 2; ++b)
#pragma unroll
            for (int m = 0; m < 4; ++m)
#pragma unroll
                for (int n = 0; n < 2; ++n) acc[a][b][m][n] = (f32x4){0.f, 0.f, 0.f, 0.f};
    bf16x8 At[4][2], B0[2][2], B1[2][2];
    unsigned cA = (unsigned)(S.a_ptr(cur) - bA), cB = (unsigned)(S.b_ptr(cur) - bB);
    unsigned coff[2][2], noff[2][2];
    S.a_off(cur, tid, coff);
    PG8_STAGE_B(PG8_SB(0, 0), cB); PG8_STAGE_B(PG8_SB(0, 1), cB + hstepB); PG8_STAGE_A(PG8_SA(0, 0), cA, coff, 0); PG8_STAGE_A(PG8_SA(0, 1), cA, coff, 1);
    if (wr == 1) PG8_BAR;
    PG8_WAIT_V(2); PG8_BAR;
    PG8_STAGE_B(PG8_SB(1, 0), cB + kstepB); PG8_STAGE_A(PG8_SA(1, 0), cA + kstepA, coff, 0); PG8_STAGE_B(PG8_SB(1, 1), cB + hstepB + kstepB);
    PG8_WAIT_V(6); PG8_BAR;
    for (;;) {
        const bool has_next = S.next(ui + 1, nxt);
        unsigned nA = cA, nB = cB;
#pragma unroll
        for (int h = 0; h < 2; ++h)
#pragma unroll
            for (int i = 0; i < 2; ++i) noff[h][i] = coff[h][i];
        if (has_next) { nA = (unsigned)(S.a_ptr(nxt) - bA); nB = (unsigned)(S.b_ptr(nxt) - bB); S.a_off(nxt, tid_(), noff); }
        for (int t = 0; t < nt; t += 2) {
            if constexpr (MID) { if (2 * t == nt) E.mid(acc, cur, wr, wc, fr, fq); }
            const bool last = (t == nt - 2);
            const unsigned a1 = cA + (unsigned)(t + 1) * kstepA;
            const unsigned a2 = last ? nA : cA + (unsigned)(t + 2) * kstepA, b2 = last ? nB : cB + (unsigned)(t + 2) * kstepB;
            const unsigned a3 = a2 + kstepA, b3 = b2 + kstepB;
            unsigned so[2][2]; const unsigned lmask = last ? 0xffffffffu : 0u;
#pragma unroll
            for (int h = 0; h < 2; ++h)
#pragma unroll
                for (int i = 0; i < 2; ++i) so[h][i] = coff[h][i] ^ ((coff[h][i] ^ noff[h][i]) & lmask);
            PG8_LDB(B0, 0, 0); PG8_LDB(B1, 0, 1); PG8_SCHED; PG8_LDA(At, 0, 0); PG8_STAGE_A(PG8_SA(1, 1), a1, coff, 1);
            PG8_WAIT_V(8); PG8_WAIT_L(0); PG8_BAR; PG8_MMA(0, 0, At, B0); PG8_MMA(0, 1, At, B1); PG8_BAR; PG8_SCHED;
            PG8_LDA(At, 0, 1); PG8_STAGE_B(PG8_SB(0, 0), b2); PG8_STAGE_B(PG8_SB(0, 1), b2 + hstepB); PG8_STAGE_A(PG8_SA(0, 0), a2, so, 0);
            PG8_WAIT_V(8); PG8_WAIT_L(0); PG8_BAR; PG8_MMA(1, 0, At, B0); PG8_MMA(1, 1, At, B1); PG8_BAR; PG8_SCHED;
            PG8_LDB(B0, 1, 0); PG8_LDB(B1, 1, 1); PG8_SCHED; PG8_LDA(At, 1, 0); PG8_STAGE_A(PG8_SA(0, 1), a2, so, 1);
            PG8_WAIT_V(8); PG8_WAIT_L(0); PG8_BAR; PG8_MMA(0, 0, At, B0); PG8_MMA(0, 1, At, B1); PG8_BAR; PG8_SCHED;
            PG8_LDA(At, 1, 1); PG8_STAGE_B(PG8_SB(1, 0), b3); PG8_STAGE_B(PG8_SB(1, 1), b3 + hstepB); PG8_STAGE_A(PG8_SA(1, 0), a3, so, 0);
            PG8_WAIT_V(8); PG8_WAIT_L(0); PG8_BAR; PG8_MMA(1, 0, At, B0); PG8_MMA(1, 1, At, B1); PG8_BAR; PG8_SCHED;
        }
        if constexpr (ALIGN_EPI) { if (wr == 0) PG8_BAR; }
        E(acc, cur, wr, wc, fr, fq);
        if (!has_next) break;
#pragma unroll
        for (int a = 0; a < 2; ++a)
#pragma unroll
            for (int b = 0; b < 2; ++b)
#pragma unroll
                for (int m = 0; m < 4; ++m)
#pragma unroll
                    for (int n = 0; n < 2; ++n) acc[a][b][m][n] = (f32x4){0.f, 0.f, 0.f, 0.f};
        cur = nxt; cA = nA; cB = nB; ++ui;
#pragma unroll
        for (int h = 0; h < 2; ++h)
#pragma unroll
            for (int i = 0; i < 2; ++i) coff[h][i] = noff[h][i];
        if constexpr (ALIGN_EPI) { if (wr == 1) PG8_BAR; }
    }
    PG8_WAIT_V(0);
    if constexpr (!ALIGN_EPI) { if (wr == 0) PG8_BAR; }
    PG8_BAR;
#undef PG8_SA
#undef PG8_SB
#undef PG8_STAGE_A
#undef PG8_STAGE_B
#undef PG8_LDA
#undef PG8_LDB
#undef PG8_MMA
#undef PG8_WAIT_V
#undef PG8_WAIT_L
#undef PG8_BAR
#undef PG8_SCHED
}

struct DenseSched {
    const char* A; const char* Bt; int K, kstepA, ldb; int lda_bytes; int nM, nN, G, c;
    __device__ __forceinline__ void init(const void* A_, int lda_elems, const void* Bt_, int M, int N, int K_, int G_, int c_) {
        A = (const char*)A_; Bt = (const char*)Bt_; K = K_; ldb = K_; kstepA = BK * 2; lda_bytes = lda_elems * 2; nM = M / BM; nN = N / BM; G = G_; c = c_; }
    __device__ __forceinline__ bool next(int i, Unit& u) const {
        const long L = (long)i * G + c; if (L >= (long)nM * nN) return false;
        const int nwg = nM * nN; int wgid = (int)L; { const int q = nwg / 8, r = nwg % 8, xcd = wgid % 8, off = wgid / 8; wgid = (xcd < r ? xcd * (q + 1) : r * (q + 1) + (xcd - r) * q) + off; }
        const int nig = 8 * nN, gid = wgid / nig, fm = gid * 8, gsz = (nM - fm) < 8 ? (nM - fm) : 8;
        u.pm = fm + ((wgid % nig) % gsz); u.pn = (wgid % nig) / gsz; u.e = 0; return true;
    }
    __device__ __forceinline__ const char* a_base() const { return A; }
    __device__ __forceinline__ const char* b_base() const { return Bt; }
    __device__ __forceinline__ const char* a_ptr(const Unit& u) const { return A + (size_t)u.pm * BM * lda_bytes; }
    __device__ __forceinline__ void a_off(const Unit&, int tid, unsigned (&off)[2][2]) const {
#pragma unroll
        for (int i = 0; i < 2; ++i) { int R, C; stage_rc(tid * 16 + i * 8192, R, C);
#pragma unroll
            for (int h = 0; h < 2; ++h) off[h][i] = (unsigned)((h * HALF + R) * lda_bytes + C * 2); }
    }
    __device__ __forceinline__ const char* b_ptr(const Unit& u) const { return Bt + (size_t)u.pn * BM * K * 2; }
};
}
#define MAXROWS2 327680
#define MAXUNITS2 (MAXROWS2 / 256)
#define ZPAD 4608
constexpr int LDS_BYTES = 147456;
constexpr int LDS_MISC = 135168;

namespace wsl {
constexpr size_t al(size_t x) { return (x + 255) & ~(size_t)255; }
constexpr size_t O_ctl = 0;
constexpr size_t O_mod = O_ctl + al(65536);
constexpr size_t O_rope = O_mod + al((size_t)NL * NB * 6144 * 4);
constexpr size_t O_bias1 = O_rope + al((size_t)NT * 32 * 8);
constexpr size_t O_wsc = O_bias1 + al((size_t)NL * 2 * 256 * 4);
constexpr size_t O_Wt_in = O_wsc + al((size_t)NL * 8 * 128 * 128 * 2);
constexpr size_t O_Wt_pn = O_Wt_in + al((size_t)NL * ZPAD * ND * 2);
constexpr size_t O_Wt_pg = O_Wt_pn + al((size_t)NL * ND * 512 * 2);
constexpr size_t O_Wt_out = O_Wt_pg + al((size_t)NL * ND * 512 * 2);
constexpr size_t O_Wt_rs = O_Wt_out + al((size_t)NL * ND * ND * 2);
constexpr size_t O_Wt_ds = O_Wt_rs + al((size_t)NL * 768 * ND * 2);
constexpr size_t O_Wt_w1 = O_Wt_ds + al((size_t)NL * ND * 256 * 2);
constexpr size_t O_h = O_Wt_w1 + al((size_t)NL * 2 * 256 * 2048 * 2);
constexpr size_t O_xb = O_h + al((size_t)NT * ND * 2);
constexpr size_t O_gates = O_xb + al((size_t)NT * ND * 2);
constexpr size_t O_kc = O_gates + al((size_t)NT * 32 * 4);
constexpr size_t O_vc = O_kc + al((size_t)NB * 256 * 128 * 2);
constexpr size_t O_idx = O_vc + al((size_t)NB * 256 * 128 * 2);
constexpr size_t O_slot = O_idx + al((size_t)NT * 8 * 4);
constexpr size_t O_wts = O_slot + al((size_t)NT * 8 * 4);
constexpr size_t O_counts = O_wts + al((size_t)NT * 8 * 4);
constexpr size_t O_cursor = O_counts + al(1024);
constexpr size_t O_bhist = O_cursor + al(1024);
constexpr size_t O_row_tok = O_bhist + al(1024 * 256 * 4);
constexpr size_t O_row_w = O_row_tok + al((size_t)MAXROWS2 * 4);
constexpr size_t O_unit_e = O_row_w + al((size_t)MAXROWS2 * 4);
constexpr size_t O_REGION = O_unit_e + al((size_t)MAXUNITS2 * 4);
constexpr size_t O_qn = O_REGION;
constexpr size_t O_qr = O_qn + al((size_t)NT * 512 * 2);
constexpr size_t O_kvraw = O_qr + al((size_t)NT * 512 * 2);
constexpr size_t O_ksv = O_kvraw + al((size_t)NT * 256 * 2);
constexpr size_t O_kwv = O_ksv + al((size_t)NT * 256 * 2);
constexpr size_t O_u = O_kwv + al((size_t)NT * 256 * 2);
constexpr size_t O_v = O_u + al((size_t)NT * 512 * 2);
constexpr size_t O_sga = O_v + al((size_t)NT * 512 * 2);
constexpr size_t O_sgb = O_sga + al((size_t)NT * ND * 2);
constexpr size_t O_cpart = O_sgb + al((size_t)NT * ND * 2);
constexpr size_t O_onsa = O_cpart + al((size_t)2 * 4 * 4096 * 256 * 4);
constexpr size_t O_ogm = O_onsa + al((size_t)NT * 512 * 2);
constexpr size_t O_merged = O_ogm + al((size_t)NT * 512 * 2);
constexpr size_t O_END_MIX = O_merged + al((size_t)NT * ND * 2);
constexpr size_t O_logits = O_REGION;
constexpr size_t O_sact = O_logits + al((size_t)NT * NE * 4);
constexpr size_t O_shout = O_sact + al((size_t)NT * 256 * 2);
constexpr size_t O_act = O_shout + al((size_t)NT * ND * 2);
constexpr size_t O_yslot = O_act + al((size_t)MAXROWS2 * 256 * 2);
constexpr size_t O_END_MOE = O_yslot + al((size_t)MAXROWS2 * ND * 2);
constexpr size_t O_END_ACT = O_END_MIX > O_END_MOE ? O_END_MIX : O_END_MOE;
constexpr size_t O_Wt_eg = O_END_ACT;
constexpr size_t O_Wt_ed = O_Wt_eg + al((size_t)NL * NE * 512 * ND * 2);
constexpr size_t O_TOTAL = O_Wt_ed + al((size_t)NL * NE * ND * 256 * 2);
}
struct OP {
    const float *x, *c; const int* pos;
    const float *w_mod, *b_mod, *w_in, *q_gain, *k_gain, *pe_k, *pe_v, *w1k, *w2k, *w1v, *w2v, *ln_g, *ln_b, *gm_ws, *gm_bs,
                *wpn, *wpg, *w_out, *w_router, *b_router, *wge, *wue, *wde, *wgs, *wus, *wds;
    float* out;
    float* xres;
    char* ws;
    long long xoff;
    int ph_lo, ph_hi, l_lo, l_hi, conv_l_lo, conv_l_hi;
    __host__ __device__ __forceinline__ unsigned* ctl() const { return (unsigned*)(ws + wsl::O_ctl + (0)); }
    __host__ __device__ __forceinline__ float* mod() const { return (float*)(ws + wsl::O_mod + (0)); }
    __host__ __device__ __forceinline__ float* rope() const { return (float*)(ws + wsl::O_rope + (0)); }
    __host__ __device__ __forceinline__ float* bias1() const { return (float*)(ws + wsl::O_bias1 + (0)); }
    __host__ __device__ __forceinline__ bf16_t* wsc() const { return (bf16_t*)(ws + wsl::O_wsc + (0)); }
    __host__ __device__ __forceinline__ bf16_t* Wt_in() const { return (bf16_t*)(ws + wsl::O_Wt_in + (0)); }
    __host__ __device__ __forceinline__ bf16_t* Wt_pn() const { return (bf16_t*)(ws + wsl::O_Wt_pn + (0)); }
    __host__ __device__ __forceinline__ bf16_t* Wt_pg() const { return (bf16_t*)(ws + wsl::O_Wt_pg + (0)); }
    __host__ __device__ __forceinline__ bf16_t* Wt_out() const { return (bf16_t*)(ws + wsl::O_Wt_out + (0)); }
    __host__ __device__ __forceinline__ bf16_t* Wt_rs() const { return (bf16_t*)(ws + wsl::O_Wt_rs + (0)); }
    __host__ __device__ __forceinline__ bf16_t* Wt_ds() const { return (bf16_t*)(ws + wsl::O_Wt_ds + (0)); }
    __host__ __device__ __forceinline__ bf16_t* Wt_w1() const { return (bf16_t*)(ws + wsl::O_Wt_w1 + (0)); }
    __host__ __device__ __forceinline__ bf16_t* h() const { return (bf16_t*)(ws + wsl::O_h + (0)); }
    __host__ __device__ __forceinline__ bf16_t* xb() const { return (bf16_t*)(ws + wsl::O_xb + (0)); }
    __host__ __device__ __forceinline__ float* gates() const { return (float*)(ws + wsl::O_gates + (0)); }
    __host__ __device__ __forceinline__ bf16_t* kc() const { return (bf16_t*)(ws + wsl::O_kc + (0)); }
    __host__ __device__ __forceinline__ bf16_t* vc() const { return (bf16_t*)(ws + wsl::O_vc + (0)); }
    __host__ __device__ __forceinline__ int* idx() const { return (int*)(ws + wsl::O_idx + (0)); }
    __host__ __device__ __forceinline__ int* slot() const { return (int*)(ws + wsl::O_slot + (0)); }
    __host__ __device__ __forceinline__ float* wts() const { return (float*)(ws + wsl::O_wts + (0)); }
    __host__ __device__ __forceinline__ int* counts() const { return (int*)(ws + wsl::O_counts + (0)); }
    __host__ __device__ __forceinline__ int* cursor() const { return (int*)(ws + wsl::O_cursor + (0)); }
    __host__ __device__ __forceinline__ int* bhist() const { return (int*)(ws + wsl::O_bhist + (0)); }
    __host__ __device__ __forceinline__ int* row_tok() const { return (int*)(ws + wsl::O_row_tok + (0)); }
    __host__ __device__ __forceinline__ float* row_w() const { return (float*)(ws + wsl::O_row_w + (0)); }
    __host__ __device__ __forceinline__ int* unit_e() const { return (int*)(ws + wsl::O_unit_e + (0)); }
    __host__ __device__ __forceinline__ bf16_t* qn() const { return (bf16_t*)(ws + wsl::O_qn + (0)); }
    __host__ __device__ __forceinline__ bf16_t* qr() const { return (bf16_t*)(ws + wsl::O_qr + (0)); }
    __host__ __device__ __forceinline__ bf16_t* kvraw() const { return (bf16_t*)(ws + wsl::O_kvraw + (0)); }
    __host__ __device__ __forceinline__ bf16_t* ksv() const { return (bf16_t*)(ws + wsl::O_ksv + (0)); }
    __host__ __device__ __forceinline__ bf16_t* kwv() const { return (bf16_t*)(ws + wsl::O_kwv + (0)); }
    __host__ __device__ __forceinline__ bf16_t* u() const { return (bf16_t*)(ws + wsl::O_u + (0)); }
    __host__ __device__ __forceinline__ bf16_t* v() const { return (bf16_t*)(ws + wsl::O_v + (0)); }
    __host__ __device__ __forceinline__ bf16_t* sga() const { return (bf16_t*)(ws + wsl::O_sga + (0)); }
    __host__ __device__ __forceinline__ bf16_t* sgb() const { return (bf16_t*)(ws + wsl::O_sgb + (0)); }
    __host__ __device__ __forceinline__ float* cpart() const { return (float*)(ws + wsl::O_cpart + (0)); }
    __host__ __device__ __forceinline__ bf16_t* onsa() const { return (bf16_t*)(ws + wsl::O_onsa + (0)); }
    __host__ __device__ __forceinline__ bf16_t* ogm() const { return (bf16_t*)(ws + wsl::O_ogm + (0)); }
    __host__ __device__ __forceinline__ bf16_t* merged() const { return (bf16_t*)(ws + wsl::O_merged + (0)); }
    __host__ __device__ __forceinline__ float* logits() const { return (float*)(ws + wsl::O_logits + (0)); }
    __host__ __device__ __forceinline__ bf16_t* sact() const { return (bf16_t*)(ws + wsl::O_sact + (0)); }
    __host__ __device__ __forceinline__ bf16_t* shout() const { return (bf16_t*)(ws + wsl::O_shout + (0)); }
    __host__ __device__ __forceinline__ bf16_t* act() const { return (bf16_t*)(ws + wsl::O_act + (0)); }
    __host__ __device__ __forceinline__ bf16_t* yslot() const { return (bf16_t*)(ws + wsl::O_yslot + (0)); }
    __host__ __device__ __forceinline__ bf16_t* Wt_eg() const { return (bf16_t*)(ws + wsl::O_Wt_eg + (xoff)); }
    __host__ __device__ __forceinline__ bf16_t* Wt_ed() const { return (bf16_t*)(ws + wsl::O_Wt_ed + (xoff)); }
};

__device__ __forceinline__ float bf2f(bf16_t b) { return __uint_as_float(((unsigned)b) << 16); }
__device__ __forceinline__ unsigned f2bf(float f) { unsigned u = __float_as_uint(f); return (u + 0x7fffu + ((u >> 16) & 1u)) >> 16; }
__device__ __forceinline__ unsigned pk2(float lo, float hi) { return pg8::cvt_pk_bf16(lo, hi); }
__device__ __forceinline__ float fsigmoid(float x) { return __builtin_amdgcn_rcpf(1.0f + __expf(-x)); }
__device__ __forceinline__ float fgelu(float x) { const float u2 = 1.5957691216057308f * (x + 0.044715f * x * x * x); return x * __builtin_amdgcn_rcpf(1.0f + __expf(-u2)); }
__device__ __forceinline__ float fsilu(float x) { return x * __builtin_amdgcn_rcpf(1.0f + __expf(-x)); }

struct TrItem { const float* src; bf16_t* dst; int ld, scol, nvalid, K, nd0, k0, f8; };
#define W8_SCALE 64.0f
#define H8_SCALE 8.0f
__device__ __forceinline__ unsigned pk4_e4m3(float a, float b, float c, float d) {
    int w = __builtin_amdgcn_cvt_pk_fp8_f32(__builtin_amdgcn_fmed3f(a, -240.f, 240.f), __builtin_amdgcn_fmed3f(b, -240.f, 240.f), 0, false);
    w = __builtin_amdgcn_cvt_pk_fp8_f32(__builtin_amdgcn_fmed3f(c, -240.f, 240.f), __builtin_amdgcn_fmed3f(d, -240.f, 240.f), w, true); return (unsigned)w; }
__device__ __forceinline__ void tr_load(const TrItem& it, f32x4 (&v)[16], int lane) {
    const int n4 = (lane & 7) * 4, kr = lane >> 3;
    const float* s = it.src + (size_t)(it.k0 + kr) * it.ld + it.scol + n4;
#pragma unroll
    for (int i = 0; i < 16; ++i) v[i] = (n4 < it.nvalid) ? __builtin_nontemporal_load((const f32x4*)(s + (size_t)(8 * i) * it.ld)) : (f32x4){0.f, 0.f, 0.f, 0.f};
}
#define TR_PITCH 72
typedef short tr_v4i16 __attribute__((ext_vector_type(4)));
__device__ __forceinline__ void tr_store(const TrItem& it, const f32x4 (&v)[16], LAS float* scrf, int lane) {
    LAS unsigned char* scr = (LAS unsigned char*)scrf;
    const int n4 = (lane & 7) * 4, kr = lane >> 3;
#pragma unroll
    for (int i = 0; i < 16; ++i) { const u32x2 w = {pk2(v[i].x, v[i].y), pk2(v[i].z, v[i].w)}; *(LAS u32x2*)(scr + (8 * i + kr) * TR_PITCH + n4 * 2) = w; }
    asm volatile("s_waitcnt lgkmcnt(0)" ::: "memory");
    const int n = lane & 31, hk = lane >> 5;
    const LAS unsigned char* rb = scr + ((lane & 15) >> 2) * TR_PITCH + (16 * ((lane >> 4) & 1) + 4 * (lane & 3)) * 2;
#pragma unroll
    for (int j = 0; j < 8; ++j) {
        const int cc = 2 * j + hk;
        const tr_v4i16 a = __builtin_amdgcn_ds_read_tr16_b64_v4i16((LAS tr_v4i16*)(rb + (8 * cc) * TR_PITCH)), b = __builtin_amdgcn_ds_read_tr16_b64_v4i16((LAS tr_v4i16*)(rb + (8 * cc + 4) * TR_PITCH));
        const bf16x8 o = {a[0], a[1], a[2], a[3], b[0], b[1], b[2], b[3]};
        if (it.f8) { const u32x4 ow = __builtin_bit_cast(u32x4, o);
            const u32x2 w8 = {pk4_e4m3(__uint_as_float(ow.x << 16) * W8_SCALE, __uint_as_float(ow.x & 0xffff0000u) * W8_SCALE, __uint_as_float(ow.y << 16) * W8_SCALE, __uint_as_float(ow.y & 0xffff0000u) * W8_SCALE),
                              pk4_e4m3(__uint_as_float(ow.z << 16) * W8_SCALE, __uint_as_float(ow.z & 0xffff0000u) * W8_SCALE, __uint_as_float(ow.w << 16) * W8_SCALE, __uint_as_float(ow.w & 0xffff0000u) * W8_SCALE)};
            *(u32x2*)((unsigned char*)it.dst + (size_t)(it.nd0 + n) * it.K + it.k0 + 8 * cc) = w8; }
        else *(bf16x8*)(it.dst + (size_t)(it.nd0 + n) * it.K + it.k0 + 8 * cc) = o;
    }
    asm volatile("s_waitcnt lgkmcnt(0)" ::: "memory");
}
__device__ __forceinline__ void tr_item(const float* src, int ld, int scol, int nvalid, bf16_t* dst, int K, int nd0, int k0, LAS float* scr, int lane, int f8 = 0) {
    TrItem it{src, dst, ld, scol, nvalid, K, nd0, k0, f8}; f32x4 v[16]; tr_load(it, v, lane); tr_store(it, v, scr, lane);
}
__device__ __forceinline__ int win_srccol(int nd0, int& nvalid) {
    const int pn = nd0 >> 8, q = nd0 & 255, bj = q >> 7, wc = (q & 127) >> 5; nvalid = 32;
    if (pn < 2) return ZQ + (4 * pn + wc) * 64 + 32 * bj;
    if (pn < 5) return ZKC + (pn - 2) * 256 + wc * 64 + 32 * bj;
    if (pn < 7) return ZU + (pn - 5) * 256 + q;
    if (pn < 9) return ZV + (pn - 7) * 256 + q;
    if (pn < 17) return (bj ? ZGB : ZGA) + (pn - 9) * 128 + (q & 127);
    nvalid = (q == 0) ? 24 : 0; return ZG;
}
__device__ __forceinline__ void ph_prologue(const OP& p, LAS unsigned char* lds, int bid, int nb) {
    const int tid = tid_(), lane = tid & 63, wave = tid >> 6;
    {
        LAS float* sc = (LAS float*)lds;
        LAS float* part = sc + NB * ND;
        bool have_sc = false;
        for (int job = bid; job < NL * 96 + 16; job += nb) {
            __syncthreads();
            if (job < NL * 96) {
                if (!have_sc) { for (int i = tid; i < NB * ND; i += 512) { const float cv = p.c[i]; sc[i] = cv / (1.0f + expf(-cv)); } have_sc = true; __syncthreads(); }
                const int l = job / 96, j = (job % 96) * 64 + lane;
                const float* w = p.w_mod + (size_t)l * ND * 6144 + (size_t)(wave * 128) * 6144 + j;
                float acc[NB];
#pragma unroll
                for (int b = 0; b < NB; ++b) acc[b] = 0.f;
                for (int bt = 0; bt < 4; ++bt) {
                    float wv[32];
#pragma unroll
                    for (int i = 0; i < 32; ++i) wv[i] = w[(size_t)(bt * 32 + i) * 6144];
#pragma unroll
                    for (int i = 0; i < 32; ++i)
#pragma unroll
                        for (int b = 0; b < NB; ++b) acc[b] = fmaf(sc[b * ND + wave * 128 + bt * 32 + i], wv[i], acc[b]);
                }
#pragma unroll
                for (int b = 0; b < NB; ++b) part[(wave * NB + b) * 64 + lane] = acc[b];
                __syncthreads();
                { const int b = wave; float s = p.b_mod[l * 6144 + j];
#pragma unroll
                  for (int ww = 0; ww < 8; ++ww) s += part[(ww * NB + b) * 64 + lane];
                  p.mod()[((size_t)l * NB + b) * 6144 + j] = s; }
            } else {
                const int jb = job - NL * 96, l = jb >> 3, kv = (jb >> 2) & 1, f = (jb & 3) * 64 + lane;
                const float* pe = (kv ? p.pe_v : p.pe_k) + l * 2048 + wave * 256; const float* w1 = (kv ? p.w1v : p.w1k) + (size_t)l * 2048 * 256 + (size_t)(wave * 256) * 256 + f; float a = 0.f;
                for (int bt = 0; bt < 8; ++bt) {
                    float wv[32];
#pragma unroll
                    for (int i = 0; i < 32; ++i) wv[i] = w1[(size_t)(bt * 32 + i) * 256];
#pragma unroll
                    for (int i = 0; i < 32; ++i) a = fmaf(pe[bt * 32 + i], wv[i], a);
                }
                part[wave * 64 + lane] = a;
                __syncthreads();
                if (wave == 0) { float s = 0.f;
#pragma unroll
                    for (int ww = 0; ww < 8; ++ww) s += part[ww * 64 + lane];
                    p.bias1()[(l * 2 + kv) * 256 + f] = s; }
            }
        }
        __syncthreads();
    }
    const int gt = bid * 512 + tid, ngt = nb * 512;
    for (int it = gt; it < NT * 32; it += ngt) { const int t = it >> 5, i = it & 31; const float inv = (float)pow(10000.0, -(double)i / 32.0); const float ang = (float)p.pos[t] * inv;
        float sn, cs; sincosf(ang, &sn, &cs); *(f32x2*)(p.rope() + (size_t)it * 2) = (f32x2){cs, sn}; }
    for (int it = gt; it < NL * 8 * 128 * 128; it += ngt) { const int s = it & 127, t = (it >> 7) & 127; p.wsc()[it] = (bf16_t)f2bf(s <= t ? p.gm_ws[it] : 0.f); }
    LAS float* scr = (LAS float*)lds + wave * (128 * 33);
    const int gw = bid * 8 + wave, ngw = nb * 8;
    constexpr int I_IN = (ZPAD / 32) * 8, I_P = 32 * 4, I_O = 32 * 8, I_R = 8 * 8, I_SG = 16 * 8, I_DS = 32 * 2, I_W1 = 8 * 16, I_SMALL = I_IN + 2 * I_P + I_O + I_R + I_SG + I_DS + 2 * I_W1;
    for (int it = gw; it < NL * I_SMALL; it += ngw) {
        const int l = it / I_SMALL; int r = it % I_SMALL;
        if (r < I_IN) { const int nd0 = (r >> 3) * 32, k0 = (r & 7) * 128; int nv; const int sc = win_srccol(nd0, nv); tr_item(p.w_in + (size_t)l * ND * INC, INC, sc, nv, p.Wt_in() + (size_t)l * ZPAD * ND, ND, nd0, k0, scr, lane); continue; } r -= I_IN;
        if (r < I_P) { const int nd0 = (r >> 2) * 32, k0 = (r & 3) * 128; tr_item(p.wpn + (size_t)l * 512 * ND, ND, nd0, 32, (bf16_t*)((unsigned char*)p.Wt_pn() + (size_t)l * ND * ND), ND, nd0, k0, scr, lane, 1); continue; } r -= I_P;
        if (r < I_P) { const int nd0 = (r >> 2) * 32, k0 = (r & 3) * 128; tr_item(p.wpg + (size_t)l * 512 * ND, ND, nd0, 32, (bf16_t*)((unsigned char*)p.Wt_pn() + (size_t)l * ND * ND + 512), ND, nd0, k0, scr, lane, 1); continue; } r -= I_P;
        if (r < I_O) { const int nd0 = (r >> 3) * 32, k0 = (r & 7) * 128; tr_item(p.w_out + (size_t)l * ND * ND, ND, nd0, 32, (bf16_t*)((unsigned char*)p.Wt_out() + (size_t)l * ND * ND), ND, nd0, k0, scr, lane, 1); continue; } r -= I_O;
        if (r < I_R) { const int nd0 = (r >> 3) * 32, k0 = (r & 7) * 128; tr_item(p.w_router + (size_t)l * ND * NE, NE, nd0, 32, p.Wt_rs() + (size_t)l * 768 * ND, ND, nd0, k0, scr, lane); continue; } r -= I_R;
        if (r < I_SG) { const int nd0 = (r >> 3) * 32, k0 = (r & 7) * 128; const int tile = nd0 >> 8, q = nd0 & 255;
            tr_item((q < 128 ? p.wgs : p.wus) + (size_t)l * ND * 256, 256, tile * 128 + (q & 127), 32, (bf16_t*)((unsigned char*)(p.Wt_rs() + (size_t)l * 768 * ND + (size_t)256 * ND)), ND, nd0, k0, scr, lane, 1); continue; } r -= I_SG;
        if (r < I_DS) { const int nd0 = (r >> 1) * 32, k0 = (r & 1) * 128; tr_item(p.wds + (size_t)l * 256 * ND, ND, nd0, 32, p.Wt_ds() + (size_t)l * ND * 256, 256, nd0, k0, scr, lane); continue; } r -= I_DS;
        { const int kv = r / I_W1; r %= I_W1; const int nd0 = (r >> 4) * 32, k0 = (r & 15) * 128;
          tr_item((kv ? p.w1v : p.w1k) + (size_t)l * 2048 * 256, 256, nd0, 32, p.Wt_w1() + ((size_t)l * 2 + kv) * 256 * 2048, 2048, nd0, k0, scr, lane); }
    }
    constexpr int I_E = 128 + 64;
    const int nle = (p.conv_l_hi - p.conv_l_lo) * NE;
    auto expert_item = [&](long it) {
        const int le = (int)(it / I_E), l = p.conv_l_lo + le / NE, e = le % NE; int r = (int)(it % I_E); TrItem ti;
        if (r < 128) { const int nd0 = (r >> 3) * 32, k0 = (r & 7) * 128; const int tile = nd0 >> 8, q = nd0 & 255;
            ti = TrItem{(q < 128 ? p.wge : p.wue) + ((size_t)l * NE + e) * ND * 256, (bf16_t*)((unsigned char*)p.Wt_eg() + ((size_t)l * NE + e) * 512 * ND), 256, tile * 128 + (q & 127), 32, ND, nd0, k0, 1}; }
        else { r -= 128; const int nd0 = (r >> 1) * 32, k0 = (r & 1) * 128; ti = TrItem{p.wde + ((size_t)l * NE + e) * 256 * ND, (bf16_t*)((unsigned char*)p.Wt_ed() + ((size_t)l * NE + e) * ND * 256), ND, nd0, 32, 256, nd0, k0, 1}; }
        return ti;
    };
    const long nit = (long)nle * I_E;
    if (gw < nit) {
        f32x4 va[16], vb[16];
        TrItem ia = expert_item(gw), ib = ia; tr_load(ia, va, lane);
        for (long it = gw; it < nit; it += 2 * ngw) {
            const bool hb = it + ngw < nit, ha = it + 2 * ngw < nit;
            if (hb) { ib = expert_item(it + ngw); tr_load(ib, vb, lane); }
            tr_store(ia, va, scr, lane);
            if (ha) { ia = expert_item(it + 2 * ngw); tr_load(ia, va, lane); }
            if (hb) tr_store(ib, vb, scr, lane);
        }
    }
}

__device__ __forceinline__ void ph_norm(const OP& p, const float* xin, int l, int sh_off, int sc_off, int bid, int nb) {
    const int lane = tid_() & 63, w = tid_() >> 6;
    for (int t = bid * 8 + w; t < NT; t += nb * 8) {
        const float* xr = xin + (size_t)t * ND;
        f32x4 v[4]; float ss = 0.f;
#pragma unroll
        for (int i = 0; i < 4; ++i) { v[i] = *(const f32x4*)(xr + i * 256 + lane * 4); ss += v[i].x * v[i].x + v[i].y * v[i].y + v[i].z * v[i].z + v[i].w * v[i].w; }
#pragma unroll
        for (int o = 32; o >= 1; o >>= 1) ss += __shfl_xor(ss, o);
        const float rstd = rsqrtf(ss * (1.0f / ND) + 1e-6f);
        const float* mb = p.mod() + ((size_t)l * NB + (t >> 12)) * 6144;
#pragma unroll
        for (int i = 0; i < 4; ++i) {
            const int cidx = i * 256 + lane * 4;
            const f32x4 sc = *(const f32x4*)(mb + sc_off + cidx), sh = *(const f32x4*)(mb + sh_off + cidx);
            u32x2 o; o.x = pk2(v[i].x * rstd * (1.f + sc.x) + sh.x, v[i].y * rstd * (1.f + sc.y) + sh.y); o.y = pk2(v[i].z * rstd * (1.f + sc.z) + sh.z, v[i].w * rstd * (1.f + sc.w) + sh.w);
            *(u32x2*)(p.h() + (size_t)t * ND + cidx) = o;
        }
    }
}

__device__ __forceinline__ void ph_norm_b(const OP& p, const bf16_t* xin, int l, int sh_off, int sc_off, int bid, int nb, unsigned char* h8) {
    const int lane = tid_() & 63, w = tid_() >> 6;
    for (int t = bid * 8 + w; t < NT; t += nb * 8) {
        float v[2][8]; float ss = 0.f;
#pragma unroll
        for (int i = 0; i < 2; ++i) { const u32x4 r = *(const u32x4*)(xin + (size_t)t * ND + i * 512 + lane * 8); const unsigned rw[4] = {r.x, r.y, r.z, r.w};
#pragma unroll
            for (int k = 0; k < 4; ++k) { v[i][2 * k] = __uint_as_float(rw[k] << 16); v[i][2 * k + 1] = __uint_as_float(rw[k] & 0xffff0000u); ss += v[i][2 * k] * v[i][2 * k] + v[i][2 * k + 1] * v[i][2 * k + 1]; } }
#pragma unroll
        for (int o = 32; o >= 1; o >>= 1) ss += __shfl_xor(ss, o);
        const float rstd = rsqrtf(ss * (1.0f / ND) + 1e-6f);
        const float* mb = p.mod() + ((size_t)l * NB + (t >> 12)) * 6144;
#pragma unroll
        for (int i = 0; i < 2; ++i) {
            const int cidx = i * 512 + lane * 8;
            const f32x4 sc0 = *(const f32x4*)(mb + sc_off + cidx), sc1 = *(const f32x4*)(mb + sc_off + cidx + 4), sh0 = *(const f32x4*)(mb + sh_off + cidx), sh1 = *(const f32x4*)(mb + sh_off + cidx + 4);
            u32x4 o; o.x = pk2(v[i][0] * rstd * (1.f + sc0.x) + sh0.x, v[i][1] * rstd * (1.f + sc0.y) + sh0.y); o.y = pk2(v[i][2] * rstd * (1.f + sc0.z) + sh0.z, v[i][3] * rstd * (1.f + sc0.w) + sh0.w);
            o.z = pk2(v[i][4] * rstd * (1.f + sc1.x) + sh1.x, v[i][5] * rstd * (1.f + sc1.y) + sh1.y); o.w = pk2(v[i][6] * rstd * (1.f + sc1.z) + sh1.z, v[i][7] * rstd * (1.f + sc1.w) + sh1.w);
            *(u32x4*)(p.h() + (size_t)t * ND + cidx) = o;
            if (h8) {
                const u32x2 w8 = {pk4_e4m3((v[i][0] * rstd * (1.f + sc0.x) + sh0.x) * H8_SCALE, (v[i][1] * rstd * (1.f + sc0.y) + sh0.y) * H8_SCALE, (v[i][2] * rstd * (1.f + sc0.z) + sh0.z) * H8_SCALE, (v[i][3] * rstd * (1.f + sc0.w) + sh0.w) * H8_SCALE),
                                  pk4_e4m3((v[i][4] * rstd * (1.f + sc1.x) + sh1.x) * H8_SCALE, (v[i][5] * rstd * (1.f + sc1.y) + sh1.y) * H8_SCALE, (v[i][6] * rstd * (1.f + sc1.z) + sh1.z) * H8_SCALE, (v[i][7] * rstd * (1.f + sc1.w) + sh1.w) * H8_SCALE)};
                *(u32x2*)(h8 + (size_t)t * ND + cidx) = w8; }
        }
    }
}

#define LDS_GAIN (LDS_MISC + 256)
struct EpiZ {
    static constexpr bool PERM = true;
    const OP* pp; LAS unsigned char* lds;
    __device__ __forceinline__ void operator()(const f32x4 (&acc)[2][2][4][2], const pg8::Unit& u, int wr, int wc, int fr, int fq) const {
        const OP& p = *pp; const int pn = u.pn;
        const int row0 = u.pm * 256 + wr * 64 + fr;
        if (pn < 5) {
            const bool normed = (pn < 2) || (pn >= 3 && wc < 2);
            bf16_t* dst; int ldd, cbase;
            if (pn < 2) { dst = p.qn(); ldd = 512; cbase = (4 * pn + wc) * 64; }
            else if (pn == 2) { dst = p.kvraw(); ldd = 256; cbase = wc * 64; }
            else if (pn == 3) { dst = p.ksv(); ldd = 256; cbase = wc * 64; }
            else { dst = p.kwv(); ldd = 256; cbase = wc * 64; }
            const LAS float* gain = (const LAS float*)(lds + LDS_GAIN) + (pn < 2 ? 0 : 64);
            const float osc = (pn < 2) ? 0.125f * 1.4426950408889634f : 1.0f;
            f32x4 g0[2], g1[2];
#pragma unroll
            for (int n = 0; n < 2; ++n) { g0[n] = *(const LAS f32x4*)(gain + 8 * fq + 4 * n); g1[n] = *(const LAS f32x4*)(gain + 32 + 8 * fq + 4 * n); }
#pragma unroll
            for (int ai = 0; ai < 2; ++ai)
#pragma unroll
                for (int m = 0; m < 4; ++m) {
                    const int row = row0 + ai * 128 + m * 16;
                    f32x4 y0[2], y1[2];
#pragma unroll
                    for (int n = 0; n < 2; ++n) { y0[n] = acc[ai][0][m][n]; y1[n] = acc[ai][1][m][n]; }
                    float ss = 0.f;
#pragma unroll
                    for (int n = 0; n < 2; ++n) { ss += y0[n].x * y0[n].x + y0[n].y * y0[n].y + y0[n].z * y0[n].z + y0[n].w * y0[n].w; ss += y1[n].x * y1[n].x + y1[n].y * y1[n].y + y1[n].z * y1[n].z + y1[n].w * y1[n].w; }
                    ss += __shfl_xor(ss, 16); ss += __shfl_xor(ss, 32);
                    const float rs = rsqrtf(ss * (1.0f / 64.f) + 1e-6f) * osc;
#pragma unroll
                    for (int n = 0; n < 2; ++n) { y0[n] = normed ? y0[n] * rs * g0[n] : y0[n]; y1[n] = normed ? y1[n] * rs * g1[n] : y1[n]; }
                    u32x4 w0, w1; w0.x = pk2(y0[0].x, y0[0].y); w0.y = pk2(y0[0].z, y0[0].w); w0.z = pk2(y0[1].x, y0[1].y); w0.w = pk2(y0[1].z, y0[1].w);
                    w1.x = pk2(y1[0].x, y1[0].y); w1.y = pk2(y1[0].z, y1[0].w); w1.z = pk2(y1[1].x, y1[1].y); w1.w = pk2(y1[1].z, y1[1].w);
                    *(u32x4*)(dst + (size_t)row * ldd + cbase + 8 * fq) = w0; *(u32x4*)(dst + (size_t)row * ldd + cbase + 32 + 8 * fq) = w1;
                }
        } else if (pn >= 9 && pn < 17) {
            const int col0 = (pn - 9) * 128 + wc * 32 + 8 * fq;
            bf16_t* da = p.sga(); bf16_t* db = p.sgb();
#pragma unroll
            for (int ai = 0; ai < 2; ++ai)
#pragma unroll
                for (int m = 0; m < 4; ++m) {
                    const size_t ro = (size_t)(row0 + ai * 128 + m * 16) * 1024 + col0;
                    float ra[8], sb[8];
#pragma unroll
                    for (int n = 0; n < 2; ++n) { const f32x4 ga = acc[ai][0][m][n], gb = acc[ai][1][m][n];
                        const float gav[4] = {ga.x, ga.y, ga.z, ga.w}, gbv[4] = {gb.x, gb.y, gb.z, gb.w};
#pragma unroll
                        for (int k = 0; k < 4; ++k) { const float ea = __expf(-gav[k]), eb = fminf(__expf(-gbv[k]), 1e20f); const float dbv = 1.0f + eb;
                            ra[4 * n + k] = dbv * __builtin_amdgcn_rcpf(1.0f + ea); sb[4 * n + k] = __builtin_amdgcn_rcpf(dbv); } }
                    u32x4 wa, wb; wa.x = pk2(ra[0], ra[1]); wa.y = pk2(ra[2], ra[3]); wa.z = pk2(ra[4], ra[5]); wa.w = pk2(ra[6], ra[7]);
                    wb.x = pk2(sb[0], sb[1]); wb.y = pk2(sb[2], sb[3]); wb.z = pk2(sb[4], sb[5]); wb.w = pk2(sb[6], sb[7]);
                    *(u32x4*)(da + ro) = wa; *(u32x4*)(db + ro) = wb;
                }
        } else if (pn < 17) {
            bf16_t* dst; int ldd, ct; const bool is_gelu = pn < 9;
            if (pn < 7) { dst = p.u(); ldd = 512; ct = (pn - 5) * 256; } else { dst = p.v(); ldd = 512; ct = (pn - 7) * 256; }
            const int col0 = ct + wc * 32 + 8 * fq;
#pragma unroll
            for (int ai = 0; ai < 2; ++ai)
#pragma unroll
                for (int m = 0; m < 4; ++m) {
                    bf16_t* rowp = dst + (size_t)(row0 + ai * 128 + m * 16) * ldd + col0;
#pragma unroll
                    for (int bj = 0; bj < 2; ++bj) {
                        f32x4 v0 = acc[ai][bj][m][0], v1 = acc[ai][bj][m][1];
                        f32x4 a0, a1, m0, m1;
                        if (is_gelu) { a0 = 1.5957691216057308f * (v0 + 0.044715f * v0 * v0 * v0); a1 = 1.5957691216057308f * (v1 + 0.044715f * v1 * v1 * v1); m0 = v0; m1 = v1; }
                        else { a0 = v0; a1 = v1; m0 = (f32x4){1.f, 1.f, 1.f, 1.f}; m1 = m0; }
                        v0 = (f32x4){m0.x * fsigmoid(a0.x), m0.y * fsigmoid(a0.y), m0.z * fsigmoid(a0.z), m0.w * fsigmoid(a0.w)};
                        v1 = (f32x4){m1.x * fsigmoid(a1.x), m1.y * fsigmoid(a1.y), m1.z * fsigmoid(a1.z), m1.w * fsigmoid(a1.w)};
                        u32x4 w; w.x = pk2(v0.x, v0.y); w.y = pk2(v0.z, v0.w); w.z = pk2(v1.x, v1.y); w.w = pk2(v1.z, v1.w);
                        *(u32x4*)(rowp + bj * 128) = w;
                    }
                }
        } else {
            if (wc == 0) {
#pragma unroll
                for (int ai = 0; ai < 2; ++ai)
#pragma unroll
                    for (int m = 0; m < 4; ++m) {
                        float* rowp = p.gates() + (size_t)(row0 + ai * 128 + m * 16) * 32 + 8 * fq;
                        const f32x4 v0 = acc[ai][0][m][0], v1 = acc[ai][0][m][1];
                        *(f32x4*)(rowp) = (f32x4){fsigmoid(v0.x), fsigmoid(v0.y), fsigmoid(v0.z), fsigmoid(v0.w)};
                        *(f32x4*)(rowp + 4) = (f32x4){fsigmoid(v1.x), fsigmoid(v1.y), fsigmoid(v1.z), fsigmoid(v1.w)};
                    }
            }
        }
    }
};

struct RopeIt { const bf16_t* src; bf16_t* dst; const float* rp; int j; };
__device__ __forceinline__ void rope_addr(const OP& p, long it, RopeIt& r) {
    const int j = (int)(it & 3); const long hvi = it >> 2; const int t = (int)(hvi / 12), hv = (int)(hvi % 12);
    if (hv < 8) { r.src = p.qn() + (size_t)t * 512 + hv * 64; r.dst = p.qr() + (size_t)t * 512 + hv * 64; }
    else if (hv < 10) { r.src = p.ksv() + (size_t)t * 256 + (hv - 8) * 64; r.dst = (bf16_t*)r.src; }
    else { r.src = p.kwv() + (size_t)t * 256 + (hv - 10) * 64; r.dst = (bf16_t*)r.src; }
    r.rp = p.rope() + ((size_t)t * 32 + 8 * j) * 2; r.j = j;
}
__device__ __forceinline__ void rope_apply(const RopeIt& r, const u32x4 a, const u32x4 b, const f32x4 c0, const f32x4 c1, const f32x4 c2, const f32x4 c3) {
    const float cs[8] = {c0.x, c0.z, c1.x, c1.z, c2.x, c2.z, c3.x, c3.z}, sn[8] = {c0.y, c0.w, c1.y, c1.w, c2.y, c2.w, c3.y, c3.w};
    const unsigned aw[4] = {a.x, a.y, a.z, a.w}, bw[4] = {b.x, b.y, b.z, b.w};
    unsigned oa[4], ob[4];
#pragma unroll
    for (int k = 0; k < 4; ++k) {
        const float x1l = __uint_as_float(aw[k] << 16), x1h = __uint_as_float(aw[k] & 0xffff0000u), x2l = __uint_as_float(bw[k] << 16), x2h = __uint_as_float(bw[k] & 0xffff0000u);
        oa[k] = pk2(x1l * cs[2 * k] - x2l * sn[2 * k], x1h * cs[2 * k + 1] - x2h * sn[2 * k + 1]);
        ob[k] = pk2(x2l * cs[2 * k] + x1l * sn[2 * k], x2h * cs[2 * k + 1] + x1h * sn[2 * k + 1]);
    }
    *(u32x4*)(r.dst + 8 * r.j) = (u32x4){oa[0], oa[1], oa[2], oa[3]}; *(u32x4*)(r.dst + 32 + 8 * r.j) = (u32x4){ob[0], ob[1], ob[2], ob[3]};
}
__device__ __forceinline__ void ph_rope(const OP& p, int bid, int nb) {
    const long nitems = (long)NT * 12 * 4, stride = (long)nb * 512;
    long it = (long)bid * 512 + tid_();
    for (; it + 3 * stride < nitems; it += 4 * stride) {
        RopeIt r[4]; u32x4 a[4], b[4]; f32x4 c[4][4];
#pragma unroll
        for (int u = 0; u < 4; ++u) { rope_addr(p, it + u * stride, r[u]); a[u] = *(const u32x4*)(r[u].src + 8 * r[u].j); b[u] = *(const u32x4*)(r[u].src + 32 + 8 * r[u].j);
#pragma unroll
            for (int k = 0; k < 4; ++k) c[u][k] = *(const f32x4*)(r[u].rp + 4 * k); }
#pragma unroll
        for (int u = 0; u < 4; ++u) rope_apply(r[u], a[u], b[u], c[u][0], c[u][1], c[u][2], c[u][3]);
    }
    for (; it < nitems; it += stride) {
        RopeIt r; rope_addr(p, it, r);
        const u32x4 a = *(const u32x4*)(r.src + 8 * r.j), b = *(const u32x4*)(r.src + 32 + 8 * r.j);
        const f32x4 c0 = *(const f32x4*)(r.rp), c1 = *(const f32x4*)(r.rp + 4), c2 = *(const f32x4*)(r.rp + 8), c3 = *(const f32x4*)(r.rp + 12);
        rope_apply(r, a, b, c0, c1, c2, c3);
    }
}
struct CmpSched {
    const char* kvraw; const char* w1; int K, kstepA, ldb; int G, c;
    __device__ __forceinline__ bool next(int i, pg8::Unit& u) const { const int L = i * G + c; if (L >= 128) return false; u.e = L; u.pm = L & 15; u.pn = 0; return true; }
    __device__ __forceinline__ const char* a_base() const { return kvraw; }
    __device__ __forceinline__ const char* b_base() const { return w1; }
    __device__ __forceinline__ const char* a_ptr(const pg8::Unit& u) const { return kvraw; }
    __device__ __forceinline__ void a_off(const pg8::Unit& u, int tid, unsigned (&off)[2][2]) const {
        const int kv = u.e >> 6, s = (u.e >> 4) & 3;
#pragma unroll
        for (int i = 0; i < 2; ++i) { int R, C; pg8::stage_rc(tid * 16 + i * 8192, R, C);
#pragma unroll
            for (int h = 0; h < 2; ++h) { int r = u.pm * 256 + h * 128 + R; r = r < 4080 ? r : 4079; const int b = r / 510, rem = r - b * 510, n = rem >> 1, hh = rem & 1;
                off[h][i] = (unsigned)(((b * NS + 16 * n + 8 * s) * 256 + kv * 128 + hh * 64 + C) * 2); } }
    }
    __device__ __forceinline__ const char* b_ptr(const pg8::Unit& u) const { const int kv = u.e >> 6, s = (u.e >> 4) & 3; return w1 + ((size_t)kv * 256 * 2048 + s * 512) * 2; }
};
struct EpiCmp {
    static constexpr bool PERM = false;
    float* cpart;
    __device__ __forceinline__ void operator()(const f32x4 (&acc)[2][2][4][2], const pg8::Unit& u, int wr, int wc, int fr, int fq) const {
        float* base = cpart + (size_t)(u.e >> 4) * 4096 * 256;
        const int row0 = u.pm * 256 + wr * 64 + fr, col0 = wc * 32 + 4 * fq;
#pragma unroll
        for (int ai = 0; ai < 2; ++ai)
#pragma unroll
            for (int m = 0; m < 4; ++m) { float* rowp = base + (size_t)(row0 + ai * 128 + m * 16) * 256 + col0;
#pragma unroll
                for (int bj = 0; bj < 2; ++bj)
#pragma unroll
                    for (int n = 0; n < 2; ++n) *(f32x4*)(rowp + bj * 128 + n * 16) = acc[ai][bj][m][n]; }
    }
};
__device__ __forceinline__ void ph_cmp2(const OP& p, int l, LAS unsigned char* lds, int bid, int nb) {
    const int tid = tid_(), lane = tid & 63, wave = tid >> 6;
    LAS float* w2s = (LAS float*)lds;
    LAS float* hid = w2s + 256 * 64 + wave * 256;
    int kv_loaded = -1;
    for (int it0 = bid * 8; it0 < 2 * 4096; it0 += nb * 8) {
        const int it = it0 + wave, kv = it0 >> 12, r = it & 4095;
        if (kv != kv_loaded) { __syncthreads(); const float* w2 = (kv ? p.w2v : p.w2k) + (size_t)l * 256 * 64;
            for (int i = tid; i < 256 * 64 / 4; i += 512) *(LAS f32x4*)(w2s + i * 4) = *(const f32x4*)(w2 + i * 4);
            kv_loaded = kv; __syncthreads(); }
        bf16_t* dstbase = kv ? p.vc() : p.kc();
        if (r >= 4080) { if (r < 4088) { const int b = r - 4080; dstbase[((size_t)b * 256 + 255) * 128 + lane] = 0; dstbase[((size_t)b * 256 + 255) * 128 + 64 + lane] = 0; } continue; }
        const float* cp = p.cpart() + ((size_t)kv * 4 * 4096 + r) * 256 + lane * 4;
        f32x4 a = *(const f32x4*)(p.bias1() + (l * 2 + kv) * 256 + lane * 4);
        { f32x4 pv[4];
#pragma unroll
          for (int s = 0; s < 4; ++s) pv[s] = *(const f32x4*)(cp + (size_t)s * 4096 * 256);
#pragma unroll
          for (int s = 0; s < 4; ++s) a += pv[s]; }
        asm volatile("s_waitcnt lgkmcnt(0)" ::: "memory");
        *(LAS f32x4*)(hid + lane * 4) = (f32x4){fgelu(a.x), fgelu(a.y), fgelu(a.z), fgelu(a.w)};
        asm volatile("s_waitcnt lgkmcnt(0)" ::: "memory");
        float o = 0.f;
#pragma unroll 16
        for (int f = 0; f < 256; ++f) o = fmaf(hid[f], w2s[f * 64 + lane], o);
        const int b = r / 510, rem = r - b * 510, n = rem >> 1, hh = rem & 1;
        if (!kv) { float ss = o * o;
#pragma unroll
            for (int x = 32; x >= 1; x >>= 1) ss += __shfl_xor(ss, x);
            o = o * rsqrtf(ss * (1.f / 64.f) + 1e-6f) * p.k_gain[l * 64 + lane]; }
        dstbase[((size_t)b * 256 + n) * 128 + hh * 64 + lane] = (bf16_t)f2bf(o);
    }
    __syncthreads();
}

#define GM_PITCH 520
typedef short v4i16_t __attribute__((ext_vector_type(4)));
__device__ __forceinline__ s16x4 ds_tr16(const LAS bf16_t* ptr) { return __builtin_bit_cast(s16x4, __builtin_amdgcn_ds_read_tr16_b64_v4i16((LAS v4i16_t*)ptr)); }
__device__ __forceinline__ void ph_gmlp(const OP& p, int l, LAS unsigned char* lds, int bid, int nb) {
    const int tid = tid_(), lane = tid & 63, wave = tid >> 6;
    LAS bf16_t* vn = (LAS bf16_t*)lds;
    for (int ch = bid; ch < NT / 128; ch += nb) {
        const size_t base = (size_t)ch * 128;
        __syncthreads();
        f32x4 g0 = *(const f32x4*)(p.ln_g + l * 512 + lane * 8), g1 = *(const f32x4*)(p.ln_g + l * 512 + lane * 8 + 4), b0 = *(const f32x4*)(p.ln_b + l * 512 + lane * 8), b1 = *(const f32x4*)(p.ln_b + l * 512 + lane * 8 + 4);
#pragma unroll 4
        for (int tt = 0; tt < 16; ++tt) {
            const int t = wave * 16 + tt;
            const u32x4 raw = *(const u32x4*)(p.v() + (base + t) * 512 + lane * 8);
            float x[8] = {__uint_as_float(raw.x << 16), __uint_as_float(raw.x & 0xffff0000u), __uint_as_float(raw.y << 16), __uint_as_float(raw.y & 0xffff0000u),
                          __uint_as_float(raw.z << 16), __uint_as_float(raw.z & 0xffff0000u), __uint_as_float(raw.w << 16), __uint_as_float(raw.w & 0xffff0000u)};
            float s = 0.f;
#pragma unroll
            for (int i = 0; i < 8; ++i) s += x[i];
#pragma unroll
            for (int o = 32; o >= 1; o >>= 1) s += __shfl_xor(s, o);
            const float mu = s * (1.f / 512.f); float q = 0.f;
#pragma unroll
            for (int i = 0; i < 8; ++i) { x[i] -= mu; q += x[i] * x[i]; }
#pragma unroll
            for (int o = 32; o >= 1; o >>= 1) q += __shfl_xor(q, o);
            const float rstd = rsqrtf(q * (1.f / 512.f) + 1e-6f);
            u32x4 w; w.x = pk2(x[0] * rstd * g0.x + b0.x, x[1] * rstd * g0.y + b0.y); w.y = pk2(x[2] * rstd * g0.z + b0.z, x[3] * rstd * g0.w + b0.w);
            w.z = pk2(x[4] * rstd * g1.x + b1.x, x[5] * rstd * g1.y + b1.y); w.w = pk2(x[6] * rstd * g1.z + b1.z, x[7] * rstd * g1.w + b1.w);
            *(LAS u32x4*)(vn + t * GM_PITCH + lane * 8) = w;
        }
        __syncthreads();
        const int g = wave, r32 = lane & 31, hi = lane >> 5;
        const bf16_t* wsg = p.wsc() + ((size_t)l * 8 + g) * 128 * 128;
        const LAS bf16_t* bbase = vn + (8 * hi + ((lane & 15) >> 2)) * GM_PITCH + g * 64 + 16 * ((lane >> 4) & 1) + 4 * (lane & 3);
        const float* bsg = p.gm_bs + (l * 8 + g) * 128;
#pragma unroll
        for (int mt = 3; mt >= 0; --mt) {
            bf16x8 af[8];
#pragma unroll
            for (int ks = 0; ks < 2 * (mt + 1); ++ks) af[ks] = *(const bf16x8*)(wsg + (size_t)(32 * mt + r32) * 128 + 16 * ks + 8 * hi);
            float bsv[16];
#pragma unroll
            for (int rg = 0; rg < 16; ++rg) bsv[rg] = bsg[32 * mt + (rg & 3) + 8 * (rg >> 2) + 4 * hi];
            f32x16 acc0, acc1;
#pragma unroll
            for (int i = 0; i < 16; ++i) { acc0[i] = 0.f; acc1[i] = 0.f; }
#pragma unroll
            for (int ks = 0; ks < 2 * (mt + 1); ++ks) {
                const LAS bf16_t* bp = bbase + 16 * ks * GM_PITCH;
                const s16x4 b00 = ds_tr16(bp), b01 = ds_tr16(bp + 4 * GM_PITCH), b10 = ds_tr16(bp + 32), b11 = ds_tr16(bp + 4 * GM_PITCH + 32);
                const bf16x8 bf0 = {b00[0], b00[1], b00[2], b00[3], b01[0], b01[1], b01[2], b01[3]}, bf1 = {b10[0], b10[1], b10[2], b10[3], b11[0], b11[1], b11[2], b11[3]};
                acc0 = __builtin_amdgcn_mfma_f32_32x32x16_bf16(af[ks], bf0, acc0, 0, 0, 0);
                acc1 = __builtin_amdgcn_mfma_f32_32x32x16_bf16(af[ks], bf1, acc1, 0, 0, 0);
            }
#pragma unroll
            for (int rg = 0; rg < 16; ++rg) {
                const int t = 32 * mt + (rg & 3) + 8 * (rg >> 2) + 4 * hi;
                vn[t * GM_PITCH + g * 64 + r32] = (bf16_t)f2bf(acc0[rg] + bsv[rg]); vn[t * GM_PITCH + g * 64 + 32 + r32] = (bf16_t)f2bf(acc1[rg] + bsv[rg]);
            }
        }
        asm volatile("s_waitcnt lgkmcnt(0)" ::: "memory");
        for (int i0 = 0; i0 < 16; i0 += 4) {
            u32x4 uv4[4];
#pragma unroll
            for (int ii = 0; ii < 4; ++ii) { const int t = 8 * (i0 + ii) + (lane >> 3), c8 = (lane & 7) * 8; uv4[ii] = *(const u32x4*)(p.u() + (base + t) * 512 + g * 64 + c8); }
#pragma unroll
            for (int ii = 0; ii < 4; ++ii) {
                const int t = 8 * (i0 + ii) + (lane >> 3), c8 = (lane & 7) * 8;
                const u32x4 mv = *(const LAS u32x4*)(vn + t * GM_PITCH + g * 64 + c8);
                const u32x4 uv = uv4[ii];
                const unsigned mw[4] = {mv.x, mv.y, mv.z, mv.w}, uw[4] = {uv.x, uv.y, uv.z, uv.w}; unsigned ow[4];
                float of[8];
#pragma unroll
                for (int k = 0; k < 4; ++k) { of[2 * k] = __uint_as_float(mw[k] << 16) * __uint_as_float(uw[k] << 16) * H8_SCALE; of[2 * k + 1] = __uint_as_float(mw[k] & 0xffff0000u) * __uint_as_float(uw[k] & 0xffff0000u) * H8_SCALE; }
                (void)ow;
                *(u32x2*)((unsigned char*)p.onsa() + (base + t) * 1024 + 512 + g * 64 + c8) = (u32x2){pk4_e4m3(of[0], of[1], of[2], of[3]), pk4_e4m3(of[4], of[5], of[6], of[7])};
            }
        }
    }
    __syncthreads();
}
#define AT_PITCH 144
#define AT_TILE (64 * AT_PITCH)
#define AT_IMP (4 * AT_TILE)
#define AT_SELM (AT_IMP + 64 * 65 * 4)
#define AT_OST (AT_SELM + 1024)
#define AT_OPITCH 272
#define AT_LOG2E 1.4426950408889634f
#define LDS_ADD(ptr, val) (void)__hip_atomic_fetch_add((ptr), (val), __ATOMIC_RELAXED, __HIP_MEMORY_SCOPE_WORKGROUP)
__device__ __forceinline__ float xhalf_max(float v) { const auto r = __builtin_amdgcn_permlane32_swap(__float_as_uint(v), __float_as_uint(v), false, false); return fmaxf(__uint_as_float(r[0]), __uint_as_float(r[1])); }
__device__ __forceinline__ float xhalf_sum(float v) { const auto r = __builtin_amdgcn_permlane32_swap(__float_as_uint(v), __float_as_uint(v), false, false); return __uint_as_float(r[0]) + __uint_as_float(r[1]); }
__device__ __forceinline__ float max3f(float a, float b, float c) { float r; asm("v_max3_f32 %0, %1, %2, %3" : "=v"(r) : "v"(a), "v"(b), "v"(c)); return r; }
enum { AM_CMP1 = 0, AM_CMP2 = 1, AM_SEL = 2, AM_WIN = 3 };

struct AttnWave {
    f32x16 o0, o1;
    f32x16 ls;
    float M, L;
};

template <int MODE, bool FIXM>
__device__ __forceinline__ void attn_tile(AttnWave& W, const bf16x8 (&qt)[4], const LAS unsigned char* Kl, const LAS unsigned char* Vl, int lane, int r32, int hi,
                                          int lim, bool diag, bool ledge, bool lanesel, float invl, LAS unsigned* imp_row, int jbase) {
    f32x16 s0, s1;
    const float sinit = 0.f;
    const unsigned lmask = (FIXM && MODE == AM_SEL && !lanesel) ? 0u : 0xffffffffu;
#pragma unroll
    for (int i = 0; i < 16; ++i) { s0[i] = sinit; s1[i] = sinit; }
    bf16x8 ka[2][4];
#pragma unroll
    for (int ks = 0; ks < 4; ++ks) { ka[0][ks] = *(const LAS bf16x8*)(Kl + r32 * AT_PITCH + (16 * ks + 8 * hi) * 2); ka[1][ks] = *(const LAS bf16x8*)(Kl + (32 + r32) * AT_PITCH + (16 * ks + 8 * hi) * 2); }
    __builtin_amdgcn_s_setprio(1);
#pragma unroll
    for (int ks = 0; ks < 4; ++ks) { s0 = __builtin_amdgcn_mfma_f32_32x32x16_bf16(ka[0][ks], qt[ks], s0, 0, 0, 0); s1 = __builtin_amdgcn_mfma_f32_32x32x16_bf16(ka[1][ks], qt[ks], s1, 0, 0, 0); }
    __builtin_amdgcn_s_setprio(0);
    s16x4 va[2][2][2][2];
    if (MODE != AM_CMP1) {
        const LAS unsigned char* vb = Vl + ((lane & 15) >> 2) * AT_PITCH + (16 * ((lane >> 4) & 1) + 4 * (lane & 3)) * 2 + (4 * hi) * AT_PITCH;
#pragma unroll
        for (int mt = 0; mt < 2; ++mt)
#pragma unroll
            for (int s = 0; s < 2; ++s) { const LAS unsigned char* vk = vb + (32 * mt + 16 * s) * AT_PITCH;
                va[mt][s][0][0] = ds_tr16((const LAS bf16_t*)(vk)); va[mt][s][0][1] = ds_tr16((const LAS bf16_t*)(vk + 8 * AT_PITCH));
                va[mt][s][1][0] = ds_tr16((const LAS bf16_t*)(vk + 64)); va[mt][s][1][1] = ds_tr16((const LAS bf16_t*)(vk + 8 * AT_PITCH + 64)); }
    }
    const float NEG = -INFINITY;
    if (MODE == AM_CMP1 || MODE == AM_CMP2) {
#pragma unroll
        for (int r = 0; r < 16; ++r) { const int k0 = (r & 3) + 8 * (r >> 2) + 4 * hi; s0[r] = (k0 < lim) ? s0[r] : NEG; s1[r] = (32 + k0 < lim) ? s1[r] : NEG; }
    } else {
        if (diag) {
#pragma unroll
            for (int r = 0; r < 16; ++r) { const int k0 = (r & 3) + 8 * (r >> 2) + 4 * hi; s0[r] = (k0 <= lim) ? s0[r] : NEG; s1[r] = (32 + k0 <= lim) ? s1[r] : NEG; }
        }
        if (MODE == AM_WIN && ledge) {
#pragma unroll
            for (int r = 0; r < 16; ++r) { const int k0 = (r & 3) + 8 * (r >> 2) + 4 * hi; s0[r] = (k0 > lim) ? s0[r] : NEG; s1[r] = (32 + k0 > lim) ? s1[r] : NEG; }
        }
    }
    float Mn = W.M;
    if (MODE != AM_CMP2 && !FIXM) {
        float mx = max3f(s0[0], s1[0], s0[1]);
#pragma unroll
        for (int r = 1; r < 15; ++r) mx = max3f(mx, s1[r], s0[r + 1]);
        mx = max3f(mx, s1[15], s1[15]);
        mx = xhalf_max(mx);
        if (MODE == AM_SEL) mx = lanesel ? mx : NEG;
        Mn = fmaxf(W.M, mx);
    }
    const float Msub = (MODE == AM_SEL && !lanesel) ? INFINITY : Mn;
    float ps = 0.f;
    if (FIXM) {
        if (MODE == AM_SEL || MODE == AM_WIN) {
#pragma unroll
            for (int r = 0; r < 16; ++r) { s0[r] = __builtin_amdgcn_exp2f(s0[r]); s1[r] = __builtin_amdgcn_exp2f(s1[r]); }
        } else {
#pragma unroll
            for (int r = 0; r < 16; ++r) { s0[r] = __builtin_amdgcn_exp2f(s0[r]); s1[r] = __builtin_amdgcn_exp2f(s1[r]); ps += s0[r] + s1[r]; }
        }
    } else {
#pragma unroll
        for (int r = 0; r < 16; ++r) { s0[r] = __builtin_amdgcn_exp2f(s0[r] - Msub); s1[r] = __builtin_amdgcn_exp2f(s1[r] - Msub); ps += s0[r] + s1[r]; }
    }
    if (MODE == AM_CMP1) {
        ps = xhalf_sum(ps);
        if (FIXM) { W.L += ps; return; }
        const float alpha = __builtin_amdgcn_exp2f(W.M - Mn);
        W.L = W.L * alpha + ps; W.M = Mn;
        return;
    }
    if (MODE == AM_CMP2) {
#pragma unroll
        for (int r = 0; r < 16; ++r) { s0[r] *= invl; s1[r] *= invl; }
#pragma unroll
        for (int i = 0; i < 4; ++i) {
            const float q0 = (s0[4 * i] + s0[4 * i + 1]) + (s0[4 * i + 2] + s0[4 * i + 3]), q1 = (s1[4 * i] + s1[4 * i + 1]) + (s1[4 * i + 2] + s1[4 * i + 3]);
            const int j0 = jbase + 2 * i + hi, j1 = j0 + 8;
            LDS_ADD(imp_row + j0, (unsigned)(q0 * 268435456.f + 0.5f)); LDS_ADD(imp_row + j1, (unsigned)(q1 * 268435456.f + 0.5f));
            LDS_ADD(imp_row + j0 + 1, (unsigned)(s0[4 * i + 3] * 268435456.f + 0.5f)); if (j1 + 1 < 64) LDS_ADD(imp_row + j1 + 1, (unsigned)(s1[4 * i + 3] * 268435456.f + 0.5f));
        }
    } else {
        if (!(FIXM && (MODE == AM_SEL || MODE == AM_WIN))) ps = xhalf_sum(ps);
        if (!FIXM && __builtin_amdgcn_ballot_w64(Mn != W.M) != 0ull) {
            const float alpha = __builtin_amdgcn_exp2f(W.M - Mn);
            W.L *= alpha;
#pragma unroll
            for (int r = 0; r < 16; ++r) { W.o0[r] *= alpha; W.o1[r] *= alpha; }
            W.M = Mn;
        }
        W.L += ps;
    }
    __builtin_amdgcn_s_setprio(1);
#pragma unroll
    for (int mt = 0; mt < 2; ++mt)
#pragma unroll
        for (int s = 0; s < 2; ++s) {
            const f32x16& sv = mt ? s1 : s0;
            bf16x8 pb;
            { unsigned w0 = pk2(sv[8 * s + 0], sv[8 * s + 1]), w1 = pk2(sv[8 * s + 2], sv[8 * s + 3]), w2 = pk2(sv[8 * s + 4], sv[8 * s + 5]), w3 = pk2(sv[8 * s + 6], sv[8 * s + 7]);
              if (FIXM && MODE == AM_SEL) { w0 &= lmask; w1 &= lmask; w2 &= lmask; w3 &= lmask; }
              const u32x4 wv = {w0, w1, w2, w3}; pb = __builtin_bit_cast(bf16x8, wv); }
            const s16x4 a00 = va[mt][s][0][0], a01 = va[mt][s][0][1], a10 = va[mt][s][1][0], a11 = va[mt][s][1][1];
            const bf16x8 av0 = {a00[0], a00[1], a00[2], a00[3], a01[0], a01[1], a01[2], a01[3]}, av1 = {a10[0], a10[1], a10[2], a10[3], a11[0], a11[1], a11[2], a11[3]};
            W.o0 = __builtin_amdgcn_mfma_f32_32x32x16_bf16(av0, pb, W.o0, 0, 0, 0);
            W.o1 = __builtin_amdgcn_mfma_f32_32x32x16_bf16(av1, pb, W.o1, 0, 0, 0);
            if (FIXM && (MODE == AM_SEL || MODE == AM_WIN)) { const bf16x8 ones = {0x3f80, 0x3f80, 0x3f80, 0x3f80, 0x3f80, 0x3f80, 0x3f80, 0x3f80}; W.ls = __builtin_amdgcn_mfma_f32_32x32x16_bf16(ones, pb, W.ls, 0, 0, 0); }
        }
    __builtin_amdgcn_s_setprio(0);
}

__device__ __forceinline__ void at_store_tile(LAS unsigned char* lds, int buf, int tid, const u32x4& kr, const u32x4& vr) {
    const int key = tid >> 3, ch = tid & 7;
    *(LAS u32x4*)(lds + (2 * buf) * AT_TILE + key * AT_PITCH + ch * 16) = kr;
    *(LAS u32x4*)(lds + (2 * buf + 1) * AT_TILE + key * AT_PITCH + ch * 16) = vr;
}

#define ATT_TILE(MODE_, ...) do { if (fixm) attn_tile<MODE_, true>(__VA_ARGS__); else attn_tile<MODE_, false>(__VA_ARGS__); } while (0)
__device__ __forceinline__ void ph_attn(const OP& p, int l, LAS unsigned char* lds, int bid, int nb) {
    const int tid = tid_(), lane = tid & 63, wave = tid >> 6, r32 = lane & 31, hi = lane >> 5;
    const int g = wave >> 1, qh = wave & 1, qloc = 32 * qh + r32;
    LAS unsigned* imp = (LAS unsigned*)(lds + AT_IMP);
    LAS unsigned* selm = (LAS unsigned*)(lds + AT_SELM);
    LAS unsigned char* ost = lds + AT_OST + wave * (32 * AT_OPITCH);
    const int key_ld = tid >> 3, ch_ld = tid & 7;
    float gq = fabsf(p.q_gain[l * 64 + lane]), gk = fabsf(p.k_gain[l * 64 + lane]);
#pragma unroll
    for (int o = 32; o >= 1; o >>= 1) { gq = fmaxf(gq, __shfl_xor(gq, o)); gk = fmaxf(gk, __shfl_xor(gk, o)); }
    const float sbound = 8.0f * gq * gk * 1.001f + 0.01f;
    const bool fixm = sbound < 40.0f;
    const float Mfix = sbound * AT_LOG2E;
    for (int round = 0;; ++round) {
        const int idx = round * nb + ((round & 1) ? (nb - 1 - bid) : bid);
        if (idx >= 1024) break;
        const int qb = 63 - (idx >> 4), b = (idx & 15) >> 1, kvh = idx & 1, hq = kvh * 4 + g;
        const int t = qb * 64 + qloc; const size_t tok = (size_t)b * NS + t;
        __syncthreads();
        for (int i = tid; i < 64 * 65; i += 512) imp[i] = 0u;
        if (tid < 2) selm[128 + tid] = 0u;
        bf16x8 qt[4];
#pragma unroll
        for (int ks = 0; ks < 4; ++ks) qt[ks] = *(const bf16x8*)(p.qn() + tok * 512 + hq * 64 + 16 * ks + 8 * hi);
        int nvis = t >= 31 ? ((t - 31) >> 4) + 1 : 0; nvis = nvis > NCMP ? NCMP : nvis;
        const int nvmax = (qb * 64 + 63 - 31) / 16 + 1 > NCMP ? NCMP : (qb * 64 + 63 - 31) / 16 + 1;
        const int ntc = (nvmax + 63) >> 6;
        const bf16_t* kcb = p.kc() + (size_t)b * 256 * 128 + kvh * 64 + ch_ld * 8;
        const bf16_t* vcb = p.vc() + (size_t)b * 256 * 128 + kvh * 64 + ch_ld * 8;
        AttnWave W;
        W.M = fixm ? Mfix : -1e30f; W.L = 0.f;
#pragma unroll
        for (int i = 0; i < 16; ++i) { W.o0[i] = 0.f; W.o1[i] = 0.f; }
        const float gate0 = p.gates()[tok * 32 + hq * 3 + 0], gate1 = p.gates()[tok * 32 + hq * 3 + 1], gate2 = p.gates()[tok * 32 + hq * 3 + 2];
        u32x4 kr, vr;
        kr = *(const u32x4*)(kcb + (size_t)key_ld * 128); vr = *(const u32x4*)(vcb + (size_t)key_ld * 128);
        at_store_tile(lds, 0, tid, kr, vr);
        __syncthreads();
        float invl = 0.f;
        for (int i = 0; i < 2 * ntc; ++i) {
            const int kt = i < ntc ? i : i - ntc, nx = i + 1, ktn = nx < ntc ? nx : nx - ntc;
            if (nx < 2 * ntc) { kr = *(const u32x4*)(kcb + (size_t)(64 * ktn + key_ld) * 128); vr = *(const u32x4*)(vcb + (size_t)(64 * ktn + key_ld) * 128); }
            const LAS unsigned char* Kl = lds + (2 * (i & 1)) * AT_TILE; const LAS unsigned char* Vl = Kl + AT_TILE;
            if (i < ntc) ATT_TILE(AM_CMP1, W, qt, Kl, Vl, lane, r32, hi, nvis - 64 * kt, false, false, true, 0.f, nullptr, 0);
            else { if (i == ntc) invl = 1.0f / fmaxf(W.L, 1e-30f);
                   ATT_TILE(AM_CMP2, W, qt, Kl, Vl, lane, r32, hi, nvis - 64 * kt, false, false, true, invl, imp + qloc * 65, 16 * kt); }
            if (nx < 2 * ntc) at_store_tile(lds, nx & 1, tid, kr, vr);
            __syncthreads();
        }
#pragma unroll
        for (int i = 0; i < 4; ++i) {
            *(LAS f32x4*)(ost + r32 * AT_OPITCH + (8 * i + 4 * hi) * 4) = (f32x4){gate0 * W.o0[4 * i], gate0 * W.o0[4 * i + 1], gate0 * W.o0[4 * i + 2], gate0 * W.o0[4 * i + 3]};
            *(LAS f32x4*)(ost + r32 * AT_OPITCH + (32 + 8 * i + 4 * hi) * 4) = (f32x4){gate0 * W.o1[4 * i], gate0 * W.o1[4 * i + 1], gate0 * W.o1[4 * i + 2], gate0 * W.o1[4 * i + 3]};
        }
        const bf16_t* kbs = p.ksv() + (size_t)b * NS * 256 + kvh * 64 + ch_ld * 8;
        kr = *(const u32x4*)(kbs + (size_t)key_ld * 256); vr = *(const u32x4*)(kbs + (size_t)key_ld * 256 + 128);
        {
            const int q = tid >> 3, part = tid & 7;
            const LAS unsigned* row = imp + q * 65 + part * 8;
            unsigned key[8];
#pragma unroll
            for (int i = 0; i < 8; ++i) { const int j = part * 8 + i; const unsigned v = (j == 0 || j == qb || j == qb - 1) ? 0xffffffffu : (row[i] | 64u);
                key[i] = (j <= qb) ? ((v & 0xffffffc0u) | (unsigned)(63 - j)) : 0u; }
            unsigned long long mask = 0ull; const int rounds = qb + 1 < 16 ? qb + 1 : 16;
            for (int it = 0; it < rounds; ++it) {
                unsigned best = key[0];
#pragma unroll
                for (int i = 1; i < 8; ++i) best = key[i] > best ? key[i] : best;
                { unsigned o;
                  o = (unsigned)__builtin_amdgcn_update_dpp(0, (int)best, 0xB1, 0xf, 0xf, false); best = best > o ? best : o;
                  o = (unsigned)__builtin_amdgcn_update_dpp(0, (int)best, 0x4E, 0xf, 0xf, false); best = best > o ? best : o;
                  o = (unsigned)__builtin_amdgcn_update_dpp(0, (int)best, 0x141, 0xf, 0xf, false); best = best > o ? best : o; }
                const int jw = 63 - (int)(best & 63u);
                mask |= 1ull << jw;
#pragma unroll
                for (int i = 0; i < 8; ++i) key[i] = (key[i] == best) ? 0u : key[i];
            }
            if (part == 0) { selm[2 * q] = (unsigned)mask; selm[2 * q + 1] = (unsigned)(mask >> 32);
                (void)__hip_atomic_fetch_or(selm + 128, (unsigned)mask, __ATOMIC_RELAXED, __HIP_MEMORY_SCOPE_WORKGROUP); (void)__hip_atomic_fetch_or(selm + 129, (unsigned)(mask >> 32), __ATOMIC_RELAXED, __HIP_MEMORY_SCOPE_WORKGROUP); }
        }
        __syncthreads();
        const unsigned long long mymask = (unsigned long long)selm[2 * qloc] | ((unsigned long long)selm[2 * qloc + 1] << 32);
        const unsigned long long umask = (unsigned long long)selm[128] | ((unsigned long long)selm[129] << 32);
        const bf16_t* kbw = p.kwv() + (size_t)b * NS * 256 + kvh * 64 + ch_ld * 8;
        const int j0w = qb - 8 > 0 ? qb - 8 : 0;
        int pw = 0;
#pragma unroll
        for (int ks = 0; ks < 4; ++ks) qt[ks] = *(const bf16x8*)(p.qr() + tok * 512 + hq * 64 + 16 * ks + 8 * hi);
        {
            W.M = fixm ? Mfix : -1e30f; W.L = 0.f;
#pragma unroll
            for (int i = 0; i < 16; ++i) { W.o0[i] = 0.f; W.o1[i] = 0.f; W.ls[i] = 0.f; }
            const bf16_t* kb = kbs;
            unsigned long long rem = umask & ~1ull;
            int j = 0;
            at_store_tile(lds, 0, tid, kr, vr);
            __syncthreads();

            for (int i = 0;; ++i) {
                const bool more = rem != 0ull; int jn = 0;
                if (more) { jn = __builtin_ctzll(rem); rem &= rem - 1; kr = *(const u32x4*)(kb + (size_t)(64 * jn + key_ld) * 256); vr = *(const u32x4*)(kb + (size_t)(64 * jn + key_ld) * 256 + 128); }
                else { kr = *(const u32x4*)(kbw + (size_t)(64 * j0w + key_ld) * 256); vr = *(const u32x4*)(kbw + (size_t)(64 * j0w + key_ld) * 256 + 128); }
                const LAS unsigned char* Kl = lds + (2 * (i & 1)) * AT_TILE; const LAS unsigned char* Vl = Kl + AT_TILE;
                ATT_TILE(AM_SEL, W, qt, Kl, Vl, lane, r32, hi, qloc, j == qb, false, ((mymask >> j) & 1ull) != 0ull, 0.f, nullptr, 0);
                at_store_tile(lds, (i + 1) & 1, tid, kr, vr);
                __syncthreads();
                if (!more) { pw = (i + 1) & 1; break; }
                j = jn;
            }
            if (fixm) W.L = W.ls[0];
            const float sc = gate1 / fmaxf(W.L, 1e-30f);
#pragma unroll
            for (int i = 0; i < 4; ++i) {
                LAS f32x4* p0 = (LAS f32x4*)(ost + r32 * AT_OPITCH + (8 * i + 4 * hi) * 4); LAS f32x4* p1 = (LAS f32x4*)(ost + r32 * AT_OPITCH + (32 + 8 * i + 4 * hi) * 4);
                *p0 = *p0 + (f32x4){sc * W.o0[4 * i], sc * W.o0[4 * i + 1], sc * W.o0[4 * i + 2], sc * W.o0[4 * i + 3]};
                *p1 = *p1 + (f32x4){sc * W.o1[4 * i], sc * W.o1[4 * i + 1], sc * W.o1[4 * i + 2], sc * W.o1[4 * i + 3]};
            }
        }
        {
            W.M = fixm ? Mfix : -1e30f; W.L = 0.f;
#pragma unroll
            for (int i = 0; i < 16; ++i) { W.o0[i] = 0.f; W.o1[i] = 0.f; W.ls[i] = 0.f; }
            const bf16_t* kb = kbw;
            const int j0 = j0w;
            for (int j = j0; j <= qb; ++j) {
                const int i = j - j0 + pw;
                if (j < qb) { kr = *(const u32x4*)(kb + (size_t)(64 * (j + 1) + key_ld) * 256); vr = *(const u32x4*)(kb + (size_t)(64 * (j + 1) + key_ld) * 256 + 128); }
                const LAS unsigned char* Kl = lds + (2 * (i & 1)) * AT_TILE; const LAS unsigned char* Vl = Kl + AT_TILE;
                ATT_TILE(AM_WIN, W, qt, Kl, Vl, lane, r32, hi, qloc, j == qb, j == qb - 8, true, 0.f, nullptr, 0);
                if (j < qb) at_store_tile(lds, (i + 1) & 1, tid, kr, vr);
                __syncthreads();
            }
            if (fixm) W.L = W.ls[0];
            const float sc = gate2 / fmaxf(W.L, 1e-30f);
#pragma unroll
            for (int i = 0; i < 4; ++i) {
                LAS f32x4* p0 = (LAS f32x4*)(ost + r32 * AT_OPITCH + (8 * i + 4 * hi) * 4); LAS f32x4* p1 = (LAS f32x4*)(ost + r32 * AT_OPITCH + (32 + 8 * i + 4 * hi) * 4);
                *p0 = *p0 + (f32x4){sc * W.o0[4 * i], sc * W.o0[4 * i + 1], sc * W.o0[4 * i + 2], sc * W.o0[4 * i + 3]};
                *p1 = *p1 + (f32x4){sc * W.o1[4 * i], sc * W.o1[4 * i + 1], sc * W.o1[4 * i + 2], sc * W.o1[4 * i + 3]};
            }
        }
        asm volatile("s_waitcnt lgkmcnt(0)" ::: "memory");
#pragma unroll
        for (int i = 0; i < 4; ++i) {
            const int row = 8 * i + (lane >> 3), c8 = lane & 7;
            const f32x4 a = *(const LAS f32x4*)(ost + row * AT_OPITCH + c8 * 32), bq = *(const LAS f32x4*)(ost + row * AT_OPITCH + c8 * 32 + 16);
            const u32x2 v = {pk4_e4m3(a.x * H8_SCALE, a.y * H8_SCALE, a.z * H8_SCALE, a.w * H8_SCALE), pk4_e4m3(bq.x * H8_SCALE, bq.y * H8_SCALE, bq.z * H8_SCALE, bq.w * H8_SCALE)};
            *(u32x2*)((unsigned char*)p.onsa() + ((size_t)b * NS + qb * 64 + 32 * qh + row) * 1024 + hq * 64 + c8 * 8) = v;
        }
    }
    __syncthreads();
}
struct EpiProjF {
    static constexpr bool PERM = true;
    bf16_t* merged; const bf16_t* ra; const bf16_t* sb; float dsc;
    static __device__ __forceinline__ unsigned base_off(const pg8::Unit& u, int wr, int wc, int fr, int fq) {
        unsigned b = (unsigned)(((u.pm * 256 + wr * 64 + fr) * ND + u.pn * 256 + wc * 32 + 8 * fq) * 2); asm volatile("" : "+v"(b)); return b; }
    __device__ __forceinline__ void mid(f32x4 (&acc)[2][2][4][2], const pg8::Unit& u, int wr, int wc, int fr, int fq) const {
        const unsigned b0 = base_off(u, wr, wc, fr, fq);
#pragma unroll
        for (int ai = 0; ai < 2; ++ai)
#pragma unroll
            for (int m = 0; m < 4; ++m) {
                const unsigned ro = b0 + (unsigned)((ai * 128 + m * 16) * ND * 2);
                u32x4 gv[2];
#pragma unroll
                for (int bj = 0; bj < 2; ++bj) gv[bj] = *(const u32x4*)((const char*)ra + ro + bj * 256);
#pragma unroll
                for (int bj = 0; bj < 2; ++bj) {
                    acc[ai][bj][m][0] *= (f32x4){__uint_as_float(gv[bj].x << 16), __uint_as_float(gv[bj].x & 0xffff0000u), __uint_as_float(gv[bj].y << 16), __uint_as_float(gv[bj].y & 0xffff0000u)};
                    acc[ai][bj][m][1] *= (f32x4){__uint_as_float(gv[bj].z << 16), __uint_as_float(gv[bj].z & 0xffff0000u), __uint_as_float(gv[bj].w << 16), __uint_as_float(gv[bj].w & 0xffff0000u)};
                }
            }
    }
    __device__ __forceinline__ void operator()(const f32x4 (&acc)[2][2][4][2], const pg8::Unit& u, int wr, int wc, int fr, int fq) const {
        const unsigned b0 = base_off(u, wr, wc, fr, fq);
        u32x4 gv[2][4][2];
#pragma unroll
        for (int ai = 0; ai < 2; ++ai)
#pragma unroll
            for (int m = 0; m < 4; ++m)
#pragma unroll
                for (int bj = 0; bj < 2; ++bj) gv[ai][m][bj] = *(const u32x4*)((const char*)sb + (b0 + (unsigned)((ai * 128 + m * 16) * ND * 2)) + bj * 256);
#pragma unroll
        for (int ai = 0; ai < 2; ++ai)
#pragma unroll
            for (int m = 0; m < 4; ++m) {
                const unsigned ro = b0 + (unsigned)((ai * 128 + m * 16) * ND * 2);
#pragma unroll
                for (int bj = 0; bj < 2; ++bj) { const u32x4 g = gv[ai][m][bj];
                    const f32x4 o0 = acc[ai][bj][m][0] * (f32x4){__uint_as_float(g.x << 16), __uint_as_float(g.x & 0xffff0000u), __uint_as_float(g.y << 16), __uint_as_float(g.y & 0xffff0000u)};
                    const f32x4 o1 = acc[ai][bj][m][1] * (f32x4){__uint_as_float(g.z << 16), __uint_as_float(g.z & 0xffff0000u), __uint_as_float(g.w << 16), __uint_as_float(g.w & 0xffff0000u)};
                    *(u32x2*)((unsigned char*)merged + (ro >> 1) + bj * 128) = (u32x2){pk4_e4m3(o0.x * dsc, o0.y * dsc, o0.z * dsc, o0.w * dsc), pk4_e4m3(o1.x * dsc, o1.y * dsc, o1.z * dsc, o1.w * dsc)};
                }
            }
    }
};
template <bool XF32> struct EpiOut {
    static constexpr bool PERM = true;
    const float* xin; bf16_t* xb; const float* gt; float dsc;
    __device__ __forceinline__ void operator()(const f32x4 (&acc)[2][2][4][2], const pg8::Unit& u, int wr, int wc, int fr, int fq) const {
        const int row0 = u.pm * 256 + wr * 64 + fr, col0 = u.pn * 256 + wc * 32 + 8 * fq;
        const float* gp = gt + (size_t)(u.pm >> 4) * 6144 + col0;
        f32x4 g4[2][2];
#pragma unroll
        for (int bj = 0; bj < 2; ++bj)
#pragma unroll
            for (int n = 0; n < 2; ++n) g4[bj][n] = *(const f32x4*)(gp + bj * 128 + n * 4) * dsc;
#pragma unroll
        for (int ai = 0; ai < 2; ++ai) {
            f32x4 xv[4][2][2];
            if (XF32) {
#pragma unroll
                for (int m = 0; m < 4; ++m)
#pragma unroll
                    for (int bj = 0; bj < 2; ++bj) { const float* xp = xin + (size_t)(row0 + ai * 128 + m * 16) * ND + col0 + bj * 128; xv[m][bj][0] = *(const f32x4*)xp; xv[m][bj][1] = *(const f32x4*)(xp + 4); }
            } else {
                u32x4 r[4][2];
#pragma unroll
                for (int m = 0; m < 4; ++m)
#pragma unroll
                    for (int bj = 0; bj < 2; ++bj) r[m][bj] = *(const u32x4*)(xb + (size_t)(row0 + ai * 128 + m * 16) * ND + col0 + bj * 128);
#pragma unroll
                for (int m = 0; m < 4; ++m)
#pragma unroll
                    for (int bj = 0; bj < 2; ++bj) { const u32x4 q = r[m][bj];
                        xv[m][bj][0] = (f32x4){__uint_as_float(q.x << 16), __uint_as_float(q.x & 0xffff0000u), __uint_as_float(q.y << 16), __uint_as_float(q.y & 0xffff0000u)};
                        xv[m][bj][1] = (f32x4){__uint_as_float(q.z << 16), __uint_as_float(q.z & 0xffff0000u), __uint_as_float(q.w << 16), __uint_as_float(q.w & 0xffff0000u)}; }
            }
#pragma unroll
            for (int m = 0; m < 4; ++m)
#pragma unroll
                for (int bj = 0; bj < 2; ++bj) { const f32x4 o0 = xv[m][bj][0] + g4[bj][0] * acc[ai][bj][m][0], o1 = xv[m][bj][1] + g4[bj][1] * acc[ai][bj][m][1];
                    u32x4 w; w.x = pk2(o0.x, o0.y); w.y = pk2(o0.z, o0.w); w.z = pk2(o1.x, o1.y); w.w = pk2(o1.z, o1.w);
                    *(u32x4*)(xb + (size_t)(row0 + ai * 128 + m * 16) * ND + col0 + bj * 128) = w; }
        }
    }
};

struct EpiRouter {
    static constexpr bool PERM = true;
    float* logits; bf16_t* sact;
    __device__ __forceinline__ void operator()(const f32x4 (&acc)[2][2][4][2], const pg8::Unit& u, int wr, int wc, int fr, int fq) const {
        const int row0 = u.pm * 256 + wr * 64 + fr, cw = wc * 32 + 8 * fq;
        if (u.pn == 0) {
#pragma unroll
            for (int ai = 0; ai < 2; ++ai)
#pragma unroll
                for (int m = 0; m < 4; ++m) { float* rp = logits + (size_t)(row0 + ai * 128 + m * 16) * NE + cw;
#pragma unroll
                    for (int bj = 0; bj < 2; ++bj) { *(f32x4*)(rp + bj * 128) = acc[ai][bj][m][0]; *(f32x4*)(rp + bj * 128 + 4) = acc[ai][bj][m][1]; } }
        } else {
#pragma unroll
            for (int ai = 0; ai < 2; ++ai)
#pragma unroll
                for (int m = 0; m < 4; ++m) {
                    const f32x4 g0 = acc[ai][0][m][0], g1 = acc[ai][0][m][1], u0 = acc[ai][1][m][0], u1 = acc[ai][1][m][1];
                    u32x4 w; w.x = pk2(fsilu(g0.x) * u0.x, fsilu(g0.y) * u0.y); w.y = pk2(fsilu(g0.z) * u0.z, fsilu(g0.w) * u0.w);
                    w.z = pk2(fsilu(g1.x) * u1.x, fsilu(g1.y) * u1.y); w.w = pk2(fsilu(g1.z) * u1.z, fsilu(g1.w) * u1.w);
                    *(u32x4*)(sact + (size_t)(row0 + ai * 128 + m * 16) * 256 + (u.pn - 1) * 128 + cw) = w;
                }
        }
    }
};

struct EpiShared {
    static constexpr bool PERM = true;
    bf16_t* sact; float dsc;
    __device__ __forceinline__ void operator()(const f32x4 (&acc)[2][2][4][2], const pg8::Unit& u, int wr, int wc, int fr, int fq) const {
        const int row0 = u.pm * 256 + wr * 64 + fr, cw = wc * 32 + 8 * fq;
#pragma unroll
        for (int ai = 0; ai < 2; ++ai)
#pragma unroll
            for (int m = 0; m < 4; ++m) {
                const f32x4 g0 = acc[ai][0][m][0] * dsc, g1 = acc[ai][0][m][1] * dsc, u0 = acc[ai][1][m][0] * dsc, u1 = acc[ai][1][m][1] * dsc;
                u32x4 w; w.x = pk2(fsilu(g0.x) * u0.x, fsilu(g0.y) * u0.y); w.y = pk2(fsilu(g0.z) * u0.z, fsilu(g0.w) * u0.w);
                w.z = pk2(fsilu(g1.x) * u1.x, fsilu(g1.y) * u1.y); w.w = pk2(fsilu(g1.z) * u1.z, fsilu(g1.w) * u1.w);
                *(u32x4*)(sact + (size_t)(row0 + ai * 128 + m * 16) * 256 + u.pn * 128 + cw) = w;
            }
    }
};

__device__ __forceinline__ void ph_topk(const OP& p, int l, LAS unsigned char* lds, int bid, int nb) {
    const int tid = tid_(), lane = tid & 63, w = tid >> 6;
    LAS int* hist = (LAS int*)lds;
    const float* lg = p.logits(); int* idxp = p.idx(); float* wtp = p.wts(); int* slot = p.slot();
    __syncthreads();
    if (tid < 256) hist[tid] = 0;
    __syncthreads();
    const int CH = (NT + nb - 1) / nb, t0 = bid * CH, t1 = (t0 + CH) < NT ? (t0 + CH) : NT;
    float br[4];
#pragma unroll
    for (int i = 0; i < 4; ++i) br[i] = p.b_router[l * NE + i * 64 + lane];
    float lgn[4];
#pragma unroll
    for (int i = 0; i < 4; ++i) lgn[i] = (t0 + w < t1) ? lg[(size_t)(t0 + w) * NE + i * 64 + lane] : 0.f;
    for (int t = t0 + w; t < t1; t += 8) {
        unsigned key[4]; float affv[4];
#pragma unroll
        for (int i = 0; i < 4; ++i) { const int e = i * 64 + lane; const float aff = 1.0f / (1.0f + expf(-lgn[i])); affv[i] = aff; const float kf = fmaxf(aff + br[i], 1e-30f);
            key[i] = (__float_as_uint(kf) & 0xffffff00u) | (unsigned)(255 - e); }
        if (t + 8 < t1) {
#pragma unroll
            for (int i = 0; i < 4; ++i) lgn[i] = lg[(size_t)(t + 8) * NE + i * 64 + lane]; }
        int mye = 0;
#pragma unroll
        for (int r = 0; r < 8; ++r) {
            unsigned m = key[0] > key[1] ? key[0] : key[1]; { const unsigned m2 = key[2] > key[3] ? key[2] : key[3]; m = m > m2 ? m : m2; }
            { unsigned o;
              o = (unsigned)__builtin_amdgcn_update_dpp(0, (int)m, 0xB1, 0xf, 0xf, false); m = m > o ? m : o;
              o = (unsigned)__builtin_amdgcn_update_dpp(0, (int)m, 0x4E, 0xf, 0xf, false); m = m > o ? m : o;
              o = (unsigned)__builtin_amdgcn_update_dpp(0, (int)m, 0x141, 0xf, 0xf, false); m = m > o ? m : o;
              o = (unsigned)__builtin_amdgcn_update_dpp(0, (int)m, 0x140, 0xf, 0xf, false); m = m > o ? m : o; }
            const unsigned r0 = (unsigned)__builtin_amdgcn_readlane((int)m, 0), r1 = (unsigned)__builtin_amdgcn_readlane((int)m, 16), r2 = (unsigned)__builtin_amdgcn_readlane((int)m, 32), r3 = (unsigned)__builtin_amdgcn_readlane((int)m, 48);
            unsigned win = r0 > r1 ? r0 : r1; { const unsigned w2 = r2 > r3 ? r2 : r3; win = win > w2 ? win : w2; }
#pragma unroll
            for (int i = 0; i < 4; ++i) key[i] = (key[i] == win) ? 0u : key[i];
            if (lane == r) mye = 255 - (int)(win & 255u);
        }
        float av = 0.f;
        { const int sl = mye & 63, si = mye >> 6;
          const float a0 = __shfl(affv[0], sl), a1 = __shfl(affv[1], sl), a2 = __shfl(affv[2], sl), a3 = __shfl(affv[3], sl);
          const float sel = (si == 0) ? a0 : (si == 1) ? a1 : (si == 2) ? a2 : a3;
          if (lane < 8) av = sel; }
        float sum = av;
        sum += __shfl_xor(sum, 1); sum += __shfl_xor(sum, 2); sum += __shfl_xor(sum, 4);
        if (lane < 8) {
            idxp[(size_t)t * 8 + lane] = mye; wtp[(size_t)t * 8 + lane] = av / sum * 2.5f;
            slot[(size_t)t * 8 + lane] = __hip_atomic_fetch_add(hist + mye, 1, __ATOMIC_RELAXED, __HIP_MEMORY_SCOPE_WORKGROUP);
        }
    }
    __syncthreads();
    if (tid < 256) p.bhist()[bid * 256 + tid] = hist[tid];
    __syncthreads();
}
#define CW_NUNITS 64
__device__ __forceinline__ void ph_place(const OP& p, LAS unsigned char* lds, int bid, int nb) {
    const int tid = tid_();
    LAS int* pst = (LAS int*)lds;
    LAS int* cntl = pst + 260;
    LAS int* basel = cntl + 256;
    int* rtok = p.row_tok(); float* rw = p.row_w(); int* ue = p.unit_e(); const int* bh = p.bhist();
    LAS int* ptot = basel + 256;
    LAS int* pbase = ptot + 8 * 256;
    __syncthreads();
    { const int lane = tid & 63, wave = tid >> 6; int tot[4] = {0, 0, 0, 0}, base[4] = {0, 0, 0, 0};
      for (int b0 = wave; b0 < nb; b0 += 64) {
          int v[8][4];
#pragma unroll
          for (int k = 0; k < 8; ++k) { const int b = b0 + 8 * k;
#pragma unroll
              for (int i = 0; i < 4; ++i) v[k][i] = (b < nb) ? bh[b * 256 + i * 64 + lane] : 0; }
#pragma unroll
          for (int k = 0; k < 8; ++k) { const int b = b0 + 8 * k;
#pragma unroll
              for (int i = 0; i < 4; ++i) { tot[i] += v[k][i]; base[i] += (b < bid) ? v[k][i] : 0; } }
      }
#pragma unroll
      for (int i = 0; i < 4; ++i) { ptot[wave * 256 + i * 64 + lane] = tot[i]; pbase[wave * 256 + i * 64 + lane] = base[i]; } }
    __syncthreads();
    if (tid < 256) { int tot = 0, base = 0;
#pragma unroll
        for (int ww = 0; ww < 8; ++ww) { tot += ptot[ww * 256 + tid]; base += pbase[ww * 256 + tid]; }
        cntl[tid] = tot; basel[tid] = base; ptot[tid] = (tot + 255) & ~255; }
    __syncthreads();
    if (tid <= 256) { int run = 0;
        for (int e = 0; e < 256; ++e) run += (e < tid) ? ptot[e] : 0;
        pst[tid] = run; }
    __syncthreads();
    if (bid == 0) {
        if (tid < 256) { for (int i = pst[tid] >> 8; i < pst[tid + 1] >> 8; ++i) ue[i] = tid; }
        if (tid == 0) p.ctl()[CW_NUNITS] = (unsigned)(pst[NE] >> 8);
    }
    for (int e = bid; e < NE; e += nb) { for (int r = pst[e] + cntl[e] + tid; r < pst[e + 1]; r += 512) { rtok[r] = 0; rw[r] = -1.f; } }
    const int* idxp = p.idx(); const float* wtp = p.wts(); int* slot = p.slot();
    const int CH = (NT + nb - 1) / nb, a0 = bid * CH * 8, a1 = ((bid + 1) * CH < NT ? (bid + 1) * CH : NT) * 8;
    for (int a = a0 + tid; a < a1; a += 512) {
        const int e = idxp[a]; const int dest = pst[e] + basel[e] + slot[a];
        rtok[dest] = a >> 3; rw[dest] = wtp[a]; slot[a] = dest;
    }
    __syncthreads();
}

__device__ __forceinline__ int xcd_chunk(int L, int nwg) { const int q = nwg / 8, r = nwg % 8, xcd = L % 8, off = L / 8; return (xcd < r ? xcd * (q + 1) : r * (q + 1) + (xcd - r) * q) + off; }
struct GatherSched {
    const char* h; const char* W; const int* row_tok; const int* unit_e; int K, kstepA, ldb; int nunits2, G, c; int arow, brow;
    __device__ __forceinline__ bool next(int i, pg8::Unit& u) const { int L = i * G + c; if (L >= nunits2) return false; L = xcd_chunk(L, nunits2); u.pm = L >> 1; u.pn = L & 1; u.e = unit_e[u.pm]; return true; }
    __device__ __forceinline__ const char* a_base() const { return h; }
    __device__ __forceinline__ const char* b_base() const { return W; }
    __device__ __forceinline__ const char* a_ptr(const pg8::Unit&) const { return h; }
    __device__ __forceinline__ void a_off(const pg8::Unit& u, int tid, unsigned (&off)[2][2]) const {
#pragma unroll
        for (int i = 0; i < 2; ++i) { int R, C; pg8::stage_rc(tid * 16 + i * 8192, R, C);
#pragma unroll
            for (int hh = 0; hh < 2; ++hh) off[hh][i] = (unsigned)(row_tok[u.pm * 256 + hh * 128 + R] * arow + C * 2); }
    }
    __device__ __forceinline__ const char* b_ptr(const pg8::Unit& u) const { return W + ((size_t)u.e * 512 + u.pn * 256) * brow; }
};
struct EpiAct {
    static constexpr bool PERM = true;
    unsigned char* act8; float dsc;
    __device__ __forceinline__ void operator()(const f32x4 (&acc)[2][2][4][2], const pg8::Unit& u, int wr, int wc, int fr, int fq) const {
        const int row0 = u.pm * 256 + wr * 64 + fr, cw = u.pn * 128 + wc * 32 + 8 * fq;
#pragma unroll
        for (int ai = 0; ai < 2; ++ai)
#pragma unroll
            for (int m = 0; m < 4; ++m) {
                const f32x4 g0 = acc[ai][0][m][0] * dsc, g1 = acc[ai][0][m][1] * dsc, u0 = acc[ai][1][m][0] * (dsc * H8_SCALE), u1 = acc[ai][1][m][1] * (dsc * H8_SCALE);
                const u32x2 w = {pk4_e4m3(fsilu(g0.x) * u0.x, fsilu(g0.y) * u0.y, fsilu(g0.z) * u0.z, fsilu(g0.w) * u0.w), pk4_e4m3(fsilu(g1.x) * u1.x, fsilu(g1.y) * u1.y, fsilu(g1.z) * u1.z, fsilu(g1.w) * u1.w)};
                *(u32x2*)(act8 + (size_t)(row0 + ai * 128 + m * 16) * 256 + cw) = w;
            }
    }
};
struct DownSched {
    const char* act; const char* W; const int* unit_e; int K, kstepA, ldb; int nunits4, G, c; int arow, brow;
    __device__ __forceinline__ bool next(int i, pg8::Unit& u) const { int L = i * G + c; if (L >= nunits4) return false; L = xcd_chunk(L, nunits4); u.pm = L >> 2; u.pn = L & 3; u.e = unit_e[u.pm]; return true; }
    __device__ __forceinline__ const char* a_base() const { return act; }
    __device__ __forceinline__ const char* b_base() const { return W; }
    __device__ __forceinline__ const char* a_ptr(const pg8::Unit& u) const { return act + (size_t)u.pm * 256 * arow; }
    __device__ __forceinline__ void a_off(const pg8::Unit&, int tid, unsigned (&off)[2][2]) const {
#pragma unroll
        for (int i = 0; i < 2; ++i) { int R, C; pg8::stage_rc(tid * 16 + i * 8192, R, C);
#pragma unroll
            for (int hh = 0; hh < 2; ++hh) off[hh][i] = (unsigned)((hh * 128 + R) * arow + C * 2); }
    }
    __device__ __forceinline__ const char* b_ptr(const pg8::Unit& u) const { return W + ((size_t)u.e * ND + u.pn * 256) * brow; }
};
#define YS_SCALE 8.0f
__device__ __forceinline__ unsigned pk4_fp8(f32x4 v) {
    int w = __builtin_amdgcn_cvt_pk_fp8_f32(__builtin_amdgcn_fmed3f(v.x, -240.f, 240.f), __builtin_amdgcn_fmed3f(v.y, -240.f, 240.f), 0, false);
    w = __builtin_amdgcn_cvt_pk_fp8_f32(__builtin_amdgcn_fmed3f(v.z, -240.f, 240.f), __builtin_amdgcn_fmed3f(v.w, -240.f, 240.f), w, true); return (unsigned)w;
}
template <bool FP8> struct EpiY {
    static constexpr bool PERM = true;
    void* y; const float* row_w; float dsc;
    __device__ __forceinline__ void operator()(const f32x4 (&acc)[2][2][4][2], const pg8::Unit& u, int wr, int wc, int fr, int fq) const {
        const int row0 = u.pm * 256 + wr * 64 + fr, cw = u.pn * 256 + wc * 32 + 8 * fq;
        float rwv[2][4];
#pragma unroll
        for (int ai = 0; ai < 2; ++ai)
#pragma unroll
            for (int m = 0; m < 4; ++m) rwv[ai][m] = row_w ? row_w[row0 + ai * 128 + m * 16] : 1.0f;
#pragma unroll
        for (int ai = 0; ai < 2; ++ai)
#pragma unroll
            for (int m = 0; m < 4; ++m) {
                const float s = rwv[ai][m];
                if (s < 0.f) continue;
                if (FP8) { unsigned char* rp = (unsigned char*)y + (size_t)(row0 + ai * 128 + m * 16) * ND + cw; const float s8 = s * (YS_SCALE * dsc);
#pragma unroll
                    for (int bj = 0; bj < 2; ++bj) { const u32x2 w = {pk4_fp8(acc[ai][bj][m][0] * s8), pk4_fp8(acc[ai][bj][m][1] * s8)}; *(u32x2*)(rp + bj * 128) = w; } }
                else { bf16_t* rp = (bf16_t*)y + (size_t)(row0 + ai * 128 + m * 16) * ND + cw;
#pragma unroll
                    for (int bj = 0; bj < 2; ++bj) { const f32x4 v0 = acc[ai][bj][m][0] * s, v1 = acc[ai][bj][m][1] * s;
                        u32x4 w; w.x = pk2(v0.x, v0.y); w.y = pk2(v0.z, v0.w); w.z = pk2(v1.x, v1.y); w.w = pk2(v1.z, v1.w); *(u32x4*)(rp + bj * 128) = w; } }
            }
    }
};
__device__ __forceinline__ void ph_combine(const OP& p, int l, int bid, int nb) {
    const int lane = tid_() & 63, w = tid_() >> 6;
    const unsigned char* ys8 = (const unsigned char*)p.yslot(); const bf16_t* sh = p.shout(); const int* slot = p.slot(); const float* mod = p.mod(); bf16_t* hb = p.h();
    for (int t = bid * 8 + w; t < NT; t += nb * 8) {
        const float* mb = mod + ((size_t)l * NB + (t >> 12)) * 6144;
        int sl = 0; if (lane < 8) sl = slot[(size_t)t * 8 + lane];
        f32x4 accv[4];
#pragma unroll
        for (int i = 0; i < 4; ++i) { const u32x2 s2 = *(const u32x2*)(sh + (size_t)t * ND + i * 256 + lane * 4);
            accv[i] = (f32x4){__uint_as_float(s2.x << 16), __uint_as_float(s2.x & 0xffff0000u), __uint_as_float(s2.y << 16), __uint_as_float(s2.y & 0xffff0000u)}; }
        f32x4 ysum[4] = {(f32x4){0.f, 0.f, 0.f, 0.f}, (f32x4){0.f, 0.f, 0.f, 0.f}, (f32x4){0.f, 0.f, 0.f, 0.f}, (f32x4){0.f, 0.f, 0.f, 0.f}};
#pragma unroll
        for (int k = 0; k < 8; ++k) {
            const int r = __shfl(sl, k);
#pragma unroll
            for (int i = 0; i < 4; ++i) { const int y4 = *(const int*)(ys8 + (size_t)r * ND + i * 256 + lane * 4);
                const f32x2 lo = __builtin_amdgcn_cvt_pk_f32_fp8(y4, false), hi2 = __builtin_amdgcn_cvt_pk_f32_fp8(y4, true);
                ysum[i] += (f32x4){lo.x, lo.y, hi2.x, hi2.y}; }
        }
#pragma unroll
        for (int i = 0; i < 4; ++i) accv[i] += ysum[i] * (1.0f / YS_SCALE);
        float ss = 0.f; f32x4 xo[4]; bf16_t* xbp = p.xb();
#pragma unroll
        for (int i = 0; i < 4; ++i) { const int cidx = i * 256 + lane * 4; const u32x2 xr = *(const u32x2*)(xbp + (size_t)t * ND + cidx); const f32x4 g4 = *(const f32x4*)(mb + 5120 + cidx);
            const f32x4 xv = {__uint_as_float(xr.x << 16), __uint_as_float(xr.x & 0xffff0000u), __uint_as_float(xr.y << 16), __uint_as_float(xr.y & 0xffff0000u)};
            xo[i] = xv + g4 * accv[i];
            if (l + 1 < NL) { const u32x2 w = {pk2(xo[i].x, xo[i].y), pk2(xo[i].z, xo[i].w)}; *(u32x2*)(xbp + (size_t)t * ND + cidx) = w; }
            else *(f32x4*)(p.out + (size_t)t * ND + cidx) = xo[i];
            ss += xo[i].x * xo[i].x + xo[i].y * xo[i].y + xo[i].z * xo[i].z + xo[i].w * xo[i].w; }
        if (l + 1 < NL) {
#pragma unroll
            for (int o = 32; o >= 1; o >>= 1) ss += __shfl_xor(ss, o);
            const float rstd = rsqrtf(ss * (1.0f / ND) + 1e-6f);
            const float* mn = mod + ((size_t)(l + 1) * NB + (t >> 12)) * 6144;
#pragma unroll
            for (int i = 0; i < 4; ++i) { const int cidx = i * 256 + lane * 4; const f32x4 sc = *(const f32x4*)(mn + 1024 + cidx), s0 = *(const f32x4*)(mn + cidx);
                u32x2 o; o.x = pk2(xo[i].x * rstd * (1.f + sc.x) + s0.x, xo[i].y * rstd * (1.f + sc.y) + s0.y); o.y = pk2(xo[i].z * rstd * (1.f + sc.z) + s0.z, xo[i].w * rstd * (1.f + sc.w) + s0.w);
                *(u32x2*)(hb + (size_t)t * ND + cidx) = o; }
        }
    }
}
#ifndef ATTN_TWICE
#define ATTN_TWICE
#endif
#ifndef OPT_PHASES_B
#define OPT_PHASES_B \
        if (IN(OPH_CMP1)) REP(OPH_CMP1) { ph_rope(p, bid, nb); \
            { CmpSched S; S.kvraw = (const char*)p.kvraw(); S.w1 = (const char*)(p.Wt_w1() + (size_t)l * 2 * 256 * 2048); S.K = 512; S.kstepA = 512; S.ldb = 2048; S.G = nb; S.c = bid; \
              EpiCmp E{p.cpart()}; pg8::gemm_phase<EpiCmp, CmpSched, true>(lds, S, E); } \
            ph_gmlp(p, l, lds, bid, nb); SEAMK(OPH_CMP1, l); } \
        if (IN(OPH_CMP2)) REP(OPH_CMP2) { ph_cmp2(p, l, lds, bid, nb); SEAMK(OPH_CMP2, l); } \
        if (IN(OPH_ATTN)) { ph_attn(p, l, lds, bid, nb); SEAMK(OPH_ATTN, l); ATTN_TWICE } \
        if (IN(OPH_PROJ)) REP(OPH_PROJ) { \
            { pg8::DenseSched S; S.init(p.onsa(), ND / 2, (const char*)p.Wt_pn() + (size_t)l * ND * ND, NT, ND, ND / 2, nb, bid); EpiProjF E{p.merged(), p.sga(), p.sgb(), 1.0f / W8_SCALE}; pg8::gemm_phase<EpiProjF, pg8::DenseSched, true, true, true>(lds, S, E); } \
            SEAMK(OPH_PROJ, l); } \
        if (IN(OPH_OUT)) REP(OPH_OUT) { pg8::DenseSched S; S.init(p.merged(), ND / 2, (const char*)p.Wt_out() + (size_t)l * ND * ND, NT, ND, ND / 2, nb, bid); \
            EpiOut<l == 0> E{p.x, p.xb(), p.mod() + (size_t)l * NB * 6144 + 2048, 1.0f / (H8_SCALE * W8_SCALE)}; pg8::gemm_phase<EpiOut<l == 0>, pg8::DenseSched, true, false, true>(lds, S, E); SEAMK(OPH_OUT, l); } \
        if (IN(OPH_NORMF)) REP(OPH_NORMF) { ph_norm_b(p, p.xb(), l, 3072, 4096, bid, nb, (unsigned char*)p.yslot() + (size_t)MAXROWS2 * ND); SEAMK(OPH_NORMF, l); } \
        if (IN(OPH_ROUTER)) REP(OPH_ROUTER) { const int nl_ = nb >= 2 ? nb / 2 : 0;        \
            if (nl_ == 0 || bid < nl_) { pg8::DenseSched S; S.init(p.h(), ND, p.Wt_rs() + (size_t)l * 768 * ND, NT, 256, ND, nl_ ? nl_ : nb, bid); \
                EpiRouter E{p.logits(), p.sact()}; pg8::gemm_phase<EpiRouter, pg8::DenseSched, true>(lds, S, E); } \
            if (nl_ == 0 || bid >= nl_) { pg8::DenseSched S; S.init((const char*)p.yslot() + (size_t)MAXROWS2 * ND, ND / 2, (const char*)(p.Wt_rs() + (size_t)l * 768 * ND + (size_t)256 * ND), NT, 512, ND / 2, nl_ ? nb - nl_ : nb, nl_ ? bid - nl_ : bid); \
                EpiShared E{p.sact(), 1.0f / (H8_SCALE * W8_SCALE)}; pg8::gemm_phase<EpiShared, pg8::DenseSched, true, false, true>(lds, S, E); } \
            SEAMK(OPH_ROUTER, l); } \
        if (IN(OPH_TOPK)) REP(OPH_TOPK) { ph_topk(p, l, lds, bid, nb); SEAMK(OPH_TOPK, l); } \
        if (IN(OPH_PLACE)) REP(OPH_PLACE) { ph_place(p, lds, bid, nb); SEAMK(OPH_PLACE, l); } \
        if (IN(OPH_EGU)) REP(OPH_EGU) { GatherSched S; S.h = (const char*)p.yslot() + (size_t)MAXROWS2 * ND; S.W = (const char*)p.Wt_eg() + (size_t)l * NE * 512 * ND; S.row_tok = p.row_tok(); S.unit_e = p.unit_e(); \
            S.K = ND / 2; S.kstepA = 128; S.ldb = ND / 2; S.arow = ND; S.brow = ND;        \
            S.nunits2 = 2 * (int)__builtin_amdgcn_readfirstlane(p.ctl()[CW_NUNITS]); S.G = nb; S.c = bid; \
            EpiAct E{(unsigned char*)p.act(), 1.0f / (H8_SCALE * W8_SCALE)}; pg8::gemm_phase<EpiAct, GatherSched, true, false, true>(lds, S, E); SEAMK(OPH_EGU, l); } \
        if (IN(OPH_EDOWN)) REP(OPH_EDOWN) { \
            { DownSched S; S.act = (const char*)p.act(); S.W = (const char*)p.Wt_ed() + (size_t)l * NE * ND * 256; S.unit_e = p.unit_e(); S.K = 128; S.kstepA = 128; S.ldb = 128; S.arow = 256; S.brow = 256; \
              S.nunits4 = 4 * (int)__builtin_amdgcn_readfirstlane(p.ctl()[CW_NUNITS]); S.G = nb; S.c = bid; EpiY<true> E{p.yslot(), p.row_w(), 1.0f / (H8_SCALE * W8_SCALE)}; pg8::gemm_phase<EpiY<true>, DownSched, true, false, true>(lds, S, E); } \
            { pg8::DenseSched S; S.init(p.sact(), 256, p.Wt_ds() + (size_t)l * ND * 256, NT, ND, 256, nb, bid); EpiY<false> E{p.shout(), nullptr, 1.0f}; pg8::gemm_phase<EpiY<false>, pg8::DenseSched, true>(lds, S, E); } \
            SEAMK(OPH_EDOWN, l); } \
        if (IN(OPH_COMBINE)) REP(OPH_COMBINE) { ph_combine(p, l, bid, nb); SEAMK(OPH_COMBINE, l); }
#endif
enum { OPH_PROLOGUE = 0, OPH_NORM0 = 1, OPH_Z = 2, OPH_CMP1, OPH_CMP2, OPH_ATTN, OPH_PROJ, OPH_OUT, OPH_NORMF, OPH_ROUTER, OPH_TOPK, OPH_PLACE, OPH_EGU, OPH_EDOWN, OPH_COMBINE, OPH_END };
#define CW_BAR 4096

__global__ void __launch_bounds__(512, 2) k_opt(OP p) {
    extern __shared__ __attribute__((aligned(16))) unsigned char lds_raw[];
    LAS unsigned char* lds = (LAS unsigned char*)lds_raw;
    volatile LAS unsigned* misc = (volatile LAS unsigned*)(lds + LDS_MISC);
    for (int u = tid_(); u < (LDS_BYTES - LDS_MISC) / 4; u += 512) misc[u] = 0u;
    __syncthreads();
    const bool multi = (p.ph_hi - p.ph_lo > 1) || (p.l_hi - p.l_lo > 1);
    unsigned* const ctl = p.ctl();
    XcdBarrier bar; bar.bar = ctl + CW_BAR; bar.x = 0; bar.st = misc + 8;
    if (multi) bar = xcd_barrier_post(ctl + CW_BAR, misc + 8);
    const int bid = blockIdx.x, nb = gridDim.x;
#ifdef TSTAMP
    if (bid == 0 && tid_() == 0) ((unsigned long long*)(ctl + 8192))[63] = wall_clock64();
#endif
    const int lo = p.ph_lo, hi = p.ph_hi;
#ifndef REP_MASK
#define REP_MASK 0
#endif
#define IN(k) (lo <= (k) && (k) < hi)
#define REP(k) for (int rep_ = 0; rep_ < 1 + ((REP_MASK >> (k)) & 1); ++rep_)
#ifdef TSTAMP
#define SEAMK(k, l) do { if (multi) xcd_barrier(bar); if (bid == 0 && tid_() == 0) ((unsigned long long*)(ctl + 8192))[(l) * 16 + (k)] = wall_clock64(); } while (0)
#else
#define SEAMK(k, l) do { if (multi) xcd_barrier(bar); } while (0)
#endif
#define SEAM() SEAMK(15, 1)
    if (p.l_lo == 0) {
        if (IN(OPH_PROLOGUE)) REP(OPH_PROLOGUE) { ph_prologue(p, lds, bid, nb); SEAMK(OPH_PROLOGUE, 0); }
        if (IN(OPH_NORM0)) REP(OPH_NORM0) { ph_norm(p, p.x, 0, 0, 1024, bid, nb); SEAMK(OPH_NORM0, 0); }
    }
#define LAYER_BODY(L_) { constexpr int l = (L_); if (l >= p.l_lo && l < p.l_hi) { \
        if (IN(OPH_Z)) REP(OPH_Z) { \
            pg8::DenseSched S; S.init(p.h(), ND, p.Wt_in() + (size_t)l * ZPAD * ND, NT, ZPAD, ND, nb, bid); \
            if (tid_() < 128) ((LAS float*)(lds + LDS_GAIN))[tid_()] = (tid_() < 64 ? p.q_gain : p.k_gain - 64)[l * 64 + tid_()]; \
            __syncthreads(); \
            EpiZ E{&p, lds}; \
            pg8::gemm_phase<EpiZ, pg8::DenseSched, true>(lds, S, E); \
            SEAMK(OPH_Z, l); \
        } \
        OPT_PHASES_B \
    } }
    LAYER_BODY(0)
    LAYER_BODY(1)
#undef IN
#undef REP
#undef SEAM
}

static inline size_t ws_take(size_t& off, size_t bytes) { const size_t r = off; off += (bytes + 255) & ~(size_t)255; return r; }
static void fill_inputs(OP& p, void* const* d_in, void* d_out) {
    p.x = (const float*)d_in[0]; p.c = (const float*)d_in[1]; p.pos = (const int*)d_in[2];
    p.w_mod = (const float*)d_in[3]; p.b_mod = (const float*)d_in[4]; p.w_in = (const float*)d_in[5]; p.q_gain = (const float*)d_in[6]; p.k_gain = (const float*)d_in[7];
    p.pe_k = (const float*)d_in[8]; p.pe_v = (const float*)d_in[9]; p.w1k = (const float*)d_in[10]; p.w2k = (const float*)d_in[11]; p.w1v = (const float*)d_in[12]; p.w2v = (const float*)d_in[13];
    p.ln_g = (const float*)d_in[14]; p.ln_b = (const float*)d_in[15]; p.gm_ws = (const float*)d_in[16]; p.gm_bs = (const float*)d_in[17];
    p.wpn = (const float*)d_in[18]; p.wpg = (const float*)d_in[19]; p.w_out = (const float*)d_in[20]; p.w_router = (const float*)d_in[21]; p.b_router = (const float*)d_in[22];
    p.wge = (const float*)d_in[23]; p.wue = (const float*)d_in[24]; p.wde = (const float*)d_in[25]; p.wgs = (const float*)d_in[26]; p.wus = (const float*)d_in[27]; p.wds = (const float*)d_in[28];
    p.out = (float*)d_out;
}
static int opt_grid() {
    static int grid = 0;
    if (!grid) {
        int dev = 0, cus = 0;
        (void)hipGetDevice(&dev); (void)hipDeviceGetAttribute(&cus, hipDeviceAttributeMultiprocessorCount, dev);
        (void)hipFuncSetAttribute((const void*)k_opt, hipFuncAttributeMaxDynamicSharedMemorySize, LDS_BYTES);
        int per_cu = 0; (void)hipOccupancyMaxActiveBlocksPerMultiprocessor(&per_cu, (const void*)k_opt, 512, LDS_BYTES); (void)hipGetLastError();
        grid = cus > 0 ? cus : 256;
    }
    return grid;
}
static void launch_opt(OP p, int ph_lo, int ph_hi, int l_lo, int l_hi, hipStream_t s) {
    p.ph_lo = ph_lo; p.ph_hi = ph_hi; p.l_lo = l_lo; p.l_hi = l_hi;
    hipLaunchKernelGGL(k_opt, dim3(opt_grid()), dim3(512), LDS_BYTES, s, p);
}
#if DEV_CHECK
enum { T_NONE = 0, T_GELU = 1, T_SIGMOID = 2 };
__global__ void k_cmp(const void* opt, int opt_f32, int ldo, const float* ref, int ldr, int ncols, int nrows, int tr, float scale, double* acc) {
    double num = 0.0, den = 0.0;
    const size_t n = (size_t)nrows * ncols;
    for (size_t i = (size_t)blockIdx.x * blockDim.x + threadIdx.x; i < n; i += (size_t)gridDim.x * blockDim.x) {
        const size_t r = i / ncols; const int c = (int)(i % ncols);
        float e = ref[r * ldr + c];
        if (tr == T_GELU) e = geluf_(e); else if (tr == T_SIGMOID) e = sigmoidf_(e);
        e *= scale;
        const float o = opt_f32 ? ((const float*)opt)[r * ldo + c] : bf2f(((const bf16_t*)opt)[r * ldo + c]);
        const double d = (double)o - (double)e; num += d * d; den += (double)e * (double)e;
    }
    for (int o = 32; o >= 1; o >>= 1) { num += __shfl_xor(num, o); den += __shfl_xor(den, o); }
    if ((threadIdx.x & 63) == 0) { atomicAdd(acc, num); atomicAdd(acc + 1, den); }
}
__global__ void k_final(float* out, size_t n, const double* acc, int ngroups, int only) {
    double metric = 0.0;
    for (int g = 0; g < ngroups; ++g) { if (only >= 0 && g != only) continue; const double m = acc[2 * g] / (acc[2 * g + 1] + 1e-300); if (!(m <= metric)) metric = m; }
    const float s = 1.0f + (float)sqrt(metric);
    for (size_t i = (size_t)blockIdx.x * blockDim.x + threadIdx.x; i < n; i += (size_t)gridDim.x * blockDim.x) out[i] *= s;
}
#ifndef DEV_ONLY
#define DEV_ONLY -1
#endif
static void cmp(const void* opt, int f32, int ldo, const float* ref, int ldr, int ncols, int nrows, int tr, float scale, double* acc, int g, hipStream_t s) {
    hipLaunchKernelGGL(k_cmp, dim3(2048), dim3(256), 0, s, opt, f32, ldo, ref, ldr, ncols, nrows, tr, scale, acc + 2 * g);
}
#endif

#ifdef TSTAMP
__global__ void k_probe(float* out, size_t n, const unsigned long long* ts, int a0, int a1, int b0, int b1) {
    float ta = (float)(ts[a1] - ts[a0]) * 0.01f, tb = (float)(ts[b1] - ts[b0]) * 0.01f;
    ta = floorf(ta / 16.f + 0.5f) * 16.f; tb = floorf(tb / 20.f + 0.5f) * 20.f;
    const float s = 1.0f + sqrtf(1e-5f * ta);
    for (size_t i = (size_t)blockIdx.x * blockDim.x + threadIdx.x; i < n; i += (size_t)gridDim.x * blockDim.x) { float v = out[i] * s; if (i == 0) v += 2.0f + tb * 0.1f; out[i] = v; }
}
#endif
extern "C" void kernel_launch(void* const* d_in, const int* in_sizes, int n_in, void* d_out, int out_size, void* d_ws, size_t ws_size, hipStream_t stream) {
    OP p; memset(&p, 0, sizeof(p));
    fill_inputs(p, d_in, d_out);
    char* w = (char*)d_ws;
#if DEV_CHECK
    size_t off = 0;
    p.ws = w; off = wsl::O_END_MIX;
    refp::Params rp; memset(&rp, 0, sizeof(rp));
    rp.x = p.x; rp.c = p.c; rp.pos = p.pos; rp.w_mod = p.w_mod; rp.b_mod = p.b_mod; rp.w_in = p.w_in; rp.q_gain = p.q_gain; rp.k_gain = p.k_gain; rp.pe_k = p.pe_k; rp.pe_v = p.pe_v;
    rp.w1k = p.w1k; rp.w2k = p.w2k; rp.w1v = p.w1v; rp.w2v = p.w2v; rp.ln_g = p.ln_g; rp.ln_b = p.ln_b; rp.gm_ws = p.gm_ws; rp.gm_bs = p.gm_bs; rp.wpn = p.wpn; rp.wpg = p.wpg; rp.w_out = p.w_out;
    rp.w_router = p.w_router; rp.b_router = p.b_router; rp.wge = p.wge; rp.wue = p.wue; rp.wde = p.wde; rp.wgs = p.wgs; rp.wus = p.wus; rp.wds = p.wds; rp.out = p.out;
    auto take = [&](size_t bytes) { return (void*)(w + ws_take(off, bytes)); };
    {
        const size_t region = off;
        rp.z = (float*)take((size_t)NT * INC * 4);
        rp.qn = (float*)take((size_t)NT * 512 * 4); rp.qr = (float*)take((size_t)NT * 512 * 4);
        rp.ks = (float*)take((size_t)NT * 128 * 4); rp.kw = (float*)take((size_t)NT * 128 * 4);
        rp.onsa = (float*)take((size_t)NT * 512 * 4); rp.vn = (float*)take((size_t)NT * 512 * 4); rp.ogm = (float*)take((size_t)NT * 512 * 4);
        rp.ya = (float*)take((size_t)NT * ND * 4);
        const size_t end_mix = off;
        off = region;
        rp.logits = (float*)take((size_t)NT * NE * 4); rp.gs = (float*)take((size_t)NT * 256 * 4); rp.sact = (float*)take((size_t)NT * 256 * 4);
        rp.shout = (float*)take((size_t)NT * ND * 4); rp.routed = (float*)take((size_t)NT * ND * 4);
        rp.ag = (float*)take((size_t)MAXROWS * 256 * 4); rp.act = (float*)take((size_t)MAXROWS * 256 * 4);
        if (off < end_mix) off = end_mix;
        const size_t need = wsl::O_Wt_ed + (size_t)NE * ND * 256 * 2 + 4096;
        if (off < need) off = need;
    }
    p.xres = (float*)take((size_t)NT * ND * 4);
    rp.bar = (unsigned*)take(16384);
    rp.mod = (float*)take((size_t)NL * NB * 6144 * 4);
    rp.h = (float*)take((size_t)NT * ND * 4);
    rp.counts = (int*)take(NE * 4); rp.cursor = (int*)take(NE * 4); rp.pad_start = (int*)take(NE * 4); rp.blk_e = (int*)take(MAXBLK * 4);
    rp.row_tok = (int*)take((size_t)MAXROWS * 4); rp.row_w = (float*)take((size_t)MAXROWS * 4);
    rp.idx = (int*)take((size_t)NT * 8 * 4); rp.wts = (float*)take((size_t)NT * 8 * 4);
    rp.kc = (float*)take((size_t)NB * NCMP * 2 * 64 * 4); rp.vc = (float*)take((size_t)NB * NCMP * 2 * 64 * 4);
    double* acc = (double*)take(4096);
    if (off > ws_size) { fprintf(stderr, "dev: workspace too small: need %zu have %zu\n", off, ws_size); return; }
    p.xoff = 0;
    (void)hipMemsetAsync(p.ws + wsl::O_ctl, 0, 65536, stream);
    (void)hipMemsetAsync(acc, 0, 4096, stream);
    using namespace refp;
    const int G = 2048;
    launch_phase<PH_MOD>(rp, 0, 48, stream);
    launch_phase<PH_NORM_A>(rp, 0, G, stream);
    launch_phase<PH_GEMM_Z>(rp, 0, G, stream);
    launch_phase<PH_PREP>(rp, 0, G, stream);
    p.conv_l_lo = 0; p.conv_l_hi = 0;
    launch_opt(p, OPH_PROLOGUE, OPH_PROLOGUE + 1, 0, 1, stream);
    launch_opt(p, OPH_NORM0, OPH_NORM0 + 1, 0, 1, stream);
    launch_opt(p, OPH_Z, OPH_Z + 1, 0, 1, stream);
    launch_opt(p, OPH_CMP1, OPH_CMP1 + 1, 0, 1, stream);
    int g = 0;
    cmp(p.qn(), 0, 512, rp.qn, 512, 512, NT, T_NONE, 0.125f, acc, g++, stream);
    cmp(p.qr(), 0, 512, rp.qr, 512, 512, NT, T_NONE, 0.125f, acc, g++, stream);
    cmp(p.kvraw(), 0, 256, rp.z + ZKC, INC, 256, NT, T_NONE, 1.f, acc, g++, stream);
    cmp(p.ksv(), 0, 256, rp.ks, 128, 128, NT, T_NONE, 1.f, acc, g++, stream);
    cmp(p.ksv() + 128, 0, 256, rp.z + ZVS, INC, 128, NT, T_NONE, 1.f, acc, g++, stream);
    cmp(p.kwv(), 0, 256, rp.kw, 128, 128, NT, T_NONE, 1.f, acc, g++, stream);
    cmp(p.kwv() + 128, 0, 256, rp.z + ZVW, INC, 128, NT, T_NONE, 1.f, acc, g++, stream);
    cmp(p.u(), 0, 512, rp.z + ZU, INC, 512, NT, T_GELU, 1.f, acc, g++, stream);
    cmp(p.v(), 0, 512, rp.z + ZV, INC, 512, NT, T_GELU, 1.f, acc, g++, stream);
    cmp(p.sga(), 0, 1024, rp.z + ZGA, INC, 1024, NT, T_SIGMOID, 1.f, acc, g++, stream);
    cmp(p.sgb(), 0, 1024, rp.z + ZGB, INC, 1024, NT, T_SIGMOID, 1.f, acc, g++, stream);
    cmp(p.gates(), 1, 32, rp.z + ZG, INC, 24, NT, T_SIGMOID, 1.f, acc, g++, stream);
    cmp(p.h(), 0, 1024, rp.h, 1024, 1024, NT, T_NONE, 1.f, acc, g++, stream);
    launch_opt(p, OPH_CMP2, OPH_CMP2 + 1, 0, 1, stream);
    for (int b = 0; b < NB; ++b) { cmp(p.kc() + (size_t)b * 256 * 128, 0, 128, rp.kc + (size_t)b * 255 * 128, 128, 128, 255, T_NONE, 1.f, acc, g, stream);
                                   cmp(p.vc() + (size_t)b * 256 * 128, 0, 128, rp.vc + (size_t)b * 255 * 128, 128, 128, 255, T_NONE, 1.f, acc, g + 1, stream); }
    g += 2;
    launch_phase<PH_ATTN>(rp, 0, 2048, stream);
    cmp(p.ogm(), 0, 512, rp.ogm, 512, 512, NT, T_NONE, 1.f, acc, g++, stream);
    launch_opt(p, OPH_ATTN, OPH_ATTN + 1, 0, 1, stream);
    cmp(p.onsa(), 0, 512, rp.onsa, 512, 512, NT, T_NONE, 1.f, acc, g++, stream);
    launch_phase<PH_PROJ>(rp, 0, G, stream);
    launch_phase<PH_OUT>(rp, 0, G, stream);
    launch_opt(p, OPH_PROJ, OPH_PROJ + 1, 0, 1, stream);
    cmp(p.merged(), 0, 1024, rp.ya, 1024, 1024, NT, T_NONE, 1.f, acc, g++, stream);
    launch_opt(p, OPH_OUT, OPH_OUT + 1, 0, 1, stream);
    cmp(p.xres, 1, 1024, rp.out, 1024, 1024, NT, T_NONE, 1.f, acc, g++, stream);
    launch_phase<PH_NORM_F>(rp, 0, G, stream);
    launch_opt(p, OPH_NORMF, OPH_NORMF + 1, 0, 1, stream);
    cmp(p.h(), 0, 1024, rp.h, 1024, 1024, NT, T_NONE, 1.f, acc, g++, stream);
    p.conv_l_lo = 0; p.conv_l_hi = 1;
    launch_opt(p, OPH_PROLOGUE, OPH_PROLOGUE + 1, 0, 1, stream);
    launch_opt(p, OPH_ROUTER, OPH_ROUTER + 1, 0, 1, stream);
    launch_opt(p, OPH_TOPK, OPH_TOPK + 1, 0, 1, stream);
    launch_opt(p, OPH_PLACE, OPH_PLACE + 1, 0, 1, stream);
    launch_opt(p, OPH_EGU, OPH_EGU + 1, 0, 1, stream);
    launch_opt(p, OPH_EDOWN, OPH_EDOWN + 1, 0, 1, stream);
    launch_opt(p, OPH_COMBINE, OPH_COMBINE + 1, 0, 1, stream);
    launch_phase<PH_NORM_F>(rp, 0, G, stream);
    launch_phase<PH_ROUTER>(rp, 0, G, stream);
    launch_phase<PH_TOPK>(rp, 0, G, stream);
    launch_phase<PH_SCAN>(rp, 0, G, stream);
    launch_phase<PH_PLACE>(rp, 0, G, stream);
    launch_phase<PH_EGATE>(rp, 0, G, stream);
    launch_phase<PH_EUP>(rp, 0, G, stream);
    launch_phase<PH_EDOWN>(rp, 0, G, stream);
    launch_phase<PH_FINAL>(rp, 0, G, stream);
    cmp(p.xres, 1, 1024, rp.out, 1024, 1024, NT, T_NONE, 1.f, acc, g++, stream);
    for (int l = 1; l < NL; ++l) {
        launch_phase<PH_NORM_A>(rp, l, G, stream); launch_phase<PH_GEMM_Z>(rp, l, G, stream); launch_phase<PH_PREP>(rp, l, G, stream); launch_phase<PH_ATTN>(rp, l, 2048, stream);
        launch_phase<PH_PROJ>(rp, l, G, stream); launch_phase<PH_OUT>(rp, l, G, stream); launch_phase<PH_NORM_F>(rp, l, G, stream); launch_phase<PH_ROUTER>(rp, l, G, stream);
        launch_phase<PH_TOPK>(rp, l, G, stream); launch_phase<PH_SCAN>(rp, l, G, stream); launch_phase<PH_PLACE>(rp, l, G, stream); launch_phase<PH_EGATE>(rp, l, G, stream);
        launch_phase<PH_EUP>(rp, l, G, stream); launch_phase<PH_EDOWN>(rp, l, G, stream); launch_phase<PH_FINAL>(rp, l, G, stream);
    }
    hipLaunchKernelGGL(k_final, dim3(2048), dim3(256), 0, stream, p.out, (size_t)NT * ND, acc, g, (int)DEV_ONLY);
#else
    p.ws = w; p.xres = p.out; p.xoff = 0;
    if (wsl::O_TOTAL > ws_size) { fprintf(stderr, "workspace too small: need %zu have %zu\n", (size_t)wsl::O_TOTAL, ws_size); return; }
    p.conv_l_lo = 0; p.conv_l_hi = NL;
    (void)hipMemsetAsync(p.ws + wsl::O_ctl, 0, 65536, stream);
    launch_opt(p, 0, OPH_END, 0, NL, stream);
#ifdef TSTAMP
    hipLaunchKernelGGL(k_probe, dim3(2048), dim3(256), 0, stream, p.out, (size_t)NT * ND, (const unsigned long long*)(p.ws + wsl::O_ctl + 32768), (int)TS_A0, (int)TS_A1, (int)TS_B0, (int)TS_B1);
#endif
#endif
}
```

```cpp
#define DEV_CHECK 0
#include <hip/hip_runtime.h>
#include <stdint.h>
#include <string.h>
#include <stdio.h>

#ifndef DEV_CHECK
#define DEV_CHECK 0
#endif

#define NB 8
#define NS 4096
#define ND 1024
#define NT (NB * NS)
#define NL 2
#define INC 4376
#define NCMP 255
#define NE 256
#define MAXROWS 294912
#define MAXBLK 2304
#define ZQ 0
#define ZKC 512
#define ZVC 640
#define ZKS 768
#define ZVS 896
#define ZKW 1024
#define ZVW 1152
#define ZG 1280
#define ZU 1304
#define ZV 1816
#define ZGA 2328
#define ZGB 3352

#define LAS __attribute__((address_space(3)))
#define GAS __attribute__((address_space(1)))
typedef unsigned short bf16_t;
typedef short bf16x8 __attribute__((ext_vector_type(8)));
typedef short s16x4 __attribute__((ext_vector_type(4)));
typedef float f32x2 __attribute__((ext_vector_type(2)));
typedef float f32x4 __attribute__((ext_vector_type(4)));
typedef float f32x16 __attribute__((ext_vector_type(16)));
typedef unsigned u32x2 __attribute__((ext_vector_type(2)));
typedef unsigned u32x4 __attribute__((ext_vector_type(4)));
#define XB_TMO      128
#define XB_XCNT(j)  (256  + 64 * (j))
#define XB_XSUB(j)  (1280 + 64 * (j))
#define XB_XGEN(j)  (2304 + 64 * (j))
#define XB_TOP      3328
#define XB_TOPGEN   3392
#define XCD_BAR_WORDS 3456
#define XB_SPIN_CAP (1u << 22)
#define LAS __attribute__((address_space(3)))

__device__ __forceinline__ unsigned xb_ld(unsigned* p)              { return __hip_atomic_load(p, __ATOMIC_RELAXED, __HIP_MEMORY_SCOPE_AGENT); }
__device__ __forceinline__ unsigned xb_add(unsigned* p, unsigned v) { return __hip_atomic_fetch_add(p, v, __ATOMIC_RELAXED, __HIP_MEMORY_SCOPE_AGENT); }
__device__ __forceinline__ unsigned xb_xcc_id() { return (unsigned)__builtin_amdgcn_s_getreg((3 << 11) | 20) & 0xFu; }
#define XB_SPIN(cond, bar) do { unsigned _sp = 0; while (cond) { __builtin_amdgcn_s_sleep(1); \
    if ((++_sp & 255u) == 0u) { if (xb_ld(&(bar)[XB_TMO])) break; if (_sp > XB_SPIN_CAP) { atomicAdd(&(bar)[XB_TMO], 1u); break; } } } } while (0)

struct XcdBarrier { unsigned* bar; unsigned x; volatile LAS unsigned* st; };

__device__ __forceinline__ XcdBarrier xcd_barrier_post(unsigned* bar, volatile LAS unsigned* st) {
    XcdBarrier b; b.bar = bar; b.x = xb_xcc_id(); b.st = st;
    if (threadIdx.x == 0) (void)xb_add(&bar[XB_XCNT(b.x)], 1u);
    return b;
}
__device__ __forceinline__ void xcd_barrier_complete(unsigned* bar, unsigned x, unsigned& nloc, unsigned& nx) {
    const unsigned G = gridDim.x * gridDim.y * gridDim.z;
    unsigned sum, cnt, mine, sp = 0u;
    for (;;) {
        sum = 0u; cnt = 0u; mine = 0u;
#pragma unroll
        for (unsigned j = 0; j < 16; ++j) { const unsigned c = xb_ld(&bar[XB_XCNT(j)]); sum += c; cnt += (c > 0u) ? 1u : 0u; mine = (j == x) ? c : mine; }
        if (sum == G) break;
        __builtin_amdgcn_s_sleep(1);
        if ((++sp & 255u) == 0u) { if (xb_ld(&bar[XB_TMO])) break; if (sp > XB_SPIN_CAP) { atomicAdd(&bar[XB_TMO], 1u); break; } }
    }
    nloc = mine > 0u ? mine : 1u; nx = cnt > 0u ? cnt : 1u;
}
__device__ __noinline__ void xcd_barrier(const XcdBarrier b) {
    asm volatile("s_waitcnt vmcnt(0)" ::: "memory");
    __syncthreads();
    if (threadIdx.x == 0) {
        unsigned* bar = b.bar;
        __builtin_amdgcn_s_waitcnt(0);
        unsigned nloc = b.st[0], nx = b.st[1];
        if (nloc == 0u) { xcd_barrier_complete(bar, b.x, nloc, nx); b.st[0] = nloc; b.st[1] = nx; }
        const unsigned old = xb_add(&bar[XB_XSUB(b.x)], 1u);
        const unsigned gen = old / nloc;
        if (old + 1u == (gen + 1u) * nloc) {
            __builtin_amdgcn_fence(__ATOMIC_RELEASE, "agent");
            asm volatile("s_waitcnt vmcnt(0)" ::: "memory");
            const unsigned og = xb_add(&bar[XB_TOP], 1u);
            const unsigned tg = og / nx;
            if (og + 1u == (tg + 1u) * nx) xb_add(&bar[XB_TOPGEN], 1u);
            else XB_SPIN(xb_ld(&bar[XB_TOPGEN]) == tg, bar);
            __builtin_amdgcn_fence(__ATOMIC_ACQUIRE, "agent");
            xb_add(&bar[XB_XGEN(b.x)], 1u);
            asm volatile("s_waitcnt vmcnt(0)" ::: "memory");
        } else {
            XB_SPIN(xb_ld(&bar[XB_XGEN(b.x)]) == gen, bar);
            __builtin_amdgcn_fence(__ATOMIC_ACQUIRE, "agent");
            asm volatile("s_waitcnt vmcnt(0)" ::: "memory");
        }
    }
    __syncthreads();
}

__device__ __forceinline__ int tid_() { int t = threadIdx.x; asm volatile("" : "+v"(t)); return t; }
__device__ __forceinline__ float sigmoidf_(float x) { return 1.0f / (1.0f + expf(-x)); }
__device__ __forceinline__ float siluf_(float x) { return x / (1.0f + expf(-x)); }
__device__ __forceinline__ float geluf_(float x) { return 0.5f * x * (1.0f + tanhf(0.7978845608028654f * (x + 0.044715f * x * x * x))); }
__device__ __forceinline__ float wave_sum(float v) {
#pragma unroll
    for (int o = 32; o >= 1; o >>= 1) v += __shfl_xor(v, o);
    return v;
}

#if DEV_CHECK
namespace refp {
struct Params {
    const float *x, *c; const int* pos;
    const float *w_mod, *b_mod, *w_in, *q_gain, *k_gain, *pe_k, *pe_v, *w1k, *w2k, *w1v, *w2v, *ln_g, *ln_b, *gm_ws, *gm_bs,
                *wpn, *wpg, *w_out, *w_router, *b_router, *wge, *wue, *wde, *wgs, *wus, *wds;
    float* out;
    float *mod, *h, *z, *qn, *qr, *ks, *kw, *kc, *vc, *onsa, *vn, *ogm, *ya;
    float *logits, *gs, *sact, *shout, *routed, *ag, *act, *row_w, *wts;
    int *idx, *counts, *cursor, *pad_start, *row_tok, *blk_e;
    unsigned* bar;
};


enum { M_STORE = 0, M_RESID = 1, M_SILU_MUL = 2, M_SIG_SET = 3, M_SIG_ADD = 4, M_SCATTER = 5 };
struct GemmArgs {
    const float* A; int lda; const int* gather;
    const float* Bm; int ldb; size_t strideB; const int* blk_e;
    float* C; int ldc; int M, N, K;
    const float* aux; int ldaux; const float* aux2;
};

template <int MODE, bool GATHER>
__device__ __forceinline__ void sgemm(const GemmArgs& g, float* smem, int bid, int nb) {
    float (*As)[128] = (float (*)[128])smem;
    float (*Bs)[128] = (float (*)[128])(smem + 16 * 128);
    const int tid = tid_(), tx = tid & 15, ty = tid >> 4;
    const int ntn = (g.N + 127) / 128, ntm = g.M / 128, ntiles = ntm * ntn;
    for (int tile = bid; tile < ntiles; tile += nb) {
        const int tm = tile / ntn, tn = tile % ntn;
        const int row0 = tm * 128, col0 = tn * 128;
        const float* Bp = g.Bm;
        if (g.blk_e) { const int e = g.blk_e[tm]; if (e < 0) continue; Bp += (size_t)e * g.strideB; }
        float acc[8][8];
#pragma unroll
        for (int i = 0; i < 8; ++i)
#pragma unroll
            for (int j = 0; j < 8; ++j) acc[i][j] = 0.f;
        const float* arow[2];
#pragma unroll
        for (int i = 0; i < 2; ++i) {
            const int id = tid + i * 256, r = id >> 2;
            int srow = row0 + r;
            if (GATHER) { srow = g.gather[row0 + r]; srow = srow < 0 ? 0 : srow; }
            arow[i] = g.A + (size_t)srow * g.lda + (id & 3) * 4;
        }
        for (int k0 = 0; k0 < g.K; k0 += 16) {
            float4 av[2], bv[2];
#pragma unroll
            for (int i = 0; i < 2; ++i) av[i] = *(const float4*)(arow[i] + k0);
#pragma unroll
            for (int i = 0; i < 2; ++i) {
                const int id = tid + i * 256, kr = id >> 5, cq = (id & 31) * 4, cc = col0 + cq;
                if (cc < g.N) bv[i] = *(const float4*)(Bp + (size_t)(k0 + kr) * g.ldb + cc);
                else bv[i] = make_float4(0.f, 0.f, 0.f, 0.f);
            }
            __syncthreads();
#pragma unroll
            for (int i = 0; i < 2; ++i) {
                const int id = tid + i * 256, r = id >> 2, kq = (id & 3) * 4;
                As[kq + 0][r] = av[i].x; As[kq + 1][r] = av[i].y; As[kq + 2][r] = av[i].z; As[kq + 3][r] = av[i].w;
                const int kr = id >> 5, cq = (id & 31) * 4;
                *(float4*)&Bs[kr][cq] = bv[i];
            }
            __syncthreads();
#pragma unroll
            for (int k = 0; k < 16; ++k) {
                const float4 a0 = *(const float4*)&As[k][ty * 4], a1 = *(const float4*)&As[k][64 + ty * 4];
                const float4 b0 = *(const float4*)&Bs[k][tx * 4], b1 = *(const float4*)&Bs[k][64 + tx * 4];
                const float a[8] = {a0.x, a0.y, a0.z, a0.w, a1.x, a1.y, a1.z, a1.w};
                const float b[8] = {b0.x, b0.y, b0.z, b0.w, b1.x, b1.y, b1.z, b1.w};
#pragma unroll
                for (int i = 0; i < 8; ++i)
#pragma unroll
                    for (int j = 0; j < 8; ++j) acc[i][j] = fmaf(a[i], b[j], acc[i][j]);
            }
        }
#pragma unroll
        for (int i = 0; i < 8; ++i) {
            const int r = row0 + (i < 4 ? ty * 4 + i : 64 + ty * 4 + (i - 4));
            int tok = 0; float rw = 0.f;
            if (MODE == M_SCATTER) { tok = g.gather[r]; rw = g.aux[r]; if (tok < 0) continue; }
#pragma unroll
            for (int jh = 0; jh < 2; ++jh) {
                const int cidx = col0 + jh * 64 + tx * 4;
                if (cidx >= g.N) continue;
                float4 v = make_float4(acc[i][jh * 4 + 0], acc[i][jh * 4 + 1], acc[i][jh * 4 + 2], acc[i][jh * 4 + 3]);
                if (MODE == M_STORE) {
                    *(float4*)(g.C + (size_t)r * g.ldc + cidx) = v;
                } else if (MODE == M_RESID) {
                    const float4 rr = *(const float4*)(g.aux + (size_t)r * g.ldaux + cidx);
                    const float4 gt = *(const float4*)(g.aux2 + (size_t)(r >> 12) * 6144 + cidx);
                    v.x = rr.x + gt.x * v.x; v.y = rr.y + gt.y * v.y; v.z = rr.z + gt.z * v.z; v.w = rr.w + gt.w * v.w;
                    *(float4*)(g.C + (size_t)r * g.ldc + cidx) = v;
                } else if (MODE == M_SILU_MUL) {
                    const float4 a = *(const float4*)(g.aux + (size_t)r * g.ldaux + cidx);
                    v.x *= siluf_(a.x); v.y *= siluf_(a.y); v.z *= siluf_(a.z); v.w *= siluf_(a.w);
                    *(float4*)(g.C + (size_t)r * g.ldc + cidx) = v;
                } else if (MODE == M_SIG_SET || MODE == M_SIG_ADD) {
                    const float4 a = *(const float4*)(g.aux + (size_t)r * g.ldaux + cidx);
                    v.x *= sigmoidf_(a.x); v.y *= sigmoidf_(a.y); v.z *= sigmoidf_(a.z); v.w *= sigmoidf_(a.w);
                    float4* cp = (float4*)(g.C + (size_t)r * g.ldc + cidx);
                    if (MODE == M_SIG_ADD) { const float4 o = *cp; v.x += o.x; v.y += o.y; v.z += o.z; v.w += o.w; }
                    *cp = v;
                } else if (MODE == M_SCATTER) {
                    float* cp = g.C + (size_t)tok * g.ldc + cidx;
                    atomicAdd(cp + 0, rw * v.x); atomicAdd(cp + 1, rw * v.y); atomicAdd(cp + 2, rw * v.z); atomicAdd(cp + 3, rw * v.w);
                }
            }
        }
    }
}

__device__ __forceinline__ void ph_mod(const Params& p, float* smem, int bid, int nb) {
    for (int i = tid_(); i < NB * ND; i += 256) smem[i] = siluf_(p.c[i]);
    __syncthreads();
    for (int it = bid * 256 + tid_(); it < NL * 6144; it += nb * 256) {
        const int l = it / 6144, j = it % 6144;
        float acc[NB];
#pragma unroll
        for (int b = 0; b < NB; ++b) acc[b] = 0.f;
        const float* w = p.w_mod + (size_t)l * ND * 6144 + j;
        for (int d = 0; d < ND; ++d) {
            const float wv = w[(size_t)d * 6144];
#pragma unroll
            for (int b = 0; b < NB; ++b) acc[b] = fmaf(smem[b * ND + d], wv, acc[b]);
        }
        const float bb = p.b_mod[l * 6144 + j];
#pragma unroll
        for (int b = 0; b < NB; ++b) p.mod[((size_t)l * NB + b) * 6144 + j] = acc[b] + bb;
    }
    __syncthreads();
}

__device__ __forceinline__ void ph_norm(const Params& p, const float* xin, int l, int sh_off, int sc_off, int bid, int nb) {
    const int lane = tid_() & 63, w = tid_() >> 6;
    for (int t = bid * 4 + w; t < NT; t += nb * 4) {
        const float* xr = xin + (size_t)t * ND;
        float4 v[4]; float ss = 0.f;
#pragma unroll
        for (int i = 0; i < 4; ++i) { v[i] = *(const float4*)(xr + i * 256 + lane * 4); ss += v[i].x * v[i].x + v[i].y * v[i].y + v[i].z * v[i].z + v[i].w * v[i].w; }
        ss = wave_sum(ss);
        const float rstd = rsqrtf(ss * (1.0f / ND) + 1e-6f);
        const float* mb = p.mod + ((size_t)l * NB + (t >> 12)) * 6144;
#pragma unroll
        for (int i = 0; i < 4; ++i) {
            const int cidx = i * 256 + lane * 4;
            const float4 sc = *(const float4*)(mb + sc_off + cidx), sh = *(const float4*)(mb + sh_off + cidx);
            float4 o;
            o.x = v[i].x * rstd * (1.f + sc.x) + sh.x; o.y = v[i].y * rstd * (1.f + sc.y) + sh.y;
            o.z = v[i].z * rstd * (1.f + sc.z) + sh.z; o.w = v[i].w * rstd * (1.f + sc.w) + sh.w;
            *(float4*)(p.h + (size_t)t * ND + cidx) = o;
        }
    }
}

__device__ __forceinline__ void ph_prep(const Params& p, int l, int bid, int nb) {
    const int lane = tid_() & 63, w = tid_() >> 6;
    const int i32 = lane & 31;
    const float inv = (float)pow(10000.0, -(double)i32 / 32.0);
    for (long it = (long)bid * 4 + w; it < (long)NT * 12; it += (long)nb * 4) {
        const int t = (int)(it / 12), hv = (int)(it % 12);
        int zc; const float* gain; float* dst; float* dst_norot = nullptr;
        if (hv < 8) { zc = ZQ + hv * 64; gain = p.q_gain + l * 64; dst = p.qr + (size_t)t * 512 + hv * 64; dst_norot = p.qn + (size_t)t * 512 + hv * 64; }
        else if (hv < 10) { zc = ZKS + (hv - 8) * 64; gain = p.k_gain + l * 64; dst = p.ks + (size_t)t * 128 + (hv - 8) * 64; }
        else { zc = ZKW + (hv - 10) * 64; gain = p.k_gain + l * 64; dst = p.kw + (size_t)t * 128 + (hv - 10) * 64; }
        const float v = p.z[(size_t)t * INC + zc + lane];
        const float ss = wave_sum(v * v);
        const float y = v * rsqrtf(ss * (1.0f / 64.f) + 1e-6f) * gain[lane];
        if (dst_norot) dst_norot[lane] = y;
        const float ang = (float)p.pos[t] * inv;
        const float cs = cosf(ang), sn = sinf(ang);
        const float other = __shfl_xor(y, 32);
        const float r = lane < 32 ? (y * cs - other * sn) : (y * cs + other * sn);
        dst[lane] = r;
    }
}

__device__ __forceinline__ void ph_compress(const Params& p, int l, float* smem, int bid, int nb) {
    float* A = smem;
    float* hid = smem + 2048;
    float* red = smem + 2048 + 256;
    const int tid = tid_();
    for (int u = bid; u < 2 * NB * NCMP * 2; u += nb) {
        const int kv = u / (NB * NCMP * 2), r = u % (NB * NCMP * 2), b = r / (NCMP * 2), n = (r / 2) % NCMP, hh = r & 1;
        const float* pe = (kv ? p.pe_v : p.pe_k) + l * 2048;
        const float* w1 = (kv ? p.w1v : p.w1k) + (size_t)l * 2048 * 256;
        const float* w2 = (kv ? p.w2v : p.w2k) + (size_t)l * 256 * 64;
        const int zc = (kv ? ZVC : ZKC) + hh * 64;
        __syncthreads();
        for (int k = tid; k < 2048; k += 256) { const int li = k >> 6, d = k & 63; A[k] = p.z[((size_t)b * NS + 16 * n + li) * INC + zc + d] + pe[k]; }
        __syncthreads();
        float acc = 0.f;
        for (int k = 0; k < 2048; ++k) acc = fmaf(A[k], w1[(size_t)k * 256 + tid], acc);
        hid[tid] = geluf_(acc);
        __syncthreads();
        if (tid < 64) {
            float o = 0.f;
            for (int f = 0; f < 256; ++f) o = fmaf(hid[f], w2[f * 64 + tid], o);
            float* dst = (kv ? p.vc : p.kc) + (((size_t)b * NCMP + n) * 2 + hh) * 64;
            if (kv) dst[tid] = o;
            else { const float ss = wave_sum(o * o); dst[tid] = o * rsqrtf(ss * (1.f / 64.f) + 1e-6f) * p.k_gain[l * 64 + tid]; }
        }
    }
    __syncthreads();
}

__device__ __forceinline__ void ph_gmln(const Params& p, int l, int bid, int nb) {
    const int lane = tid_() & 63, w = tid_() >> 6;
    for (int t = bid * 4 + w; t < NT; t += nb * 4) {
        float v[8]; float s = 0.f;
#pragma unroll
        for (int i = 0; i < 8; ++i) { v[i] = geluf_(p.z[(size_t)t * INC + ZV + i * 64 + lane]); s += v[i]; }
        const float mu = wave_sum(s) * (1.f / 512.f);
        float q = 0.f;
#pragma unroll
        for (int i = 0; i < 8; ++i) { const float d = v[i] - mu; q += d * d; }
        const float rstd = rsqrtf(wave_sum(q) * (1.f / 512.f) + 1e-6f);
#pragma unroll
        for (int i = 0; i < 8; ++i) { const int cidx = i * 64 + lane; p.vn[(size_t)t * 512 + cidx] = (v[i] - mu) * rstd * p.ln_g[l * 512 + cidx] + p.ln_b[l * 512 + cidx]; }
    }
}

__device__ __forceinline__ void ph_gmmix(const Params& p, int l, float* smem, int bid, int nb) {
    const int tid = tid_(), cidx = tid & 63, w = tid >> 6;
    for (int u = bid; u < 256 * 8; u += nb) {
        const int ch = u >> 3, g = u & 7;
        const size_t base = (size_t)ch * 128;
        __syncthreads();
        for (int i = tid; i < 128 * 64; i += 256) smem[i] = p.vn[(base + (i >> 6)) * 512 + g * 64 + (i & 63)];
        __syncthreads();
        const float* ws = p.gm_ws + ((size_t)l * 8 + g) * 128 * 128;
        for (int tl = w; tl < 128; tl += 4) {
            float acc = 0.f;
            for (int s = 0; s <= tl; ++s) acc = fmaf(ws[tl * 128 + s], smem[s * 64 + cidx], acc);
            const float mixed = acc + p.gm_bs[(l * 8 + g) * 128 + tl];
            const float uu = geluf_(p.z[(base + tl) * INC + ZU + g * 64 + cidx]);
            p.ogm[(base + tl) * 512 + g * 64 + cidx] = uu * mixed;
        }
    }
    __syncthreads();
}

__device__ __forceinline__ float dot32(const float (&q)[32], const float* k) {
    float s = 0.f;
#pragma unroll
    for (int i = 0; i < 8; ++i) { const float4 kv = *(const float4*)(k + i * 4); s = fmaf(q[i * 4], kv.x, s); s = fmaf(q[i * 4 + 1], kv.y, s); s = fmaf(q[i * 4 + 2], kv.z, s); s = fmaf(q[i * 4 + 3], kv.w, s); }
    s += __shfl_xor(s, 1);
    return s;
}
__device__ __forceinline__ void axpy32(float (&o)[32], float e, const float* v) {
#pragma unroll
    for (int i = 0; i < 8; ++i) { const float4 vv = *(const float4*)(v + i * 4); o[i * 4] = fmaf(e, vv.x, o[i * 4]); o[i * 4 + 1] = fmaf(e, vv.y, o[i * 4 + 1]); o[i * 4 + 2] = fmaf(e, vv.z, o[i * 4 + 2]); o[i * 4 + 3] = fmaf(e, vv.w, o[i * 4 + 3]); }
}

__device__ __forceinline__ void ph_attn(const Params& p, int l, float* smem, int bid, int nb) {
    float* imp = smem;
    unsigned long long* selm = (unsigned long long*)(smem + 2048);
    const int tid = tid_(), ql = tid >> 3, g = (tid >> 1) & 3, hf = tid & 1;
    const float scale = 0.125f;
    for (int unit = bid; unit < 2048; unit += nb) {
        const int qb = 63 - (unit >> 5), b = (unit & 31) >> 2, kvh = (unit >> 1) & 1, qh = unit & 1;
        const int qi = qh * 32 + ql;
        const int t = qb * 64 + qi, hq = kvh * 4 + g;
        const size_t tok = (size_t)b * NS + t;
        float q[32], o[32];
        const float gate0 = sigmoidf_(p.z[tok * INC + ZG + hq * 3 + 0]), gate1 = sigmoidf_(p.z[tok * INC + ZG + hq * 3 + 1]), gate2 = sigmoidf_(p.z[tok * INC + ZG + hq * 3 + 2]);
        float* outp = p.onsa + tok * 512 + hq * 64 + hf * 32;
        const int ho = kvh * 64 + hf * 32;
#pragma unroll
        for (int i = 0; i < 8; ++i) { const float4 v = *(const float4*)(p.qn + tok * 512 + hq * 64 + hf * 32 + i * 4); q[i * 4] = v.x; q[i * 4 + 1] = v.y; q[i * 4 + 2] = v.z; q[i * 4 + 3] = v.w; }
        int nvis = t >= 31 ? (t - 31) / 16 + 1 : 0; if (nvis > NCMP) nvis = NCMP;
        const float* kcb = p.kc + (size_t)b * NCMP * 128 + ho;
        const float* vcb = p.vc + (size_t)b * NCMP * 128 + ho;
        float m = -INFINITY;
        for (int n = 0; n < nvis; ++n) { const float s = dot32(q, kcb + n * 128) * scale; m = fmaxf(m, s); }
        float lsum = 0.f;
#pragma unroll
        for (int i = 0; i < 32; ++i) o[i] = 0.f;
        for (int n = 0; n < nvis; ++n) { const float s = dot32(q, kcb + n * 128) * scale; const float e = expf(s - m); lsum += e; axpy32(o, e, vcb + n * 128); }
        const float inv = 1.0f / fmaxf(lsum, 1e-30f);
#pragma unroll
        for (int i = 0; i < 8; ++i) *(float4*)(outp + i * 4) = make_float4(gate0 * o[i * 4] * inv, gate0 * o[i * 4 + 1] * inv, gate0 * o[i * 4 + 2] * inv, gate0 * o[i * 4 + 3] * inv);
        __syncthreads();
        for (int j = 0; j <= qb; ++j) {
            float a = 0.f;
            for (int n = 4 * j - 1; n <= 4 * j + 3; ++n) if (n >= 0 && n < nvis) { const float s = dot32(q, kcb + n * 128) * scale; a += expf(s - m) * inv; }
            a += __shfl_xor(a, 2); a += __shfl_xor(a, 4);
            if (g == 0 && hf == 0) imp[ql * 64 + j] = a;
        }
        __syncthreads();
        if (g == 0 && hf == 0) {
            unsigned long long mask = 0ull;
            for (int it = 0; it < 16; ++it) {
                int best = -1; float bv = 0.f;
                for (int j = 0; j < 64; ++j) {
                    if ((mask >> j) & 1ull) continue;
                    const bool forced = (j == 0) || (j == qb) || (j == qb - 1);
                    const float v = forced ? INFINITY : (j <= qb ? imp[ql * 64 + j] : -INFINITY);
                    if (best < 0 || v > bv) { best = j; bv = v; }
                }
                mask |= 1ull << best;
            }
            selm[ql] = mask;
        }
        __syncthreads();
        const unsigned long long mask = selm[ql];
#pragma unroll
        for (int i = 0; i < 8; ++i) { const float4 v = *(const float4*)(p.qr + tok * 512 + hq * 64 + hf * 32 + i * 4); q[i * 4] = v.x; q[i * 4 + 1] = v.y; q[i * 4 + 2] = v.z; q[i * 4 + 3] = v.w; }
        {
            float mm = -INFINITY, ll = 0.f;
#pragma unroll
            for (int i = 0; i < 32; ++i) o[i] = 0.f;
            for (int j = 0; j <= qb; ++j) {
                if (!((mask >> j) & 1ull)) continue;
                for (int s = 0; s < 64; ++s) {
                    const int tk = j * 64 + s; if (tk > t) break;
                    const size_t kt = (size_t)b * NS + tk;
                    const float sc = dot32(q, p.ks + kt * 128 + ho) * scale;
                    if (sc > mm) { const float corr = expf(mm - sc); ll *= corr;
#pragma unroll
                        for (int i = 0; i < 32; ++i) o[i] *= corr;
                        mm = sc; }
                    const float e = expf(sc - mm); ll += e; axpy32(o, e, p.z + kt * INC + ZVS + ho);
                }
            }
            const float iv = gate1 / fmaxf(ll, 1e-30f);
#pragma unroll
            for (int i = 0; i < 8; ++i) { float4 c = *(float4*)(outp + i * 4); c.x += o[i * 4] * iv; c.y += o[i * 4 + 1] * iv; c.z += o[i * 4 + 2] * iv; c.w += o[i * 4 + 3] * iv; *(float4*)(outp + i * 4) = c; }
        }
        {
            float mm = -INFINITY, ll = 0.f;
#pragma unroll
            for (int i = 0; i < 32; ++i) o[i] = 0.f;
            const int k0 = t - 511 > 0 ? t - 511 : 0;
            for (int tk = k0; tk <= t; ++tk) {
                const size_t kt = (size_t)b * NS + tk;
                const float sc = dot32(q, p.kw + kt * 128 + ho) * scale;
                if (sc > mm) { const float corr = expf(mm - sc); ll *= corr;
#pragma unroll
                    for (int i = 0; i < 32; ++i) o[i] *= corr;
                    mm = sc; }
                const float e = expf(sc - mm); ll += e; axpy32(o, e, p.z + kt * INC + ZVW + ho);
            }
            const float iv = gate2 / fmaxf(ll, 1e-30f);
#pragma unroll
            for (int i = 0; i < 8; ++i) { float4 c = *(float4*)(outp + i * 4); c.x += o[i * 4] * iv; c.y += o[i * 4 + 1] * iv; c.z += o[i * 4 + 2] * iv; c.w += o[i * 4 + 3] * iv; *(float4*)(outp + i * 4) = c; }
        }
    }
    __syncthreads();
}

__device__ __forceinline__ void ph_topk(const Params& p, int l, int bid, int nb) {
    const int lane = tid_() & 63, w = tid_() >> 6;
    for (int t = bid * 4 + w; t < NT; t += nb * 4) {
        float aff[4], key[4]; bool used[4];
#pragma unroll
        for (int i = 0; i < 4; ++i) { const int e = i * 64 + lane; aff[i] = sigmoidf_(p.logits[(size_t)t * NE + e]); key[i] = aff[i] + p.b_router[l * NE + e]; used[i] = false; }
        float topv[8]; int tope[8]; float sum = 0.f;
#pragma unroll
        for (int r = 0; r < 8; ++r) {
            float bv = -INFINITY; int be = 1 << 30; float ba = 0.f;
#pragma unroll
            for (int i = 0; i < 4; ++i) { const int e = i * 64 + lane; if (!used[i] && (key[i] > bv || (key[i] == bv && e < be))) { bv = key[i]; be = e; ba = aff[i]; } }
#pragma unroll
            for (int o = 32; o >= 1; o >>= 1) {
                const float ov = __shfl_xor(bv, o); const int oe = __shfl_xor(be, o); const float oa = __shfl_xor(ba, o);
                if (ov > bv || (ov == bv && oe < be)) { bv = ov; be = oe; ba = oa; }
            }
#pragma unroll
            for (int i = 0; i < 4; ++i) if (i * 64 + lane == be) used[i] = true;
            topv[r] = ba; tope[r] = be; sum += ba;
        }
        if (lane < 8) {
            float tv = 0.f; int te = 0;
#pragma unroll
            for (int r = 0; r < 8; ++r) if (lane == r) { tv = topv[r]; te = tope[r]; }
            p.idx[(size_t)t * 8 + lane] = te;
            p.wts[(size_t)t * 8 + lane] = tv / sum * 2.5f;
            atomicAdd(&p.counts[te], 1);
        }
    }
}

__device__ __forceinline__ void ph_scan(const Params& p, int* ismem, int bid) {
    if (bid != 0) return;
    const int tid = tid_();
    ismem[tid] = (p.counts[tid] + 127) / 128 * 128;
    __syncthreads();
    if (tid == 0) { int run = 0; for (int e = 0; e < NE; ++e) { const int v = ismem[e]; ismem[e] = run; run += v; } ismem[NE] = run; }
    __syncthreads();
    const int st = ismem[tid], en = (tid == NE - 1) ? ismem[NE] : ismem[tid + 1];
    p.pad_start[tid] = st; p.cursor[tid] = 0;
    for (int i = st / 128; i < en / 128; ++i) p.blk_e[i] = tid;
    for (int i = ismem[NE] / 128 + tid; i < MAXBLK; i += 256) p.blk_e[i] = -1;
    __syncthreads();
}

__device__ __forceinline__ void ph_place(const Params& p, int bid, int nb) {
    for (int a = bid * 256 + tid_(); a < NT * 8; a += nb * 256) {
        const int e = p.idx[a];
        const int pos = atomicAdd(&p.cursor[e], 1);
        const int dest = p.pad_start[e] + pos;
        p.row_tok[dest] = a >> 3; p.row_w[dest] = p.wts[a];
    }
}

enum { PH_MOD = 0, PH_NORM_A, PH_GEMM_Z, PH_PREP, PH_ATTN, PH_PROJ, PH_OUT, PH_NORM_F, PH_ROUTER, PH_TOPK, PH_SCAN, PH_PLACE, PH_EGATE, PH_EUP, PH_EDOWN, PH_FINAL, PH_COUNT };

template <int PH>
__device__ __forceinline__ void run_phase(const Params& p, int l, float* smem, int bid, int nb) {
    const float* xin = (l == 0) ? p.x : p.out;
    if constexpr (PH == PH_MOD) { ph_mod(p, smem, bid, nb); }
    else if constexpr (PH == PH_NORM_A) { ph_norm(p, xin, l, 0, 1024, bid, nb); }
    else if constexpr (PH == PH_GEMM_Z) {
        GemmArgs g{}; g.A = p.h; g.lda = ND; g.Bm = p.w_in + (size_t)l * ND * INC; g.ldb = INC; g.C = p.z; g.ldc = INC; g.M = NT; g.N = INC; g.K = ND;
        sgemm<M_STORE, false>(g, smem, bid, nb);
    }
    else if constexpr (PH == PH_PREP) { ph_prep(p, l, bid, nb); ph_compress(p, l, smem, bid, nb); ph_gmln(p, l, bid, nb); }
    else if constexpr (PH == PH_ATTN) { ph_attn(p, l, smem, bid, nb); ph_gmmix(p, l, smem, bid, nb); }
    else if constexpr (PH == PH_PROJ) {
        GemmArgs g{}; g.A = p.onsa; g.lda = 512; g.Bm = p.wpn + (size_t)l * 512 * ND; g.ldb = ND; g.C = p.ya; g.ldc = ND; g.M = NT; g.N = ND; g.K = 512; g.aux = p.z + ZGA; g.ldaux = INC;
        sgemm<M_SIG_SET, false>(g, smem, bid, nb);
        g.A = p.ogm; g.Bm = p.wpg + (size_t)l * 512 * ND; g.aux = p.z + ZGB;
        sgemm<M_SIG_ADD, false>(g, smem, bid, nb);
    }
    else if constexpr (PH == PH_OUT) {
        GemmArgs g{}; g.A = p.ya; g.lda = ND; g.Bm = p.w_out + (size_t)l * ND * ND; g.ldb = ND; g.C = p.out; g.ldc = ND; g.M = NT; g.N = ND; g.K = ND;
        g.aux = xin; g.ldaux = ND; g.aux2 = p.mod + (size_t)l * NB * 6144 + 2048;
        sgemm<M_RESID, false>(g, smem, bid, nb);
    }
    else if constexpr (PH == PH_NORM_F) {
        ph_norm(p, p.out, l, 3072, 4096, bid, nb);
        for (size_t i = (size_t)bid * 256 + tid_(); i < (size_t)NT * ND / 4; i += (size_t)nb * 256) ((float4*)p.routed)[i] = make_float4(0.f, 0.f, 0.f, 0.f);
        for (int i = bid * 256 + tid_(); i < MAXROWS; i += nb * 256) { p.row_tok[i] = -1; p.row_w[i] = 0.f; }
        if (bid == 0) p.counts[tid_()] = 0;
    }
    else if constexpr (PH == PH_ROUTER) {
        GemmArgs g{}; g.A = p.h; g.lda = ND; g.Bm = p.w_router + (size_t)l * ND * NE; g.ldb = NE; g.C = p.logits; g.ldc = NE; g.M = NT; g.N = NE; g.K = ND;
        sgemm<M_STORE, false>(g, smem, bid, nb);
        g.Bm = p.wgs + (size_t)l * ND * 256; g.C = p.gs;
        sgemm<M_STORE, false>(g, smem, bid, nb);
    }
    else if constexpr (PH == PH_TOPK) {
        ph_topk(p, l, bid, nb);
        GemmArgs g{}; g.A = p.h; g.lda = ND; g.Bm = p.wus + (size_t)l * ND * 256; g.ldb = 256; g.C = p.sact; g.ldc = 256; g.M = NT; g.N = 256; g.K = ND; g.aux = p.gs; g.ldaux = 256;
        sgemm<M_SILU_MUL, false>(g, smem, bid, nb);
    }
    else if constexpr (PH == PH_SCAN) {
        ph_scan(p, (int*)smem, bid);
        GemmArgs g{}; g.A = p.sact; g.lda = 256; g.Bm = p.wds + (size_t)l * 256 * ND; g.ldb = ND; g.C = p.shout; g.ldc = ND; g.M = NT; g.N = ND; g.K = 256;
        sgemm<M_STORE, false>(g, smem, bid, nb);
    }
    else if constexpr (PH == PH_PLACE) { ph_place(p, bid, nb); }
    else if constexpr (PH == PH_EGATE) {
        GemmArgs g{}; g.A = p.h; g.lda = ND; g.gather = p.row_tok; g.Bm = p.wge + (size_t)l * NE * ND * 256; g.ldb = 256; g.strideB = (size_t)ND * 256; g.blk_e = p.blk_e;
        g.C = p.ag; g.ldc = 256; g.M = MAXROWS; g.N = 256; g.K = ND;
        sgemm<M_STORE, true>(g, smem, bid, nb);
    }
    else if constexpr (PH == PH_EUP) {
        GemmArgs g{}; g.A = p.h; g.lda = ND; g.gather = p.row_tok; g.Bm = p.wue + (size_t)l * NE * ND * 256; g.ldb = 256; g.strideB = (size_t)ND * 256; g.blk_e = p.blk_e;
        g.C = p.act; g.ldc = 256; g.M = MAXROWS; g.N = 256; g.K = ND; g.aux = p.ag; g.ldaux = 256;
        sgemm<M_SILU_MUL, true>(g, smem, bid, nb);
    }
    else if constexpr (PH == PH_EDOWN) {
        GemmArgs g{}; g.A = p.act; g.lda = 256; g.gather = p.row_tok; g.Bm = p.wde + (size_t)l * NE * 256 * ND; g.ldb = ND; g.strideB = (size_t)256 * ND; g.blk_e = p.blk_e;
        g.C = p.routed; g.ldc = ND; g.M = MAXROWS; g.N = ND; g.K = 256; g.aux = p.row_w;
        sgemm<M_SCATTER, false>(g, smem, bid, nb);
    }
    else if constexpr (PH == PH_FINAL) {
        const float* gt = p.mod + (size_t)l * NB * 6144 + 5120;
        for (size_t i = (size_t)bid * 256 + tid_(); i < (size_t)NT * ND / 4; i += (size_t)nb * 256) {
            const size_t e0 = i * 4; const int r = (int)(e0 >> 10), cidx = (int)(e0 & 1023);
            const float4 g4 = *(const float4*)(gt + (size_t)(r >> 12) * 6144 + cidx);
            const float4 a = ((const float4*)p.routed)[i], s = ((const float4*)p.shout)[i]; float4 o = ((float4*)p.out)[i];
            o.x += g4.x * (a.x + s.x); o.y += g4.y * (a.y + s.y); o.z += g4.z * (a.z + s.z); o.w += g4.w * (a.w + s.w);
            ((float4*)p.out)[i] = o;
        }
    }
}


#define SMEM_FLOATS 8192
template <int PH>
__global__ void __launch_bounds__(256, 2) k_phase(Params p, int l) {
    __shared__ float smem[SMEM_FLOATS];
    run_phase<PH>(p, l, smem, blockIdx.x, gridDim.x);
}
template <int PH> static void launch_phase(const Params& p, int l, int grid, hipStream_t s) { hipLaunchKernelGGL(k_phase<PH>, dim3(grid), dim3(256), 0, s, p, l); }
}
#endif
namespace pg8 {
constexpr int BM = 256, BK = 64, HALF = 128, HTB = HALF * BK * 2, STAGE_BYTES = 8 * HTB;

__host__ __device__ __forceinline__ int lds_byte(int r, int c) { const int st = (r >> 4) * 2 + (c >> 5), rr = r & 15, cc = c & 31, ob = rr * 64 + cc * 2; return st * 1024 + (ob ^ (((ob >> 9) & 1) << 5)); }
__host__ __device__ __forceinline__ void stage_rc(int b, int& R, int& C) { const int st = b / 1024, sb = b % 1024, swz = sb ^ (((sb >> 9) & 1) << 5); R = (st >> 1) * 16 + swz / 64; C = (st & 1) * 32 + (swz % 64) / 2; }
__host__ __device__ __forceinline__ int perm32(int rho) { const int n = rho >> 4, i = rho & 15; return 8 * (i >> 2) + 4 * n + (i & 3); }

struct Unit { int pm, pn, e; };

__device__ __forceinline__ const char* uptr(const char* p) { return p; }
__device__ __forceinline__ unsigned cvt_pk_bf16(float lo, float hi) { unsigned r; asm volatile("v_cvt_pk_bf16_f32 %0, %1, %2" : "=v"(r) : "v"(lo), "v"(hi)); return r; }

typedef long pg8_l2 __attribute__((ext_vector_type(2)));
template <bool F8> __device__ __forceinline__ f32x4 pg8_mma(const bf16x8& b, const bf16x8& a, const f32x4& c) {
    if constexpr (F8) { const pg8_l2 bl = __builtin_bit_cast(pg8_l2, b), al = __builtin_bit_cast(pg8_l2, a);
        f32x4 r = __builtin_amdgcn_mfma_f32_16x16x32_fp8_fp8(bl[0], al[0], c, 0, 0, 0); return __builtin_amdgcn_mfma_f32_16x16x32_fp8_fp8(bl[1], al[1], r, 0, 0, 0); }
    else return __builtin_amdgcn_mfma_f32_16x16x32_bf16(b, a, c, 0, 0, 0);
}
template <class Epi, class Sched, bool ALIGN_EPI = true, bool MID = false, bool F8 = false>
__device__ __forceinline__ void gemm_phase(LAS unsigned char* lds, const Sched& S, const Epi& E) {
    const int tid = tid_(), wid = __builtin_amdgcn_readfirstlane(tid >> 6), lane = tid & 63, wr = wid >> 2, wc = wid & 3, fr = lane & 15, fq = lane >> 4;
    const int K = S.K, nt = K / BK;
    unsigned voffB[2];
#pragma unroll
    for (int i = 0; i < 2; ++i) { int R, C; stage_rc(tid * 16 + i * 8192, R, C); const int Rb = Epi::PERM ? ((R & ~31) + perm32(R & 31)) : R; voffB[i] = (unsigned)(Rb * S.ldb + C) * 2u; }
    const unsigned kstepB = (unsigned)(BK * 2), kstepA = (unsigned)S.kstepA;
    const unsigned hstepB = (unsigned)(HALF * S.ldb * 2);
    const char* const bA = S.a_base(); const char* const bB = S.b_base();
    const unsigned ldsw = (unsigned)wid * 1024u;
    const int aoff = lds_byte(wr * 64 + fr, fq * 8), boff = lds_byte(wc * 32 + fr, fq * 8);
#define PG8_SA(b, h) (((b) * 2 + (h)) * HTB)
#define PG8_SB(b, h) ((4 + (b) * 2 + (h)) * HTB)
#define PG8_STAGE_B(bufoff, gbase) do { _Pragma("unroll") for (int _i = 0; _i < 2; ++_i) \
        __builtin_amdgcn_global_load_lds((const unsigned*)(bB + (unsigned)((gbase) + voffB[_i])), (LAS unsigned*)(lds + (bufoff) + ldsw + _i * 8192), 16, 0, 0); } while (0)
#define PG8_STAGE_A(bufoff, gbase, offs, h) do { _Pragma("unroll") for (int _i = 0; _i < 2; ++_i) \
        __builtin_amdgcn_global_load_lds((const unsigned*)(bA + (unsigned)((gbase) + (offs)[h][_i])), (LAS unsigned*)(lds + (bufoff) + ldsw + _i * 8192), 16, 0, 0); } while (0)
#define PG8_LDA(dst, b, h) do { _Pragma("unroll") for (int m = 0; m < 4; ++m) _Pragma("unroll") for (int k = 0; k < 2; ++k) dst[m][k] = *(const LAS bf16x8*)(lds + PG8_SA(b, h) + aoff + m * 2048 + k * 1024); } while (0)
#define PG8_LDB(dst, b, h) do { _Pragma("unroll") for (int n = 0; n < 2; ++n) _Pragma("unroll") for (int k = 0; k < 2; ++k) dst[n][k] = *(const LAS bf16x8*)(lds + PG8_SB(b, h) + boff + n * 2048 + k * 1024); } while (0)
#define PG8_MMA(ai, bj, At, Bt) do { __builtin_amdgcn_s_setprio(1); _Pragma("unroll") for (int m = 0; m < 4; ++m) _Pragma("unroll") for (int n = 0; n < 2; ++n) _Pragma("unroll") for (int k = 0; k < 2; ++k) \
        acc[ai][bj][m][n] = pg8_mma<F8>(Bt[n][k], At[m][k], acc[ai][bj][m][n]); __builtin_amdgcn_s_setprio(0); } while (0)
#define PG8_WAIT_V(n) asm volatile("s_waitcnt vmcnt(" #n ")" ::: "memory")
#define PG8_WAIT_L(n) asm volatile("s_waitcnt lgkmcnt(" #n ")" ::: "memory")
#define PG8_BAR __builtin_amdgcn_s_barrier()
#define PG8_SCHED __builtin_amdgcn_sched_barrier(0)
    Unit cur, nxt; int ui = 0;
    if (!S.next(0, cur)) return;
    f32x4 acc[2][2][4][2];
#pragma unroll
    for (int a = 0; a < 2; ++a)
#pragma unroll
        for (int b = 0; b < 2; ++b)
#pragma unroll
            for (int m = 0; m < 4; ++m)
#pragma unroll
                for (int n = 0; n < 2; ++n) acc[a][b][m][n] = (f32x4){0.f, 0.f, 0.f, 0.f};
    bf16x8 At[4][2], B0[2][2], B1[2][2];
    unsigned cA = (unsigned)(S.a_ptr(cur) - bA), cB = (unsigned)(S.b_ptr(cur) - bB);
    unsigned coff[2][2], noff[2][2];
    S.a_off(cur, tid, coff);
    PG8_STAGE_B(PG8_SB(0, 0), cB); PG8_STAGE_B(PG8_SB(0, 1), cB + hstepB); PG8_STAGE_A(PG8_SA(0, 0), cA, coff, 0); PG8_STAGE_A(PG8_SA(0, 1), cA, coff, 1);
    if (wr == 1) PG8_BAR;
    PG8_WAIT_V(2); PG8_BAR;
    PG8_STAGE_B(PG8_SB(1, 0), cB + kstepB); PG8_STAGE_A(PG8_SA(1, 0), cA + kstepA, coff, 0); PG8_STAGE_B(PG8_SB(1, 1), cB + hstepB + kstepB);
    PG8_WAIT_V(6); PG8_BAR;
    for (;;) {
        const bool has_next = S.next(ui + 1, nxt);
        unsigned nA = cA, nB = cB;
#pragma unroll
        for (int h = 0; h < 2; ++h)
#pragma unroll
            for (int i = 0; i < 2; ++i) noff[h][i] = coff[h][i];
        if (has_next) { nA = (unsigned)(S.a_ptr(nxt) - bA); nB = (unsigned)(S.b_ptr(nxt) - bB); S.a_off(nxt, tid_(), noff); }
        for (int t = 0; t < nt; t += 2) {
            if constexpr (MID) { if (2 * t == nt) E.mid(acc, cur, wr, wc, fr, fq); }
            const bool last = (t == nt - 2);
            const unsigned a1 = cA + (unsigned)(t + 1) * kstepA;
            const unsigned a2 = last ? nA : cA + (unsigned)(t + 2) * kstepA, b2 = last ? nB : cB + (unsigned)(t + 2) * kstepB;
            const unsigned a3 = a2 + kstepA, b3 = b2 + kstepB;
            unsigned so[2][2]; const unsigned lmask = last ? 0xffffffffu : 0u;
#pragma unroll
            for (int h = 0; h < 2; ++h)
#pragma unroll
                for (int i = 0; i < 2; ++i) so[h][i] = coff[h][i] ^ ((coff[h][i] ^ noff[h][i]) & lmask);
            PG8_LDB(B0, 0, 0); PG8_LDB(B1, 0, 1); PG8_SCHED; PG8_LDA(At, 0, 0); PG8_STAGE_A(PG8_SA(1, 1), a1, coff, 1);
            PG8_WAIT_V(8); PG8_WAIT_L(0); PG8_BAR; PG8_MMA(0, 0, At, B0); PG8_MMA(0, 1, At, B1); PG8_BAR; PG8_SCHED;
            PG8_LDA(At, 0, 1); PG8_STAGE_B(PG8_SB(0, 0), b2); PG8_STAGE_B(PG8_SB(0, 1), b2 + hstepB); PG8_STAGE_A(PG8_SA(0, 0), a2, so, 0);
            PG8_WAIT_V(8); PG8_WAIT_L(0); PG8_BAR; PG8_MMA(1, 0, At, B0); PG8_MMA(1, 1, At, B1); PG8_BAR; PG8_SCHED;
            PG8_LDB(B0, 1, 0); PG8_LDB(B1, 1, 1); PG8_SCHED; PG8_LDA(At, 1, 0); PG8_STAGE_A(PG8_SA(0, 1), a2, so, 1);
            PG8_WAIT_V(8); PG8_WAIT_L(0); PG8_BAR; PG8_MMA(0, 0, At, B0); PG8_MMA(0, 1, At, B1); PG8_BAR; PG8_SCHED;
            PG8_LDA(At, 1, 1); PG8_STAGE_B(PG8_SB(1, 0), b3); PG8_STAGE_B(PG8_SB(1, 1), b3 + hstepB); PG8_STAGE_A(PG8_SA(1, 0), a3, so, 0);
            PG8_WAIT_V(8); PG8_WAIT_L(0); PG8_BAR; PG8_MMA(1, 0, At, B0); PG8_MMA(1, 1, At, B1); PG8_BAR; PG8_SCHED;
        }
        if constexpr (ALIGN_EPI) { if (wr == 0) PG8_BAR; }
        E(acc, cur, wr, wc, fr, fq);
        if (!has_next) break;
#pragma unroll
        for (int a = 0; a < 2; ++a)
#pragma unroll
            for (int b = 0; b < 2; ++b)
#pragma unroll
                for (int m = 0; m < 4; ++m)
#pragma unroll
                    for (int n = 0; n < 2; ++n) acc[a][b][m][n] = (f32x4){0.f, 0.f, 0.f, 0.f};
        cur = nxt; cA = nA; cB = nB; ++ui;
#pragma unroll
        for (int h = 0; h < 2; ++h)
#pragma unroll
            for (int i = 0; i < 2; ++i) coff[h][i] = noff[h][i];
        if constexpr (ALIGN_EPI) { if (wr == 1) PG8_BAR; }
    }
    PG8_WAIT_V(0);
    if constexpr (!ALIGN_EPI) { if (wr == 0) PG8_BAR; }
    PG8_BAR;
#undef PG8_SA
#undef PG8_SB
#undef PG8_STAGE_A
#undef PG8_STAGE_B
#undef PG8_LDA
#undef PG8_LDB
#undef PG8_MMA
#undef PG8_WAIT_V
#undef PG8_WAIT_L
#undef PG8_BAR
#undef PG8_SCHED
}

struct DenseSched {
    const char* A; const char* Bt; int K, kstepA, ldb; int lda_bytes; int nM, nN, G, c;
    __device__ __forceinline__ void init(const void* A_, int lda_elems, const void* Bt_, int M, int N, int K_, int G_, int c_) {
        A = (const char*)A_; Bt = (const char*)Bt_; K = K_; ldb = K_; kstepA = BK * 2; lda_bytes = lda_elems * 2; nM = M / BM; nN = N / BM; G = G_; c = c_; }
    __device__ __forceinline__ bool next(int i, Unit& u) const {
        const long L = (long)i * G + c; if (L >= (long)nM * nN) return false;
        const int nwg = nM * nN; int wgid = (int)L; { const int q = nwg / 8, r = nwg % 8, xcd = wgid % 8, off = wgid / 8; wgid = (xcd < r ? xcd * (q + 1) : r * (q + 1) + (xcd - r) * q) + off; }
        const int nig = 8 * nN, gid = wgid / nig, fm = gid * 8, gsz = (nM - fm) < 8 ? (nM - fm) : 8;
        u.pm = fm + ((wgid % nig) % gsz); u.pn = (wgid % nig) / gsz; u.e = 0; return true;
    }
    __device__ __forceinline__ const char* a_base() const { return A; }
    __device__ __forceinline__ const char* b_base() const { return Bt; }
    __device__ __forceinline__ const char* a_ptr(const Unit& u) const { return A + (size_t)u.pm * BM * lda_bytes; }
    __device__ __forceinline__ void a_off(const Unit&, int tid, unsigned (&off)[2][2]) const {
#pragma unroll
        for (int i = 0; i < 2; ++i) { int R, C; stage_rc(tid * 16 + i * 8192, R, C);
#pragma unroll
            for (int h = 0; h < 2; ++h) off[h][i] = (unsigned)((h * HALF + R) * lda_bytes + C * 2); }
    }
    __device__ __forceinline__ const char* b_ptr(const Unit& u) const { return Bt + (size_t)u.pn * BM * K * 2; }
};
}
#define MAXROWS2 327680
#define MAXUNITS2 (MAXROWS2 / 256)
#define ZPAD 4608
constexpr int LDS_BYTES = 147456;
constexpr int LDS_MISC = 135168;

namespace wsl {
constexpr size_t al(size_t x) { return (x + 255) & ~(size_t)255; }
constexpr size_t O_ctl = 0;
constexpr size_t O_mod = O_ctl + al(65536);
constexpr size_t O_rope = O_mod + al((size_t)NL * NB * 6144 * 4);
constexpr size_t O_bias1 = O_rope + al((size_t)NT * 32 * 8);
constexpr size_t O_wsc = O_bias1 + al((size_t)NL * 2 * 256 * 4);
constexpr size_t O_Wt_in = O_wsc + al((size_t)NL * 8 * 128 * 128 * 2);
constexpr size_t O_Wt_pn = O_Wt_in + al((size_t)NL * ZPAD * ND * 2);
constexpr size_t O_Wt_pg = O_Wt_pn + al((size_t)NL * ND * 512 * 2);
constexpr size_t O_Wt_out = O_Wt_pg + al((size_t)NL * ND * 512 * 2);
constexpr size_t O_Wt_rs = O_Wt_out + al((size_t)NL * ND * ND * 2);
constexpr size_t O_Wt_ds = O_Wt_rs + al((size_t)NL * 768 * ND * 2);
constexpr size_t O_Wt_w1 = O_Wt_ds + al((size_t)NL * ND * 256 * 2);
constexpr size_t O_h = O_Wt_w1 + al((size_t)NL * 2 * 256 * 2048 * 2);
constexpr size_t O_xb = O_h + al((size_t)NT * ND * 2);
constexpr size_t O_gates = O_xb + al((size_t)NT * ND * 2);
constexpr size_t O_kc = O_gates + al((size_t)NT * 32 * 4);
constexpr size_t O_vc = O_kc + al((size_t)NB * 256 * 128 * 2);
constexpr size_t O_idx = O_vc + al((size_t)NB * 256 * 128 * 2);
constexpr size_t O_slot = O_idx + al((size_t)NT * 8 * 4);
constexpr size_t O_wts = O_slot + al((size_t)NT * 8 * 4);
constexpr size_t O_counts = O_wts + al((size_t)NT * 8 * 4);
constexpr size_t O_cursor = O_counts + al(1024);
constexpr size_t O_bhist = O_cursor + al(1024);
constexpr size_t O_row_tok = O_bhist + al(1024 * 256 * 4);
constexpr size_t O_row_w = O_row_tok + al((size_t)MAXROWS2 * 4);
constexpr size_t O_unit_e = O_row_w + al((size_t)MAXROWS2 * 4);
constexpr size_t O_REGION = O_unit_e + al((size_t)MAXUNITS2 * 4);
constexpr size_t O_qn = O_REGION;
constexpr size_t O_qr = O_qn + al((size_t)NT * 512 * 2);
constexpr size_t O_kvraw = O_qr + al((size_t)NT * 512 * 2);
constexpr size_t O_ksv = O_kvraw + al((size_t)NT * 256 * 2);
constexpr size_t O_kwv = O_ksv + al((size_t)NT * 256 * 2);
constexpr size_t O_u = O_kwv + al((size_t)NT * 256 * 2);
constexpr size_t O_v = O_u + al((size_t)NT * 512 * 2);
constexpr size_t O_sga = O_v + al((size_t)NT * 512 * 2);
constexpr size_t O_sgb = O_sga + al((size_t)NT * ND * 2);
constexpr size_t O_cpart = O_sgb + al((size_t)NT * ND * 2);
constexpr size_t O_onsa = O_cpart + al((size_t)2 * 4 * 4096 * 256 * 4);
constexpr size_t O_ogm = O_onsa + al((size_t)NT * 512 * 2);
constexpr size_t O_merged = O_ogm + al((size_t)NT * 512 * 2);
constexpr size_t O_END_MIX = O_merged + al((size_t)NT * ND * 2);
constexpr size_t O_logits = O_REGION;
constexpr size_t O_sact = O_logits + al((size_t)NT * NE * 4);
constexpr size_t O_shout = O_sact + al((size_t)NT * 256 * 2);
constexpr size_t O_act = O_shout + al((size_t)NT * ND * 2);
constexpr size_t O_yslot = O_act + al((size_t)MAXROWS2 * 256 * 2);
constexpr size_t O_END_MOE = O_yslot + al((size_t)MAXROWS2 * ND * 2);
constexpr size_t O_END_ACT = O_END_MIX > O_END_MOE ? O_END_MIX : O_END_MOE;
constexpr size_t O_Wt_eg = O_END_ACT;
constexpr size_t O_Wt_ed = O_Wt_eg + al((size_t)NL * NE * 512 * ND * 2);
constexpr size_t O_TOTAL = O_Wt_ed + al((size_t)NL * NE * ND * 256 * 2);
}
struct OP {
    const float *x, *c; const int* pos;
    const float *w_mod, *b_mod, *w_in, *q_gain, *k_gain, *pe_k, *pe_v, *w1k, *w2k, *w1v, *w2v, *ln_g, *ln_b, *gm_ws, *gm_bs,
                *wpn, *wpg, *w_out, *w_router, *b_router, *wge, *wue, *wde, *wgs, *wus, *wds;
    float* out;
    float* xres;
    char* ws;
    long long xoff;
    int ph_lo, ph_hi, l_lo, l_hi, conv_l_lo, conv_l_hi;
    __host__ __device__ __forceinline__ unsigned* ctl() const { return (unsigned*)(ws + wsl::O_ctl + (0)); }
    __host__ __device__ __forceinline__ float* mod() const { return (float*)(ws + wsl::O_mod + (0)); }
    __host__ __device__ __forceinline__ float* rope() const { return (float*)(ws + wsl::O_rope + (0)); }
    __host__ __device__ __forceinline__ float* bias1() const { return (float*)(ws + wsl::O_bias1 + (0)); }
    __host__ __device__ __forceinline__ bf16_t* wsc() const { return (bf16_t*)(ws + wsl::O_wsc + (0)); }
    __host__ __device__ __forceinline__ bf16_t* Wt_in() const { return (bf16_t*)(ws + wsl::O_Wt_in + (0)); }
    __host__ __device__ __forceinline__ bf16_t* Wt_pn() const { return (bf16_t*)(ws + wsl::O_Wt_pn + (0)); }
    __host__ __device__ __forceinline__ bf16_t* Wt_pg() const { return (bf16_t*)(ws + wsl::O_Wt_pg + (0)); }
    __host__ __device__ __forceinline__ bf16_t* Wt_out() const { return (bf16_t*)(ws + wsl::O_Wt_out + (0)); }
    __host__ __device__ __forceinline__ bf16_t* Wt_rs() const { return (bf16_t*)(ws + wsl::O_Wt_rs + (0)); }
    __host__ __device__ __forceinline__ bf16_t* Wt_ds() const { return (bf16_t*)(ws + wsl::O_Wt_ds + (0)); }
    __host__ __device__ __forceinline__ bf16_t* Wt_w1() const { return (bf16_t*)(ws + wsl::O_Wt_w1 + (0)); }
    __host__ __device__ __forceinline__ bf16_t* h() const { return (bf16_t*)(ws + wsl::O_h + (0)); }
    __host__ __device__ __forceinline__ bf16_t* xb() const { return (bf16_t*)(ws + wsl::O_xb + (0)); }
    __host__ __device__ __forceinline__ float* gates() const { return (float*)(ws + wsl::O_gates + (0)); }
    __host__ __device__ __forceinline__ bf16_t* kc() const { return (bf16_t*)(ws + wsl::O_kc + (0)); }
    __host__ __device__ __forceinline__ bf16_t* vc() const { return (bf16_t*)(ws + wsl::O_vc + (0)); }
    __host__ __device__ __forceinline__ int* idx() const { return (int*)(ws + wsl::O_idx + (0)); }
    __host__ __device__ __forceinline__ int* slot() const { return (int*)(ws + wsl::O_slot + (0)); }
    __host__ __device__ __forceinline__ float* wts() const { return (float*)(ws + wsl::O_wts + (0)); }
    __host__ __device__ __forceinline__ int* counts() const { return (int*)(ws + wsl::O_counts + (0)); }
    __host__ __device__ __forceinline__ int* cursor() const { return (int*)(ws + wsl::O_cursor + (0)); }
    __host__ __device__ __forceinline__ int* bhist() const { return (int*)(ws + wsl::O_bhist + (0)); }
    __host__ __device__ __forceinline__ int* row_tok() const { return (int*)(ws + wsl::O_row_tok + (0)); }
    __host__ __device__ __forceinline__ float* row_w() const { return (float*)(ws + wsl::O_row_w + (0)); }
    __host__ __device__ __forceinline__ int* unit_e() const { return (int*)(ws + wsl::O_unit_e + (0)); }
    __host__ __device__ __forceinline__ bf16_t* qn() const { return (bf16_t*)(ws + wsl::O_qn + (0)); }
    __host__ __device__ __forceinline__ bf16_t* qr() const { return (bf16_t*)(ws + wsl::O_qr + (0)); }
    __host__ __device__ __forceinline__ bf16_t* kvraw() const { return (bf16_t*)(ws + wsl::O_kvraw + (0)); }
    __host__ __device__ __forceinline__ bf16_t* ksv() const { return (bf16_t*)(ws + wsl::O_ksv + (0)); }
    __host__ __device__ __forceinline__ bf16_t* kwv() const { return (bf16_t*)(ws + wsl::O_kwv + (0)); }
    __host__ __device__ __forceinline__ bf16_t* u() const { return (bf16_t*)(ws + wsl::O_u + (0)); }
    __host__ __device__ __forceinline__ bf16_t* v() const { return (bf16_t*)(ws + wsl::O_v + (0)); }
    __host__ __device__ __forceinline__ bf16_t* sga() const { return (bf16_t*)(ws + wsl::O_sga + (0)); }
    __host__ __device__ __forceinline__ bf16_t* sgb() const { return (bf16_t*)(ws + wsl::O_sgb + (0)); }
    __host__ __device__ __forceinline__ float* cpart() const { return (float*)(ws + wsl::O_cpart + (0)); }
    __host__ __device__ __forceinline__ bf16_t* onsa() const { return (bf16_t*)(ws + wsl::O_onsa + (0)); }
    __host__ __device__ __forceinline__ bf16_t* ogm() const { return (bf16_t*)(ws + wsl::O_ogm + (0)); }
    __host__ __device__ __forceinline__ bf16_t* merged() const { return (bf16_t*)(ws + wsl::O_merged + (0)); }
    __host__ __device__ __forceinline__ float* logits() const { return (float*)(ws + wsl::O_logits + (0)); }
    __host__ __device__ __forceinline__ bf16_t* sact() const { return (bf16_t*)(ws + wsl::O_sact + (0)); }
    __host__ __device__ __forceinline__ bf16_t* shout() const { return (bf16_t*)(ws + wsl::O_shout + (0)); }
    __host__ __device__ __forceinline__ bf16_t* act() const { return (bf16_t*)(ws + wsl::O_act + (0)); }
    __host__ __device__ __forceinline__ bf16_t* yslot() const { return (bf16_t*)(ws + wsl::O_yslot + (0)); }
    __host__ __device__ __forceinline__ bf16_t* Wt_eg() const { return (bf16_t*)(ws + wsl::O_Wt_eg + (xoff)); }
    __host__ __device__ __forceinline__ bf16_t* Wt_ed() const { return (bf16_t*)(ws + wsl::O_Wt_ed + (xoff)); }
};

__device__ __forceinline__ float bf2f(bf16_t b) { return __uint_as_float(((unsigned)b) << 16); }
__device__ __forceinline__ unsigned f2bf(float f) { unsigned u = __float_as_uint(f); return (u + 0x7fffu + ((u >> 16) & 1u)) >> 16; }
__device__ __forceinline__ unsigned pk2(float lo, float hi) { return pg8::cvt_pk_bf16(lo, hi); }
__device__ __forceinline__ float fsigmoid(float x) { return __builtin_amdgcn_rcpf(1.0f + __expf(-x)); }
__device__ __forceinline__ float fgelu(float x) { const float u2 = 1.5957691216057308f * (x + 0.044715f * x * x * x); return x * __builtin_amdgcn_rcpf(1.0f + __expf(-u2)); }
__device__ __forceinline__ float fsilu(float x) { return x * __builtin_amdgcn_rcpf(1.0f + __expf(-x)); }

struct TrItem { const float* src; bf16_t* dst; int ld, scol, nvalid, K, nd0, k0, f8; };
#define W8_SCALE 64.0f
#define H8_SCALE 8.0f
__device__ __forceinline__ unsigned pk4_e4m3(float a, float b, float c, float d) {
    int w = __builtin_amdgcn_cvt_pk_fp8_f32(__builtin_amdgcn_fmed3f(a, -240.f, 240.f), __builtin_amdgcn_fmed3f(b, -240.f, 240.f), 0, false);
    w = __builtin_amdgcn_cvt_pk_fp8_f32(__builtin_amdgcn_fmed3f(c, -240.f, 240.f), __builtin_amdgcn_fmed3f(d, -240.f, 240.f), w, true); return (unsigned)w; }
__device__ __forceinline__ void tr_load(const TrItem& it, f32x4 (&v)[16], int lane) {
    const int n4 = (lane & 7) * 4, kr = lane >> 3;
    const float* s = it.src + (size_t)(it.k0 + kr) * it.ld + it.scol + n4;
#pragma unroll
    for (int i = 0; i < 16; ++i) v[i] = (n4 < it.nvalid) ? __builtin_nontemporal_load((const f32x4*)(s + (size_t)(8 * i) * it.ld)) : (f32x4){0.f, 0.f, 0.f, 0.f};
}
#define TR_PITCH 72
typedef short tr_v4i16 __attribute__((ext_vector_type(4)));
__device__ __forceinline__ void tr_store(const TrItem& it, const f32x4 (&v)[16], LAS float* scrf, int lane) {
    LAS unsigned char* scr = (LAS unsigned char*)scrf;
    const int n4 = (lane & 7) * 4, kr = lane >> 3;
#pragma unroll
    for (int i = 0; i < 16; ++i) { const u32x2 w = {pk2(v[i].x, v[i].y), pk2(v[i].z, v[i].w)}; *(LAS u32x2*)(scr + (8 * i + kr) * TR_PITCH + n4 * 2) = w; }
    asm volatile("s_waitcnt lgkmcnt(0)" ::: "memory");
    const int n = lane & 31, hk = lane >> 5;
    const LAS unsigned char* rb = scr + ((lane & 15) >> 2) * TR_PITCH + (16 * ((lane >> 4) & 1) + 4 * (lane & 3)) * 2;
    if (it.f8) {
#pragma unroll
        for (int j = 0; j < 4; ++j) {
            const int cc = 4 * j + 2 * hk;
            unsigned w8[4];
#pragma unroll
            for (int q = 0; q < 2; ++q) {
                const tr_v4i16 a = __builtin_amdgcn_ds_read_tr16_b64_v4i16((LAS tr_v4i16*)(rb + (8 * (cc + q)) * TR_PITCH)), b = __builtin_amdgcn_ds_read_tr16_b64_v4i16((LAS tr_v4i16*)(rb + (8 * (cc + q) + 4) * TR_PITCH));
                const bf16x8 o = {a[0], a[1], a[2], a[3], b[0], b[1], b[2], b[3]}; const u32x4 ow = __builtin_bit_cast(u32x4, o);
                w8[2 * q] = pk4_e4m3(__uint_as_float(ow.x << 16) * W8_SCALE, __uint_as_float(ow.x & 0xffff0000u) * W8_SCALE, __uint_as_float(ow.y << 16) * W8_SCALE, __uint_as_float(ow.y & 0xffff0000u) * W8_SCALE);
                w8[2 * q + 1] = pk4_e4m3(__uint_as_float(ow.z << 16) * W8_SCALE, __uint_as_float(ow.z & 0xffff0000u) * W8_SCALE, __uint_as_float(ow.w << 16) * W8_SCALE, __uint_as_float(ow.w & 0xffff0000u) * W8_SCALE);
            }
            *(u32x4*)((unsigned char*)it.dst + (size_t)(it.nd0 + n) * it.K + it.k0 + 8 * cc) = (u32x4){w8[0], w8[1], w8[2], w8[3]};
        }
    } else {
#pragma unroll
        for (int j = 0; j < 8; ++j) {
            const int cc = 2 * j + hk;
            const tr_v4i16 a = __builtin_amdgcn_ds_read_tr16_b64_v4i16((LAS tr_v4i16*)(rb + (8 * cc) * TR_PITCH)), b = __builtin_amdgcn_ds_read_tr16_b64_v4i16((LAS tr_v4i16*)(rb + (8 * cc + 4) * TR_PITCH));
            const bf16x8 o = {a[0], a[1], a[2], a[3], b[0], b[1], b[2], b[3]};
            *(bf16x8*)(it.dst + (size_t)(it.nd0 + n) * it.K + it.k0 + 8 * cc) = o;
        }
    }
    asm volatile("s_waitcnt lgkmcnt(0)" ::: "memory");
}
__device__ __forceinline__ void tr_item(const float* src, int ld, int scol, int nvalid, bf16_t* dst, int K, int nd0, int k0, LAS float* scr, int lane, int f8 = 0) {
    TrItem it{src, dst, ld, scol, nvalid, K, nd0, k0, f8}; f32x4 v[16]; tr_load(it, v, lane); tr_store(it, v, scr, lane);
}
__device__ __forceinline__ int win_srccol(int nd0, int& nvalid) {
    const int pn = nd0 >> 8, q = nd0 & 255, bj = q >> 7, wc = (q & 127) >> 5; nvalid = 32;
    if (pn < 2) return ZQ + (4 * pn + wc) * 64 + 32 * bj;
    if (pn < 5) return ZKC + (pn - 2) * 256 + wc * 64 + 32 * bj;
    if (pn < 7) return ZU + (pn - 5) * 256 + q;
    if (pn < 9) return ZV + (pn - 7) * 256 + q;
    if (pn < 17) return (bj ? ZGB : ZGA) + (pn - 9) * 128 + (q & 127);
    nvalid = (q == 0) ? 24 : 0; return ZG;
}
__device__ __forceinline__ void ph_prologue(const OP& p, LAS unsigned char* lds, int bid, int nb) {
    const int tid = tid_(), lane = tid & 63, wave = tid >> 6;
    {
        LAS float* sc = (LAS float*)lds;
        LAS float* part = sc + NB * ND;
        bool have_sc = false;
        for (int job = bid; job < NL * 96 + 16; job += nb) {
            __syncthreads();
            if (job < NL * 96) {
                if (!have_sc) { for (int i = tid; i < NB * ND; i += 512) { const float cv = p.c[i]; sc[i] = cv / (1.0f + expf(-cv)); } have_sc = true; __syncthreads(); }
                const int l = job / 96, j = (job % 96) * 64 + lane;
                const float* w = p.w_mod + (size_t)l * ND * 6144 + (size_t)(wave * 128) * 6144 + j;
                float acc[NB];
#pragma unroll
                for (int b = 0; b < NB; ++b) acc[b] = 0.f;
                for (int bt = 0; bt < 4; ++bt) {
                    float wv[32];
#pragma unroll
                    for (int i = 0; i < 32; ++i) wv[i] = w[(size_t)(bt * 32 + i) * 6144];
#pragma unroll
                    for (int i = 0; i < 32; ++i)
#pragma unroll
                        for (int b = 0; b < NB; ++b) acc[b] = fmaf(sc[b * ND + wave * 128 + bt * 32 + i], wv[i], acc[b]);
                }
#pragma unroll
                for (int b = 0; b < NB; ++b) part[(wave * NB + b) * 64 + lane] = acc[b];
                __syncthreads();
                { const int b = wave; float s = p.b_mod[l * 6144 + j];
#pragma unroll
                  for (int ww = 0; ww < 8; ++ww) s += part[(ww * NB + b) * 64 + lane];
                  p.mod()[((size_t)l * NB + b) * 6144 + j] = s; }
            } else {
                const int jb = job - NL * 96, l = jb >> 3, kv = (jb >> 2) & 1, f = (jb & 3) * 64 + lane;
                const float* pe = (kv ? p.pe_v : p.pe_k) + l * 2048 + wave * 256; const float* w1 = (kv ? p.w1v : p.w1k) + (size_t)l * 2048 * 256 + (size_t)(wave * 256) * 256 + f; float a = 0.f;
                for (int bt = 0; bt < 8; ++bt) {
                    float wv[32];
#pragma unroll
                    for (int i = 0; i < 32; ++i) wv[i] = w1[(size_t)(bt * 32 + i) * 256];
#pragma unroll
                    for (int i = 0; i < 32; ++i) a = fmaf(pe[bt * 32 + i], wv[i], a);
                }
                part[wave * 64 + lane] = a;
                __syncthreads();
                if (wave == 0) { float s = 0.f;
#pragma unroll
                    for (int ww = 0; ww < 8; ++ww) s += part[ww * 64 + lane];
                    p.bias1()[(l * 2 + kv) * 256 + f] = s; }
            }
        }
        __syncthreads();
    }
    const int gt = bid * 512 + tid, ngt = nb * 512;
    for (int it = gt; it < NT * 32; it += ngt) { const int t = it >> 5, i = it & 31; const float inv = (float)pow(10000.0, -(double)i / 32.0); const float ang = (float)p.pos[t] * inv;
        float sn, cs; sincosf(ang, &sn, &cs); *(f32x2*)(p.rope() + (size_t)it * 2) = (f32x2){cs, sn}; }
    for (int it = gt; it < NL * 8 * 128 * 128; it += ngt) { const int s = it & 127, t = (it >> 7) & 127; p.wsc()[it] = (bf16_t)f2bf(s <= t ? p.gm_ws[it] : 0.f); }
    LAS float* scr = (LAS float*)lds + wave * (128 * 33);
    const int gw = bid * 8 + wave, ngw = nb * 8;
    constexpr int I_IN = (ZPAD / 32) * 8, I_P = 32 * 4, I_O = 32 * 8, I_R = 8 * 8, I_SG = 16 * 8, I_DS = 32 * 2, I_W1 = 8 * 16, I_SMALL = I_IN + 2 * I_P + I_O + I_R + I_SG + I_DS + 2 * I_W1;
    for (int it = gw; it < NL * I_SMALL; it += ngw) {
        const int l = it / I_SMALL; int r = it % I_SMALL;
        if (r < I_IN) { const int nd0 = (r >> 3) * 32, k0 = (r & 7) * 128; int nv; const int sc = win_srccol(nd0, nv); tr_item(p.w_in + (size_t)l * ND * INC, INC, sc, nv, p.Wt_in() + (size_t)l * ZPAD * ND, ND, nd0, k0, scr, lane); continue; } r -= I_IN;
        if (r < I_P) { const int nd0 = (r >> 2) * 32, k0 = (r & 3) * 128; tr_item(p.wpn + (size_t)l * 512 * ND, ND, nd0, 32, (bf16_t*)((unsigned char*)p.Wt_pn() + (size_t)l * ND * ND), ND, nd0, k0, scr, lane, 1); continue; } r -= I_P;
        if (r < I_P) { const int nd0 = (r >> 2) * 32, k0 = (r & 3) * 128; tr_item(p.wpg + (size_t)l * 512 * ND, ND, nd0, 32, (bf16_t*)((unsigned char*)p.Wt_pn() + (size_t)l * ND * ND + 512), ND, nd0, k0, scr, lane, 1); continue; } r -= I_P;
        if (r < I_O) { const int nd0 = (r >> 3) * 32, k0 = (r & 7) * 128; tr_item(p.w_out + (size_t)l * ND * ND, ND, nd0, 32, (bf16_t*)((unsigned char*)p.Wt_out() + (size_t)l * ND * ND), ND, nd0, k0, scr, lane, 1); continue; } r -= I_O;
        if (r < I_R) { const int nd0 = (r >> 3) * 32, k0 = (r & 7) * 128; tr_item(p.w_router + (size_t)l * ND * NE, NE, nd0, 32, p.Wt_rs() + (size_t)l * 768 * ND, ND, nd0, k0, scr, lane); continue; } r -= I_R;
        if (r < I_SG) { const int nd0 = (r >> 3) * 32, k0 = (r & 7) * 128; const int tile = nd0 >> 8, q = nd0 & 255;
            tr_item((q < 128 ? p.wgs : p.wus) + (size_t)l * ND * 256, 256, tile * 128 + (q & 127), 32, p.Wt_rs() + (size_t)l * 768 * ND, ND, 256 + nd0, k0, scr, lane); continue; } r -= I_SG;
        if (r < I_DS) { const int nd0 = (r >> 1) * 32, k0 = (r & 1) * 128; tr_item(p.wds + (size_t)l * 256 * ND, ND, nd0, 32, p.Wt_ds() + (size_t)l * ND * 256, 256, nd0, k0, scr, lane); continue; } r -= I_DS;
        { const int kv = r / I_W1; r %= I_W1; const int nd0 = (r >> 4) * 32, k0 = (r & 15) * 128;
          tr_item((kv ? p.w1v : p.w1k) + (size_t)l * 2048 * 256, 256, nd0, 32, p.Wt_w1() + ((size_t)l * 2 + kv) * 256 * 2048, 2048, nd0, k0, scr, lane); }
    }
    constexpr int I_E = 128 + 64;
    const int nle = (p.conv_l_hi - p.conv_l_lo) * NE;
    auto expert_item = [&](long it) {
        const int le = (int)(it / I_E), l = p.conv_l_lo + le / NE, e = le % NE; int r = (int)(it % I_E); TrItem ti;
        if (r < 128) { const int nd0 = (r >> 3) * 32, k0 = (r & 7) * 128; const int tile = nd0 >> 8, q = nd0 & 255;
            ti = TrItem{(q < 128 ? p.wge : p.wue) + ((size_t)l * NE + e) * ND * 256, (bf16_t*)((unsigned char*)p.Wt_eg() + ((size_t)l * NE + e) * 512 * ND), 256, tile * 128 + (q & 127), 32, ND, nd0, k0, 1}; }
        else { r -= 128; const int nd0 = (r >> 1) * 32, k0 = (r & 1) * 128; ti = TrItem{p.wde + ((size_t)l * NE + e) * 256 * ND, (bf16_t*)((unsigned char*)p.Wt_ed() + ((size_t)l * NE + e) * ND * 256), ND, nd0, 32, 256, nd0, k0, 1}; }
        return ti;
    };
    const long nit = (long)nle * I_E;
    if (gw < nit) {
        f32x4 va[16], vb[16];
        TrItem ia = expert_item(gw), ib = ia; tr_load(ia, va, lane);
        for (long it = gw; it < nit; it += 2 * ngw) {
            const bool hb = it + ngw < nit, ha = it + 2 * ngw < nit;
            if (hb) { ib = expert_item(it + ngw); tr_load(ib, vb, lane); }
            tr_store(ia, va, scr, lane);
            if (ha) { ia = expert_item(it + 2 * ngw); tr_load(ia, va, lane); }
            if (hb) tr_store(ib, vb, scr, lane);
        }
    }
}

__device__ __forceinline__ void ph_norm(const OP& p, const float* xin, int l, int sh_off, int sc_off, int bid, int nb) {
    const int lane = tid_() & 63, w = tid_() >> 6;
    for (int t = bid * 8 + w; t < NT; t += nb * 8) {
        const float* xr = xin + (size_t)t * ND;
        f32x4 v[4]; float ss = 0.f;
#pragma unroll
        for (int i = 0; i < 4; ++i) { v[i] = *(const f32x4*)(xr + i * 256 + lane * 4); ss += v[i].x * v[i].x + v[i].y * v[i].y + v[i].z * v[i].z + v[i].w * v[i].w; }
#pragma unroll
        for (int o = 32; o >= 1; o >>= 1) ss += __shfl_xor(ss, o);
        const float rstd = rsqrtf(ss * (1.0f / ND) + 1e-6f);
        const float* mb = p.mod() + ((size_t)l * NB + (t >> 12)) * 6144;
#pragma unroll
        for (int i = 0; i < 4; ++i) {
            const int cidx = i * 256 + lane * 4;
            const f32x4 sc = *(const f32x4*)(mb + sc_off + cidx), sh = *(const f32x4*)(mb + sh_off + cidx);
            u32x2 o; o.x = pk2(v[i].x * rstd * (1.f + sc.x) + sh.x, v[i].y * rstd * (1.f + sc.y) + sh.y); o.y = pk2(v[i].z * rstd * (1.f + sc.z) + sh.z, v[i].w * rstd * (1.f + sc.w) + sh.w);
            *(u32x2*)(p.h() + (size_t)t * ND + cidx) = o;
        }
    }
}

__device__ __forceinline__ void ph_norm_b(const OP& p, const bf16_t* xin, int l, int sh_off, int sc_off, int bid, int nb, unsigned char* h8) {
    const int lane = tid_() & 63, w = tid_() >> 6;
    for (int t = bid * 8 + w; t < NT; t += nb * 8) {
        float v[2][8]; float ss = 0.f;
#pragma unroll
        for (int i = 0; i < 2; ++i) { const u32x4 r = *(const u32x4*)(xin + (size_t)t * ND + i * 512 + lane * 8); const unsigned rw[4] = {r.x, r.y, r.z, r.w};
#pragma unroll
            for (int k = 0; k < 4; ++k) { v[i][2 * k] = __uint_as_float(rw[k] << 16); v[i][2 * k + 1] = __uint_as_float(rw[k] & 0xffff0000u); ss += v[i][2 * k] * v[i][2 * k] + v[i][2 * k + 1] * v[i][2 * k + 1]; } }
#pragma unroll
        for (int o = 32; o >= 1; o >>= 1) ss += __shfl_xor(ss, o);
        const float rstd = rsqrtf(ss * (1.0f / ND) + 1e-6f);
        const float* mb = p.mod() + ((size_t)l * NB + (t >> 12)) * 6144;
#pragma unroll
        for (int i = 0; i < 2; ++i) {
            const int cidx = i * 512 + lane * 8;
            const f32x4 sc0 = *(const f32x4*)(mb + sc_off + cidx), sc1 = *(const f32x4*)(mb + sc_off + cidx + 4), sh0 = *(const f32x4*)(mb + sh_off + cidx), sh1 = *(const f32x4*)(mb + sh_off + cidx + 4);
            u32x4 o; o.x = pk2(v[i][0] * rstd * (1.f + sc0.x) + sh0.x, v[i][1] * rstd * (1.f + sc0.y) + sh0.y); o.y = pk2(v[i][2] * rstd * (1.f + sc0.z) + sh0.z, v[i][3] * rstd * (1.f + sc0.w) + sh0.w);
            o.z = pk2(v[i][4] * rstd * (1.f + sc1.x) + sh1.x, v[i][5] * rstd * (1.f + sc1.y) + sh1.y); o.w = pk2(v[i][6] * rstd * (1.f + sc1.z) + sh1.z, v[i][7] * rstd * (1.f + sc1.w) + sh1.w);
            *(u32x4*)(p.h() + (size_t)t * ND + cidx) = o;
            if (h8) {
                const u32x2 w8 = {pk4_e4m3((v[i][0] * rstd * (1.f + sc0.x) + sh0.x) * H8_SCALE, (v[i][1] * rstd * (1.f + sc0.y) + sh0.y) * H8_SCALE, (v[i][2] * rstd * (1.f + sc0.z) + sh0.z) * H8_SCALE, (v[i][3] * rstd * (1.f + sc0.w) + sh0.w) * H8_SCALE),
                                  pk4_e4m3((v[i][4] * rstd * (1.f + sc1.x) + sh1.x) * H8_SCALE, (v[i][5] * rstd * (1.f + sc1.y) + sh1.y) * H8_SCALE, (v[i][6] * rstd * (1.f + sc1.z) + sh1.z) * H8_SCALE, (v[i][7] * rstd * (1.f + sc1.w) + sh1.w) * H8_SCALE)};
                *(u32x2*)(h8 + (size_t)t * ND + cidx) = w8; }
        }
    }
}

#define LDS_GAIN (LDS_MISC + 256)
struct EpiZ {
    static constexpr bool PERM = true;
    const OP* pp; LAS unsigned char* lds;
    __device__ __forceinline__ void operator()(const f32x4 (&acc)[2][2][4][2], const pg8::Unit& u, int wr, int wc, int fr, int fq) const {
        const OP& p = *pp; const int pn = u.pn;
        const int row0 = u.pm * 256 + wr * 64 + fr;
        if (pn < 5) {
            const bool normed = (pn < 2) || (pn >= 3 && wc < 2);
            bf16_t* dst; int ldd, cbase;
            if (pn < 2) { dst = p.qn(); ldd = 512; cbase = (4 * pn + wc) * 64; }
            else if (pn == 2) { dst = p.kvraw(); ldd = 256; cbase = wc * 64; }
            else if (pn == 3) { dst = p.ksv(); ldd = 256; cbase = wc * 64; }
            else { dst = p.kwv(); ldd = 256; cbase = wc * 64; }
            const LAS float* gain = (const LAS float*)(lds + LDS_GAIN) + (pn < 2 ? 0 : 64);
            const float osc = (pn < 2) ? 0.125f * 1.4426950408889634f : 1.0f;
            f32x4 g0[2], g1[2];
#pragma unroll
            for (int n = 0; n < 2; ++n) { g0[n] = *(const LAS f32x4*)(gain + 8 * fq + 4 * n); g1[n] = *(const LAS f32x4*)(gain + 32 + 8 * fq + 4 * n); }
#pragma unroll
            for (int ai = 0; ai < 2; ++ai)
#pragma unroll
                for (int m = 0; m < 4; ++m) {
                    const int row = row0 + ai * 128 + m * 16;
                    f32x4 y0[2], y1[2];
#pragma unroll
                    for (int n = 0; n < 2; ++n) { y0[n] = acc[ai][0][m][n]; y1[n] = acc[ai][1][m][n]; }
                    float ss = 0.f;
#pragma unroll
                    for (int n = 0; n < 2; ++n) { ss += y0[n].x * y0[n].x + y0[n].y * y0[n].y + y0[n].z * y0[n].z + y0[n].w * y0[n].w; ss += y1[n].x * y1[n].x + y1[n].y * y1[n].y + y1[n].z * y1[n].z + y1[n].w * y1[n].w; }
                    ss += __shfl_xor(ss, 16); ss += __shfl_xor(ss, 32);
                    const float rs = rsqrtf(ss * (1.0f / 64.f) + 1e-6f) * osc;
#pragma unroll
                    for (int n = 0; n < 2; ++n) { y0[n] = normed ? y0[n] * rs * g0[n] : y0[n]; y1[n] = normed ? y1[n] * rs * g1[n] : y1[n]; }
                    u32x4 w0, w1; w0.x = pk2(y0[0].x, y0[0].y); w0.y = pk2(y0[0].z, y0[0].w); w0.z = pk2(y0[1].x, y0[1].y); w0.w = pk2(y0[1].z, y0[1].w);
                    w1.x = pk2(y1[0].x, y1[0].y); w1.y = pk2(y1[0].z, y1[0].w); w1.z = pk2(y1[1].x, y1[1].y); w1.w = pk2(y1[1].z, y1[1].w);
                    *(u32x4*)(dst + (size_t)row * ldd + cbase + 8 * fq) = w0; *(u32x4*)(dst + (size_t)row * ldd + cbase + 32 + 8 * fq) = w1;
                }
        } else if (pn >= 9 && pn < 17) {
            const int col0 = (pn - 9) * 128 + wc * 32 + 8 * fq;
            bf16_t* da = p.sga(); bf16_t* db = p.sgb();
#pragma unroll
            for (int ai = 0; ai < 2; ++ai)
#pragma unroll
                for (int m = 0; m < 4; ++m) {
                    const size_t ro = (size_t)(row0 + ai * 128 + m * 16) * 1024 + col0;
                    float ra[8], sb[8];
#pragma unroll
                    for (int n = 0; n < 2; ++n) { const f32x4 ga = acc[ai][0][m][n], gb = acc[ai][1][m][n];
                        const float gav[4] = {ga.x, ga.y, ga.z, ga.w}, gbv[4] = {gb.x, gb.y, gb.z, gb.w};
#pragma unroll
                        for (int k = 0; k < 4; ++k) { const float ea = __expf(-gav[k]), eb = fminf(__expf(-gbv[k]), 1e20f); const float dbv = 1.0f + eb;
                            ra[4 * n + k] = dbv * __builtin_amdgcn_rcpf(1.0f + ea); sb[4 * n + k] = __builtin_amdgcn_rcpf(dbv); } }
                    u32x4 wa, wb; wa.x = pk2(ra[0], ra[1]); wa.y = pk2(ra[2], ra[3]); wa.z = pk2(ra[4], ra[5]); wa.w = pk2(ra[6], ra[7]);
                    wb.x = pk2(sb[0], sb[1]); wb.y = pk2(sb[2], sb[3]); wb.z = pk2(sb[4], sb[5]); wb.w = pk2(sb[6], sb[7]);
                    *(u32x4*)(da + ro) = wa; *(u32x4*)(db + ro) = wb;
                }
        } else if (pn < 17) {
            bf16_t* dst; int ldd, ct; const bool is_gelu = pn < 9;
            if (pn < 7) { dst = p.u(); ldd = 512; ct = (pn - 5) * 256; } else { dst = p.v(); ldd = 512; ct = (pn - 7) * 256; }
            const int col0 = ct + wc * 32 + 8 * fq;
#pragma unroll
            for (int ai = 0; ai < 2; ++ai)
#pragma unroll
                for (int m = 0; m < 4; ++m) {
                    bf16_t* rowp = dst + (size_t)(row0 + ai * 128 + m * 16) * ldd + col0;
#pragma unroll
                    for (int bj = 0; bj < 2; ++bj) {
                        f32x4 v0 = acc[ai][bj][m][0], v1 = acc[ai][bj][m][1];
                        f32x4 a0, a1, m0, m1;
                        if (is_gelu) { a0 = 1.5957691216057308f * (v0 + 0.044715f * v0 * v0 * v0); a1 = 1.5957691216057308f * (v1 + 0.044715f * v1 * v1 * v1); m0 = v0; m1 = v1; }
                        else { a0 = v0; a1 = v1; m0 = (f32x4){1.f, 1.f, 1.f, 1.f}; m1 = m0; }
                        v0 = (f32x4){m0.x * fsigmoid(a0.x), m0.y * fsigmoid(a0.y), m0.z * fsigmoid(a0.z), m0.w * fsigmoid(a0.w)};
                        v1 = (f32x4){m1.x * fsigmoid(a1.x), m1.y * fsigmoid(a1.y), m1.z * fsigmoid(a1.z), m1.w * fsigmoid(a1.w)};
                        u32x4 w; w.x = pk2(v0.x, v0.y); w.y = pk2(v0.z, v0.w); w.z = pk2(v1.x, v1.y); w.w = pk2(v1.z, v1.w);
                        *(u32x4*)(rowp + bj * 128) = w;
                    }
                }
        } else {
            if (wc == 0) {
#pragma unroll
                for (int ai = 0; ai < 2; ++ai)
#pragma unroll
                    for (int m = 0; m < 4; ++m) {
                        float* rowp = p.gates() + (size_t)(row0 + ai * 128 + m * 16) * 32 + 8 * fq;
                        const f32x4 v0 = acc[ai][0][m][0], v1 = acc[ai][0][m][1];
                        *(f32x4*)(rowp) = (f32x4){fsigmoid(v0.x), fsigmoid(v0.y), fsigmoid(v0.z), fsigmoid(v0.w)};
                        *(f32x4*)(rowp + 4) = (f32x4){fsigmoid(v1.x), fsigmoid(v1.y), fsigmoid(v1.z), fsigmoid(v1.w)};
                    }
            }
        }
    }
};

struct RopeIt { const bf16_t* src; bf16_t* dst; const float* rp; int j; };
__device__ __forceinline__ void rope_addr(const OP& p, long it, RopeIt& r) {
    const int j = (int)(it & 3); const long hvi = it >> 2; const int t = (int)(hvi / 12), hv = (int)(hvi % 12);
    if (hv < 8) { r.src = p.qn() + (size_t)t * 512 + hv * 64; r.dst = p.qr() + (size_t)t * 512 + hv * 64; }
    else if (hv < 10) { r.src = p.ksv() + (size_t)t * 256 + (hv - 8) * 64; r.dst = (bf16_t*)r.src; }
    else { r.src = p.kwv() + (size_t)t * 256 + (hv - 10) * 64; r.dst = (bf16_t*)r.src; }
    r.rp = p.rope() + ((size_t)t * 32 + 8 * j) * 2; r.j = j;
}
__device__ __forceinline__ void rope_apply(const RopeIt& r, const u32x4 a, const u32x4 b, const f32x4 c0, const f32x4 c1, const f32x4 c2, const f32x4 c3) {
    const float cs[8] = {c0.x, c0.z, c1.x, c1.z, c2.x, c2.z, c3.x, c3.z}, sn[8] = {c0.y, c0.w, c1.y, c1.w, c2.y, c2.w, c3.y, c3.w};
    const unsigned aw[4] = {a.x, a.y, a.z, a.w}, bw[4] = {b.x, b.y, b.z, b.w};
    unsigned oa[4], ob[4];
#pragma unroll
    for (int k = 0; k < 4; ++k) {
        const float x1l = __uint_as_float(aw[k] << 16), x1h = __uint_as_float(aw[k] & 0xffff0000u), x2l = __uint_as_float(bw[k] << 16), x2h = __uint_as_float(bw[k] & 0xffff0000u);
        oa[k] = pk2(x1l * cs[2 * k] - x2l * sn[2 * k], x1h * cs[2 * k + 1] - x2h * sn[2 * k + 1]);
        ob[k] = pk2(x2l * cs[2 * k] + x1l * sn[2 * k], x2h * cs[2 * k + 1] + x1h * sn[2 * k + 1]);
    }
    *(u32x4*)(r.dst + 8 * r.j) = (u32x4){oa[0], oa[1], oa[2], oa[3]}; *(u32x4*)(r.dst + 32 + 8 * r.j) = (u32x4){ob[0], ob[1], ob[2], ob[3]};
}
__device__ __forceinline__ void ph_rope(const OP& p, int bid, int nb) {
    const long nitems = (long)NT * 12 * 4, stride = (long)nb * 512;
    long it = (long)bid * 512 + tid_();
    for (; it + 3 * stride < nitems; it += 4 * stride) {
        RopeIt r[4]; u32x4 a[4], b[4]; f32x4 c[4][4];
#pragma unroll
        for (int u = 0; u < 4; ++u) { rope_addr(p, it + u * stride, r[u]); a[u] = *(const u32x4*)(r[u].src + 8 * r[u].j); b[u] = *(const u32x4*)(r[u].src + 32 + 8 * r[u].j);
#pragma unroll
            for (int k = 0; k < 4; ++k) c[u][k] = *(const f32x4*)(r[u].rp + 4 * k); }
#pragma unroll
        for (int u = 0; u < 4; ++u) rope_apply(r[u], a[u], b[u], c[u][0], c[u][1], c[u][2], c[u][3]);
    }
    for (; it < nitems; it += stride) {
        RopeIt r; rope_addr(p, it, r);
        const u32x4 a = *(const u32x4*)(r.src + 8 * r.j), b = *(const u32x4*)(r.src + 32 + 8 * r.j);
        const f32x4 c0 = *(const f32x4*)(r.rp), c1 = *(const f32x4*)(r.rp + 4), c2 = *(const f32x4*)(r.rp + 8), c3 = *(const f32x4*)(r.rp + 12);
        rope_apply(r, a, b, c0, c1, c2, c3);
    }
}
struct CmpSched {
    const char* kvraw; const char* w1; int K, kstepA, ldb; int G, c;
    __device__ __forceinline__ bool next(int i, pg8::Unit& u) const { const int L = i * G + c; if (L >= 128) return false; u.e = L; u.pm = L & 15; u.pn = 0; return true; }
    __device__ __forceinline__ const char* a_base() const { return kvraw; }
    __device__ __forceinline__ const char* b_base() const { return w1; }
    __device__ __forceinline__ const char* a_ptr(const pg8::Unit& u) const { return kvraw; }
    __device__ __forceinline__ void a_off(const pg8::Unit& u, int tid, unsigned (&off)[2][2]) const {
        const int kv = u.e >> 6, s = (u.e >> 4) & 3;
#pragma unroll
        for (int i = 0; i < 2; ++i) { int R, C; pg8::stage_rc(tid * 16 + i * 8192, R, C);
#pragma unroll
            for (int h = 0; h < 2; ++h) { int r = u.pm * 256 + h * 128 + R; r = r < 4080 ? r : 4079; const int b = r / 510, rem = r - b * 510, n = rem >> 1, hh = rem & 1;
                off[h][i] = (unsigned)(((b * NS + 16 * n + 8 * s) * 256 + kv * 128 + hh * 64 + C) * 2); } }
    }
    __device__ __forceinline__ const char* b_ptr(const pg8::Unit& u) const { const int kv = u.e >> 6, s = (u.e >> 4) & 3; return w1 + ((size_t)kv * 256 * 2048 + s * 512) * 2; }
};
struct EpiCmp {
    static constexpr bool PERM = false;
    float* cpart;
    __device__ __forceinline__ void operator()(const f32x4 (&acc)[2][2][4][2], const pg8::Unit& u, int wr, int wc, int fr, int fq) const {
        float* base = cpart + (size_t)(u.e >> 4) * 4096 * 256;
        const int row0 = u.pm * 256 + wr * 64 + fr, col0 = wc * 32 + 4 * fq;
#pragma unroll
        for (int ai = 0; ai < 2; ++ai)
#pragma unroll
            for (int m = 0; m < 4; ++m) { float* rowp = base + (size_t)(row0 + ai * 128 + m * 16) * 256 + col0;
#pragma unroll
                for (int bj = 0; bj < 2; ++bj)
#pragma unroll
                    for (int n = 0; n < 2; ++n) *(f32x4*)(rowp + bj * 128 + n * 16) = acc[ai][bj][m][n]; }
    }
};
__device__ __forceinline__ void ph_cmp2(const OP& p, int l, LAS unsigned char* lds, int bid, int nb) {
    const int tid = tid_(), lane = tid & 63, wave = tid >> 6;
    LAS float* w2s = (LAS float*)lds;
    LAS float* hid = w2s + 256 * 64 + wave * 256;
    int kv_loaded = -1;
    for (int it0 = bid * 8; it0 < 2 * 4096; it0 += nb * 8) {
        const int it = it0 + wave, kv = it0 >> 12, r = it & 4095;
        if (kv != kv_loaded) { __syncthreads(); const float* w2 = (kv ? p.w2v : p.w2k) + (size_t)l * 256 * 64;
            for (int i = tid; i < 256 * 64 / 4; i += 512) *(LAS f32x4*)(w2s + i * 4) = *(const f32x4*)(w2 + i * 4);
            kv_loaded = kv; __syncthreads(); }
        bf16_t* dstbase = kv ? p.vc() : p.kc();
        if (r >= 4080) { if (r < 4088) { const int b = r - 4080; dstbase[((size_t)b * 256 + 255) * 128 + lane] = 0; dstbase[((size_t)b * 256 + 255) * 128 + 64 + lane] = 0; } continue; }
        const float* cp = p.cpart() + ((size_t)kv * 4 * 4096 + r) * 256 + lane * 4;
        f32x4 a = *(const f32x4*)(p.bias1() + (l * 2 + kv) * 256 + lane * 4);
        { f32x4 pv[4];
#pragma unroll
          for (int s = 0; s < 4; ++s) pv[s] = *(const f32x4*)(cp + (size_t)s * 4096 * 256);
#pragma unroll
          for (int s = 0; s < 4; ++s) a += pv[s]; }
        asm volatile("s_waitcnt lgkmcnt(0)" ::: "memory");
        *(LAS f32x4*)(hid + lane * 4) = (f32x4){fgelu(a.x), fgelu(a.y), fgelu(a.z), fgelu(a.w)};
        asm volatile("s_waitcnt lgkmcnt(0)" ::: "memory");
        float o = 0.f;
#pragma unroll 16
        for (int f = 0; f < 256; ++f) o = fmaf(hid[f], w2s[f * 64 + lane], o);
        const int b = r / 510, rem = r - b * 510, n = rem >> 1, hh = rem & 1;
        if (!kv) { float ss = o * o;
#pragma unroll
            for (int x = 32; x >= 1; x >>= 1) ss += __shfl_xor(ss, x);
            o = o * rsqrtf(ss * (1.f / 64.f) + 1e-6f) * p.k_gain[l * 64 + lane]; }
        dstbase[((size_t)b * 256 + n) * 128 + hh * 64 + lane] = (bf16_t)f2bf(o);
    }
    __syncthreads();
}

#define GM_PITCH 520
typedef short v4i16_t __attribute__((ext_vector_type(4)));
__device__ __forceinline__ s16x4 ds_tr16(const LAS bf16_t* ptr) { return __builtin_bit_cast(s16x4, __builtin_amdgcn_ds_read_tr16_b64_v4i16((LAS v4i16_t*)ptr)); }
__device__ __forceinline__ void ph_gmlp(const OP& p, int l, LAS unsigned char* lds, int bid, int nb) {
    const int tid = tid_(), lane = tid & 63, wave = tid >> 6;
    LAS bf16_t* vn = (LAS bf16_t*)lds;
    for (int ch = bid; ch < NT / 128; ch += nb) {
        const size_t base = (size_t)ch * 128;
        __syncthreads();
        f32x4 g0 = *(const f32x4*)(p.ln_g + l * 512 + lane * 8), g1 = *(const f32x4*)(p.ln_g + l * 512 + lane * 8 + 4), b0 = *(const f32x4*)(p.ln_b + l * 512 + lane * 8), b1 = *(const f32x4*)(p.ln_b + l * 512 + lane * 8 + 4);
#pragma unroll 4
        for (int tt = 0; tt < 16; ++tt) {
            const int t = wave * 16 + tt;
            const u32x4 raw = *(const u32x4*)(p.v() + (base + t) * 512 + lane * 8);
            float x[8] = {__uint_as_float(raw.x << 16), __uint_as_float(raw.x & 0xffff0000u), __uint_as_float(raw.y << 16), __uint_as_float(raw.y & 0xffff0000u),
                          __uint_as_float(raw.z << 16), __uint_as_float(raw.z & 0xffff0000u), __uint_as_float(raw.w << 16), __uint_as_float(raw.w & 0xffff0000u)};
            float s = 0.f;
#pragma unroll
            for (int i = 0; i < 8; ++i) s += x[i];
#pragma unroll
            for (int o = 32; o >= 1; o >>= 1) s += __shfl_xor(s, o);
            const float mu = s * (1.f / 512.f); float q = 0.f;
#pragma unroll
            for (int i = 0; i < 8; ++i) { x[i] -= mu; q += x[i] * x[i]; }
#pragma unroll
            for (int o = 32; o >= 1; o >>= 1) q += __shfl_xor(q, o);
            const float rstd = rsqrtf(q * (1.f / 512.f) + 1e-6f);
            u32x4 w; w.x = pk2(x[0] * rstd * g0.x + b0.x, x[1] * rstd * g0.y + b0.y); w.y = pk2(x[2] * rstd * g0.z + b0.z, x[3] * rstd * g0.w + b0.w);
            w.z = pk2(x[4] * rstd * g1.x + b1.x, x[5] * rstd * g1.y + b1.y); w.w = pk2(x[6] * rstd * g1.z + b1.z, x[7] * rstd * g1.w + b1.w);
            *(LAS u32x4*)(vn + t * GM_PITCH + lane * 8) = w;
        }
        __syncthreads();
        const int g = wave, r32 = lane & 31, hi = lane >> 5;
        const bf16_t* wsg = p.wsc() + ((size_t)l * 8 + g) * 128 * 128;
        const LAS bf16_t* bbase = vn + (8 * hi + ((lane & 15) >> 2)) * GM_PITCH + g * 64 + 16 * ((lane >> 4) & 1) + 4 * (lane & 3);
        const float* bsg = p.gm_bs + (l * 8 + g) * 128;
#pragma unroll
        for (int mt = 3; mt >= 0; --mt) {
            bf16x8 af[8];
#pragma unroll
            for (int ks = 0; ks < 2 * (mt + 1); ++ks) af[ks] = *(const bf16x8*)(wsg + (size_t)(32 * mt + r32) * 128 + 16 * ks + 8 * hi);
            float bsv[16];
#pragma unroll
            for (int rg = 0; rg < 16; ++rg) bsv[rg] = bsg[32 * mt + (rg & 3) + 8 * (rg >> 2) + 4 * hi];
            f32x16 acc0, acc1;
#pragma unroll
            for (int i = 0; i < 16; ++i) { acc0[i] = 0.f; acc1[i] = 0.f; }
#pragma unroll
            for (int ks = 0; ks < 2 * (mt + 1); ++ks) {
                const LAS bf16_t* bp = bbase + 16 * ks * GM_PITCH;
                const s16x4 b00 = ds_tr16(bp), b01 = ds_tr16(bp + 4 * GM_PITCH), b10 = ds_tr16(bp + 32), b11 = ds_tr16(bp + 4 * GM_PITCH + 32);
                const bf16x8 bf0 = {b00[0], b00[1], b00[2], b00[3], b01[0], b01[1], b01[2], b01[3]}, bf1 = {b10[0], b10[1], b10[2], b10[3], b11[0], b11[1], b11[2], b11[3]};
                acc0 = __builtin_amdgcn_mfma_f32_32x32x16_bf16(af[ks], bf0, acc0, 0, 0, 0);
                acc1 = __builtin_amdgcn_mfma_f32_32x32x16_bf16(af[ks], bf1, acc1, 0, 0, 0);
            }
#pragma unroll
            for (int rg = 0; rg < 16; ++rg) {
                const int t = 32 * mt + (rg & 3) + 8 * (rg >> 2) + 4 * hi;
                vn[t * GM_PITCH + g * 64 + r32] = (bf16_t)f2bf(acc0[rg] + bsv[rg]); vn[t * GM_PITCH + g * 64 + 32 + r32] = (bf16_t)f2bf(acc1[rg] + bsv[rg]);
            }
        }
        asm volatile("s_waitcnt lgkmcnt(0)" ::: "memory");
        for (int i0 = 0; i0 < 16; i0 += 4) {
            u32x4 uv4[4];
#pragma unroll
            for (int ii = 0; ii < 4; ++ii) { const int t = 8 * (i0 + ii) + (lane >> 3), c8 = (lane & 7) * 8; uv4[ii] = *(const u32x4*)(p.u() + (base + t) * 512 + g * 64 + c8); }
#pragma unroll
            for (int ii = 0; ii < 4; ++ii) {
                const int t = 8 * (i0 + ii) + (lane >> 3), c8 = (lane & 7) * 8;
                const u32x4 mv = *(const LAS u32x4*)(vn + t * GM_PITCH + g * 64 + c8);
                const u32x4 uv = uv4[ii];
                const unsigned mw[4] = {mv.x, mv.y, mv.z, mv.w}, uw[4] = {uv.x, uv.y, uv.z, uv.w}; unsigned ow[4];
                float of[8];
#pragma unroll
                for (int k = 0; k < 4; ++k) { of[2 * k] = __uint_as_float(mw[k] << 16) * __uint_as_float(uw[k] << 16) * H8_SCALE; of[2 * k + 1] = __uint_as_float(mw[k] & 0xffff0000u) * __uint_as_float(uw[k] & 0xffff0000u) * H8_SCALE; }
                (void)ow;
                *(u32x2*)((unsigned char*)p.onsa() + (base + t) * 1024 + 512 + g * 64 + c8) = (u32x2){pk4_e4m3(of[0], of[1], of[2], of[3]), pk4_e4m3(of[4], of[5], of[6], of[7])};
            }
        }
    }
    __syncthreads();
}
#define AT_PITCH 144
#define AT_TILE (64 * AT_PITCH)
#define AT_IMP (4 * AT_TILE)
#define AT_SELM (AT_IMP + 64 * 65 * 4)
#define AT_OST (AT_SELM + 1024)
#define AT_OPITCH 272
#define AT_LOG2E 1.4426950408889634f
#define LDS_ADD(ptr, val) (void)__hip_atomic_fetch_add((ptr), (val), __ATOMIC_RELAXED, __HIP_MEMORY_SCOPE_WORKGROUP)
__device__ __forceinline__ float xhalf_max(float v) { const auto r = __builtin_amdgcn_permlane32_swap(__float_as_uint(v), __float_as_uint(v), false, false); return fmaxf(__uint_as_float(r[0]), __uint_as_float(r[1])); }
__device__ __forceinline__ float xhalf_sum(float v) { const auto r = __builtin_amdgcn_permlane32_swap(__float_as_uint(v), __float_as_uint(v), false, false); return __uint_as_float(r[0]) + __uint_as_float(r[1]); }
__device__ __forceinline__ float max3f(float a, float b, float c) { float r; asm("v_max3_f32 %0, %1, %2, %3" : "=v"(r) : "v"(a), "v"(b), "v"(c)); return r; }
enum { AM_CMP1 = 0, AM_CMP2 = 1, AM_SEL = 2, AM_WIN = 3 };

struct AttnWave {
    f32x16 o0, o1;
    f32x16 ls;
    float M, L;
};

template <int MODE, bool FIXM>
__device__ __forceinline__ void attn_tile(AttnWave& W, const bf16x8 (&qt)[4], const LAS unsigned char* Kl, const LAS unsigned char* Vl, int lane, int r32, int hi,
                                          int lim, bool diag, bool ledge, bool lanesel, float invl, LAS unsigned* imp_row, int jbase) {
    f32x16 s0, s1;
    const float sinit = 0.f;
    const unsigned lmask = (FIXM && MODE == AM_SEL && !lanesel) ? 0u : 0xffffffffu;
#pragma unroll
    for (int i = 0; i < 16; ++i) { s0[i] = sinit; s1[i] = sinit; }
    bf16x8 ka[2][4];
#pragma unroll
    for (int ks = 0; ks < 4; ++ks) { ka[0][ks] = *(const LAS bf16x8*)(Kl + r32 * AT_PITCH + (16 * ks + 8 * hi) * 2); ka[1][ks] = *(const LAS bf16x8*)(Kl + (32 + r32) * AT_PITCH + (16 * ks + 8 * hi) * 2); }
    __builtin_amdgcn_s_setprio(1);
#pragma unroll
    for (int ks = 0; ks < 4; ++ks) { s0 = __builtin_amdgcn_mfma_f32_32x32x16_bf16(ka[0][ks], qt[ks], s0, 0, 0, 0); s1 = __builtin_amdgcn_mfma_f32_32x32x16_bf16(ka[1][ks], qt[ks], s1, 0, 0, 0); }
    __builtin_amdgcn_s_setprio(0);
    s16x4 va[2][2][2][2];
    if (MODE != AM_CMP1) {
        const LAS unsigned char* vb = Vl + ((lane & 15) >> 2) * AT_PITCH + (16 * ((lane >> 4) & 1) + 4 * (lane & 3)) * 2 + (4 * hi) * AT_PITCH;
#pragma unroll
        for (int mt = 0; mt < 2; ++mt)
#pragma unroll
            for (int s = 0; s < 2; ++s) { const LAS unsigned char* vk = vb + (32 * mt + 16 * s) * AT_PITCH;
                va[mt][s][0][0] = ds_tr16((const LAS bf16_t*)(vk)); va[mt][s][0][1] = ds_tr16((const LAS bf16_t*)(vk + 8 * AT_PITCH));
                va[mt][s][1][0] = ds_tr16((const LAS bf16_t*)(vk + 64)); va[mt][s][1][1] = ds_tr16((const LAS bf16_t*)(vk + 8 * AT_PITCH + 64)); }
    }
    const float NEG = -INFINITY;
    if (MODE == AM_CMP1 || MODE == AM_CMP2) {
#pragma unroll
        for (int r = 0; r < 16; ++r) { const int k0 = (r & 3) + 8 * (r >> 2) + 4 * hi; s0[r] = (k0 < lim) ? s0[r] : NEG; s1[r] = (32 + k0 < lim) ? s1[r] : NEG; }
    } else {
        if (diag) {
#pragma unroll
            for (int r = 0; r < 16; ++r) { const int k0 = (r & 3) + 8 * (r >> 2) + 4 * hi; s0[r] = (k0 <= lim) ? s0[r] : NEG; s1[r] = (32 + k0 <= lim) ? s1[r] : NEG; }
        }
        if (MODE == AM_WIN && ledge) {
#pragma unroll
            for (int r = 0; r < 16; ++r) { const int k0 = (r & 3) + 8 * (r >> 2) + 4 * hi; s0[r] = (k0 > lim) ? s0[r] : NEG; s1[r] = (32 + k0 > lim) ? s1[r] : NEG; }
        }
    }
    float Mn = W.M;
    if (MODE != AM_CMP2 && !FIXM) {
        float mx = max3f(s0[0], s1[0], s0[1]);
#pragma unroll
        for (int r = 1; r < 15; ++r) mx = max3f(mx, s1[r], s0[r + 1]);
        mx = max3f(mx, s1[15], s1[15]);
        mx = xhalf_max(mx);
        if (MODE == AM_SEL) mx = lanesel ? mx : NEG;
        Mn = fmaxf(W.M, mx);
    }
    const float Msub = (MODE == AM_SEL && !lanesel) ? INFINITY : Mn;
    float ps = 0.f;
    if (FIXM) {
        if (MODE == AM_SEL || MODE == AM_WIN) {
#pragma unroll
            for (int r = 0; r < 16; ++r) { s0[r] = __builtin_amdgcn_exp2f(s0[r]); s1[r] = __builtin_amdgcn_exp2f(s1[r]); }
        } else {
#pragma unroll
            for (int r = 0; r < 16; ++r) { s0[r] = __builtin_amdgcn_exp2f(s0[r]); s1[r] = __builtin_amdgcn_exp2f(s1[r]); ps += s0[r] + s1[r]; }
        }
    } else {
#pragma unroll
        for (int r = 0; r < 16; ++r) { s0[r] = __builtin_amdgcn_exp2f(s0[r] - Msub); s1[r] = __builtin_amdgcn_exp2f(s1[r] - Msub); ps += s0[r] + s1[r]; }
    }
    if (MODE == AM_CMP1) {
        ps = xhalf_sum(ps);
        if (FIXM) { W.L += ps; return; }
        const float alpha = __builtin_amdgcn_exp2f(W.M - Mn);
        W.L = W.L * alpha + ps; W.M = Mn;
        return;
    }
    if (MODE == AM_CMP2) {
#pragma unroll
        for (int r = 0; r < 16; ++r) { s0[r] *= invl; s1[r] *= invl; }
#pragma unroll
        for (int i = 0; i < 4; ++i) {
            const float q0 = (s0[4 * i] + s0[4 * i + 1]) + (s0[4 * i + 2] + s0[4 * i + 3]), q1 = (s1[4 * i] + s1[4 * i + 1]) + (s1[4 * i + 2] + s1[4 * i + 3]);
            const int j0 = jbase + 2 * i + hi, j1 = j0 + 8;
            LDS_ADD(imp_row + j0, (unsigned)(q0 * 268435456.f + 0.5f)); LDS_ADD(imp_row + j1, (unsigned)(q1 * 268435456.f + 0.5f));
            LDS_ADD(imp_row + j0 + 1, (unsigned)(s0[4 * i + 3] * 268435456.f + 0.5f)); if (j1 + 1 < 64) LDS_ADD(imp_row + j1 + 1, (unsigned)(s1[4 * i + 3] * 268435456.f + 0.5f));
        }
    } else {
        if (!(FIXM && (MODE == AM_SEL || MODE == AM_WIN))) ps = xhalf_sum(ps);
        if (!FIXM && __builtin_amdgcn_ballot_w64(Mn != W.M) != 0ull) {
            const float alpha = __builtin_amdgcn_exp2f(W.M - Mn);
            W.L *= alpha;
#pragma unroll
            for (int r = 0; r < 16; ++r) { W.o0[r] *= alpha; W.o1[r] *= alpha; }
            W.M = Mn;
        }
        W.L += ps;
    }
    __builtin_amdgcn_s_setprio(1);
#pragma unroll
    for (int mt = 0; mt < 2; ++mt)
#pragma unroll
        for (int s = 0; s < 2; ++s) {
            const f32x16& sv = mt ? s1 : s0;
            bf16x8 pb;
            { unsigned w0 = pk2(sv[8 * s + 0], sv[8 * s + 1]), w1 = pk2(sv[8 * s + 2], sv[8 * s + 3]), w2 = pk2(sv[8 * s + 4], sv[8 * s + 5]), w3 = pk2(sv[8 * s + 6], sv[8 * s + 7]);
              if (FIXM && MODE == AM_SEL) { w0 &= lmask; w1 &= lmask; w2 &= lmask; w3 &= lmask; }
              const u32x4 wv = {w0, w1, w2, w3}; pb = __builtin_bit_cast(bf16x8, wv); }
            const s16x4 a00 = va[mt][s][0][0], a01 = va[mt][s][0][1], a10 = va[mt][s][1][0], a11 = va[mt][s][1][1];
            const bf16x8 av0 = {a00[0], a00[1], a00[2], a00[3], a01[0], a01[1], a01[2], a01[3]}, av1 = {a10[0], a10[1], a10[2], a10[3], a11[0], a11[1], a11[2], a11[3]};
            W.o0 = __builtin_amdgcn_mfma_f32_32x32x16_bf16(av0, pb, W.o0, 0, 0, 0);
            W.o1 = __builtin_amdgcn_mfma_f32_32x32x16_bf16(av1, pb, W.o1, 0, 0, 0);
            if (FIXM && (MODE == AM_SEL || MODE == AM_WIN)) { const bf16x8 ones = {0x3f80, 0x3f80, 0x3f80, 0x3f80, 0x3f80, 0x3f80, 0x3f80, 0x3f80}; W.ls = __builtin_amdgcn_mfma_f32_32x32x16_bf16(ones, pb, W.ls, 0, 0, 0); }
        }
    __builtin_amdgcn_s_setprio(0);
}

__device__ __forceinline__ void at_store_tile(LAS unsigned char* lds, int buf, int tid, const u32x4& kr, const u32x4& vr) {
    const int key = tid >> 3, ch = tid & 7;
    *(LAS u32x4*)(lds + (2 * buf) * AT_TILE + key * AT_PITCH + ch * 16) = kr;
    *(LAS u32x4*)(lds + (2 * buf + 1) * AT_TILE + key * AT_PITCH + ch * 16) = vr;
}

#define ATT_TILE(MODE_, ...) do { if (fixm) attn_tile<MODE_, true>(__VA_ARGS__); else attn_tile<MODE_, false>(__VA_ARGS__); } while (0)
__device__ __forceinline__ void ph_attn(const OP& p, int l, LAS unsigned char* lds, int bid, int nb) {
    const int tid = tid_(), lane = tid & 63, wave = tid >> 6, r32 = lane & 31, hi = lane >> 5;
    const int g = wave >> 1, qh = wave & 1, qloc = 32 * qh + r32;
    LAS unsigned* imp = (LAS unsigned*)(lds + AT_IMP);
    LAS unsigned* selm = (LAS unsigned*)(lds + AT_SELM);
    LAS unsigned char* ost = lds + AT_OST + wave * (32 * AT_OPITCH);
    const int key_ld = tid >> 3, ch_ld = tid & 7;
    float gq = fabsf(p.q_gain[l * 64 + lane]), gk = fabsf(p.k_gain[l * 64 + lane]);
#pragma unroll
    for (int o = 32; o >= 1; o >>= 1) { gq = fmaxf(gq, __shfl_xor(gq, o)); gk = fmaxf(gk, __shfl_xor(gk, o)); }
    const float sbound = 8.0f * gq * gk * 1.001f + 0.01f;
    const bool fixm = sbound < 40.0f;
    const float Mfix = sbound * AT_LOG2E;
    for (int round = 0;; ++round) {
        const int idx = round * nb + ((round & 1) ? (nb - 1 - bid) : bid);
        if (idx >= 1024) break;
        const int qb = 63 - (idx >> 4), b = (idx & 15) >> 1, kvh = idx & 1, hq = kvh * 4 + g;
        const int t = qb * 64 + qloc; const size_t tok = (size_t)b * NS + t;
        __syncthreads();
        for (int i = tid; i < 64 * 65; i += 512) imp[i] = 0u;
        if (tid < 2) selm[128 + tid] = 0u;
        bf16x8 qt[4];
#pragma unroll
        for (int ks = 0; ks < 4; ++ks) qt[ks] = *(const bf16x8*)(p.qn() + tok * 512 + hq * 64 + 16 * ks + 8 * hi);
        int nvis = t >= 31 ? ((t - 31) >> 4) + 1 : 0; nvis = nvis > NCMP ? NCMP : nvis;
        const int nvmax = (qb * 64 + 63 - 31) / 16 + 1 > NCMP ? NCMP : (qb * 64 + 63 - 31) / 16 + 1;
        const int ntc = (nvmax + 63) >> 6;
        const bf16_t* kcb = p.kc() + (size_t)b * 256 * 128 + kvh * 64 + ch_ld * 8;
        const bf16_t* vcb = p.vc() + (size_t)b * 256 * 128 + kvh * 64 + ch_ld * 8;
        AttnWave W;
        W.M = fixm ? Mfix : -1e30f; W.L = 0.f;
#pragma unroll
        for (int i = 0; i < 16; ++i) { W.o0[i] = 0.f; W.o1[i] = 0.f; }
        const float gate0 = p.gates()[tok * 32 + hq * 3 + 0], gate1 = p.gates()[tok * 32 + hq * 3 + 1], gate2 = p.gates()[tok * 32 + hq * 3 + 2];
        u32x4 kr, vr;
        kr = *(const u32x4*)(kcb + (size_t)key_ld * 128); vr = *(const u32x4*)(vcb + (size_t)key_ld * 128);
        at_store_tile(lds, 0, tid, kr, vr);
        __syncthreads();
        float invl = 0.f;
        for (int i = 0; i < 2 * ntc; ++i) {
            const int kt = i < ntc ? i : i - ntc, nx = i + 1, ktn = nx < ntc ? nx : nx - ntc;
            if (nx < 2 * ntc) { kr = *(const u32x4*)(kcb + (size_t)(64 * ktn + key_ld) * 128); vr = *(const u32x4*)(vcb + (size_t)(64 * ktn + key_ld) * 128); }
            const LAS unsigned char* Kl = lds + (2 * (i & 1)) * AT_TILE; const LAS unsigned char* Vl = Kl + AT_TILE;
            if (i < ntc) ATT_TILE(AM_CMP1, W, qt, Kl, Vl, lane, r32, hi, nvis - 64 * kt, false, false, true, 0.f, nullptr, 0);
            else { if (i == ntc) invl = 1.0f / fmaxf(W.L, 1e-30f);
                   ATT_TILE(AM_CMP2, W, qt, Kl, Vl, lane, r32, hi, nvis - 64 * kt, false, false, true, invl, imp + qloc * 65, 16 * kt); }
            if (nx < 2 * ntc) at_store_tile(lds, nx & 1, tid, kr, vr);
            __syncthreads();
        }
#pragma unroll
        for (int i = 0; i < 4; ++i) {
            *(LAS f32x4*)(ost + r32 * AT_OPITCH + (8 * i + 4 * hi) * 4) = (f32x4){gate0 * W.o0[4 * i], gate0 * W.o0[4 * i + 1], gate0 * W.o0[4 * i + 2], gate0 * W.o0[4 * i + 3]};
            *(LAS f32x4*)(ost + r32 * AT_OPITCH + (32 + 8 * i + 4 * hi) * 4) = (f32x4){gate0 * W.o1[4 * i], gate0 * W.o1[4 * i + 1], gate0 * W.o1[4 * i + 2], gate0 * W.o1[4 * i + 3]};
        }
        const bf16_t* kbs = p.ksv() + (size_t)b * NS * 256 + kvh * 64 + ch_ld * 8;
        kr = *(const u32x4*)(kbs + (size_t)key_ld * 256); vr = *(const u32x4*)(kbs + (size_t)key_ld * 256 + 128);
        {
            const int q = tid >> 3, part = tid & 7;
            const LAS unsigned* row = imp + q * 65 + part * 8;
            unsigned key[8];
#pragma unroll
            for (int i = 0; i < 8; ++i) { const int j = part * 8 + i; const unsigned v = (j == 0 || j == qb || j == qb - 1) ? 0xffffffffu : (row[i] | 64u);
                key[i] = (j <= qb) ? ((v & 0xffffffc0u) | (unsigned)(63 - j)) : 0u; }
            unsigned long long mask = 0ull; const int rounds = qb + 1 < 16 ? qb + 1 : 16;
            for (int it = 0; it < rounds; ++it) {
                unsigned best = key[0];
#pragma unroll
                for (int i = 1; i < 8; ++i) best = key[i] > best ? key[i] : best;
                { unsigned o;
                  o = (unsigned)__builtin_amdgcn_update_dpp(0, (int)best, 0xB1, 0xf, 0xf, false); best = best > o ? best : o;
                  o = (unsigned)__builtin_amdgcn_update_dpp(0, (int)best, 0x4E, 0xf, 0xf, false); best = best > o ? best : o;
                  o = (unsigned)__builtin_amdgcn_update_dpp(0, (int)best, 0x141, 0xf, 0xf, false); best = best > o ? best : o; }
                const int jw = 63 - (int)(best & 63u);
                mask |= 1ull << jw;
#pragma unroll
                for (int i = 0; i < 8; ++i) key[i] = (key[i] == best) ? 0u : key[i];
            }
            if (part == 0) { selm[2 * q] = (unsigned)mask; selm[2 * q + 1] = (unsigned)(mask >> 32);
                (void)__hip_atomic_fetch_or(selm + 128, (unsigned)mask, __ATOMIC_RELAXED, __HIP_MEMORY_SCOPE_WORKGROUP); (void)__hip_atomic_fetch_or(selm + 129, (unsigned)(mask >> 32), __ATOMIC_RELAXED, __HIP_MEMORY_SCOPE_WORKGROUP); }
        }
        __syncthreads();
        const unsigned long long mymask = (unsigned long long)selm[2 * qloc] | ((unsigned long long)selm[2 * qloc + 1] << 32);
        const unsigned long long umask = (unsigned long long)selm[128] | ((unsigned long long)selm[129] << 32);
        const bf16_t* kbw = p.kwv() + (size_t)b * NS * 256 + kvh * 64 + ch_ld * 8;
        const int j0w = qb - 8 > 0 ? qb - 8 : 0;
        int pw = 0;
#pragma unroll
        for (int ks = 0; ks < 4; ++ks) qt[ks] = *(const bf16x8*)(p.qr() + tok * 512 + hq * 64 + 16 * ks + 8 * hi);
        {
            W.M = fixm ? Mfix : -1e30f; W.L = 0.f;
#pragma unroll
            for (int i = 0; i < 16; ++i) { W.o0[i] = 0.f; W.o1[i] = 0.f; W.ls[i] = 0.f; }
            const bf16_t* kb = kbs;
            unsigned long long rem = umask & ~1ull;
            int j = 0;
            at_store_tile(lds, 0, tid, kr, vr);
            __syncthreads();

            for (int i = 0;; ++i) {
                const bool more = rem != 0ull; int jn = 0;
                if (more) { jn = __builtin_ctzll(rem); rem &= rem - 1; kr = *(const u32x4*)(kb + (size_t)(64 * jn + key_ld) * 256); vr = *(const u32x4*)(kb + (size_t)(64 * jn + key_ld) * 256 + 128); }
                else { kr = *(const u32x4*)(kbw + (size_t)(64 * j0w + key_ld) * 256); vr = *(const u32x4*)(kbw + (size_t)(64 * j0w + key_ld) * 256 + 128); }
                const LAS unsigned char* Kl = lds + (2 * (i & 1)) * AT_TILE; const LAS unsigned char* Vl = Kl + AT_TILE;
                ATT_TILE(AM_SEL, W, qt, Kl, Vl, lane, r32, hi, qloc, j == qb, false, ((mymask >> j) & 1ull) != 0ull, 0.f, nullptr, 0);
                at_store_tile(lds, (i + 1) & 1, tid, kr, vr);
                __syncthreads();
                if (!more) { pw = (i + 1) & 1; break; }
                j = jn;
            }
            if (fixm) W.L = W.ls[0];
            const float sc = gate1 / fmaxf(W.L, 1e-30f);
#pragma unroll
            for (int i = 0; i < 4; ++i) {
                LAS f32x4* p0 = (LAS f32x4*)(ost + r32 * AT_OPITCH + (8 * i + 4 * hi) * 4); LAS f32x4* p1 = (LAS f32x4*)(ost + r32 * AT_OPITCH + (32 + 8 * i + 4 * hi) * 4);
                *p0 = *p0 + (f32x4){sc * W.o0[4 * i], sc * W.o0[4 * i + 1], sc * W.o0[4 * i + 2], sc * W.o0[4 * i + 3]};
                *p1 = *p1 + (f32x4){sc * W.o1[4 * i], sc * W.o1[4 * i + 1], sc * W.o1[4 * i + 2], sc * W.o1[4 * i + 3]};
            }
        }
        {
            W.M = fixm ? Mfix : -1e30f; W.L = 0.f;
#pragma unroll
            for (int i = 0; i < 16; ++i) { W.o0[i] = 0.f; W.o1[i] = 0.f; W.ls[i] = 0.f; }
            const bf16_t* kb = kbw;
            const int j0 = j0w;
            for (int j = j0; j <= qb; ++j) {
                const int i = j - j0 + pw;
                if (j < qb) { kr = *(const u32x4*)(kb + (size_t)(64 * (j + 1) + key_ld) * 256); vr = *(const u32x4*)(kb + (size_t)(64 * (j + 1) + key_ld) * 256 + 128); }
                const LAS unsigned char* Kl = lds + (2 * (i & 1)) * AT_TILE; const LAS unsigned char* Vl = Kl + AT_TILE;
                ATT_TILE(AM_WIN, W, qt, Kl, Vl, lane, r32, hi, qloc, j == qb, j == qb - 8, true, 0.f, nullptr, 0);
                if (j < qb) at_store_tile(lds, (i + 1) & 1, tid, kr, vr);
                __syncthreads();
            }
            if (fixm) W.L = W.ls[0];
            const float sc = gate2 / fmaxf(W.L, 1e-30f);
#pragma unroll
            for (int i = 0; i < 4; ++i) {
                LAS f32x4* p0 = (LAS f32x4*)(ost + r32 * AT_OPITCH + (8 * i + 4 * hi) * 4); LAS f32x4* p1 = (LAS f32x4*)(ost + r32 * AT_OPITCH + (32 + 8 * i + 4 * hi) * 4);
                *p0 = *p0 + (f32x4){sc * W.o0[4 * i], sc * W.o0[4 * i + 1], sc * W.o0[4 * i + 2], sc * W.o0[4 * i + 3]};
                *p1 = *p1 + (f32x4){sc * W.o1[4 * i], sc * W.o1[4 * i + 1], sc * W.o1[4 * i + 2], sc * W.o1[4 * i + 3]};
            }
        }
        asm volatile("s_waitcnt lgkmcnt(0)" ::: "memory");
#pragma unroll
        for (int i = 0; i < 4; ++i) {
            const int row = 8 * i + (lane >> 3), c8 = lane & 7;
            const f32x4 a = *(const LAS f32x4*)(ost + row * AT_OPITCH + c8 * 32), bq = *(const LAS f32x4*)(ost + row * AT_OPITCH + c8 * 32 + 16);
            const u32x2 v = {pk4_e4m3(a.x * H8_SCALE, a.y * H8_SCALE, a.z * H8_SCALE, a.w * H8_SCALE), pk4_e4m3(bq.x * H8_SCALE, bq.y * H8_SCALE, bq.z * H8_SCALE, bq.w * H8_SCALE)};
            *(u32x2*)((unsigned char*)p.onsa() + ((size_t)b * NS + qb * 64 + 32 * qh + row) * 1024 + hq * 64 + c8 * 8) = v;
        }
    }
    __syncthreads();
}
struct EpiProjF {
    static constexpr bool PERM = true;
    bf16_t* merged; const bf16_t* ra; const bf16_t* sb; float dsc;
    static __device__ __forceinline__ unsigned base_off(const pg8::Unit& u, int wr, int wc, int fr, int fq) {
        unsigned b = (unsigned)(((u.pm * 256 + wr * 64 + fr) * ND + u.pn * 256 + wc * 32 + 8 * fq) * 2); asm volatile("" : "+v"(b)); return b; }
    __device__ __forceinline__ void mid(f32x4 (&acc)[2][2][4][2], const pg8::Unit& u, int wr, int wc, int fr, int fq) const {
        const unsigned b0 = base_off(u, wr, wc, fr, fq);
#pragma unroll
        for (int ai = 0; ai < 2; ++ai)
#pragma unroll
            for (int m = 0; m < 4; ++m) {
                const unsigned ro = b0 + (unsigned)((ai * 128 + m * 16) * ND * 2);
                u32x4 gv[2];
#pragma unroll
                for (int bj = 0; bj < 2; ++bj) gv[bj] = *(const u32x4*)((const char*)ra + ro + bj * 256);
#pragma unroll
                for (int bj = 0; bj < 2; ++bj) {
                    acc[ai][bj][m][0] *= (f32x4){__uint_as_float(gv[bj].x << 16), __uint_as_float(gv[bj].x & 0xffff0000u), __uint_as_float(gv[bj].y << 16), __uint_as_float(gv[bj].y & 0xffff0000u)};
                    acc[ai][bj][m][1] *= (f32x4){__uint_as_float(gv[bj].z << 16), __uint_as_float(gv[bj].z & 0xffff0000u), __uint_as_float(gv[bj].w << 16), __uint_as_float(gv[bj].w & 0xffff0000u)};
                }
            }
    }
    __device__ __forceinline__ void operator()(const f32x4 (&acc)[2][2][4][2], const pg8::Unit& u, int wr, int wc, int fr, int fq) const {
        const unsigned b0 = base_off(u, wr, wc, fr, fq);
        u32x4 gv[2][4][2];
#pragma unroll
        for (int ai = 0; ai < 2; ++ai)
#pragma unroll
            for (int m = 0; m < 4; ++m)
#pragma unroll
                for (int bj = 0; bj < 2; ++bj) gv[ai][m][bj] = *(const u32x4*)((const char*)sb + (b0 + (unsigned)((ai * 128 + m * 16) * ND * 2)) + bj * 256);
#pragma unroll
        for (int ai = 0; ai < 2; ++ai)
#pragma unroll
            for (int m = 0; m < 4; ++m) {
                const unsigned ro = b0 + (unsigned)((ai * 128 + m * 16) * ND * 2);
#pragma unroll
                for (int bj = 0; bj < 2; ++bj) { const u32x4 g = gv[ai][m][bj];
                    const f32x4 o0 = acc[ai][bj][m][0] * (f32x4){__uint_as_float(g.x << 16), __uint_as_float(g.x & 0xffff0000u), __uint_as_float(g.y << 16), __uint_as_float(g.y & 0xffff0000u)};
                    const f32x4 o1 = acc[ai][bj][m][1] * (f32x4){__uint_as_float(g.z << 16), __uint_as_float(g.z & 0xffff0000u), __uint_as_float(g.w << 16), __uint_as_float(g.w & 0xffff0000u)};
                    *(u32x2*)((unsigned char*)merged + (ro >> 1) + bj * 128) = (u32x2){pk4_e4m3(o0.x * dsc, o0.y * dsc, o0.z * dsc, o0.w * dsc), pk4_e4m3(o1.x * dsc, o1.y * dsc, o1.z * dsc, o1.w * dsc)};
                }
            }
    }
};
template <bool XF32> struct EpiOut {
    static constexpr bool PERM = true;
    const float* xin; bf16_t* xb; const float* gt; float dsc;
    __device__ __forceinline__ void operator()(const f32x4 (&acc)[2][2][4][2], const pg8::Unit& u, int wr, int wc, int fr, int fq) const {
        const int row0 = u.pm * 256 + wr * 64 + fr, col0 = u.pn * 256 + wc * 32 + 8 * fq;
        const float* gp = gt + (size_t)(u.pm >> 4) * 6144 + col0;
        f32x4 g4[2][2];
#pragma unroll
        for (int bj = 0; bj < 2; ++bj)
#pragma unroll
            for (int n = 0; n < 2; ++n) g4[bj][n] = *(const f32x4*)(gp + bj * 128 + n * 4) * dsc;
#pragma unroll
        for (int ai = 0; ai < 2; ++ai) {
            f32x4 xv[4][2][2];
            if (XF32) {
#pragma unroll
                for (int m = 0; m < 4; ++m)
#pragma unroll
                    for (int bj = 0; bj < 2; ++bj) { const float* xp = xin + (size_t)(row0 + ai * 128 + m * 16) * ND + col0 + bj * 128; xv[m][bj][0] = *(const f32x4*)xp; xv[m][bj][1] = *(const f32x4*)(xp + 4); }
            } else {
                u32x4 r[4][2];
#pragma unroll
                for (int m = 0; m < 4; ++m)
#pragma unroll
                    for (int bj = 0; bj < 2; ++bj) r[m][bj] = *(const u32x4*)(xb + (size_t)(row0 + ai * 128 + m * 16) * ND + col0 + bj * 128);
#pragma unroll
                for (int m = 0; m < 4; ++m)
#pragma unroll
                    for (int bj = 0; bj < 2; ++bj) { const u32x4 q = r[m][bj];
                        xv[m][bj][0] = (f32x4){__uint_as_float(q.x << 16), __uint_as_float(q.x & 0xffff0000u), __uint_as_float(q.y << 16), __uint_as_float(q.y & 0xffff0000u)};
                        xv[m][bj][1] = (f32x4){__uint_as_float(q.z << 16), __uint_as_float(q.z & 0xffff0000u), __uint_as_float(q.w << 16), __uint_as_float(q.w & 0xffff0000u)}; }
            }
#pragma unroll
            for (int m = 0; m < 4; ++m)
#pragma unroll
                for (int bj = 0; bj < 2; ++bj) { const f32x4 o0 = xv[m][bj][0] + g4[bj][0] * acc[ai][bj][m][0], o1 = xv[m][bj][1] + g4[bj][1] * acc[ai][bj][m][1];
                    u32x4 w; w.x = pk2(o0.x, o0.y); w.y = pk2(o0.z, o0.w); w.z = pk2(o1.x, o1.y); w.w = pk2(o1.z, o1.w);
                    *(u32x4*)(xb + (size_t)(row0 + ai * 128 + m * 16) * ND + col0 + bj * 128) = w; }
        }
    }
};

struct EpiRouter {
    static constexpr bool PERM = true;
    float* logits; bf16_t* sact;
    __device__ __forceinline__ void operator()(const f32x4 (&acc)[2][2][4][2], const pg8::Unit& u, int wr, int wc, int fr, int fq) const {
        const int row0 = u.pm * 256 + wr * 64 + fr, cw = wc * 32 + 8 * fq;
        if (u.pn == 0) {
#pragma unroll
            for (int ai = 0; ai < 2; ++ai)
#pragma unroll
                for (int m = 0; m < 4; ++m) { float* rp = logits + (size_t)(row0 + ai * 128 + m * 16) * NE + cw;
#pragma unroll
                    for (int bj = 0; bj < 2; ++bj) { *(f32x4*)(rp + bj * 128) = acc[ai][bj][m][0]; *(f32x4*)(rp + bj * 128 + 4) = acc[ai][bj][m][1]; } }
        } else {
#pragma unroll
            for (int ai = 0; ai < 2; ++ai)
#pragma unroll
                for (int m = 0; m < 4; ++m) {
                    const f32x4 g0 = acc[ai][0][m][0], g1 = acc[ai][0][m][1], u0 = acc[ai][1][m][0], u1 = acc[ai][1][m][1];
                    u32x4 w; w.x = pk2(fsilu(g0.x) * u0.x, fsilu(g0.y) * u0.y); w.y = pk2(fsilu(g0.z) * u0.z, fsilu(g0.w) * u0.w);
                    w.z = pk2(fsilu(g1.x) * u1.x, fsilu(g1.y) * u1.y); w.w = pk2(fsilu(g1.z) * u1.z, fsilu(g1.w) * u1.w);
                    *(u32x4*)(sact + (size_t)(row0 + ai * 128 + m * 16) * 256 + (u.pn - 1) * 128 + cw) = w;
                }
        }
    }
};

__device__ __forceinline__ void ph_topk(const OP& p, int l, LAS unsigned char* lds, int bid, int nb) {
    const int tid = tid_(), lane = tid & 63, w = tid >> 6;
    LAS int* hist = (LAS int*)lds;
    const float* lg = p.logits(); int* idxp = p.idx(); float* wtp = p.wts(); int* slot = p.slot();
    __syncthreads();
    if (tid < 256) hist[tid] = 0;
    __syncthreads();
    const int CH = (NT + nb - 1) / nb, t0 = bid * CH, t1 = (t0 + CH) < NT ? (t0 + CH) : NT;
    float br[4];
#pragma unroll
    for (int i = 0; i < 4; ++i) br[i] = p.b_router[l * NE + i * 64 + lane];
    float lgn[4];
#pragma unroll
    for (int i = 0; i < 4; ++i) lgn[i] = (t0 + w < t1) ? lg[(size_t)(t0 + w) * NE + i * 64 + lane] : 0.f;
    for (int t = t0 + w; t < t1; t += 8) {
        unsigned key[4]; float affv[4];
#pragma unroll
        for (int i = 0; i < 4; ++i) { const int e = i * 64 + lane; const float aff = 1.0f / (1.0f + expf(-lgn[i])); affv[i] = aff; const float kf = fmaxf(aff + br[i], 1e-30f);
            key[i] = (__float_as_uint(kf) & 0xffffff00u) | (unsigned)(255 - e); }
        if (t + 8 < t1) {
#pragma unroll
            for (int i = 0; i < 4; ++i) lgn[i] = lg[(size_t)(t + 8) * NE + i * 64 + lane]; }
        int mye = 0;
#pragma unroll
        for (int r = 0; r < 8; ++r) {
            unsigned m = key[0] > key[1] ? key[0] : key[1]; { const unsigned m2 = key[2] > key[3] ? key[2] : key[3]; m = m > m2 ? m : m2; }
            { unsigned o;
              o = (unsigned)__builtin_amdgcn_update_dpp(0, (int)m, 0xB1, 0xf, 0xf, false); m = m > o ? m : o;
              o = (unsigned)__builtin_amdgcn_update_dpp(0, (int)m, 0x4E, 0xf, 0xf, false); m = m > o ? m : o;
              o = (unsigned)__builtin_amdgcn_update_dpp(0, (int)m, 0x141, 0xf, 0xf, false); m = m > o ? m : o;
              o = (unsigned)__builtin_amdgcn_update_dpp(0, (int)m, 0x140, 0xf, 0xf, false); m = m > o ? m : o; }
            const unsigned r0 = (unsigned)__builtin_amdgcn_readlane((int)m, 0), r1 = (unsigned)__builtin_amdgcn_readlane((int)m, 16), r2 = (unsigned)__builtin_amdgcn_readlane((int)m, 32), r3 = (unsigned)__builtin_amdgcn_readlane((int)m, 48);
            unsigned win = r0 > r1 ? r0 : r1; { const unsigned w2 = r2 > r3 ? r2 : r3; win = win > w2 ? win : w2; }
#pragma unroll
            for (int i = 0; i < 4; ++i) key[i] = (key[i] == win) ? 0u : key[i];
            if (lane == r) mye = 255 - (int)(win & 255u);
        }
        float av = 0.f;
        { const int sl = mye & 63, si = mye >> 6;
          const float a0 = __shfl(affv[0], sl), a1 = __shfl(affv[1], sl), a2 = __shfl(affv[2], sl), a3 = __shfl(affv[3], sl);
          const float sel = (si == 0) ? a0 : (si == 1) ? a1 : (si == 2) ? a2 : a3;
          if (lane < 8) av = sel; }
        float sum = av;
        sum += __shfl_xor(sum, 1); sum += __shfl_xor(sum, 2); sum += __shfl_xor(sum, 4);
        if (lane < 8) {
            idxp[(size_t)t * 8 + lane] = mye; wtp[(size_t)t * 8 + lane] = av / sum * 2.5f;
            slot[(size_t)t * 8 + lane] = __hip_atomic_fetch_add(hist + mye, 1, __ATOMIC_RELAXED, __HIP_MEMORY_SCOPE_WORKGROUP);
        }
    }
    __syncthreads();
    if (tid < 256) p.bhist()[bid * 256 + tid] = hist[tid];
    __syncthreads();
}
#define CW_NUNITS 64
__device__ __forceinline__ void ph_place(const OP& p, LAS unsigned char* lds, int bid, int nb) {
    const int tid = tid_();
    LAS int* pst = (LAS int*)lds;
    LAS int* cntl = pst + 260;
    LAS int* basel = cntl + 256;
    int* rtok = p.row_tok(); float* rw = p.row_w(); int* ue = p.unit_e(); const int* bh = p.bhist();
    LAS int* ptot = basel + 256;
    LAS int* pbase = ptot + 8 * 256;
    __syncthreads();
    { const int lane = tid & 63, wave = tid >> 6; int tot[4] = {0, 0, 0, 0}, base[4] = {0, 0, 0, 0};
      for (int b0 = wave; b0 < nb; b0 += 64) {
          int v[8][4];
#pragma unroll
          for (int k = 0; k < 8; ++k) { const int b = b0 + 8 * k;
#pragma unroll
              for (int i = 0; i < 4; ++i) v[k][i] = (b < nb) ? bh[b * 256 + i * 64 + lane] : 0; }
#pragma unroll
          for (int k = 0; k < 8; ++k) { const int b = b0 + 8 * k;
#pragma unroll
              for (int i = 0; i < 4; ++i) { tot[i] += v[k][i]; base[i] += (b < bid) ? v[k][i] : 0; } }
      }
#pragma unroll
      for (int i = 0; i < 4; ++i) { ptot[wave * 256 + i * 64 + lane] = tot[i]; pbase[wave * 256 + i * 64 + lane] = base[i]; } }
    __syncthreads();
    if (tid < 256) { int tot = 0, base = 0;
#pragma unroll
        for (int ww = 0; ww < 8; ++ww) { tot += ptot[ww * 256 + tid]; base += pbase[ww * 256 + tid]; }
        cntl[tid] = tot; basel[tid] = base; ptot[tid] = (tot + 255) & ~255; }
    __syncthreads();
    if (tid <= 256) { int run = 0;
        for (int e = 0; e < 256; ++e) run += (e < tid) ? ptot[e] : 0;
        pst[tid] = run; }
    __syncthreads();
    if (bid == 0) {
        if (tid < 256) { for (int i = pst[tid] >> 8; i < pst[tid + 1] >> 8; ++i) ue[i] = tid; }
        if (tid == 0) p.ctl()[CW_NUNITS] = (unsigned)(pst[NE] >> 8);
    }
    for (int e = bid; e < NE; e += nb) { for (int r = pst[e] + cntl[e] + tid; r < pst[e + 1]; r += 512) { rtok[r] = 0; rw[r] = -1.f; } }
    const int* idxp = p.idx(); const float* wtp = p.wts(); int* slot = p.slot();
    const int CH = (NT + nb - 1) / nb, a0 = bid * CH * 8, a1 = ((bid + 1) * CH < NT ? (bid + 1) * CH : NT) * 8;
    for (int a = a0 + tid; a < a1; a += 512) {
        const int e = idxp[a]; const int dest = pst[e] + basel[e] + slot[a];
        rtok[dest] = a >> 3; rw[dest] = wtp[a]; slot[a] = dest;
    }
    __syncthreads();
}

__device__ __forceinline__ int xcd_chunk(int L, int nwg) { const int q = nwg / 8, r = nwg % 8, xcd = L % 8, off = L / 8; return (xcd < r ? xcd * (q + 1) : r * (q + 1) + (xcd - r) * q) + off; }
struct GatherSched {
    const char* h; const char* W; const int* row_tok; const int* unit_e; int K, kstepA, ldb; int nunits2, G, c; int arow, brow;
    __device__ __forceinline__ bool next(int i, pg8::Unit& u) const { int L = i * G + c; if (L >= nunits2) return false; L = xcd_chunk(L, nunits2); u.pm = L >> 1; u.pn = L & 1; u.e = unit_e[u.pm]; return true; }
    __device__ __forceinline__ const char* a_base() const { return h; }
    __device__ __forceinline__ const char* b_base() const { return W; }
    __device__ __forceinline__ const char* a_ptr(const pg8::Unit&) const { return h; }
    __device__ __forceinline__ void a_off(const pg8::Unit& u, int tid, unsigned (&off)[2][2]) const {
#pragma unroll
        for (int i = 0; i < 2; ++i) { int R, C; pg8::stage_rc(tid * 16 + i * 8192, R, C);
#pragma unroll
            for (int hh = 0; hh < 2; ++hh) off[hh][i] = (unsigned)(row_tok[u.pm * 256 + hh * 128 + R] * arow + C * 2); }
    }
    __device__ __forceinline__ const char* b_ptr(const pg8::Unit& u) const { return W + ((size_t)u.e * 512 + u.pn * 256) * brow; }
};
struct EpiAct {
    static constexpr bool PERM = true;
    unsigned char* act8; float dsc;
    __device__ __forceinline__ void operator()(const f32x4 (&acc)[2][2][4][2], const pg8::Unit& u, int wr, int wc, int fr, int fq) const {
        const int row0 = u.pm * 256 + wr * 64 + fr, cw = u.pn * 128 + wc * 32 + 8 * fq;
#pragma unroll
        for (int ai = 0; ai < 2; ++ai)
#pragma unroll
            for (int m = 0; m < 4; ++m) {
                const f32x4 g0 = acc[ai][0][m][0] * dsc, g1 = acc[ai][0][m][1] * dsc, u0 = acc[ai][1][m][0] * (dsc * H8_SCALE), u1 = acc[ai][1][m][1] * (dsc * H8_SCALE);
                const u32x2 w = {pk4_e4m3(fsilu(g0.x) * u0.x, fsilu(g0.y) * u0.y, fsilu(g0.z) * u0.z, fsilu(g0.w) * u0.w), pk4_e4m3(fsilu(g1.x) * u1.x, fsilu(g1.y) * u1.y, fsilu(g1.z) * u1.z, fsilu(g1.w) * u1.w)};
                *(u32x2*)(act8 + (size_t)(row0 + ai * 128 + m * 16) * 256 + cw) = w;
            }
    }
};
struct DownSched {
    const char* act; const char* W; const int* unit_e; int K, kstepA, ldb; int nunits4, G, c; int arow, brow;
    __device__ __forceinline__ bool next(int i, pg8::Unit& u) const { int L = i * G + c; if (L >= nunits4) return false; L = xcd_chunk(L, nunits4); u.pm = L >> 2; u.pn = L & 3; u.e = unit_e[u.pm]; return true; }
    __device__ __forceinline__ const char* a_base() const { return act; }
    __device__ __forceinline__ const char* b_base() const { return W; }
    __device__ __forceinline__ const char* a_ptr(const pg8::Unit& u) const { return act + (size_t)u.pm * 256 * arow; }
    __device__ __forceinline__ void a_off(const pg8::Unit&, int tid, unsigned (&off)[2][2]) const {
#pragma unroll
        for (int i = 0; i < 2; ++i) { int R, C; pg8::stage_rc(tid * 16 + i * 8192, R, C);
#pragma unroll
            for (int hh = 0; hh < 2; ++hh) off[hh][i] = (unsigned)((hh * 128 + R) * arow + C * 2); }
    }
    __device__ __forceinline__ const char* b_ptr(const pg8::Unit& u) const { return W + ((size_t)u.e * ND + u.pn * 256) * brow; }
};
#define YS_SCALE 8.0f
__device__ __forceinline__ unsigned pk4_fp8(f32x4 v) {
    int w = __builtin_amdgcn_cvt_pk_fp8_f32(__builtin_amdgcn_fmed3f(v.x, -240.f, 240.f), __builtin_amdgcn_fmed3f(v.y, -240.f, 240.f), 0, false);
    w = __builtin_amdgcn_cvt_pk_fp8_f32(__builtin_amdgcn_fmed3f(v.z, -240.f, 240.f), __builtin_amdgcn_fmed3f(v.w, -240.f, 240.f), w, true); return (unsigned)w;
}
template <bool FP8> struct EpiY {
    static constexpr bool PERM = true;
    void* y; const float* row_w; float dsc;
    __device__ __forceinline__ void operator()(const f32x4 (&acc)[2][2][4][2], const pg8::Unit& u, int wr, int wc, int fr, int fq) const {
        const int row0 = u.pm * 256 + wr * 64 + fr, cw = u.pn * 256 + wc * 32 + 8 * fq;
        float rwv[2][4];
#pragma unroll
        for (int ai = 0; ai < 2; ++ai)
#pragma unroll
            for (int m = 0; m < 4; ++m) rwv[ai][m] = row_w ? row_w[row0 + ai * 128 + m * 16] : 1.0f;
#pragma unroll
        for (int ai = 0; ai < 2; ++ai)
#pragma unroll
            for (int m = 0; m < 4; ++m) {
                const float s = rwv[ai][m];
                if (s < 0.f) continue;
                if (FP8) { unsigned char* rp = (unsigned char*)y + (size_t)(row0 + ai * 128 + m * 16) * ND + cw; const float s8 = s * (YS_SCALE * dsc);
#pragma unroll
                    for (int bj = 0; bj < 2; ++bj) { const u32x2 w = {pk4_fp8(acc[ai][bj][m][0] * s8), pk4_fp8(acc[ai][bj][m][1] * s8)}; *(u32x2*)(rp + bj * 128) = w; } }
                else { bf16_t* rp = (bf16_t*)y + (size_t)(row0 + ai * 128 + m * 16) * ND + cw;
#pragma unroll
                    for (int bj = 0; bj < 2; ++bj) { const f32x4 v0 = acc[ai][bj][m][0] * s, v1 = acc[ai][bj][m][1] * s;
                        u32x4 w; w.x = pk2(v0.x, v0.y); w.y = pk2(v0.z, v0.w); w.z = pk2(v1.x, v1.y); w.w = pk2(v1.z, v1.w); *(u32x4*)(rp + bj * 128) = w; } }
            }
    }
};
__device__ __forceinline__ void ph_combine(const OP& p, int l, int bid, int nb) {
    const int lane = tid_() & 63, w = tid_() >> 6;
    const unsigned char* ys8 = (const unsigned char*)p.yslot(); const bf16_t* sh = p.shout(); const int* slot = p.slot(); const float* mod = p.mod(); bf16_t* hb = p.h();
    for (int t = bid * 8 + w; t < NT; t += nb * 8) {
        const float* mb = mod + ((size_t)l * NB + (t >> 12)) * 6144;
        int sl = 0; if (lane < 8) sl = slot[(size_t)t * 8 + lane];
        f32x4 accv[4];
#pragma unroll
        for (int i = 0; i < 4; ++i) { const u32x2 s2 = *(const u32x2*)(sh + (size_t)t * ND + i * 256 + lane * 4);
            accv[i] = (f32x4){__uint_as_float(s2.x << 16), __uint_as_float(s2.x & 0xffff0000u), __uint_as_float(s2.y << 16), __uint_as_float(s2.y & 0xffff0000u)}; }
        f32x4 ysum[4] = {(f32x4){0.f, 0.f, 0.f, 0.f}, (f32x4){0.f, 0.f, 0.f, 0.f}, (f32x4){0.f, 0.f, 0.f, 0.f}, (f32x4){0.f, 0.f, 0.f, 0.f}};
#pragma unroll
        for (int k = 0; k < 8; ++k) {
            const int r = __shfl(sl, k);
#pragma unroll
            for (int i = 0; i < 4; ++i) { const int y4 = *(const int*)(ys8 + (size_t)r * ND + i * 256 + lane * 4);
                const f32x2 lo = __builtin_amdgcn_cvt_pk_f32_fp8(y4, false), hi2 = __builtin_amdgcn_cvt_pk_f32_fp8(y4, true);
                ysum[i] += (f32x4){lo.x, lo.y, hi2.x, hi2.y}; }
        }
#pragma unroll
        for (int i = 0; i < 4; ++i) accv[i] += ysum[i] * (1.0f / YS_SCALE);
        float ss = 0.f; f32x4 xo[4]; bf16_t* xbp = p.xb();
#pragma unroll
        for (int i = 0; i < 4; ++i) { const int cidx = i * 256 + lane * 4; const u32x2 xr = *(const u32x2*)(xbp + (size_t)t * ND + cidx); const f32x4 g4 = *(const f32x4*)(mb + 5120 + cidx);
            const f32x4 xv = {__uint_as_float(xr.x << 16), __uint_as_float(xr.x & 0xffff0000u), __uint_as_float(xr.y << 16), __uint_as_float(xr.y & 0xffff0000u)};
            xo[i] = xv + g4 * accv[i];
            if (l + 1 < NL) { const u32x2 w = {pk2(xo[i].x, xo[i].y), pk2(xo[i].z, xo[i].w)}; *(u32x2*)(xbp + (size_t)t * ND + cidx) = w; }
            else *(f32x4*)(p.out + (size_t)t * ND + cidx) = xo[i];
            ss += xo[i].x * xo[i].x + xo[i].y * xo[i].y + xo[i].z * xo[i].z + xo[i].w * xo[i].w; }
        if (l + 1 < NL) {
#pragma unroll
            for (int o = 32; o >= 1; o >>= 1) ss += __shfl_xor(ss, o);
            const float rstd = rsqrtf(ss * (1.0f / ND) + 1e-6f);
            const float* mn = mod + ((size_t)(l + 1) * NB + (t >> 12)) * 6144;
#pragma unroll
            for (int i = 0; i < 4; ++i) { const int cidx = i * 256 + lane * 4; const f32x4 sc = *(const f32x4*)(mn + 1024 + cidx), s0 = *(const f32x4*)(mn + cidx);
                u32x2 o; o.x = pk2(xo[i].x * rstd * (1.f + sc.x) + s0.x, xo[i].y * rstd * (1.f + sc.y) + s0.y); o.y = pk2(xo[i].z * rstd * (1.f + sc.z) + s0.z, xo[i].w * rstd * (1.f + sc.w) + s0.w);
                *(u32x2*)(hb + (size_t)t * ND + cidx) = o; }
        }
    }
}
#ifndef ATTN_TWICE
#define ATTN_TWICE
#endif
#ifndef OPT_PHASES_B
#define OPT_PHASES_B \
        if (IN(OPH_CMP1)) REP(OPH_CMP1) { ph_rope(p, bid, nb); \
            { CmpSched S; S.kvraw = (const char*)p.kvraw(); S.w1 = (const char*)(p.Wt_w1() + (size_t)l * 2 * 256 * 2048); S.K = 512; S.kstepA = 512; S.ldb = 2048; S.G = nb; S.c = bid; \
              EpiCmp E{p.cpart()}; pg8::gemm_phase<EpiCmp, CmpSched, true>(lds, S, E); } \
            ph_gmlp(p, l, lds, bid, nb); SEAMK(OPH_CMP1, l); } \
        if (IN(OPH_CMP2)) REP(OPH_CMP2) { ph_cmp2(p, l, lds, bid, nb); SEAMK(OPH_CMP2, l); } \
        if (IN(OPH_ATTN)) { ph_attn(p, l, lds, bid, nb); SEAMK(OPH_ATTN, l); ATTN_TWICE } \
        if (IN(OPH_PROJ)) REP(OPH_PROJ) { \
            { pg8::DenseSched S; S.init(p.onsa(), ND / 2, (const char*)p.Wt_pn() + (size_t)l * ND * ND, NT, ND, ND / 2, nb, bid); EpiProjF E{p.merged(), p.sga(), p.sgb(), 1.0f / W8_SCALE}; pg8::gemm_phase<EpiProjF, pg8::DenseSched, true, true, true>(lds, S, E); } \
            SEAMK(OPH_PROJ, l); } \
        if (IN(OPH_OUT)) REP(OPH_OUT) { pg8::DenseSched S; S.init(p.merged(), ND / 2, (const char*)p.Wt_out() + (size_t)l * ND * ND, NT, ND, ND / 2, nb, bid); \
            EpiOut<l == 0> E{p.x, p.xb(), p.mod() + (size_t)l * NB * 6144 + 2048, 1.0f / (H8_SCALE * W8_SCALE)}; pg8::gemm_phase<EpiOut<l == 0>, pg8::DenseSched, true, false, true>(lds, S, E); SEAMK(OPH_OUT, l); } \
        if (IN(OPH_NORMF)) REP(OPH_NORMF) { ph_norm_b(p, p.xb(), l, 3072, 4096, bid, nb, (unsigned char*)p.yslot() + (size_t)MAXROWS2 * ND); SEAMK(OPH_NORMF, l); } \
        if (IN(OPH_ROUTER)) REP(OPH_ROUTER) { pg8::DenseSched S; S.init(p.h(), ND, p.Wt_rs() + (size_t)l * 768 * ND, NT, 768, ND, nb, bid); \
            EpiRouter E{p.logits(), p.sact()}; pg8::gemm_phase<EpiRouter, pg8::DenseSched, true>(lds, S, E); SEAMK(OPH_ROUTER, l); } \
        if (IN(OPH_TOPK)) REP(OPH_TOPK) { ph_topk(p, l, lds, bid, nb); SEAMK(OPH_TOPK, l); } \
        if (IN(OPH_PLACE)) REP(OPH_PLACE) { ph_place(p, lds, bid, nb); SEAMK(OPH_PLACE, l); } \
        if (IN(OPH_EGU)) REP(OPH_EGU) { GatherSched S; S.h = (const char*)p.yslot() + (size_t)MAXROWS2 * ND; S.W = (const char*)p.Wt_eg() + (size_t)l * NE * 512 * ND; S.row_tok = p.row_tok(); S.unit_e = p.unit_e(); \
            S.K = ND / 2; S.kstepA = 128; S.ldb = ND / 2; S.arow = ND; S.brow = ND;        \
            S.nunits2 = 2 * (int)__builtin_amdgcn_readfirstlane(p.ctl()[CW_NUNITS]); S.G = nb; S.c = bid; \
            EpiAct E{(unsigned char*)p.act(), 1.0f / (H8_SCALE * W8_SCALE)}; pg8::gemm_phase<EpiAct, GatherSched, true, false, true>(lds, S, E); SEAMK(OPH_EGU, l); } \
        if (IN(OPH_EDOWN)) REP(OPH_EDOWN) { \
            { DownSched S; S.act = (const char*)p.act(); S.W = (const char*)p.Wt_ed() + (size_t)l * NE * ND * 256; S.unit_e = p.unit_e(); S.K = 128; S.kstepA = 128; S.ldb = 128; S.arow = 256; S.brow = 256; \
              S.nunits4 = 4 * (int)__builtin_amdgcn_readfirstlane(p.ctl()[CW_NUNITS]); S.G = nb; S.c = bid; EpiY<true> E{p.yslot(), p.row_w(), 1.0f / (H8_SCALE * W8_SCALE)}; pg8::gemm_phase<EpiY<true>, DownSched, true, false, true>(lds, S, E); } \
            { pg8::DenseSched S; S.init(p.sact(), 256, p.Wt_ds() + (size_t)l * ND * 256, NT, ND, 256, nb, bid); EpiY<false> E{p.shout(), nullptr, 1.0f}; pg8::gemm_phase<EpiY<false>, pg8::DenseSched, true>(lds, S, E); } \
            SEAMK(OPH_EDOWN, l); } \
        if (IN(OPH_COMBINE)) REP(OPH_COMBINE) { ph_combine(p, l, bid, nb); SEAMK(OPH_COMBINE, l); }
#endif
enum { OPH_PROLOGUE = 0, OPH_NORM0 = 1, OPH_Z = 2, OPH_CMP1, OPH_CMP2, OPH_ATTN, OPH_PROJ, OPH_OUT, OPH_NORMF, OPH_ROUTER, OPH_TOPK, OPH_PLACE, OPH_EGU, OPH_EDOWN, OPH_COMBINE, OPH_END };
#define CW_BAR 4096

__global__ void __launch_bounds__(512, 2) k_opt(OP p) {
    extern __shared__ __attribute__((aligned(16))) unsigned char lds_raw[];
    LAS unsigned char* lds = (LAS unsigned char*)lds_raw;
    volatile LAS unsigned* misc = (volatile LAS unsigned*)(lds + LDS_MISC);
    for (int u = tid_(); u < (LDS_BYTES - LDS_MISC) / 4; u += 512) misc[u] = 0u;
    __syncthreads();
    const bool multi = (p.ph_hi - p.ph_lo > 1) || (p.l_hi - p.l_lo > 1);
    unsigned* const ctl = p.ctl();
    XcdBarrier bar; bar.bar = ctl + CW_BAR; bar.x = 0; bar.st = misc + 8;
    if (multi) bar = xcd_barrier_post(ctl + CW_BAR, misc + 8);
    const int bid = blockIdx.x, nb = gridDim.x;
#ifdef TSTAMP
    if (bid == 0 && tid_() == 0) ((unsigned long long*)(ctl + 8192))[63] = wall_clock64();
#endif
    const int lo = p.ph_lo, hi = p.ph_hi;
#ifndef REP_MASK
#define REP_MASK 0
#endif
#define IN(k) (lo <= (k) && (k) < hi)
#define REP(k) for (int rep_ = 0; rep_ < 1 + ((REP_MASK >> (k)) & 1); ++rep_)
#ifdef TSTAMP
#define SEAMK(k, l) do { if (multi) xcd_barrier(bar); if (bid == 0 && tid_() == 0) ((unsigned long long*)(ctl + 8192))[(l) * 16 + (k)] = wall_clock64(); } while (0)
#else
#define SEAMK(k, l) do { if (multi) xcd_barrier(bar); } while (0)
#endif
#define SEAM() SEAMK(15, 1)
    if (p.l_lo == 0) {
        if (IN(OPH_PROLOGUE)) REP(OPH_PROLOGUE) { ph_prologue(p, lds, bid, nb); SEAMK(OPH_PROLOGUE, 0); }
        if (IN(OPH_NORM0)) REP(OPH_NORM0) { ph_norm(p, p.x, 0, 0, 1024, bid, nb); SEAMK(OPH_NORM0, 0); }
    }
#define LAYER_BODY(L_) { constexpr int l = (L_); if (l >= p.l_lo && l < p.l_hi) { \
        if (IN(OPH_Z)) REP(OPH_Z) { \
            pg8::DenseSched S; S.init(p.h(), ND, p.Wt_in() + (size_t)l * ZPAD * ND, NT, ZPAD, ND, nb, bid); \
            if (tid_() < 128) ((LAS float*)(lds + LDS_GAIN))[tid_()] = (tid_() < 64 ? p.q_gain : p.k_gain - 64)[l * 64 + tid_()]; \
            __syncthreads(); \
            EpiZ E{&p, lds}; \
            pg8::gemm_phase<EpiZ, pg8::DenseSched, true>(lds, S, E); \
            SEAMK(OPH_Z, l); \
        } \
        OPT_PHASES_B \
    } }
    LAYER_BODY(0)
    LAYER_BODY(1)
#undef IN
#undef REP
#undef SEAM
}

static inline size_t ws_take(size_t& off, size_t bytes) { const size_t r = off; off += (bytes + 255) & ~(size_t)255; return r; }
static void fill_inputs(OP& p, void* const* d_in, void* d_out) {
    p.x = (const float*)d_in[0]; p.c = (const float*)d_in[1]; p.pos = (const int*)d_in[2];
    p.w_mod = (const float*)d_in[3]; p.b_mod = (const float*)d_in[4]; p.w_in = (const float*)d_in[5]; p.q_gain = (const float*)d_in[6]; p.k_gain = (const float*)d_in[7];
    p.pe_k = (const float*)d_in[8]; p.pe_v = (const float*)d_in[9]; p.w1k = (const float*)d_in[10]; p.w2k = (const float*)d_in[11]; p.w1v = (const float*)d_in[12]; p.w2v = (const float*)d_in[13];
    p.ln_g = (const float*)d_in[14]; p.ln_b = (const float*)d_in[15]; p.gm_ws = (const float*)d_in[16]; p.gm_bs = (const float*)d_in[17];
    p.wpn = (const float*)d_in[18]; p.wpg = (const float*)d_in[19]; p.w_out = (const float*)d_in[20]; p.w_router = (const float*)d_in[21]; p.b_router = (const float*)d_in[22];
    p.wge = (const float*)d_in[23]; p.wue = (const float*)d_in[24]; p.wde = (const float*)d_in[25]; p.wgs = (const float*)d_in[26]; p.wus = (const float*)d_in[27]; p.wds = (const float*)d_in[28];
    p.out = (float*)d_out;
}
static int opt_grid() {
    static int grid = 0;
    if (!grid) {
        int dev = 0, cus = 0;
        (void)hipGetDevice(&dev); (void)hipDeviceGetAttribute(&cus, hipDeviceAttributeMultiprocessorCount, dev);
        (void)hipFuncSetAttribute((const void*)k_opt, hipFuncAttributeMaxDynamicSharedMemorySize, LDS_BYTES);
        int per_cu = 0; (void)hipOccupancyMaxActiveBlocksPerMultiprocessor(&per_cu, (const void*)k_opt, 512, LDS_BYTES); (void)hipGetLastError();
        grid = cus > 0 ? cus : 256;
    }
    return grid;
}
static void launch_opt(OP p, int ph_lo, int ph_hi, int l_lo, int l_hi, hipStream_t s) {
    p.ph_lo = ph_lo; p.ph_hi = ph_hi; p.l_lo = l_lo; p.l_hi = l_hi;
    hipLaunchKernelGGL(k_opt, dim3(opt_grid()), dim3(512), LDS_BYTES, s, p);
}
#if DEV_CHECK
enum { T_NONE = 0, T_GELU = 1, T_SIGMOID = 2 };
__global__ void k_cmp(const void* opt, int opt_f32, int ldo, const float* ref, int ldr, int ncols, int nrows, int tr, float scale, double* acc) {
    double num = 0.0, den = 0.0;
    const size_t n = (size_t)nrows * ncols;
    for (size_t i = (size_t)blockIdx.x * blockDim.x + threadIdx.x; i < n; i += (size_t)gridDim.x * blockDim.x) {
        const size_t r = i / ncols; const int c = (int)(i % ncols);
        float e = ref[r * ldr + c];
        if (tr == T_GELU) e = geluf_(e); else if (tr == T_SIGMOID) e = sigmoidf_(e);
        e *= scale;
        const float o = opt_f32 ? ((const float*)opt)[r * ldo + c] : bf2f(((const bf16_t*)opt)[r * ldo + c]);
        const double d = (double)o - (double)e; num += d * d; den += (double)e * (double)e;
    }
    for (int o = 32; o >= 1; o >>= 1) { num += __shfl_xor(num, o); den += __shfl_xor(den, o); }
    if ((threadIdx.x & 63) == 0) { atomicAdd(acc, num); atomicAdd(acc + 1, den); }
}
__global__ void k_final(float* out, size_t n, const double* acc, int ngroups, int only) {
    double metric = 0.0;
    for (int g = 0; g < ngroups; ++g) { if (only >= 0 && g != only) continue; const double m = acc[2 * g] / (acc[2 * g + 1] + 1e-300); if (!(m <= metric)) metric = m; }
    const float s = 1.0f + (float)sqrt(metric);
    for (size_t i = (size_t)blockIdx.x * blockDim.x + threadIdx.x; i < n; i += (size_t)gridDim.x * blockDim.x) out[i] *= s;
}
#ifndef DEV_ONLY
#define DEV_ONLY -1
#endif
static void cmp(const void* opt, int f32, int ldo, const float* ref, int ldr, int ncols, int nrows, int tr, float scale, double* acc, int g, hipStream_t s) {
    hipLaunchKernelGGL(k_cmp, dim3(2048), dim3(256), 0, s, opt, f32, ldo, ref, ldr, ncols, nrows, tr, scale, acc + 2 * g);
}
#endif

#ifdef TSTAMP
__global__ void k_probe(float* out, size_t n, const unsigned long long* ts, int a0, int a1, int b0, int b1) {
    float ta = (float)(ts[a1] - ts[a0]) * 0.01f, tb = (float)(ts[b1] - ts[b0]) * 0.01f;
    ta = floorf(ta / 16.f + 0.5f) * 16.f; tb = floorf(tb / 20.f + 0.5f) * 20.f;
    const float s = 1.0f + sqrtf(1e-5f * ta);
    for (size_t i = (size_t)blockIdx.x * blockDim.x + threadIdx.x; i < n; i += (size_t)gridDim.x * blockDim.x) { float v = out[i] * s; if (i == 0) v += 2.0f + tb * 0.1f; out[i] = v; }
}
#endif
extern "C" void kernel_launch(void* const* d_in, const int* in_sizes, int n_in, void* d_out, int out_size, void* d_ws, size_t ws_size, hipStream_t stream) {
    OP p; memset(&p, 0, sizeof(p));
    fill_inputs(p, d_in, d_out);
    char* w = (char*)d_ws;
#if DEV_CHECK
    size_t off = 0;
    p.ws = w; off = wsl::O_END_MIX;
    refp::Params rp; memset(&rp, 0, sizeof(rp));
    rp.x = p.x; rp.c = p.c; rp.pos = p.pos; rp.w_mod = p.w_mod; rp.b_mod = p.b_mod; rp.w_in = p.w_in; rp.q_gain = p.q_gain; rp.k_gain = p.k_gain; rp.pe_k = p.pe_k; rp.pe_v = p.pe_v;
    rp.w1k = p.w1k; rp.w2k = p.w2k; rp.w1v = p.w1v; rp.w2v = p.w2v; rp.ln_g = p.ln_g; rp.ln_b = p.ln_b; rp.gm_ws = p.gm_ws; rp.gm_bs = p.gm_bs; rp.wpn = p.wpn; rp.wpg = p.wpg; rp.w_out = p.w_out;
    rp.w_router = p.w_router; rp.b_router = p.b_router; rp.wge = p.wge; rp.wue = p.wue; rp.wde = p.wde; rp.wgs = p.wgs; rp.wus = p.wus; rp.wds = p.wds; rp.out = p.out;
    auto take = [&](size_t bytes) { return (void*)(w + ws_take(off, bytes)); };
    {
        const size_t region = off;
        rp.z = (float*)take((size_t)NT * INC * 4);
        rp.qn = (float*)take((size_t)NT * 512 * 4); rp.qr = (float*)take((size_t)NT * 512 * 4);
        rp.ks = (float*)take((size_t)NT * 128 * 4); rp.kw = (float*)take((size_t)NT * 128 * 4);
        rp.onsa = (float*)take((size_t)NT * 512 * 4); rp.vn = (float*)take((size_t)NT * 512 * 4); rp.ogm = (float*)take((size_t)NT * 512 * 4);
        rp.ya = (float*)take((size_t)NT * ND * 4);
        const size_t end_mix = off;
        off = region;
        rp.logits = (float*)take((size_t)NT * NE * 4); rp.gs = (float*)take((size_t)NT * 256 * 4); rp.sact = (float*)take((size_t)NT * 256 * 4);
        rp.shout = (float*)take((size_t)NT * ND * 4); rp.routed = (float*)take((size_t)NT * ND * 4);
        rp.ag = (float*)take((size_t)MAXROWS * 256 * 4); rp.act = (float*)take((size_t)MAXROWS * 256 * 4);
        if (off < end_mix) off = end_mix;
        const size_t need = wsl::O_Wt_ed + (size_t)NE * ND * 256 * 2 + 4096;
        if (off < need) off = need;
    }
    p.xres = (float*)take((size_t)NT * ND * 4);
    rp.bar = (unsigned*)take(16384);
    rp.mod = (float*)take((size_t)NL * NB * 6144 * 4);
    rp.h = (float*)take((size_t)NT * ND * 4);
    rp.counts = (int*)take(NE * 4); rp.cursor = (int*)take(NE * 4); rp.pad_start = (int*)take(NE * 4); rp.blk_e = (int*)take(MAXBLK * 4);
    rp.row_tok = (int*)take((size_t)MAXROWS * 4); rp.row_w = (float*)take((size_t)MAXROWS * 4);
    rp.idx = (int*)take((size_t)NT * 8 * 4); rp.wts = (float*)take((size_t)NT * 8 * 4);
    rp.kc = (float*)take((size_t)NB * NCMP * 2 * 64 * 4); rp.vc = (float*)take((size_t)NB * NCMP * 2 * 64 * 4);
    double* acc = (double*)take(4096);
    if (off > ws_size) { fprintf(stderr, "dev: workspace too small: need %zu have %zu\n", off, ws_size); return; }
    p.xoff = 0;
    (void)hipMemsetAsync(p.ws + wsl::O_ctl, 0, 65536, stream);
    (void)hipMemsetAsync(acc, 0, 4096, stream);
    using namespace refp;
    const int G = 2048;
    launch_phase<PH_MOD>(rp, 0, 48, stream);
    launch_phase<PH_NORM_A>(rp, 0, G, stream);
    launch_phase<PH_GEMM_Z>(rp, 0, G, stream);
    launch_phase<PH_PREP>(rp, 0, G, stream);
    p.conv_l_lo = 0; p.conv_l_hi = 0;
    launch_opt(p, OPH_PROLOGUE, OPH_PROLOGUE + 1, 0, 1, stream);
    launch_opt(p, OPH_NORM0, OPH_NORM0 + 1, 0, 1, stream);
    launch_opt(p, OPH_Z, OPH_Z + 1, 0, 1, stream);
    launch_opt(p, OPH_CMP1, OPH_CMP1 + 1, 0, 1, stream);
    int g = 0;
    cmp(p.qn(), 0, 512, rp.qn, 512, 512, NT, T_NONE, 0.125f, acc, g++, stream);
    cmp(p.qr(), 0, 512, rp.qr, 512, 512, NT, T_NONE, 0.125f, acc, g++, stream);
    cmp(p.kvraw(), 0, 256, rp.z + ZKC, INC, 256, NT, T_NONE, 1.f, acc, g++, stream);
    cmp(p.ksv(), 0, 256, rp.ks, 128, 128, NT, T_NONE, 1.f, acc, g++, stream);
    cmp(p.ksv() + 128, 0, 256, rp.z + ZVS, INC, 128, NT, T_NONE, 1.f, acc, g++, stream);
    cmp(p.kwv(), 0, 256, rp.kw, 128, 128, NT, T_NONE, 1.f, acc, g++, stream);
    cmp(p.kwv() + 128, 0, 256, rp.z + ZVW, INC, 128, NT, T_NONE, 1.f, acc, g++, stream);
    cmp(p.u(), 0, 512, rp.z + ZU, INC, 512, NT, T_GELU, 1.f, acc, g++, stream);
    cmp(p.v(), 0, 512, rp.z + ZV, INC, 512, NT, T_GELU, 1.f, acc, g++, stream);
    cmp(p.sga(), 0, 1024, rp.z + ZGA, INC, 1024, NT, T_SIGMOID, 1.f, acc, g++, stream);
    cmp(p.sgb(), 0, 1024, rp.z + ZGB, INC, 1024, NT, T_SIGMOID, 1.f, acc, g++, stream);
    cmp(p.gates(), 1, 32, rp.z + ZG, INC, 24, NT, T_SIGMOID, 1.f, acc, g++, stream);
    cmp(p.h(), 0, 1024, rp.h, 1024, 1024, NT, T_NONE, 1.f, acc, g++, stream);
    launch_opt(p, OPH_CMP2, OPH_CMP2 + 1, 0, 1, stream);
    for (int b = 0; b < NB; ++b) { cmp(p.kc() + (size_t)b * 256 * 128, 0, 128, rp.kc + (size_t)b * 255 * 128, 128, 128, 255, T_NONE, 1.f, acc, g, stream);
                                   cmp(p.vc() + (size_t)b * 256 * 128, 0, 128, rp.vc + (size_t)b * 255 * 128, 128, 128, 255, T_NONE, 1.f, acc, g + 1, stream); }
    g += 2;
    launch_phase<PH_ATTN>(rp, 0, 2048, stream);
    cmp(p.ogm(), 0, 512, rp.ogm, 512, 512, NT, T_NONE, 1.f, acc, g++, stream);
    launch_opt(p, OPH_ATTN, OPH_ATTN + 1, 0, 1, stream);
    cmp(p.onsa(), 0, 512, rp.onsa, 512, 512, NT, T_NONE, 1.f, acc, g++, stream);
    launch_phase<PH_PROJ>(rp, 0, G, stream);
    launch_phase<PH_OUT>(rp, 0, G, stream);
    launch_opt(p, OPH_PROJ, OPH_PROJ + 1, 0, 1, stream);
    cmp(p.merged(), 0, 1024, rp.ya, 1024, 1024, NT, T_NONE, 1.f, acc, g++, stream);
    launch_opt(p, OPH_OUT, OPH_OUT + 1, 0, 1, stream);
    cmp(p.xres, 1, 1024, rp.out, 1024, 1024, NT, T_NONE, 1.f, acc, g++, stream);
    launch_phase<PH_NORM_F>(rp, 0, G, stream);
    launch_opt(p, OPH_NORMF, OPH_NORMF + 1, 0, 1, stream);
    cmp(p.h(), 0, 1024, rp.h, 1024, 1024, NT, T_NONE, 1.f, acc, g++, stream);
    p.conv_l_lo = 0; p.conv_l_hi = 1;
    launch_opt(p, OPH_PROLOGUE, OPH_PROLOGUE + 1, 0, 1, stream);
    launch_opt(p, OPH_ROUTER, OPH_ROUTER + 1, 0, 1, stream);
    launch_opt(p, OPH_TOPK, OPH_TOPK + 1, 0, 1, stream);
    launch_opt(p, OPH_PLACE, OPH_PLACE + 1, 0, 1, stream);
    launch_opt(p, OPH_EGU, OPH_EGU + 1, 0, 1, stream);
    launch_opt(p, OPH_EDOWN, OPH_EDOWN + 1, 0, 1, stream);
    launch_opt(p, OPH_COMBINE, OPH_COMBINE + 1, 0, 1, stream);
    launch_phase<PH_NORM_F>(rp, 0, G, stream);
    launch_phase<PH_ROUTER>(rp, 0, G, stream);
    launch_phase<PH_TOPK>(rp, 0, G, stream);
    launch_phase<PH_SCAN>(rp, 0, G, stream);
    launch_phase<PH_PLACE>(rp, 0, G, stream);
    launch_phase<PH_EGATE>(rp, 0, G, stream);
    launch_phase<PH_EUP>(rp, 0, G, stream);
    launch_phase<PH_EDOWN>(rp, 0, G, stream);
    launch_phase<PH_FINAL>(rp, 0, G, stream);
    cmp(p.xres, 1, 1024, rp.out, 1024, 1024, NT, T_NONE, 1.f, acc, g++, stream);
    for (int l = 1; l < NL; ++l) {
        launch_phase<PH_NORM_A>(rp, l, G, stream); launch_phase<PH_GEMM_Z>(rp, l, G, stream); launch_phase<PH_PREP>(rp, l, G, stream); launch_phase<PH_ATTN>(rp, l, 2048, stream);
        launch_phase<PH_PROJ>(rp, l, G, stream); launch_phase<PH_OUT>(rp, l, G, stream); launch_phase<PH_NORM_F>(rp, l, G, stream); launch_phase<PH_ROUTER>(rp, l, G, stream);
        launch_phase<PH_TOPK>(rp, l, G, stream); launch_phase<PH_SCAN>(rp, l, G, stream); launch_phase<PH_PLACE>(rp, l, G, stream); launch_phase<PH_EGATE>(rp, l, G, stream);
        launch_phase<PH_EUP>(rp, l, G, stream); launch_phase<PH_EDOWN>(rp, l, G, stream); launch_phase<PH_FINAL>(rp, l, G, stream);
    }
    hipLaunchKernelGGL(k_final, dim3(2048), dim3(256), 0, stream, p.out, (size_t)NT * ND, acc, g, (int)DEV_ONLY);
#else
    p.ws = w; p.xres = p.out; p.xoff = 0;
    if (wsl::O_TOTAL > ws_size) { fprintf(stderr, "workspace too small: need %zu have %zu\n", (size_t)wsl::O_TOTAL, ws_size); return; }
    p.conv_l_lo = 0; p.conv_l_hi = NL;
    (void)hipMemsetAsync(p.ws + wsl::O_ctl, 0, 65536, stream);
    launch_opt(p, 0, OPH_END, 0, NL, stream);
#ifdef TSTAMP
    hipLaunchKernelGGL(k_probe, dim3(2048), dim3(256), 0, stream, p.out, (size_t)NT * ND, (const unsigned long long*)(p.ws + wsl::O_ctl + 32768), (int)TS_A0, (int)TS_A1, (int)TS_B0, (int)TS_B1);
#endif
#endif
}
```

```cpp
#define DEV_CHECK 0
#include <hip/hip_runtime.h>
#include <stdint.h>
#include <string.h>
#include <stdio.h>

#ifndef DEV_CHECK
#define DEV_CHECK 0
#endif

#define NB 8
#define NS 4096
#define ND 1024
#define NT (NB * NS)
#define NL 2
#define INC 4376
#define NCMP 255
#define NE 256
#define MAXROWS 294912
#define MAXBLK 2304
#define ZQ 0
#define ZKC 512
#define ZVC 640
#define ZKS 768
#define ZVS 896
#define ZKW 1024
#define ZVW 1152
#define ZG 1280
#define ZU 1304
#define ZV 1816
#define ZGA 2328
#define ZGB 3352

#define LAS __attribute__((address_space(3)))
#define GAS __attribute__((address_space(1)))
typedef unsigned short bf16_t;
typedef short bf16x8 __attribute__((ext_vector_type(8)));
typedef short s16x4 __attribute__((ext_vector_type(4)));
typedef float f32x2 __attribute__((ext_vector_type(2)));
typedef float f32x4 __attribute__((ext_vector_type(4)));
typedef float f32x16 __attribute__((ext_vector_type(16)));
typedef unsigned u32x2 __attribute__((ext_vector_type(2)));
typedef unsigned u32x4 __attribute__((ext_vector_type(4)));
#define XB_TMO      128
#define XB_XCNT(j)  (256  + 64 * (j))
#define XB_XSUB(j)  (1280 + 64 * (j))
#define XB_XGEN(j)  (2304 + 64 * (j))
#define XB_TOP      3328
#define XB_TOPGEN   3392
#define XCD_BAR_WORDS 3456
#define XB_SPIN_CAP (1u << 22)
#define LAS __attribute__((address_space(3)))

__device__ __forceinline__ unsigned xb_ld(unsigned* p)              { return __hip_atomic_load(p, __ATOMIC_RELAXED, __HIP_MEMORY_SCOPE_AGENT); }
__device__ __forceinline__ unsigned xb_add(unsigned* p, unsigned v) { return __hip_atomic_fetch_add(p, v, __ATOMIC_RELAXED, __HIP_MEMORY_SCOPE_AGENT); }
__device__ __forceinline__ unsigned xb_xcc_id() { return (unsigned)__builtin_amdgcn_s_getreg((3 << 11) | 20) & 0xFu; }
#define XB_SPIN(cond, bar) do { unsigned _sp = 0; while (cond) { __builtin_amdgcn_s_sleep(1); \
    if ((++_sp & 255u) == 0u) { if (xb_ld(&(bar)[XB_TMO])) break; if (_sp > XB_SPIN_CAP) { atomicAdd(&(bar)[XB_TMO], 1u); break; } } } } while (0)

struct XcdBarrier { unsigned* bar; unsigned x; volatile LAS unsigned* st; };

__device__ __forceinline__ XcdBarrier xcd_barrier_post(unsigned* bar, volatile LAS unsigned* st) {
    XcdBarrier b; b.bar = bar; b.x = xb_xcc_id(); b.st = st;
    if (threadIdx.x == 0) (void)xb_add(&bar[XB_XCNT(b.x)], 1u);
    return b;
}
__device__ __forceinline__ void xcd_barrier_complete(unsigned* bar, unsigned x, unsigned& nloc, unsigned& nx) {
    const unsigned G = gridDim.x * gridDim.y * gridDim.z;
    unsigned sum, cnt, mine, sp = 0u;
    for (;;) {
        sum = 0u; cnt = 0u; mine = 0u;
#pragma unroll
        for (unsigned j = 0; j < 16; ++j) { const unsigned c = xb_ld(&bar[XB_XCNT(j)]); sum += c; cnt += (c > 0u) ? 1u : 0u; mine = (j == x) ? c : mine; }
        if (sum == G) break;
        __builtin_amdgcn_s_sleep(1);
        if ((++sp & 255u) == 0u) { if (xb_ld(&bar[XB_TMO])) break; if (sp > XB_SPIN_CAP) { atomicAdd(&bar[XB_TMO], 1u); break; } }
    }
    nloc = mine > 0u ? mine : 1u; nx = cnt > 0u ? cnt : 1u;
}
__device__ __noinline__ void xcd_barrier(const XcdBarrier b) {
    asm volatile("s_waitcnt vmcnt(0)" ::: "memory");
    __syncthreads();
    if (threadIdx.x == 0) {
        unsigned* bar = b.bar;
        __builtin_amdgcn_s_waitcnt(0);
        unsigned nloc = b.st[0], nx = b.st[1];
        if (nloc == 0u) { xcd_barrier_complete(bar, b.x, nloc, nx); b.st[0] = nloc; b.st[1] = nx; }
        const unsigned old = xb_add(&bar[XB_XSUB(b.x)], 1u);
        const unsigned gen = old / nloc;
        if (old + 1u == (gen + 1u) * nloc) {
            __builtin_amdgcn_fence(__ATOMIC_RELEASE, "agent");
            asm volatile("s_waitcnt vmcnt(0)" ::: "memory");
            const unsigned og = xb_add(&bar[XB_TOP], 1u);
            const unsigned tg = og / nx;
            if (og + 1u == (tg + 1u) * nx) xb_add(&bar[XB_TOPGEN], 1u);
            else XB_SPIN(xb_ld(&bar[XB_TOPGEN]) == tg, bar);
            __builtin_amdgcn_fence(__ATOMIC_ACQUIRE, "agent");
            xb_add(&bar[XB_XGEN(b.x)], 1u);
            asm volatile("s_waitcnt vmcnt(0)" ::: "memory");
        } else {
            XB_SPIN(xb_ld(&bar[XB_XGEN(b.x)]) == gen, bar);
            __builtin_amdgcn_fence(__ATOMIC_ACQUIRE, "agent");
            asm volatile("s_waitcnt vmcnt(0)" ::: "memory");
        }
    }
    __syncthreads();
}

__device__ __forceinline__ int tid_() { int t = threadIdx.x; asm volatile("" : "+v"(t)); return t; }
__device__ __forceinline__ float sigmoidf_(float x) { return 1.0f / (1.0f + expf(-x)); }
__device__ __forceinline__ float siluf_(float x) { return x / (1.0f + expf(-x)); }
__device__ __forceinline__ float geluf_(float x) { return 0.5f * x * (1.0f + tanhf(0.7978845608028654f * (x + 0.044715f * x * x * x))); }
__device__ __forceinline__ float wave_sum(float v) {
#pragma unroll
    for (int o = 32; o >= 1; o >>= 1) v += __shfl_xor(v, o);
    return v;
}

#if DEV_CHECK
namespace refp {
struct Params {
    const float *x, *c; const int* pos;
    const float *w_mod, *b_mod, *w_in, *q_gain, *k_gain, *pe_k, *pe_v, *w1k, *w2k, *w1v, *w2v, *ln_g, *ln_b, *gm_ws, *gm_bs,
                *wpn, *wpg, *w_out, *w_router, *b_router, *wge, *wue, *wde, *wgs, *wus, *wds;
    float* out;
    float *mod, *h, *z, *qn, *qr, *ks, *kw, *kc, *vc, *onsa, *vn, *ogm, *ya;
    float *logits, *gs, *sact, *shout, *routed, *ag, *act, *row_w, *wts;
    int *idx, *counts, *cursor, *pad_start, *row_tok, *blk_e;
    unsigned* bar;
};


enum { M_STORE = 0, M_RESID = 1, M_SILU_MUL = 2, M_SIG_SET = 3, M_SIG_ADD = 4, M_SCATTER = 5 };
struct GemmArgs {
    const float* A; int lda; const int* gather;
    const float* Bm; int ldb; size_t strideB; const int* blk_e;
    float* C; int ldc; int M, N, K;
    const float* aux; int ldaux; const float* aux2;
};

template <int MODE, bool GATHER>
__device__ __forceinline__ void sgemm(const GemmArgs& g, float* smem, int bid, int nb) {
    float (*As)[128] = (float (*)[128])smem;
    float (*Bs)[128] = (float (*)[128])(smem + 16 * 128);
    const int tid = tid_(), tx = tid & 15, ty = tid >> 4;
    const int ntn = (g.N + 127) / 128, ntm = g.M / 128, ntiles = ntm * ntn;
    for (int tile = bid; tile < ntiles; tile += nb) {
        const int tm = tile / ntn, tn = tile % ntn;
        const int row0 = tm * 128, col0 = tn * 128;
        const float* Bp = g.Bm;
        if (g.blk_e) { const int e = g.blk_e[tm]; if (e < 0) continue; Bp += (size_t)e * g.strideB; }
        float acc[8][8];
#pragma unroll
        for (int i = 0; i < 8; ++i)
#pragma unroll
            for (int j = 0; j < 8; ++j) acc[i][j] = 0.f;
        const float* arow[2];
#pragma unroll
        for (int i = 0; i < 2; ++i) {
            const int id = tid + i * 256, r = id >> 2;
            int srow = row0 + r;
            if (GATHER) { srow = g.gather[row0 + r]; srow = srow < 0 ? 0 : srow; }
            arow[i] = g.A + (size_t)srow * g.lda + (id & 3) * 4;
        }
        for (int k0 = 0; k0 < g.K; k0 += 16) {
            float4 av[2], bv[2];
#pragma unroll
            for (int i = 0; i < 2; ++i) av[i] = *(const float4*)(arow[i] + k0);
#pragma unroll
            for (int i = 0; i < 2; ++i) {
                const int id = tid + i * 256, kr = id >> 5, cq = (id & 31) * 4, cc = col0 + cq;
                if (cc < g.N) bv[i] = *(const float4*)(Bp + (size_t)(k0 + kr) * g.ldb + cc);
                else bv[i] = make_float4(0.f, 0.f, 0.f, 0.f);
            }
            __syncthreads();
#pragma unroll
            for (int i = 0; i < 2; ++i) {
                const int id = tid + i * 256, r = id >> 2, kq = (id & 3) * 4;
                As[kq + 0][r] = av[i].x; As[kq + 1][r] = av[i].y; As[kq + 2][r] = av[i].z; As[kq + 3][r] = av[i].w;
                const int kr = id >> 5, cq = (id & 31) * 4;
                *(float4*)&Bs[kr][cq] = bv[i];
            }
            __syncthreads();
#pragma unroll
            for (int k = 0; k < 16; ++k) {
                const float4 a0 = *(const float4*)&As[k][ty * 4], a1 = *(const float4*)&As[k][64 + ty * 4];
                const float4 b0 = *(const float4*)&Bs[k][tx * 4], b1 = *(const float4*)&Bs[k][64 + tx * 4];
                const float a[8] = {a0.x, a0.y, a0.z, a0.w, a1.x, a1.y, a1.z, a1.w};
                const float b[8] = {b0.x, b0.y, b0.z, b0.w, b1.x, b1.y, b1.z, b1.w};
#pragma unroll
                for (int i = 0; i < 8; ++i)
#pragma unroll
                    for (int j = 0; j < 8; ++j) acc[i][j] = fmaf(a[i], b[j], acc[i][j]);
            }
        }
#pragma unroll
        for (int i = 0; i < 8; ++i) {
            const int r = row0 + (i < 4 ? ty * 4 + i : 64 + ty * 4 + (i - 4));
            int tok = 0; float rw = 0.f;
            if (MODE == M_SCATTER) { tok = g.gather[r]; rw = g.aux[r]; if (tok < 0) continue; }
#pragma unroll
            for (int jh = 0; jh < 2; ++jh) {
                const int cidx = col0 + jh * 64 + tx * 4;
                if (cidx >= g.N) continue;
                float4 v = make_float4(acc[i][jh * 4 + 0], acc[i][jh * 4 + 1], acc[i][jh * 4 + 2], acc[i][jh * 4 + 3]);
                if (MODE == M_STORE) {
                    *(float4*)(g.C + (size_t)r * g.ldc + cidx) = v;
                } else if (MODE == M_RESID) {
                    const float4 rr = *(const float4*)(g.aux + (size_t)r * g.ldaux + cidx);
                    const float4 gt = *(const float4*)(g.aux2 + (size_t)(r >> 12) * 6144 + cidx);
                    v.x = rr.x + gt.x * v.x; v.y = rr.y + gt.y * v.y; v.z = rr.z + gt.z * v.z; v.w = rr.w + gt.w * v.w;
                    *(float4*)(g.C + (size_t)r * g.ldc + cidx) = v;
                } else if (MODE == M_SILU_MUL) {
                    const float4 a = *(const float4*)(g.aux + (size_t)r * g.ldaux + cidx);
                    v.x *= siluf_(a.x); v.y *= siluf_(a.y); v.z *= siluf_(a.z); v.w *= siluf_(a.w);
                    *(float4*)(g.C + (size_t)r * g.ldc + cidx) = v;
                } else if (MODE == M_SIG_SET || MODE == M_SIG_ADD) {
                    const float4 a = *(const float4*)(g.aux + (size_t)r * g.ldaux + cidx);
                    v.x *= sigmoidf_(a.x); v.y *= sigmoidf_(a.y); v.z *= sigmoidf_(a.z); v.w *= sigmoidf_(a.w);
                    float4* cp = (float4*)(g.C + (size_t)r * g.ldc + cidx);
                    if (MODE == M_SIG_ADD) { const float4 o = *cp; v.x += o.x; v.y += o.y; v.z += o.z; v.w += o.w; }
                    *cp = v;
                } else if (MODE == M_SCATTER) {
                    float* cp = g.C + (size_t)tok * g.ldc + cidx;
                    atomicAdd(cp + 0, rw * v.x); atomicAdd(cp + 1, rw * v.y); atomicAdd(cp + 2, rw * v.z); atomicAdd(cp + 3, rw * v.w);
                }
            }
        }
    }
}

__device__ __forceinline__ void ph_mod(const Params& p, float* smem, int bid, int nb) {
    for (int i = tid_(); i < NB * ND; i += 256) smem[i] = siluf_(p.c[i]);
    __syncthreads();
    for (int it = bid * 256 + tid_(); it < NL * 6144; it += nb * 256) {
        const int l = it / 6144, j = it % 6144;
        float acc[NB];
#pragma unroll
        for (int b = 0; b < NB; ++b) acc[b] = 0.f;
        const float* w = p.w_mod + (size_t)l * ND * 6144 + j;
        for (int d = 0; d < ND; ++d) {
            const float wv = w[(size_t)d * 6144];
#pragma unroll
            for (int b = 0; b < NB; ++b) acc[b] = fmaf(smem[b * ND + d], wv, acc[b]);
        }
        const float bb = p.b_mod[l * 6144 + j];
#pragma unroll
        for (int b = 0; b < NB; ++b) p.mod[((size_t)l * NB + b) * 6144 + j] = acc[b] + bb;
    }
    __syncthreads();
}

__device__ __forceinline__ void ph_norm(const Params& p, const float* xin, int l, int sh_off, int sc_off, int bid, int nb) {
    const int lane = tid_() & 63, w = tid_() >> 6;
    for (int t = bid * 4 + w; t < NT; t += nb * 4) {
        const float* xr = xin + (size_t)t * ND;
        float4 v[4]; float ss = 0.f;
#pragma unroll
        for (int i = 0; i < 4; ++i) { v[i] = *(const float4*)(xr + i * 256 + lane * 4); ss += v[i].x * v[i].x + v[i].y * v[i].y + v[i].z * v[i].z + v[i].w * v[i].w; }
        ss = wave_sum(ss);
        const float rstd = rsqrtf(ss * (1.0f / ND) + 1e-6f);
        const float* mb = p.mod + ((size_t)l * NB + (t >> 12)) * 6144;
#pragma unroll
        for (int i = 0; i < 4; ++i) {
            const int cidx = i * 256 + lane * 4;
            const float4 sc = *(const float4*)(mb + sc_off + cidx), sh = *(const float4*)(mb + sh_off + cidx);
            float4 o;
            o.x = v[i].x * rstd * (1.f + sc.x) + sh.x; o.y = v[i].y * rstd * (1.f + sc.y) + sh.y;
            o.z = v[i].z * rstd * (1.f + sc.z) + sh.z; o.w = v[i].w * rstd * (1.f + sc.w) + sh.w;
            *(float4*)(p.h + (size_t)t * ND + cidx) = o;
        }
    }
}

__device__ __forceinline__ void ph_prep(const Params& p, int l, int bid, int nb) {
    const int lane = tid_() & 63, w = tid_() >> 6;
    const int i32 = lane & 31;
    const float inv = (float)pow(10000.0, -(double)i32 / 32.0);
    for (long it = (long)bid * 4 + w; it < (long)NT * 12; it += (long)nb * 4) {
        const int t = (int)(it / 12), hv = (int)(it % 12);
        int zc; const float* gain; float* dst; float* dst_norot = nullptr;
        if (hv < 8) { zc = ZQ + hv * 64; gain = p.q_gain + l * 64; dst = p.qr + (size_t)t * 512 + hv * 64; dst_norot = p.qn + (size_t)t * 512 + hv * 64; }
        else if (hv < 10) { zc = ZKS + (hv - 8) * 64; gain = p.k_gain + l * 64; dst = p.ks + (size_t)t * 128 + (hv - 8) * 64; }
        else { zc = ZKW + (hv - 10) * 64; gain = p.k_gain + l * 64; dst = p.kw + (size_t)t * 128 + (hv - 10) * 64; }
        const float v = p.z[(size_t)t * INC + zc + lane];
        const float ss = wave_sum(v * v);
        const float y = v * rsqrtf(ss * (1.0f / 64.f) + 1e-6f) * gain[lane];
        if (dst_norot) dst_norot[lane] = y;
        const float ang = (float)p.pos[t] * inv;
        const float cs = cosf(ang), sn = sinf(ang);
        const float other = __shfl_xor(y, 32);
        const float r = lane < 32 ? (y * cs - other * sn) : (y * cs + other * sn);
        dst[lane] = r;
    }
}

__device__ __forceinline__ void ph_compress(const Params& p, int l, float* smem, int bid, int nb) {
    float* A = smem;
    float* hid = smem + 2048;
    float* red = smem + 2048 + 256;
    const int tid = tid_();
    for (int u = bid; u < 2 * NB * NCMP * 2; u += nb) {
        const int kv = u / (NB * NCMP * 2), r = u % (NB * NCMP * 2), b = r / (NCMP * 2), n = (r / 2) % NCMP, hh = r & 1;
        const float* pe = (kv ? p.pe_v : p.pe_k) + l * 2048;
        const float* w1 = (kv ? p.w1v : p.w1k) + (size_t)l * 2048 * 256;
        const float* w2 = (kv ? p.w2v : p.w2k) + (size_t)l * 256 * 64;
        const int zc = (kv ? ZVC : ZKC) + hh * 64;
        __syncthreads();
        for (int k = tid; k < 2048; k += 256) { const int li = k >> 6, d = k & 63; A[k] = p.z[((size_t)b * NS + 16 * n + li) * INC + zc + d] + pe[k]; }
        __syncthreads();
        float acc = 0.f;
        for (int k = 0; k < 2048; ++k) acc = fmaf(A[k], w1[(size_t)k * 256 + tid], acc);
        hid[tid] = geluf_(acc);
        __syncthreads();
        if (tid < 64) {
            float o = 0.f;
            for (int f = 0; f < 256; ++f) o = fmaf(hid[f], w2[f * 64 + tid], o);
            float* dst = (kv ? p.vc : p.kc) + (((size_t)b * NCMP + n) * 2 + hh) * 64;
            if (kv) dst[tid] = o;
            else { const float ss = wave_sum(o * o); dst[tid] = o * rsqrtf(ss * (1.f / 64.f) + 1e-6f) * p.k_gain[l * 64 + tid]; }
        }
    }
    __syncthreads();
}

__device__ __forceinline__ void ph_gmln(const Params& p, int l, int bid, int nb) {
    const int lane = tid_() & 63, w = tid_() >> 6;
    for (int t = bid * 4 + w; t < NT; t += nb * 4) {
        float v[8]; float s = 0.f;
#pragma unroll
        for (int i = 0; i < 8; ++i) { v[i] = geluf_(p.z[(size_t)t * INC + ZV + i * 64 + lane]); s += v[i]; }
        const float mu = wave_sum(s) * (1.f / 512.f);
        float q = 0.f;
#pragma unroll
        for (int i = 0; i < 8; ++i) { const float d = v[i] - mu; q += d * d; }
        const float rstd = rsqrtf(wave_sum(q) * (1.f / 512.f) + 1e-6f);
#pragma unroll
        for (int i = 0; i < 8; ++i) { const int cidx = i * 64 + lane; p.vn[(size_t)t * 512 + cidx] = (v[i] - mu) * rstd * p.ln_g[l * 512 + cidx] + p.ln_b[l * 512 + cidx]; }
    }
}

__device__ __forceinline__ void ph_gmmix(const Params& p, int l, float* smem, int bid, int nb) {
    const int tid = tid_(), cidx = tid & 63, w = tid >> 6;
    for (int u = bid; u < 256 * 8; u += nb) {
        const int ch = u >> 3, g = u & 7;
        const size_t base = (size_t)ch * 128;
        __syncthreads();
        for (int i = tid; i < 128 * 64; i += 256) smem[i] = p.vn[(base + (i >> 6)) * 512 + g * 64 + (i & 63)];
        __syncthreads();
        const float* ws = p.gm_ws + ((size_t)l * 8 + g) * 128 * 128;
        for (int tl = w; tl < 128; tl += 4) {
            float acc = 0.f;
            for (int s = 0; s <= tl; ++s) acc = fmaf(ws[tl * 128 + s], smem[s * 64 + cidx], acc);
            const float mixed = acc + p.gm_bs[(l * 8 + g) * 128 + tl];
            const float uu = geluf_(p.z[(base + tl) * INC + ZU + g * 64 + cidx]);
            p.ogm[(base + tl) * 512 + g * 64 + cidx] = uu * mixed;
        }
    }
    __syncthreads();
}

__device__ __forceinline__ float dot32(const float (&q)[32], const float* k) {
    float s = 0.f;
#pragma unroll
    for (int i = 0; i < 8; ++i) { const float4 kv = *(const float4*)(k + i * 4); s = fmaf(q[i * 4], kv.x, s); s = fmaf(q[i * 4 + 1], kv.y, s); s = fmaf(q[i * 4 + 2], kv.z, s); s = fmaf(q[i * 4 + 3], kv.w, s); }
    s += __shfl_xor(s, 1);
    return s;
}
__device__ __forceinline__ void axpy32(float (&o)[32], float e, const float* v) {
#pragma unroll
    for (int i = 0; i < 8; ++i) { const float4 vv = *(const float4*)(v + i * 4); o[i * 4] = fmaf(e, vv.x, o[i * 4]); o[i * 4 + 1] = fmaf(e, vv.y, o[i * 4 + 1]); o[i * 4 + 2] = fmaf(e, vv.z, o[i * 4 + 2]); o[i * 4 + 3] = fmaf(e, vv.w, o[i * 4 + 3]); }
}

__device__ __forceinline__ void ph_attn(const Params& p, int l, float* smem, int bid, int nb) {
    float* imp = smem;
    unsigned long long* selm = (unsigned long long*)(smem + 2048);
    const int tid = tid_(), ql = tid >> 3, g = (tid >> 1) & 3, hf = tid & 1;
    const float scale = 0.125f;
    for (int unit = bid; unit < 2048; unit += nb) {
        const int qb = 63 - (unit >> 5), b = (unit & 31) >> 2, kvh = (unit >> 1) & 1, qh = unit & 1;
        const int qi = qh * 32 + ql;
        const int t = qb * 64 + qi, hq = kvh * 4 + g;
        const size_t tok = (size_t)b * NS + t;
        float q[32], o[32];
        const float gate0 = sigmoidf_(p.z[tok * INC + ZG + hq * 3 + 0]), gate1 = sigmoidf_(p.z[tok * INC + ZG + hq * 3 + 1]), gate2 = sigmoidf_(p.z[tok * INC + ZG + hq * 3 + 2]);
        float* outp = p.onsa + tok * 512 + hq * 64 + hf * 32;
        const int ho = kvh * 64 + hf * 32;
#pragma unroll
        for (int i = 0; i < 8; ++i) { const float4 v = *(const float4*)(p.qn + tok * 512 + hq * 64 + hf * 32 + i * 4); q[i * 4] = v.x; q[i * 4 + 1] = v.y; q[i * 4 + 2] = v.z; q[i * 4 + 3] = v.w; }
        int nvis = t >= 31 ? (t - 31) / 16 + 1 : 0; if (nvis > NCMP) nvis = NCMP;
        const float* kcb = p.kc + (size_t)b * NCMP * 128 + ho;
        const float* vcb = p.vc + (size_t)b * NCMP * 128 + ho;
        float m = -INFINITY;
        for (int n = 0; n < nvis; ++n) { const float s = dot32(q, kcb + n * 128) * scale; m = fmaxf(m, s); }
        float lsum = 0.f;
#pragma unroll
        for (int i = 0; i < 32; ++i) o[i] = 0.f;
        for (int n = 0; n < nvis; ++n) { const float s = dot32(q, kcb + n * 128) * scale; const float e = expf(s - m); lsum += e; axpy32(o, e, vcb + n * 128); }
        const float inv = 1.0f / fmaxf(lsum, 1e-30f);
#pragma unroll
        for (int i = 0; i < 8; ++i) *(float4*)(outp + i * 4) = make_float4(gate0 * o[i * 4] * inv, gate0 * o[i * 4 + 1] * inv, gate0 * o[i * 4 + 2] * inv, gate0 * o[i * 4 + 3] * inv);
        __syncthreads();
        for (int j = 0; j <= qb; ++j) {
            float a = 0.f;
            for (int n = 4 * j - 1; n <= 4 * j + 3; ++n) if (n >= 0 && n < nvis) { const float s = dot32(q, kcb + n * 128) * scale; a += expf(s - m) * inv; }
            a += __shfl_xor(a, 2); a += __shfl_xor(a, 4);
            if (g == 0 && hf == 0) imp[ql * 64 + j] = a;
        }
        __syncthreads();
        if (g == 0 && hf == 0) {
            unsigned long long mask = 0ull;
            for (int it = 0; it < 16; ++it) {
                int best = -1; float bv = 0.f;
                for (int j = 0; j < 64; ++j) {
                    if ((mask >> j) & 1ull) continue;
                    const bool forced = (j == 0) || (j == qb) || (j == qb - 1);
                    const float v = forced ? INFINITY : (j <= qb ? imp[ql * 64 + j] : -INFINITY);
                    if (best < 0 || v > bv) { best = j; bv = v; }
                }
                mask |= 1ull << best;
            }
            selm[ql] = mask;
        }
        __syncthreads();
        const unsigned long long mask = selm[ql];
#pragma unroll
        for (int i = 0; i < 8; ++i) { const float4 v = *(const float4*)(p.qr + tok * 512 + hq * 64 + hf * 32 + i * 4); q[i * 4] = v.x; q[i * 4 + 1] = v.y; q[i * 4 + 2] = v.z; q[i * 4 + 3] = v.w; }
        {
            float mm = -INFINITY, ll = 0.f;
#pragma unroll
            for (int i = 0; i < 32; ++i) o[i] = 0.f;
            for (int j = 0; j <= qb; ++j) {
                if (!((mask >> j) & 1ull)) continue;
                for (int s = 0; s < 64; ++s) {
                    const int tk = j * 64 + s; if (tk > t) break;
                    const size_t kt = (size_t)b * NS + tk;
                    const float sc = dot32(q, p.ks + kt * 128 + ho) * scale;
                    if (sc > mm) { const float corr = expf(mm - sc); ll *= corr;
#pragma unroll
                        for (int i = 0; i < 32; ++i) o[i] *= corr;
                        mm = sc; }
                    const float e = expf(sc - mm); ll += e; axpy32(o, e, p.z + kt * INC + ZVS + ho);
                }
            }
            const float iv = gate1 / fmaxf(ll, 1e-30f);
#pragma unroll
            for (int i = 0; i < 8; ++i) { float4 c = *(float4*)(outp + i * 4); c.x += o[i * 4] * iv; c.y += o[i * 4 + 1] * iv; c.z += o[i * 4 + 2] * iv; c.w += o[i * 4 + 3] * iv; *(float4*)(outp + i * 4) = c; }
        }
        {
            float mm = -INFINITY, ll = 0.f;
#pragma unroll
            for (int i = 0; i < 32; ++i) o[i] = 0.f;
            const int k0 = t - 511 > 0 ? t - 511 : 0;
            for (int tk = k0; tk <= t; ++tk) {
                const size_t kt = (size_t)b * NS + tk;
                const float sc = dot32(q, p.kw + kt * 128 + ho) * scale;
                if (sc > mm) { const float corr = expf(mm - sc); ll *= corr;
#pragma unroll
                    for (int i = 0; i < 32; ++i) o[i] *= corr;
                    mm = sc; }
                const float e = expf(sc - mm); ll += e; axpy32(o, e, p.z + kt * INC + ZVW + ho);
            }
            const float iv = gate2 / fmaxf(ll, 1e-30f);
#pragma unroll
            for (int i = 0; i < 8; ++i) { float4 c = *(float4*)(outp + i * 4); c.x += o[i * 4] * iv; c.y += o[i * 4 + 1] * iv; c.z += o[i * 4 + 2] * iv; c.w += o[i * 4 + 3] * iv; *(float4*)(outp + i * 4) = c; }
        }
    }
    __syncthreads();
}

__device__ __forceinline__ void ph_topk(const Params& p, int l, int bid, int nb) {
    const int lane = tid_() & 63, w = tid_() >> 6;
    for (int t = bid * 4 + w; t < NT; t += nb * 4) {
        float aff[4], key[4]; bool used[4];
#pragma unroll
        for (int i = 0; i < 4; ++i) { const int e = i * 64 + lane; aff[i] = sigmoidf_(p.logits[(size_t)t * NE + e]); key[i] = aff[i] + p.b_router[l * NE + e]; used[i] = false; }
        float topv[8]; int tope[8]; float sum = 0.f;
#pragma unroll
        for (int r = 0; r < 8; ++r) {
            float bv = -INFINITY; int be = 1 << 30; float ba = 0.f;
#pragma unroll
            for (int i = 0; i < 4; ++i) { const int e = i * 64 + lane; if (!used[i] && (key[i] > bv || (key[i] == bv && e < be))) { bv = key[i]; be = e; ba = aff[i]; } }
#pragma unroll
            for (int o = 32; o >= 1; o >>= 1) {
                const float ov = __shfl_xor(bv, o); const int oe = __shfl_xor(be, o); const float oa = __shfl_xor(ba, o);
                if (ov > bv || (ov == bv && oe < be)) { bv = ov; be = oe; ba = oa; }
            }
#pragma unroll
            for (int i = 0; i < 4; ++i) if (i * 64 + lane == be) used[i] = true;
            topv[r] = ba; tope[r] = be; sum += ba;
        }
        if (lane < 8) {
            float tv = 0.f; int te = 0;
#pragma unroll
            for (int r = 0; r < 8; ++r) if (lane == r) { tv = topv[r]; te = tope[r]; }
            p.idx[(size_t)t * 8 + lane] = te;
            p.wts[(size_t)t * 8 + lane] = tv / sum * 2.5f;
            atomicAdd(&p.counts[te], 1);
        }
    }
}

__device__ __forceinline__ void ph_scan(const Params& p, int* ismem, int bid) {
    if (bid != 0) return;
    const int tid = tid_();
    ismem[tid] = (p.counts[tid] + 127) / 128 * 128;
    __syncthreads();
    if (tid == 0) { int run = 0; for (int e = 0; e < NE; ++e) { const int v = ismem[e]; ismem[e] = run; run += v; } ismem[NE] = run; }
    __syncthreads();
    const int st = ismem[tid], en = (tid == NE - 1) ? ismem[NE] : ismem[tid + 1];
    p.pad_start[tid] = st; p.cursor[tid] = 0;
    for (int i = st / 128; i < en / 128; ++i) p.blk_e[i] = tid;
    for (int i = ismem[NE] / 128 + tid; i < MAXBLK; i += 256) p.blk_e[i] = -1;
    __syncthreads();
}

__device__ __forceinline__ void ph_place(const Params& p, int bid, int nb) {
    for (int a = bid * 256 + tid_(); a < NT * 8; a += nb * 256) {
        const int e = p.idx[a];
        const int pos = atomicAdd(&p.cursor[e], 1);
        const int dest = p.pad_start[e] + pos;
        p.row_tok[dest] = a >> 3; p.row_w[dest] = p.wts[a];
    }
}

enum { PH_MOD = 0, PH_NORM_A, PH_GEMM_Z, PH_PREP, PH_ATTN, PH_PROJ, PH_OUT, PH_NORM_F, PH_ROUTER, PH_TOPK, PH_SCAN, PH_PLACE, PH_EGATE, PH_EUP, PH_EDOWN, PH_FINAL, PH_COUNT };

template <int PH>
__device__ __forceinline__ void run_phase(const Params& p, int l, float* smem, int bid, int nb) {
    const float* xin = (l == 0) ? p.x : p.out;
    if constexpr (PH == PH_MOD) { ph_mod(p, smem, bid, nb); }
    else if constexpr (PH == PH_NORM_A) { ph_norm(p, xin, l, 0, 1024, bid, nb); }
    else if constexpr (PH == PH_GEMM_Z) {
        GemmArgs g{}; g.A = p.h; g.lda = ND; g.Bm = p.w_in + (size_t)l * ND * INC; g.ldb = INC; g.C = p.z; g.ldc = INC; g.M = NT; g.N = INC; g.K = ND;
        sgemm<M_STORE, false>(g, smem, bid, nb);
    }
    else if constexpr (PH == PH_PREP) { ph_prep(p, l, bid, nb); ph_compress(p, l, smem, bid, nb); ph_gmln(p, l, bid, nb); }
    else if constexpr (PH == PH_ATTN) { ph_attn(p, l, smem, bid, nb); ph_gmmix(p, l, smem, bid, nb); }
    else if constexpr (PH == PH_PROJ) {
        GemmArgs g{}; g.A = p.onsa; g.lda = 512; g.Bm = p.wpn + (size_t)l * 512 * ND; g.ldb = ND; g.C = p.ya; g.ldc = ND; g.M = NT; g.N = ND; g.K = 512; g.aux = p.z + ZGA; g.ldaux = INC;
        sgemm<M_SIG_SET, false>(g, smem, bid, nb);
        g.A = p.ogm; g.Bm = p.wpg + (size_t)l * 512 * ND; g.aux = p.z + ZGB;
        sgemm<M_SIG_ADD, false>(g, smem, bid, nb);
    }
    else if constexpr (PH == PH_OUT) {
        GemmArgs g{}; g.A = p.ya; g.lda = ND; g.Bm = p.w_out + (size_t)l * ND * ND; g.ldb = ND; g.C = p.out; g.ldc = ND; g.M = NT; g.N = ND; g.K = ND;
        g.aux = xin; g.ldaux = ND; g.aux2 = p.mod + (size_t)l * NB * 6144 + 2048;
        sgemm<M_RESID, false>(g, smem, bid, nb);
    }
    else if constexpr (PH == PH_NORM_F) {
        ph_norm(p, p.out, l, 3072, 4096, bid, nb);
        for (size_t i = (size_t)bid * 256 + tid_(); i < (size_t)NT * ND / 4; i += (size_t)nb * 256) ((float4*)p.routed)[i] = make_float4(0.f, 0.f, 0.f, 0.f);
        for (int i = bid * 256 + tid_(); i < MAXROWS; i += nb * 256) { p.row_tok[i] = -1; p.row_w[i] = 0.f; }
        if (bid == 0) p.counts[tid_()] = 0;
    }
    else if constexpr (PH == PH_ROUTER) {
        GemmArgs g{}; g.A = p.h; g.lda = ND; g.Bm = p.w_router + (size_t)l * ND * NE; g.ldb = NE; g.C = p.logits; g.ldc = NE; g.M = NT; g.N = NE; g.K = ND;
        sgemm<M_STORE, false>(g, smem, bid, nb);
        g.Bm = p.wgs + (size_t)l * ND * 256; g.C = p.gs;
        sgemm<M_STORE, false>(g, smem, bid, nb);
    }
    else if constexpr (PH == PH_TOPK) {
        ph_topk(p, l, bid, nb);
        GemmArgs g{}; g.A = p.h; g.lda = ND; g.Bm = p.wus + (size_t)l * ND * 256; g.ldb = 256; g.C = p.sact; g.ldc = 256; g.M = NT; g.N = 256; g.K = ND; g.aux = p.gs; g.ldaux = 256;
        sgemm<M_SILU_MUL, false>(g, smem, bid, nb);
    }
    else if constexpr (PH == PH_SCAN) {
        ph_scan(p, (int*)smem, bid);
        GemmArgs g{}; g.A = p.sact; g.lda = 256; g.Bm = p.wds + (size_t)l * 256 * ND; g.ldb = ND; g.C = p.shout; g.ldc = ND; g.M = NT; g.N = ND; g.K = 256;
        sgemm<M_STORE, false>(g, smem, bid, nb);
    }
    else if constexpr (PH == PH_PLACE) { ph_place(p, bid, nb); }
    else if constexpr (PH == PH_EGATE) {
        GemmArgs g{}; g.A = p.h; g.lda = ND; g.gather = p.row_tok; g.Bm = p.wge + (size_t)l * NE * ND * 256; g.ldb = 256; g.strideB = (size_t)ND * 256; g.blk_e = p.blk_e;
        g.C = p.ag; g.ldc = 256; g.M = MAXROWS; g.N = 256; g.K = ND;
        sgemm<M_STORE, true>(g, smem, bid, nb);
    }
    else if constexpr (PH == PH_EUP) {
        GemmArgs g{}; g.A = p.h; g.lda = ND; g.gather = p.row_tok; g.Bm = p.wue + (size_t)l * NE * ND * 256; g.ldb = 256; g.strideB = (size_t)ND * 256; g.blk_e = p.blk_e;
        g.C = p.act; g.ldc = 256; g.M = MAXROWS; g.N = 256; g.K = ND; g.aux = p.ag; g.ldaux = 256;
        sgemm<M_SILU_MUL, true>(g, smem, bid, nb);
    }
    else if constexpr (PH == PH_EDOWN) {
        GemmArgs g{}; g.A = p.act; g.lda = 256; g.gather = p.row_tok; g.Bm = p.wde + (size_t)l * NE * 256 * ND; g.ldb = ND; g.strideB = (size_t)256 * ND; g.blk_e = p.blk_e;
        g.C = p.routed; g.ldc = ND; g.M = MAXROWS; g.N = ND; g.K = 256; g.aux = p.row_w;
        sgemm<M_SCATTER, false>(g, smem, bid, nb);
    }
    else if constexpr (PH == PH_FINAL) {
        const float* gt = p.mod + (size_t)l * NB * 6144 + 5120;
        for (size_t i = (size_t)bid * 256 + tid_(); i < (size_t)NT * ND / 4; i += (size_t)nb * 256) {
            const size_t e0 = i * 4; const int r = (int)(e0 >> 10), cidx = (int)(e0 & 1023);
            const float4 g4 = *(const float4*)(gt + (size_t)(r >> 12) * 6144 + cidx);
            const float4 a = ((const float4*)p.routed)[i], s = ((const float4*)p.shout)[i]; float4 o = ((float4*)p.out)[i];
            o.x += g4.x * (a.x + s.x); o.y += g4.y * (a.y + s.y); o.z += g4.z * (a.z + s.z); o.w += g4.w * (a.w + s.w);
            ((float4*)p.out)[i] = o;
        }
    }
}


#define SMEM_FLOATS 8192
template <int PH>
__global__ void __launch_bounds__(256, 2) k_phase(Params p, int l) {
    __shared__ float smem[SMEM_FLOATS];
    run_phase<PH>(p, l, smem, blockIdx.x, gridDim.x);
}
template <int PH> static void launch_phase(const Params& p, int l, int grid, hipStream_t s) { hipLaunchKernelGGL(k_phase<PH>, dim3(grid), dim3(256), 0, s, p, l); }
}
#endif
namespace pg8 {
constexpr int BM = 256, BK = 64, HALF = 128, HTB = HALF * BK * 2, STAGE_BYTES = 8 * HTB;

__host__ __device__ __forceinline__ int lds_byte(int r, int c) { const int st = (r >> 4) * 2 + (c >> 5), rr = r & 15, cc = c & 31, ob = rr * 64 + cc * 2; return st * 1024 + (ob ^ (((ob >> 9) & 1) << 5)); }
__host__ __device__ __forceinline__ void stage_rc(int b, int& R, int& C) { const int st = b / 1024, sb = b % 1024, swz = sb ^ (((sb >> 9) & 1) << 5); R = (st >> 1) * 16 + swz / 64; C = (st & 1) * 32 + (swz % 64) / 2; }
__host__ __device__ __forceinline__ int perm32(int rho) { const int n = rho >> 4, i = rho & 15; return 8 * (i >> 2) + 4 * n + (i & 3); }

struct Unit { int pm, pn, e; };

__device__ __forceinline__ const char* uptr(const char* p) { return p; }
__device__ __forceinline__ unsigned cvt_pk_bf16(float lo, float hi) { unsigned r; asm volatile("v_cvt_pk_bf16_f32 %0, %1, %2" : "=v"(r) : "v"(lo), "v"(hi)); return r; }

typedef long pg8_l2 __attribute__((ext_vector_type(2)));
template <bool F8> __device__ __forceinline__ f32x4 pg8_mma(const bf16x8& b, const bf16x8& a, const f32x4& c) {
    if constexpr (F8) { const pg8_l2 bl = __builtin_bit_cast(pg8_l2, b), al = __builtin_bit_cast(pg8_l2, a);
        f32x4 r = __builtin_amdgcn_mfma_f32_16x16x32_fp8_fp8(bl[0], al[0], c, 0, 0, 0); return __builtin_amdgcn_mfma_f32_16x16x32_fp8_fp8(bl[1], al[1], r, 0, 0, 0); }
    else return __builtin_amdgcn_mfma_f32_16x16x32_bf16(b, a, c, 0, 0, 0);
}
template <class Epi, class Sched, bool ALIGN_EPI = true, bool MID = false, bool F8 = false>
__device__ __forceinline__ void gemm_phase(LAS unsigned char* lds, const Sched& S, const Epi& E) {
    const int tid = tid_(), wid = __builtin_amdgcn_readfirstlane(tid >> 6), lane = tid & 63, wr = wid >> 2, wc = wid & 3, fr = lane & 15, fq = lane >> 4;
    const int K = S.K, nt = K / BK;
    unsigned voffB[2];
#pragma unroll
    for (int i = 0; i < 2; ++i) { int R, C; stage_rc(tid * 16 + i * 8192, R, C); const int Rb = Epi::PERM ? ((R & ~31) + perm32(R & 31)) : R; voffB[i] = (unsigned)(Rb * S.ldb + C) * 2u; }
    const unsigned kstepB = (unsigned)(BK * 2), kstepA = (unsigned)S.kstepA;
    const unsigned hstepB = (unsigned)(HALF * S.ldb * 2);
    const char* const bA = S.a_base(); const char* const bB = S.b_base();
    const unsigned ldsw = (unsigned)wid * 1024u;
    const int aoff = lds_byte(wr * 64 + fr, fq * 8), boff = lds_byte(wc * 32 + fr, fq * 8);
#define PG8_SA(b, h) (((b) * 2 + (h)) * HTB)
#define PG8_SB(b, h) ((4 + (b) * 2 + (h)) * HTB)
#define PG8_STAGE_B(bufoff, gbase) do { _Pragma("unroll") for (int _i = 0; _i < 2; ++_i) \
        __builtin_amdgcn_global_load_lds((const unsigned*)(bB + (unsigned)((gbase) + voffB[_i])), (LAS unsigned*)(lds + (bufoff) + ldsw + _i * 8192), 16, 0, 0); } while (0)
#define PG8_STAGE_A(bufoff, gbase, offs, h) do { _Pragma("unroll") for (int _i = 0; _i < 2; ++_i) \
        __builtin_amdgcn_global_load_lds((const unsigned*)(bA + (unsigned)((gbase) + (offs)[h][_i])), (LAS unsigned*)(lds + (bufoff) + ldsw + _i * 8192), 16, 0, 0); } while (0)
#define PG8_LDA(dst, b, h) do { _Pragma("unroll") for (int m = 0; m < 4; ++m) _Pragma("unroll") for (int k = 0; k < 2; ++k) dst[m][k] = *(const LAS bf16x8*)(lds + PG8_SA(b, h) + aoff + m * 2048 + k * 1024); } while (0)
#define PG8_LDB(dst, b, h) do { _Pragma("unroll") for (int n = 0; n < 2; ++n) _Pragma("unroll") for (int k = 0; k < 2; ++k) dst[n][k] = *(const LAS bf16x8*)(lds + PG8_SB(b, h) + boff + n * 2048 + k * 1024); } while (0)
#define PG8_MMA(ai, bj, At, Bt) do { __builtin_amdgcn_s_setprio(1); _Pragma("unroll") for (int m = 0; m < 4; ++m) _Pragma("unroll") for (int n = 0; n < 2; ++n) _Pragma("unroll") for (int k = 0; k < 2; ++k) \
        acc[ai][bj][m][n] = pg8_mma<F8>(Bt[n][k], At[m][k], acc[ai][bj][m][n]); __builtin_amdgcn_s_setprio(0); } while (0)
#define PG8_WAIT_V(n) asm volatile("s_waitcnt vmcnt(" #n ")" ::: "memory")
#define PG8_WAIT_L(n) asm volatile("s_waitcnt lgkmcnt(" #n ")" ::: "memory")
#define PG8_BAR __builtin_amdgcn_s_barrier()
#define PG8_SCHED __builtin_amdgcn_sched_barrier(0)
    Unit cur, nxt; int ui = 0;
    if (!S.next(0, cur)) return;
    f32x4 acc[2][2][4][2];
#pragma unroll
    for (int a = 0; a < 2; ++a)
#pragma unroll
        for (int b = 0; b < 2; ++b)
#pragma unroll
            for (int m = 0; m < 4; ++m)
#pragma unroll
                for (int n = 0; n < 2; ++n) acc[a][b][m][n] = (f32x4){0.f, 0.f, 0.f, 0.f};
    bf16x8 At[4][2], B0[2][2], B1[2][2];
    unsigned cA = (unsigned)(S.a_ptr(cur) - bA), cB = (unsigned)(S.b_ptr(cur) - bB);
    unsigned coff[2][2], noff[2][2];
    S.a_off(cur, tid, coff);
    PG8_STAGE_B(PG8_SB(0, 0), cB); PG8_STAGE_B(PG8_SB(0, 1), cB + hstepB); PG8_STAGE_A(PG8_SA(0, 0), cA, coff, 0); PG8_STAGE_A(PG8_SA(0, 1), cA, coff, 1);
    if (wr == 1) PG8_BAR;
    PG8_WAIT_V(2); PG8_BAR;
    PG8_STAGE_B(PG8_SB(1, 0), cB + kstepB); PG8_STAGE_A(PG8_SA(1, 0), cA + kstepA, coff, 0); PG8_STAGE_B(PG8_SB(1, 1), cB + hstepB + kstepB);
    PG8_WAIT_V(6); PG8_BAR;
    for (;;) {
        const bool has_next = S.next(ui + 1, nxt);
        unsigned nA = cA, nB = cB;
#pragma unroll
        for (int h = 0; h < 2; ++h)
#pragma unroll
            for (int i = 0; i < 2; ++i) noff[h][i] = coff[h][i];
        if (has_next) { nA = (unsigned)(S.a_ptr(nxt) - bA); nB = (unsigned)(S.b_ptr(nxt) - bB); S.a_off(nxt, tid_(), noff); }
        for (int t = 0; t < nt; t += 2) {
            if constexpr (MID) { if (2 * t == nt) E.mid(acc, cur, wr, wc, fr, fq); }
            const bool last = (t == nt - 2);
            const unsigned a1 = cA + (unsigned)(t + 1) * kstepA;
            const unsigned a2 = last ? nA : cA + (unsigned)(t + 2) * kstepA, b2 = last ? nB : cB + (unsigned)(t + 2) * kstepB;
            const unsigned a3 = a2 + kstepA, b3 = b2 + kstepB;
            unsigned so[2][2]; const unsigned lmask = last ? 0xffffffffu : 0u;
#pragma unroll
            for (int h = 0; h < 2; ++h)
#pragma unroll
                for (int i = 0; i < 2; ++i) so[h][i] = coff[h][i] ^ ((coff[h][i] ^ noff[h][i]) & lmask);
            PG8_LDB(B0, 0, 0); PG8_LDB(B1, 0, 1); PG8_SCHED; PG8_LDA(At, 0, 0); PG8_STAGE_A(PG8_SA(1, 1), a1, coff, 1);
            PG8_WAIT_V(8); PG8_WAIT_L(0); PG8_BAR; PG8_MMA(0, 0, At, B0); PG8_MMA(0, 1, At, B1); PG8_BAR; PG8_SCHED;
            PG8_LDA(At, 0, 1); PG8_STAGE_B(PG8_SB(0, 0), b2); PG8_STAGE_B(PG8_SB(0, 1), b2 + hstepB); PG8_STAGE_A(PG8_SA(0, 0), a2, so, 0);
            PG8_WAIT_V(8); PG8_WAIT_L(0); PG8_BAR; PG8_MMA(1, 0, At, B0); PG8_MMA(1, 1, At, B1); PG8_BAR; PG8_SCHED;
            PG8_LDB(B0, 1, 0); PG8_LDB(B1, 1, 1); PG8_SCHED; PG8_LDA(At, 1, 0); PG8_STAGE_A(PG8_SA(0, 1), a2, so, 1);
            PG8_WAIT_V(8); PG8_WAIT_L(0); PG8_BAR; PG8_MMA(0, 0, At, B0); PG8_MMA(0, 1, At, B1); PG8_BAR; PG8_SCHED;
            PG8_LDA(At, 1, 1); PG8_STAGE_B(PG8_SB(1, 0), b3); PG8_STAGE_B(PG8_SB(1, 1), b3 + hstepB); PG8_STAGE_A(PG8_SA(1, 0), a3, so, 0);
            PG8_WAIT_V(8); PG8_WAIT_L(0); PG8_BAR; PG8_MMA(1, 0, At, B0); PG8_MMA(1, 1, At, B1); PG8_BAR; PG8_SCHED;
        }
        if constexpr (ALIGN_EPI) { if (wr == 0) PG8_BAR; }
        E(acc, cur, wr, wc, fr, fq);
        if (!has_next) break;
#pragma unroll
        for (int a = 0; a < 2; ++a)
#pragma unroll
            for (int b = 0; b < 2; ++b)
#pragma unroll
                for (int m = 0; m < 4; ++m)
#pragma unroll
                    for (int n = 0; n < 2; ++n) acc[a][b][m][n] = (f32x4){0.f, 0.f, 0.f, 0.f};
        cur = nxt; cA = nA; cB = nB; ++ui;
#pragma unroll
        for (int h = 0; h < 2; ++h)
#pragma unroll
            for (int i = 0; i < 2; ++i) coff[h][i] = noff[h][i];
        if constexpr (ALIGN_EPI) { if (wr == 1) PG8_BAR; }
    }
    PG8_WAIT_V(0);
    if constexpr (!ALIGN_EPI) { if (wr == 0) PG8_BAR; }
    PG8_BAR;
#undef PG8_SA
#undef PG8_SB
#undef PG8_STAGE_A
#undef PG8_STAGE_B
#undef PG8_LDA
#undef PG8_LDB
#undef PG8_MMA
#undef PG8_WAIT_V
#undef PG8_WAIT_L
#undef PG8_BAR
#undef PG8_SCHED
}

struct DenseSched {
    const char* A; const char* Bt; int K, kstepA, ldb; int lda_bytes; int nM, nN, G, c;
    __device__ __forceinline__ void init(const void* A_, int lda_elems, const void* Bt_, int M, int N, int K_, int G_, int c_) {
        A = (const char*)A_; Bt = (const char*)Bt_; K = K_; ldb = K_; kstepA = BK * 2; lda_bytes = lda_elems * 2; nM = M / BM; nN = N / BM; G = G_; c = c_; }
    __device__ __forceinline__ bool next(int i, Unit& u) const {
        const long L = (long)i * G + c; if (L >= (long)nM * nN) return false;
        const int nwg = nM * nN; int wgid = (int)L; { const int q = nwg / 8, r = nwg % 8, xcd = wgid % 8, off = wgid / 8; wgid = (xcd < r ? xcd * (q + 1) : r * (q + 1) + (xcd - r) * q) + off; }
        const int nig = 8 * nN, gid = wgid / nig, fm = gid * 8, gsz = (nM - fm) < 8 ? (nM - fm) : 8;
        u.pm = fm + ((wgid % nig) % gsz); u.pn = (wgid % nig) / gsz; u.e = 0; return true;
    }
    __device__ __forceinline__ const char* a_base() const { return A; }
    __device__ __forceinline__ const char* b_base() const { return Bt; }
    __device__ __forceinline__ const char* a_ptr(const Unit& u) const { return A + (size_t)u.pm * BM * lda_bytes; }
    __device__ __forceinline__ void a_off(const Unit&, int tid, unsigned (&off)[2][2]) const {
#pragma unroll
        for (int i = 0; i < 2; ++i) { int R, C; stage_rc(tid * 16 + i * 8192, R, C);
#pragma unroll
            for (int h = 0; h < 2; ++h) off[h][i] = (unsigned)((h * HALF + R) * lda_bytes + C * 2); }
    }
    __device__ __forceinline__ const char* b_ptr(const Unit& u) const { return Bt + (size_t)u.pn * BM * K * 2; }
};
}
#define MAXROWS2 327680
#define MAXUNITS2 (MAXROWS2 / 256)
#define ZPAD 4608
constexpr int LDS_BYTES = 147456;
constexpr int LDS_MISC = 135168;

namespace wsl {
constexpr size_t al(size_t x) { return (x + 255) & ~(size_t)255; }
constexpr size_t O_ctl = 0;
constexpr size_t O_mod = O_ctl + al(65536);
constexpr size_t O_rope = O_mod + al((size_t)NL * NB * 6144 * 4);
constexpr size_t O_bias1 = O_rope + al((size_t)NT * 32 * 8);
constexpr size_t O_wsc = O_bias1 + al((size_t)NL * 2 * 256 * 4);
constexpr size_t O_Wt_in = O_wsc + al((size_t)NL * 8 * 128 * 128 * 2);
constexpr size_t O_Wt_pn = O_Wt_in + al((size_t)NL * ZPAD * ND * 2);
constexpr size_t O_Wt_pg = O_Wt_pn + al((size_t)NL * ND * 512 * 2);
constexpr size_t O_Wt_out = O_Wt_pg + al((size_t)NL * ND * 512 * 2);
constexpr size_t O_Wt_rs = O_Wt_out + al((size_t)NL * ND * ND * 2);
constexpr size_t O_Wt_ds = O_Wt_rs + al((size_t)NL * 768 * ND * 2);
constexpr size_t O_Wt_w1 = O_Wt_ds + al((size_t)NL * ND * 256 * 2);
constexpr size_t O_h = O_Wt_w1 + al((size_t)NL * 2 * 256 * 2048 * 2);
constexpr size_t O_xb = O_h + al((size_t)NT * ND * 2);
constexpr size_t O_gates = O_xb + al((size_t)NT * ND * 2);
constexpr size_t O_kc = O_gates + al((size_t)NT * 32 * 4);
constexpr size_t O_vc = O_kc + al((size_t)NB * 256 * 128 * 2);
constexpr size_t O_idx = O_vc + al((size_t)NB * 256 * 128 * 2);
constexpr size_t O_slot = O_idx + al((size_t)NT * 8 * 4);
constexpr size_t O_wts = O_slot + al((size_t)NT * 8 * 4);
constexpr size_t O_counts = O_wts + al((size_t)NT * 8 * 4);
constexpr size_t O_cursor = O_counts + al(1024);
constexpr size_t O_bhist = O_cursor + al(1024);
constexpr size_t O_row_tok = O_bhist + al(1024 * 256 * 4);
constexpr size_t O_row_w = O_row_tok + al((size_t)MAXROWS2 * 4);
constexpr size_t O_unit_e = O_row_w + al((size_t)MAXROWS2 * 4);
constexpr size_t O_REGION = O_unit_e + al((size_t)MAXUNITS2 * 4);
constexpr size_t O_qn = O_REGION;
constexpr size_t O_qr = O_qn + al((size_t)NT * 512 * 2);
constexpr size_t O_kvraw = O_qr + al((size_t)NT * 512 * 2);
constexpr size_t O_ksv = O_kvraw + al((size_t)NT * 256 * 2);
constexpr size_t O_kwv = O_ksv + al((size_t)NT * 256 * 2);
constexpr size_t O_u = O_kwv + al((size_t)NT * 256 * 2);
constexpr size_t O_v = O_u + al((size_t)NT * 512 * 2);
constexpr size_t O_sga = O_v + al((size_t)NT * 512 * 2);
constexpr size_t O_sgb = O_sga + al((size_t)NT * ND * 2);
constexpr size_t O_cpart = O_sgb + al((size_t)NT * ND * 2);
constexpr size_t O_onsa = O_cpart + al((size_t)2 * 4 * 4096 * 256 * 4);
constexpr size_t O_ogm = O_onsa + al((size_t)NT * 512 * 2);
constexpr size_t O_merged = O_ogm + al((size_t)NT * 512 * 2);
constexpr size_t O_END_MIX = O_merged + al((size_t)NT * ND * 2);
constexpr size_t O_logits = O_REGION;
constexpr size_t O_sact = O_logits + al((size_t)NT * NE * 4);
constexpr size_t O_shout = O_sact + al((size_t)NT * 256 * 2);
constexpr size_t O_act = O_shout + al((size_t)NT * ND * 2);
constexpr size_t O_yslot = O_act + al((size_t)MAXROWS2 * 256 * 2);
constexpr size_t O_END_MOE = O_yslot + al((size_t)MAXROWS2 * ND * 2);
constexpr size_t O_END_ACT = O_END_MIX > O_END_MOE ? O_END_MIX : O_END_MOE;
constexpr size_t O_Wt_eg = O_END_ACT;
constexpr size_t O_Wt_ed = O_Wt_eg + al((size_t)NL * NE * 512 * ND * 2);
constexpr size_t O_TOTAL = O_Wt_ed + al((size_t)NL * NE * ND * 256 * 2);
}
struct OP {
    const float *x, *c; const int* pos;
    const float *w_mod, *b_mod, *w_in, *q_gain, *k_gain, *pe_k, *pe_v, *w1k, *w2k, *w1v, *w2v, *ln_g, *ln_b, *gm_ws, *gm_bs,
                *wpn, *wpg, *w_out, *w_router, *b_router, *wge, *wue, *wde, *wgs, *wus, *wds;
    float* out;
    float* xres;
    char* ws;
    long long xoff;
    int ph_lo, ph_hi, l_lo, l_hi, conv_l_lo, conv_l_hi;
    __host__ __device__ __forceinline__ unsigned* ctl() const { return (unsigned*)(ws + wsl::O_ctl + (0)); }
    __host__ __device__ __forceinline__ float* mod() const { return (float*)(ws + wsl::O_mod + (0)); }
    __host__ __device__ __forceinline__ float* rope() const { return (float*)(ws + wsl::O_rope + (0)); }
    __host__ __device__ __forceinline__ float* bias1() const { return (float*)(ws + wsl::O_bias1 + (0)); }
    __host__ __device__ __forceinline__ bf16_t* wsc() const { return (bf16_t*)(ws + wsl::O_wsc + (0)); }
    __host__ __device__ __forceinline__ bf16_t* Wt_in() const { return (bf16_t*)(ws + wsl::O_Wt_in + (0)); }
    __host__ __device__ __forceinline__ bf16_t* Wt_pn() const { return (bf16_t*)(ws + wsl::O_Wt_pn + (0)); }
    __host__ __device__ __forceinline__ bf16_t* Wt_pg() const { return (bf16_t*)(ws + wsl::O_Wt_pg + (0)); }
    __host__ __device__ __forceinline__ bf16_t* Wt_out() const { return (bf16_t*)(ws + wsl::O_Wt_out + (0)); }
    __host__ __device__ __forceinline__ bf16_t* Wt_rs() const { return (bf16_t*)(ws + wsl::O_Wt_rs + (0)); }
    __host__ __device__ __forceinline__ bf16_t* Wt_ds() const { return (bf16_t*)(ws + wsl::O_Wt_ds + (0)); }
    __host__ __device__ __forceinline__ bf16_t* Wt_w1() const { return (bf16_t*)(ws + wsl::O_Wt_w1 + (0)); }
    __host__ __device__ __forceinline__ bf16_t* h() const { return (bf16_t*)(ws + wsl::O_h + (0)); }
    __host__ __device__ __forceinline__ bf16_t* xb() const { return (bf16_t*)(ws + wsl::O_xb + (0)); }
    __host__ __device__ __forceinline__ float* gates() const { return (float*)(ws + wsl::O_gates + (0)); }
    __host__ __device__ __forceinline__ bf16_t* kc() const { return (bf16_t*)(ws + wsl::O_kc + (0)); }
    __host__ __device__ __forceinline__ bf16_t* vc() const { return (bf16_t*)(ws + wsl::O_vc + (0)); }
    __host__ __device__ __forceinline__ int* idx() const { return (int*)(ws + wsl::O_idx + (0)); }
    __host__ __device__ __forceinline__ int* slot() const { return (int*)(ws + wsl::O_slot + (0)); }
    __host__ __device__ __forceinline__ float* wts() const { return (float*)(ws + wsl::O_wts + (0)); }
    __host__ __device__ __forceinline__ int* counts() const { return (int*)(ws + wsl::O_counts + (0)); }
    __host__ __device__ __forceinline__ int* cursor() const { return (int*)(ws + wsl::O_cursor + (0)); }
    __host__ __device__ __forceinline__ int* bhist() const { return (int*)(ws + wsl::O_bhist + (0)); }
    __host__ __device__ __forceinline__ int* row_tok() const { return (int*)(ws + wsl::O_row_tok + (0)); }
    __host__ __device__ __forceinline__ float* row_w() const { return (float*)(ws + wsl::O_row_w + (0)); }
    __host__ __device__ __forceinline__ int* unit_e() const { return (int*)(ws + wsl::O_unit_e + (0)); }
    __host__ __device__ __forceinline__ bf16_t* qn() const { return (bf16_t*)(ws + wsl::O_qn + (0)); }
    __host__ __device__ __forceinline__ bf16_t* qr() const { return (bf16_t*)(ws + wsl::O_qr + (0)); }
    __host__ __device__ __forceinline__ bf16_t* kvraw() const { return (bf16_t*)(ws + wsl::O_kvraw + (0)); }
    __host__ __device__ __forceinline__ bf16_t* ksv() const { return (bf16_t*)(ws + wsl::O_ksv + (0)); }
    __host__ __device__ __forceinline__ bf16_t* kwv() const { return (bf16_t*)(ws + wsl::O_kwv + (0)); }
    __host__ __device__ __forceinline__ bf16_t* u() const { return (bf16_t*)(ws + wsl::O_u + (0)); }
    __host__ __device__ __forceinline__ bf16_t* v() const { return (bf16_t*)(ws + wsl::O_v + (0)); }
    __host__ __device__ __forceinline__ bf16_t* sga() const { return (bf16_t*)(ws + wsl::O_sga + (0)); }
    __host__ __device__ __forceinline__ bf16_t* sgb() const { return (bf16_t*)(ws + wsl::O_sgb + (0)); }
    __host__ __device__ __forceinline__ float* cpart() const { return (float*)(ws + wsl::O_cpart + (0)); }
    __host__ __device__ __forceinline__ bf16_t* onsa() const { return (bf16_t*)(ws + wsl::O_onsa + (0)); }
    __host__ __device__ __forceinline__ bf16_t* ogm() const { return (bf16_t*)(ws + wsl::O_ogm + (0)); }
    __host__ __device__ __forceinline__ bf16_t* merged() const { return (bf16_t*)(ws + wsl::O_merged + (0)); }
    __host__ __device__ __forceinline__ float* logits() const { return (float*)(ws + wsl::O_logits + (0)); }
    __host__ __device__ __forceinline__ bf16_t* sact() const { return (bf16_t*)(ws + wsl::O_sact + (0)); }
    __host__ __device__ __forceinline__ bf16_t* shout() const { return (bf16_t*)(ws + wsl::O_shout + (0)); }
    __host__ __device__ __forceinline__ bf16_t* act() const { return (bf16_t*)(ws + wsl::O_act + (0)); }
    __host__ __device__ __forceinline__ bf16_t* yslot() const { return (bf16_t*)(ws + wsl::O_yslot + (0)); }
    __host__ __device__ __forceinline__ bf16_t* Wt_eg() const { return (bf16_t*)(ws + wsl::O_Wt_eg + (xoff)); }
    __host__ __device__ __forceinline__ bf16_t* Wt_ed() const { return (bf16_t*)(ws + wsl::O_Wt_ed + (xoff)); }
};

__device__ __forceinline__ float bf2f(bf16_t b) { return __uint_as_float(((unsigned)b) << 16); }
__device__ __forceinline__ unsigned f2bf(float f) { unsigned u = __float_as_uint(f); return (u + 0x7fffu + ((u >> 16) & 1u)) >> 16; }
__device__ __forceinline__ unsigned pk2(float lo, float hi) { return pg8::cvt_pk_bf16(lo, hi); }
__device__ __forceinline__ float fsigmoid(float x) { return __builtin_amdgcn_rcpf(1.0f + __expf(-x)); }
__device__ __forceinline__ float fgelu(float x) { const float u2 = 1.5957691216057308f * (x + 0.044715f * x * x * x); return x * __builtin_amdgcn_rcpf(1.0f + __expf(-u2)); }
__device__ __forceinline__ float fsilu(float x) { return x * __builtin_amdgcn_rcpf(1.0f + __expf(-x)); }

struct TrItem { const float* src; bf16_t* dst; int ld, scol, nvalid, K, nd0, k0, f8; };
#define W8_SCALE 64.0f
#define H8_SCALE 8.0f
__device__ __forceinline__ unsigned pk4_e4m3(float a, float b, float c, float d) {
    int w = __builtin_amdgcn_cvt_pk_fp8_f32(__builtin_amdgcn_fmed3f(a, -240.f, 240.f), __builtin_amdgcn_fmed3f(b, -240.f, 240.f), 0, false);
    w = __builtin_amdgcn_cvt_pk_fp8_f32(__builtin_amdgcn_fmed3f(c, -240.f, 240.f), __builtin_amdgcn_fmed3f(d, -240.f, 240.f), w, true); return (unsigned)w; }
__device__ __forceinline__ void tr_load(const TrItem& it, f32x4 (&v)[16], int lane) {
    const int n4 = (lane & 7) * 4, kr = lane >> 3;
    const float* s = it.src + (size_t)(it.k0 + kr) * it.ld + it.scol + n4;
#pragma unroll
    for (int i = 0; i < 16; ++i) v[i] = (n4 < it.nvalid) ? __builtin_nontemporal_load((const f32x4*)(s + (size_t)(8 * i) * it.ld)) : (f32x4){0.f, 0.f, 0.f, 0.f};
}
#define TR_PITCH 72
typedef short tr_v4i16 __attribute__((ext_vector_type(4)));
__device__ __forceinline__ void tr_store(const TrItem& it, const f32x4 (&v)[16], LAS float* scrf, int lane) {
    LAS unsigned char* scr = (LAS unsigned char*)scrf;
    const int n4 = (lane & 7) * 4, kr = lane >> 3;
#pragma unroll
    for (int i = 0; i < 16; ++i) { const u32x2 w = {pk2(v[i].x, v[i].y), pk2(v[i].z, v[i].w)}; *(LAS u32x2*)(scr + (8 * i + kr) * TR_PITCH + n4 * 2) = w; }
    asm volatile("s_waitcnt lgkmcnt(0)" ::: "memory");
    const int n = lane & 31, hk = lane >> 5;
    const LAS unsigned char* rb = scr + ((lane & 15) >> 2) * TR_PITCH + (16 * ((lane >> 4) & 1) + 4 * (lane & 3)) * 2;
#pragma unroll
    for (int j = 0; j < 8; ++j) {
        const int cc = 2 * j + hk;
        const tr_v4i16 a = __builtin_amdgcn_ds_read_tr16_b64_v4i16((LAS tr_v4i16*)(rb + (8 * cc) * TR_PITCH)), b = __builtin_amdgcn_ds_read_tr16_b64_v4i16((LAS tr_v4i16*)(rb + (8 * cc + 4) * TR_PITCH));
        const bf16x8 o = {a[0], a[1], a[2], a[3], b[0], b[1], b[2], b[3]};
        if (it.f8) { const u32x4 ow = __builtin_bit_cast(u32x4, o);
            const u32x2 w8 = {pk4_e4m3(__uint_as_float(ow.x << 16) * W8_SCALE, __uint_as_float(ow.x & 0xffff0000u) * W8_SCALE, __uint_as_float(ow.y << 16) * W8_SCALE, __uint_as_float(ow.y & 0xffff0000u) * W8_SCALE),
                              pk4_e4m3(__uint_as_float(ow.z << 16) * W8_SCALE, __uint_as_float(ow.z & 0xffff0000u) * W8_SCALE, __uint_as_float(ow.w << 16) * W8_SCALE, __uint_as_float(ow.w & 0xffff0000u) * W8_SCALE)};
            *(u32x2*)((unsigned char*)it.dst + (size_t)(it.nd0 + n) * it.K + it.k0 + 8 * cc) = w8; }
        else *(bf16x8*)(it.dst + (size_t)(it.nd0 + n) * it.K + it.k0 + 8 * cc) = o;
    }
    asm volatile("s_waitcnt lgkmcnt(0)" ::: "memory");
}
__device__ __forceinline__ void tr_item(const float* src, int ld, int scol, int nvalid, bf16_t* dst, int K, int nd0, int k0, LAS float* scr, int lane, int f8 = 0) {
    TrItem it{src, dst, ld, scol, nvalid, K, nd0, k0, f8}; f32x4 v[16]; tr_load(it, v, lane); tr_store(it, v, scr, lane);
}
__device__ __forceinline__ int win_srccol(int nd0, int& nvalid) {
    const int pn = nd0 >> 8, q = nd0 & 255, bj = q >> 7, wc = (q & 127) >> 5; nvalid = 32;
    if (pn < 2) return ZQ + (4 * pn + wc) * 64 + 32 * bj;
    if (pn < 5) return ZKC + (pn - 2) * 256 + wc * 64 + 32 * bj;
    if (pn < 7) return ZU + (pn - 5) * 256 + q;
    if (pn < 9) return ZV + (pn - 7) * 256 + q;
    if (pn < 17) return (bj ? ZGB : ZGA) + (pn - 9) * 128 + (q & 127);
    nvalid = (q == 0) ? 24 : 0; return ZG;
}
__device__ __forceinline__ void ph_prologue(const OP& p, LAS unsigned char* lds, int bid, int nb) {
    const int tid = tid_(), lane = tid & 63, wave = tid >> 6;
    {
        LAS float* sc = (LAS float*)lds;
        LAS float* part = sc + NB * ND;
        bool have_sc = false;
        for (int job = bid; job < NL * 96 + 16; job += nb) {
            __syncthreads();
            if (job < NL * 96) {
                if (!have_sc) { for (int i = tid; i < NB * ND; i += 512) { const float cv = p.c[i]; sc[i] = cv / (1.0f + expf(-cv)); } have_sc = true; __syncthreads(); }
                const int l = job / 96, j = (job % 96) * 64 + lane;
                const float* w = p.w_mod + (size_t)l * ND * 6144 + (size_t)(wave * 128) * 6144 + j;
                float acc[NB];
#pragma unroll
                for (int b = 0; b < NB; ++b) acc[b] = 0.f;
                for (int bt = 0; bt < 4; ++bt) {
                    float wv[32];
#pragma unroll
                    for (int i = 0; i < 32; ++i) wv[i] = w[(size_t)(bt * 32 + i) * 6144];
#pragma unroll
                    for (int i = 0; i < 32; ++i)
#pragma unroll
                        for (int b = 0; b < NB; ++b) acc[b] = fmaf(sc[b * ND + wave * 128 + bt * 32 + i], wv[i], acc[b]);
                }
#pragma unroll
                for (int b = 0; b < NB; ++b) part[(wave * NB + b) * 64 + lane] = acc[b];
                __syncthreads();
                { const int b = wave; float s = p.b_mod[l * 6144 + j];
#pragma unroll
                  for (int ww = 0; ww < 8; ++ww) s += part[(ww * NB + b) * 64 + lane];
                  p.mod()[((size_t)l * NB + b) * 6144 + j] = s; }
            } else {
                const int jb = job - NL * 96, l = jb >> 3, kv = (jb >> 2) & 1, f = (jb & 3) * 64 + lane;
                const float* pe = (kv ? p.pe_v : p.pe_k) + l * 2048 + wave * 256; const float* w1 = (kv ? p.w1v : p.w1k) + (size_t)l * 2048 * 256 + (size_t)(wave * 256) * 256 + f; float a = 0.f;
                for (int bt = 0; bt < 8; ++bt) {
                    float wv[32];
#pragma unroll
                    for (int i = 0; i < 32; ++i) wv[i] = w1[(size_t)(bt * 32 + i) * 256];
#pragma unroll
                    for (int i = 0; i < 32; ++i) a = fmaf(pe[bt * 32 + i], wv[i], a);
                }
                part[wave * 64 + lane] = a;
                __syncthreads();
                if (wave == 0) { float s = 0.f;
#pragma unroll
                    for (int ww = 0; ww < 8; ++ww) s += part[ww * 64 + lane];
                    p.bias1()[(l * 2 + kv) * 256 + f] = s; }
            }
        }
        __syncthreads();
    }
    const int gt = bid * 512 + tid, ngt = nb * 512;
    for (int it = gt; it < NT * 32; it += ngt) { const int t = it >> 5, i = it & 31; const float inv = (float)pow(10000.0, -(double)i / 32.0); const float ang = (float)p.pos[t] * inv;
        float sn, cs; sincosf(ang, &sn, &cs); *(f32x2*)(p.rope() + (size_t)it * 2) = (f32x2){cs, sn}; }
    for (int it = gt; it < NL * 8 * 128 * 128; it += ngt) { const int s = it & 127, t = (it >> 7) & 127; p.wsc()[it] = (bf16_t)f2bf(s <= t ? p.gm_ws[it] : 0.f); }
    LAS float* scr = (LAS float*)lds + wave * (128 * 33);
    const int gw = bid * 8 + wave, ngw = nb * 8;
    constexpr int I_IN = (ZPAD / 32) * 8, I_P = 32 * 4, I_O = 32 * 8, I_R = 8 * 8, I_SG = 16 * 8, I_DS = 32 * 2, I_W1 = 8 * 16, I_SMALL = I_IN + 2 * I_P + I_O + I_R + I_SG + I_DS + 2 * I_W1;
    for (int it = gw; it < NL * I_SMALL; it += ngw) {
        const int l = it / I_SMALL; int r = it % I_SMALL;
        if (r < I_IN) { const int nd0 = (r >> 3) * 32, k0 = (r & 7) * 128; int nv; const int sc = win_srccol(nd0, nv); tr_item(p.w_in + (size_t)l * ND * INC, INC, sc, nv, p.Wt_in() + (size_t)l * ZPAD * ND, ND, nd0, k0, scr, lane); continue; } r -= I_IN;
        if (r < I_P) { const int nd0 = (r >> 2) * 32, k0 = (r & 3) * 128; tr_item(p.wpn + (size_t)l * 512 * ND, ND, nd0, 32, (bf16_t*)((unsigned char*)p.Wt_pn() + (size_t)l * ND * ND), ND, nd0, k0, scr, lane, 1); continue; } r -= I_P;
        if (r < I_P) { const int nd0 = (r >> 2) * 32, k0 = (r & 3) * 128; tr_item(p.wpg + (size_t)l * 512 * ND, ND, nd0, 32, (bf16_t*)((unsigned char*)p.Wt_pn() + (size_t)l * ND * ND + 512), ND, nd0, k0, scr, lane, 1); continue; } r -= I_P;
        if (r < I_O) { const int nd0 = (r >> 3) * 32, k0 = (r & 7) * 128; tr_item(p.w_out + (size_t)l * ND * ND, ND, nd0, 32, (bf16_t*)((unsigned char*)p.Wt_out() + (size_t)l * ND * ND), ND, nd0, k0, scr, lane, 1); continue; } r -= I_O;
        if (r < I_R) { const int nd0 = (r >> 3) * 32, k0 = (r & 7) * 128; tr_item(p.w_router + (size_t)l * ND * NE, NE, nd0, 32, p.Wt_rs() + (size_t)l * 768 * ND, ND, nd0, k0, scr, lane); continue; } r -= I_R;
        if (r < I_SG) { const int nd0 = (r >> 3) * 32, k0 = (r & 7) * 128; const int tile = nd0 >> 8, q = nd0 & 255;
            tr_item((q < 128 ? p.wgs : p.wus) + (size_t)l * ND * 256, 256, tile * 128 + (q & 127), 32, p.Wt_rs() + (size_t)l * 768 * ND, ND, 256 + nd0, k0, scr, lane); continue; } r -= I_SG;
        if (r < I_DS) { const int nd0 = (r >> 1) * 32, k0 = (r & 1) * 128; tr_item(p.wds + (size_t)l * 256 * ND, ND, nd0, 32, p.Wt_ds() + (size_t)l * ND * 256, 256, nd0, k0, scr, lane); continue; } r -= I_DS;
        { const int kv = r / I_W1; r %= I_W1; const int nd0 = (r >> 4) * 32, k0 = (r & 15) * 128;
          tr_item((kv ? p.w1v : p.w1k) + (size_t)l * 2048 * 256, 256, nd0, 32, p.Wt_w1() + ((size_t)l * 2 + kv) * 256 * 2048, 2048, nd0, k0, scr, lane); }
    }
    constexpr int I_E = 128 + 64;
    const int nle = (p.conv_l_hi - p.conv_l_lo) * NE;
    auto expert_item = [&](long it) {
        const int le = (int)(it / I_E), l = p.conv_l_lo + le / NE, e = le % NE; int r = (int)(it % I_E); TrItem ti;
        if (r < 128) { const int nd0 = (r >> 3) * 32, k0 = (r & 7) * 128; const int tile = nd0 >> 8, q = nd0 & 255;
            ti = TrItem{(q < 128 ? p.wge : p.wue) + ((size_t)l * NE + e) * ND * 256, (bf16_t*)((unsigned char*)p.Wt_eg() + ((size_t)l * NE + e) * 512 * ND), 256, tile * 128 + (q & 127), 32, ND, nd0, k0, 1}; }
        else { r -= 128; const int nd0 = (r >> 1) * 32, k0 = (r & 1) * 128; ti = TrItem{p.wde + ((size_t)l * NE + e) * 256 * ND, (bf16_t*)((unsigned char*)p.Wt_ed() + ((size_t)l * NE + e) * ND * 256), ND, nd0, 32, 256, nd0, k0, 1}; }
        return ti;
    };
    const long nit = (long)nle * I_E;
    if (gw < nit) {
        f32x4 va[16], vb[16];
        TrItem ia = expert_item(gw), ib = ia; tr_load(ia, va, lane);
        for (long it = gw; it < nit; it += 2 * ngw) {
            const bool hb = it + ngw < nit, ha = it + 2 * ngw < nit;
            if (hb) { ib = expert_item(it + ngw); tr_load(ib, vb, lane); }
            tr_store(ia, va, scr, lane);
            if (ha) { ia = expert_item(it + 2 * ngw); tr_load(ia, va, lane); }
            if (hb) tr_store(ib, vb, scr, lane);
        }
    }
}

__device__ __forceinline__ void ph_norm(const OP& p, const float* xin, int l, int sh_off, int sc_off, int bid, int nb) {
    const int lane = tid_() & 63, w = tid_() >> 6;
    for (int t = bid * 8 + w; t < NT; t += nb * 8) {
        const float* xr = xin + (size_t)t * ND;
        f32x4 v[4]; float ss = 0.f;
#pragma unroll
        for (int i = 0; i < 4; ++i) { v[i] = *(const f32x4*)(xr + i * 256 + lane * 4); ss += v[i].x * v[i].x + v[i].y * v[i].y + v[i].z * v[i].z + v[i].w * v[i].w; }
#pragma unroll
        for (int o = 32; o >= 1; o >>= 1) ss += __shfl_xor(ss, o);
        const float rstd = rsqrtf(ss * (1.0f / ND) + 1e-6f);
        const float* mb = p.mod() + ((size_t)l * NB + (t >> 12)) * 6144;
#pragma unroll
        for (int i = 0; i < 4; ++i) {
            const int cidx = i * 256 + lane * 4;
            const f32x4 sc = *(const f32x4*)(mb + sc_off + cidx), sh = *(const f32x4*)(mb + sh_off + cidx);
            u32x2 o; o.x = pk2(v[i].x * rstd * (1.f + sc.x) + sh.x, v[i].y * rstd * (1.f + sc.y) + sh.y); o.y = pk2(v[i].z * rstd * (1.f + sc.z) + sh.z, v[i].w * rstd * (1.f + sc.w) + sh.w);
            *(u32x2*)(p.h() + (size_t)t * ND + cidx) = o;
        }
    }
}

__device__ __forceinline__ void ph_norm_b(const OP& p, const bf16_t* xin, int l, int sh_off, int sc_off, int bid, int nb, unsigned char* h8) {
    const int lane = tid_() & 63, w = tid_() >> 6;
    for (int t = bid * 8 + w; t < NT; t += nb * 8) {
        float v[2][8]; float ss = 0.f;
#pragma unroll
        for (int i = 0; i < 2; ++i) { const u32x4 r = *(const u32x4*)(xin + (size_t)t * ND + i * 512 + lane * 8); const unsigned rw[4] = {r.x, r.y, r.z, r.w};
#pragma unroll
            for (int k = 0; k < 4; ++k) { v[i][2 * k] = __uint_as_float(rw[k] << 16); v[i][2 * k + 1] = __uint_as_float(rw[k] & 0xffff0000u); ss += v[i][2 * k] * v[i][2 * k] + v[i][2 * k + 1] * v[i][2 * k + 1]; } }
#pragma unroll
        for (int o = 32; o >= 1; o >>= 1) ss += __shfl_xor(ss, o);
        const float rstd = rsqrtf(ss * (1.0f / ND) + 1e-6f);
        const float* mb = p.mod() + ((size_t)l * NB + (t >> 12)) * 6144;
#pragma unroll
        for (int i = 0; i < 2; ++i) {
            const int cidx = i * 512 + lane * 8;
            const f32x4 sc0 = *(const f32x4*)(mb + sc_off + cidx), sc1 = *(const f32x4*)(mb + sc_off + cidx + 4), sh0 = *(const f32x4*)(mb + sh_off + cidx), sh1 = *(const f32x4*)(mb + sh_off + cidx + 4);
            u32x4 o; o.x = pk2(v[i][0] * rstd * (1.f + sc0.x) + sh0.x, v[i][1] * rstd * (1.f + sc0.y) + sh0.y); o.y = pk2(v[i][2] * rstd * (1.f + sc0.z) + sh0.z, v[i][3] * rstd * (1.f + sc0.w) + sh0.w);
            o.z = pk2(v[i][4] * rstd * (1.f + sc1.x) + sh1.x, v[i][5] * rstd * (1.f + sc1.y) + sh1.y); o.w = pk2(v[i][6] * rstd * (1.f + sc1.z) + sh1.z, v[i][7] * rstd * (1.f + sc1.w) + sh1.w);
            *(u32x4*)(p.h() + (size_t)t * ND + cidx) = o;
            if (h8) {
                const u32x2 w8 = {pk4_e4m3((v[i][0] * rstd * (1.f + sc0.x) + sh0.x) * H8_SCALE, (v[i][1] * rstd * (1.f + sc0.y) + sh0.y) * H8_SCALE, (v[i][2] * rstd * (1.f + sc0.z) + sh0.z) * H8_SCALE, (v[i][3] * rstd * (1.f + sc0.w) + sh0.w) * H8_SCALE),
                                  pk4_e4m3((v[i][4] * rstd * (1.f + sc1.x) + sh1.x) * H8_SCALE, (v[i][5] * rstd * (1.f + sc1.y) + sh1.y) * H8_SCALE, (v[i][6] * rstd * (1.f + sc1.z) + sh1.z) * H8_SCALE, (v[i][7] * rstd * (1.f + sc1.w) + sh1.w) * H8_SCALE)};
                *(u32x2*)(h8 + (size_t)t * ND + cidx) = w8; }
        }
    }
}

#define LDS_GAIN (LDS_MISC + 256)
struct EpiZ {
    static constexpr bool PERM = true;
    const OP* pp; LAS unsigned char* lds;
    __device__ __forceinline__ void operator()(const f32x4 (&acc)[2][2][4][2], const pg8::Unit& u, int wr, int wc, int fr, int fq) const {
        const OP& p = *pp; const int pn = u.pn;
        const int row0 = u.pm * 256 + wr * 64 + fr;
        if (pn < 5) {
            const bool normed = (pn < 2) || (pn >= 3 && wc < 2);
            bf16_t* dst; int ldd, cbase;
            if (pn < 2) { dst = p.qn(); ldd = 512; cbase = (4 * pn + wc) * 64; }
            else if (pn == 2) { dst = p.kvraw(); ldd = 256; cbase = wc * 64; }
            else if (pn == 3) { dst = p.ksv(); ldd = 256; cbase = wc * 64; }
            else { dst = p.kwv(); ldd = 256; cbase = wc * 64; }
            const LAS float* gain = (const LAS float*)(lds + LDS_GAIN) + (pn < 2 ? 0 : 64);
            const float osc = (pn < 2) ? 0.125f * 1.4426950408889634f : 1.0f;
            f32x4 g0[2], g1[2];
#pragma unroll
            for (int n = 0; n < 2; ++n) { g0[n] = *(const LAS f32x4*)(gain + 8 * fq + 4 * n); g1[n] = *(const LAS f32x4*)(gain + 32 + 8 * fq + 4 * n); }
#pragma unroll
            for (int ai = 0; ai < 2; ++ai)
#pragma unroll
                for (int m = 0; m < 4; ++m) {
                    const int row = row0 + ai * 128 + m * 16;
                    f32x4 y0[2], y1[2];
#pragma unroll
                    for (int n = 0; n < 2; ++n) { y0[n] = acc[ai][0][m][n]; y1[n] = acc[ai][1][m][n]; }
                    float ss = 0.f;
#pragma unroll
                    for (int n = 0; n < 2; ++n) { ss += y0[n].x * y0[n].x + y0[n].y * y0[n].y + y0[n].z * y0[n].z + y0[n].w * y0[n].w; ss += y1[n].x * y1[n].x + y1[n].y * y1[n].y + y1[n].z * y1[n].z + y1[n].w * y1[n].w; }
                    ss += __shfl_xor(ss, 16); ss += __shfl_xor(ss, 32);
                    const float rs = rsqrtf(ss * (1.0f / 64.f) + 1e-6f) * osc;
#pragma unroll
                    for (int n = 0; n < 2; ++n) { y0[n] = normed ? y0[n] * rs * g0[n] : y0[n]; y1[n] = normed ? y1[n] * rs * g1[n] : y1[n]; }
                    u32x4 w0, w1; w0.x = pk2(y0[0].x, y0[0].y); w0.y = pk2(y0[0].z, y0[0].w); w0.z = pk2(y0[1].x, y0[1].y); w0.w = pk2(y0[1].z, y0[1].w);
                    w1.x = pk2(y1[0].x, y1[0].y); w1.y = pk2(y1[0].z, y1[0].w); w1.z = pk2(y1[1].x, y1[1].y); w1.w = pk2(y1[1].z, y1[1].w);
                    *(u32x4*)(dst + (size_t)row * ldd + cbase + 8 * fq) = w0; *(u32x4*)(dst + (size_t)row * ldd + cbase + 32 + 8 * fq) = w1;
                }
        } else if (pn >= 9 && pn < 17) {
            const int col0 = (pn - 9) * 128 + wc * 32 + 8 * fq;
            bf16_t* da = p.sga(); bf16_t* db = p.sgb();
#pragma unroll
            for (int ai = 0; ai < 2; ++ai)
#pragma unroll
                for (int m = 0; m < 4; ++m) {
                    const size_t ro = (size_t)(row0 + ai * 128 + m * 16) * 1024 + col0;
                    float ra[8], sb[8];
#pragma unroll
                    for (int n = 0; n < 2; ++n) { const f32x4 ga = acc[ai][0][m][n], gb = acc[ai][1][m][n];
                        const float gav[4] = {ga.x, ga.y, ga.z, ga.w}, gbv[4] = {gb.x, gb.y, gb.z, gb.w};
#pragma unroll
                        for (int k = 0; k < 4; ++k) { const float ea = __expf(-gav[k]), eb = fminf(__expf(-gbv[k]), 1e20f); const float dbv = 1.0f + eb;
                            ra[4 * n + k] = dbv * __builtin_amdgcn_rcpf(1.0f + ea); sb[4 * n + k] = __builtin_amdgcn_rcpf(dbv); } }
                    *(u32x2*)((unsigned char*)da + ro) = (u32x2){pk4_e4m3(ra[0], ra[1], ra[2], ra[3]), pk4_e4m3(ra[4], ra[5], ra[6], ra[7])};
                    *(u32x2*)((unsigned char*)db + ro) = (u32x2){pk4_e4m3(sb[0], sb[1], sb[2], sb[3]), pk4_e4m3(sb[4], sb[5], sb[6], sb[7])};
                }
        } else if (pn < 17) {
            bf16_t* dst; int ldd, ct; const bool is_gelu = pn < 9;
            if (pn < 7) { dst = p.u(); ldd = 512; ct = (pn - 5) * 256; } else { dst = p.v(); ldd = 512; ct = (pn - 7) * 256; }
            const int col0 = ct + wc * 32 + 8 * fq;
#pragma unroll
            for (int ai = 0; ai < 2; ++ai)
#pragma unroll
                for (int m = 0; m < 4; ++m) {
                    bf16_t* rowp = dst + (size_t)(row0 + ai * 128 + m * 16) * ldd + col0;
#pragma unroll
                    for (int bj = 0; bj < 2; ++bj) {
                        f32x4 v0 = acc[ai][bj][m][0], v1 = acc[ai][bj][m][1];
                        f32x4 a0, a1, m0, m1;
                        if (is_gelu) { a0 = 1.5957691216057308f * (v0 + 0.044715f * v0 * v0 * v0); a1 = 1.5957691216057308f * (v1 + 0.044715f * v1 * v1 * v1); m0 = v0; m1 = v1; }
                        else { a0 = v0; a1 = v1; m0 = (f32x4){1.f, 1.f, 1.f, 1.f}; m1 = m0; }
                        v0 = (f32x4){m0.x * fsigmoid(a0.x), m0.y * fsigmoid(a0.y), m0.z * fsigmoid(a0.z), m0.w * fsigmoid(a0.w)};
                        v1 = (f32x4){m1.x * fsigmoid(a1.x), m1.y * fsigmoid(a1.y), m1.z * fsigmoid(a1.z), m1.w * fsigmoid(a1.w)};
                        u32x4 w; w.x = pk2(v0.x, v0.y); w.y = pk2(v0.z, v0.w); w.z = pk2(v1.x, v1.y); w.w = pk2(v1.z, v1.w);
                        *(u32x4*)(rowp + bj * 128) = w;
                    }
                }
        } else {
            if (wc == 0) {
#pragma unroll
                for (int ai = 0; ai < 2; ++ai)
#pragma unroll
                    for (int m = 0; m < 4; ++m) {
                        float* rowp = p.gates() + (size_t)(row0 + ai * 128 + m * 16) * 32 + 8 * fq;
                        const f32x4 v0 = acc[ai][0][m][0], v1 = acc[ai][0][m][1];
                        *(f32x4*)(rowp) = (f32x4){fsigmoid(v0.x), fsigmoid(v0.y), fsigmoid(v0.z), fsigmoid(v0.w)};
                        *(f32x4*)(rowp + 4) = (f32x4){fsigmoid(v1.x), fsigmoid(v1.y), fsigmoid(v1.z), fsigmoid(v1.w)};
                    }
            }
        }
    }
};

struct RopeIt { const bf16_t* src; bf16_t* dst; const float* rp; int j; };
__device__ __forceinline__ void rope_addr(const OP& p, long it, RopeIt& r) {
    const int j = (int)(it & 3); const long hvi = it >> 2; const int t = (int)(hvi / 12), hv = (int)(hvi % 12);
    if (hv < 8) { r.src = p.qn() + (size_t)t * 512 + hv * 64; r.dst = p.qr() + (size_t)t * 512 + hv * 64; }
    else if (hv < 10) { r.src = p.ksv() + (size_t)t * 256 + (hv - 8) * 64; r.dst = (bf16_t*)r.src; }
    else { r.src = p.kwv() + (size_t)t * 256 + (hv - 10) * 64; r.dst = (bf16_t*)r.src; }
    r.rp = p.rope() + ((size_t)t * 32 + 8 * j) * 2; r.j = j;
}
__device__ __forceinline__ void rope_apply(const RopeIt& r, const u32x4 a, const u32x4 b, const f32x4 c0, const f32x4 c1, const f32x4 c2, const f32x4 c3) {
    const float cs[8] = {c0.x, c0.z, c1.x, c1.z, c2.x, c2.z, c3.x, c3.z}, sn[8] = {c0.y, c0.w, c1.y, c1.w, c2.y, c2.w, c3.y, c3.w};
    const unsigned aw[4] = {a.x, a.y, a.z, a.w}, bw[4] = {b.x, b.y, b.z, b.w};
    unsigned oa[4], ob[4];
#pragma unroll
    for (int k = 0; k < 4; ++k) {
        const float x1l = __uint_as_float(aw[k] << 16), x1h = __uint_as_float(aw[k] & 0xffff0000u), x2l = __uint_as_float(bw[k] << 16), x2h = __uint_as_float(bw[k] & 0xffff0000u);
        oa[k] = pk2(x1l * cs[2 * k] - x2l * sn[2 * k], x1h * cs[2 * k + 1] - x2h * sn[2 * k + 1]);
        ob[k] = pk2(x2l * cs[2 * k] + x1l * sn[2 * k], x2h * cs[2 * k + 1] + x1h * sn[2 * k + 1]);
    }
    *(u32x4*)(r.dst + 8 * r.j) = (u32x4){oa[0], oa[1], oa[2], oa[3]}; *(u32x4*)(r.dst + 32 + 8 * r.j) = (u32x4){ob[0], ob[1], ob[2], ob[3]};
}
__device__ __forceinline__ void ph_rope(const OP& p, int bid, int nb) {
    const long nitems = (long)NT * 12 * 4, stride = (long)nb * 512;
    long it = (long)bid * 512 + tid_();
    for (; it + 3 * stride < nitems; it += 4 * stride) {
        RopeIt r[4]; u32x4 a[4], b[4]; f32x4 c[4][4];
#pragma unroll
        for (int u = 0; u < 4; ++u) { rope_addr(p, it + u * stride, r[u]); a[u] = *(const u32x4*)(r[u].src + 8 * r[u].j); b[u] = *(const u32x4*)(r[u].src + 32 + 8 * r[u].j);
#pragma unroll
            for (int k = 0; k < 4; ++k) c[u][k] = *(const f32x4*)(r[u].rp + 4 * k); }
#pragma unroll
        for (int u = 0; u < 4; ++u) rope_apply(r[u], a[u], b[u], c[u][0], c[u][1], c[u][2], c[u][3]);
    }
    for (; it < nitems; it += stride) {
        RopeIt r; rope_addr(p, it, r);
        const u32x4 a = *(const u32x4*)(r.src + 8 * r.j), b = *(const u32x4*)(r.src + 32 + 8 * r.j);
        const f32x4 c0 = *(const f32x4*)(r.rp), c1 = *(const f32x4*)(r.rp + 4), c2 = *(const f32x4*)(r.rp + 8), c3 = *(const f32x4*)(r.rp + 12);
        rope_apply(r, a, b, c0, c1, c2, c3);
    }
}
struct CmpSched {
    const char* kvraw; const char* w1; int K, kstepA, ldb; int G, c;
    __device__ __forceinline__ bool next(int i, pg8::Unit& u) const { const int L = i * G + c; if (L >= 128) return false; u.e = L; u.pm = L & 15; u.pn = 0; return true; }
    __device__ __forceinline__ const char* a_base() const { return kvraw; }
    __device__ __forceinline__ const char* b_base() const { return w1; }
    __device__ __forceinline__ const char* a_ptr(const pg8::Unit& u) const { return kvraw; }
    __device__ __forceinline__ void a_off(const pg8::Unit& u, int tid, unsigned (&off)[2][2]) const {
        const int kv = u.e >> 6, s = (u.e >> 4) & 3;
#pragma unroll
        for (int i = 0; i < 2; ++i) { int R, C; pg8::stage_rc(tid * 16 + i * 8192, R, C);
#pragma unroll
            for (int h = 0; h < 2; ++h) { int r = u.pm * 256 + h * 128 + R; r = r < 4080 ? r : 4079; const int b = r / 510, rem = r - b * 510, n = rem >> 1, hh = rem & 1;
                off[h][i] = (unsigned)(((b * NS + 16 * n + 8 * s) * 256 + kv * 128 + hh * 64 + C) * 2); } }
    }
    __device__ __forceinline__ const char* b_ptr(const pg8::Unit& u) const { const int kv = u.e >> 6, s = (u.e >> 4) & 3; return w1 + ((size_t)kv * 256 * 2048 + s * 512) * 2; }
};
struct EpiCmp {
    static constexpr bool PERM = false;
    float* cpart;
    __device__ __forceinline__ void operator()(const f32x4 (&acc)[2][2][4][2], const pg8::Unit& u, int wr, int wc, int fr, int fq) const {
        float* base = cpart + (size_t)(u.e >> 4) * 4096 * 256;
        const int row0 = u.pm * 256 + wr * 64 + fr, col0 = wc * 32 + 4 * fq;
#pragma unroll
        for (int ai = 0; ai < 2; ++ai)
#pragma unroll
            for (int m = 0; m < 4; ++m) { float* rowp = base + (size_t)(row0 + ai * 128 + m * 16) * 256 + col0;
#pragma unroll
                for (int bj = 0; bj < 2; ++bj)
#pragma unroll
                    for (int n = 0; n < 2; ++n) *(f32x4*)(rowp + bj * 128 + n * 16) = acc[ai][bj][m][n]; }
    }
};
__device__ __forceinline__ void ph_cmp2(const OP& p, int l, LAS unsigned char* lds, int bid, int nb) {
    const int tid = tid_(), lane = tid & 63, wave = tid >> 6;
    LAS float* w2s = (LAS float*)lds;
    LAS float* hid = w2s + 256 * 64 + wave * 256;
    int kv_loaded = -1;
    for (int it0 = bid * 8; it0 < 2 * 4096; it0 += nb * 8) {
        const int it = it0 + wave, kv = it0 >> 12, r = it & 4095;
        if (kv != kv_loaded) { __syncthreads(); const float* w2 = (kv ? p.w2v : p.w2k) + (size_t)l * 256 * 64;
            for (int i = tid; i < 256 * 64 / 4; i += 512) *(LAS f32x4*)(w2s + i * 4) = *(const f32x4*)(w2 + i * 4);
            kv_loaded = kv; __syncthreads(); }
        bf16_t* dstbase = kv ? p.vc() : p.kc();
        if (r >= 4080) { if (r < 4088) { const int b = r - 4080; dstbase[((size_t)b * 256 + 255) * 128 + lane] = 0; dstbase[((size_t)b * 256 + 255) * 128 + 64 + lane] = 0; } continue; }
        const float* cp = p.cpart() + ((size_t)kv * 4 * 4096 + r) * 256 + lane * 4;
        f32x4 a = *(const f32x4*)(p.bias1() + (l * 2 + kv) * 256 + lane * 4);
        { f32x4 pv[4];
#pragma unroll
          for (int s = 0; s < 4; ++s) pv[s] = *(const f32x4*)(cp + (size_t)s * 4096 * 256);
#pragma unroll
          for (int s = 0; s < 4; ++s) a += pv[s]; }
        asm volatile("s_waitcnt lgkmcnt(0)" ::: "memory");
        *(LAS f32x4*)(hid + lane * 4) = (f32x4){fgelu(a.x), fgelu(a.y), fgelu(a.z), fgelu(a.w)};
        asm volatile("s_waitcnt lgkmcnt(0)" ::: "memory");
        float o = 0.f;
#pragma unroll 16
        for (int f = 0; f < 256; ++f) o = fmaf(hid[f], w2s[f * 64 + lane], o);
        const int b = r / 510, rem = r - b * 510, n = rem >> 1, hh = rem & 1;
        if (!kv) { float ss = o * o;
#pragma unroll
            for (int x = 32; x >= 1; x >>= 1) ss += __shfl_xor(ss, x);
            o = o * rsqrtf(ss * (1.f / 64.f) + 1e-6f) * p.k_gain[l * 64 + lane]; }
        dstbase[((size_t)b * 256 + n) * 128 + hh * 64 + lane] = (bf16_t)f2bf(o);
    }
    __syncthreads();
}

#define GM_PITCH 520
typedef short v4i16_t __attribute__((ext_vector_type(4)));
__device__ __forceinline__ s16x4 ds_tr16(const LAS bf16_t* ptr) { return __builtin_bit_cast(s16x4, __builtin_amdgcn_ds_read_tr16_b64_v4i16((LAS v4i16_t*)ptr)); }
__device__ __forceinline__ void ph_gmlp(const OP& p, int l, LAS unsigned char* lds, int bid, int nb) {
    const int tid = tid_(), lane = tid & 63, wave = tid >> 6;
    LAS bf16_t* vn = (LAS bf16_t*)lds;
    for (int ch = bid; ch < NT / 128; ch += nb) {
        const size_t base = (size_t)ch * 128;
        __syncthreads();
        f32x4 g0 = *(const f32x4*)(p.ln_g + l * 512 + lane * 8), g1 = *(const f32x4*)(p.ln_g + l * 512 + lane * 8 + 4), b0 = *(const f32x4*)(p.ln_b + l * 512 + lane * 8), b1 = *(const f32x4*)(p.ln_b + l * 512 + lane * 8 + 4);
#pragma unroll 4
        for (int tt = 0; tt < 16; ++tt) {
            const int t = wave * 16 + tt;
            const u32x4 raw = *(const u32x4*)(p.v() + (base + t) * 512 + lane * 8);
            float x[8] = {__uint_as_float(raw.x << 16), __uint_as_float(raw.x & 0xffff0000u), __uint_as_float(raw.y << 16), __uint_as_float(raw.y & 0xffff0000u),
                          __uint_as_float(raw.z << 16), __uint_as_float(raw.z & 0xffff0000u), __uint_as_float(raw.w << 16), __uint_as_float(raw.w & 0xffff0000u)};
            float s = 0.f;
#pragma unroll
            for (int i = 0; i < 8; ++i) s += x[i];
#pragma unroll
            for (int o = 32; o >= 1; o >>= 1) s += __shfl_xor(s, o);
            const float mu = s * (1.f / 512.f); float q = 0.f;
#pragma unroll
            for (int i = 0; i < 8; ++i) { x[i] -= mu; q += x[i] * x[i]; }
#pragma unroll
            for (int o = 32; o >= 1; o >>= 1) q += __shfl_xor(q, o);
            const float rstd = rsqrtf(q * (1.f / 512.f) + 1e-6f);
            u32x4 w; w.x = pk2(x[0] * rstd * g0.x + b0.x, x[1] * rstd * g0.y + b0.y); w.y = pk2(x[2] * rstd * g0.z + b0.z, x[3] * rstd * g0.w + b0.w);
            w.z = pk2(x[4] * rstd * g1.x + b1.x, x[5] * rstd * g1.y + b1.y); w.w = pk2(x[6] * rstd * g1.z + b1.z, x[7] * rstd * g1.w + b1.w);
            *(LAS u32x4*)(vn + t * GM_PITCH + lane * 8) = w;
        }
        __syncthreads();
        const int g = wave, r32 = lane & 31, hi = lane >> 5;
        const bf16_t* wsg = p.wsc() + ((size_t)l * 8 + g) * 128 * 128;
        const LAS bf16_t* bbase = vn + (8 * hi + ((lane & 15) >> 2)) * GM_PITCH + g * 64 + 16 * ((lane >> 4) & 1) + 4 * (lane & 3);
        const float* bsg = p.gm_bs + (l * 8 + g) * 128;
#pragma unroll
        for (int mt = 3; mt >= 0; --mt) {
            bf16x8 af[8];
#pragma unroll
            for (int ks = 0; ks < 2 * (mt + 1); ++ks) af[ks] = *(const bf16x8*)(wsg + (size_t)(32 * mt + r32) * 128 + 16 * ks + 8 * hi);
            float bsv[16];
#pragma unroll
            for (int rg = 0; rg < 16; ++rg) bsv[rg] = bsg[32 * mt + (rg & 3) + 8 * (rg >> 2) + 4 * hi];
            f32x16 acc0, acc1;
#pragma unroll
            for (int i = 0; i < 16; ++i) { acc0[i] = 0.f; acc1[i] = 0.f; }
#pragma unroll
            for (int ks = 0; ks < 2 * (mt + 1); ++ks) {
                const LAS bf16_t* bp = bbase + 16 * ks * GM_PITCH;
                const s16x4 b00 = ds_tr16(bp), b01 = ds_tr16(bp + 4 * GM_PITCH), b10 = ds_tr16(bp + 32), b11 = ds_tr16(bp + 4 * GM_PITCH + 32);
                const bf16x8 bf0 = {b00[0], b00[1], b00[2], b00[3], b01[0], b01[1], b01[2], b01[3]}, bf1 = {b10[0], b10[1], b10[2], b10[3], b11[0], b11[1], b11[2], b11[3]};
                acc0 = __builtin_amdgcn_mfma_f32_32x32x16_bf16(af[ks], bf0, acc0, 0, 0, 0);
                acc1 = __builtin_amdgcn_mfma_f32_32x32x16_bf16(af[ks], bf1, acc1, 0, 0, 0);
            }
#pragma unroll
            for (int rg = 0; rg < 16; ++rg) {
                const int t = 32 * mt + (rg & 3) + 8 * (rg >> 2) + 4 * hi;
                vn[t * GM_PITCH + g * 64 + r32] = (bf16_t)f2bf(acc0[rg] + bsv[rg]); vn[t * GM_PITCH + g * 64 + 32 + r32] = (bf16_t)f2bf(acc1[rg] + bsv[rg]);
            }
        }
        asm volatile("s_waitcnt lgkmcnt(0)" ::: "memory");
        for (int i0 = 0; i0 < 16; i0 += 4) {
            u32x4 uv4[4];
#pragma unroll
            for (int ii = 0; ii < 4; ++ii) { const int t = 8 * (i0 + ii) + (lane >> 3), c8 = (lane & 7) * 8; uv4[ii] = *(const u32x4*)(p.u() + (base + t) * 512 + g * 64 + c8); }
#pragma unroll
            for (int ii = 0; ii < 4; ++ii) {
                const int t = 8 * (i0 + ii) + (lane >> 3), c8 = (lane & 7) * 8;
                const u32x4 mv = *(const LAS u32x4*)(vn + t * GM_PITCH + g * 64 + c8);
                const u32x4 uv = uv4[ii];
                const unsigned mw[4] = {mv.x, mv.y, mv.z, mv.w}, uw[4] = {uv.x, uv.y, uv.z, uv.w}; unsigned ow[4];
                float of[8];
#pragma unroll
                for (int k = 0; k < 4; ++k) { of[2 * k] = __uint_as_float(mw[k] << 16) * __uint_as_float(uw[k] << 16) * H8_SCALE; of[2 * k + 1] = __uint_as_float(mw[k] & 0xffff0000u) * __uint_as_float(uw[k] & 0xffff0000u) * H8_SCALE; }
                (void)ow;
                *(u32x2*)((unsigned char*)p.onsa() + (base + t) * 1024 + 512 + g * 64 + c8) = (u32x2){pk4_e4m3(of[0], of[1], of[2], of[3]), pk4_e4m3(of[4], of[5], of[6], of[7])};
            }
        }
    }
    __syncthreads();
}
#define AT_PITCH 144
#define AT_TILE (64 * AT_PITCH)
#define AT_IMP (4 * AT_TILE)
#define AT_SELM (AT_IMP + 64 * 65 * 4)
#define AT_OST (AT_SELM + 1024)
#define AT_OPITCH 272
#define AT_LOG2E 1.4426950408889634f
#define LDS_ADD(ptr, val) (void)__hip_atomic_fetch_add((ptr), (val), __ATOMIC_RELAXED, __HIP_MEMORY_SCOPE_WORKGROUP)
__device__ __forceinline__ float xhalf_max(float v) { const auto r = __builtin_amdgcn_permlane32_swap(__float_as_uint(v), __float_as_uint(v), false, false); return fmaxf(__uint_as_float(r[0]), __uint_as_float(r[1])); }
__device__ __forceinline__ float xhalf_sum(float v) { const auto r = __builtin_amdgcn_permlane32_swap(__float_as_uint(v), __float_as_uint(v), false, false); return __uint_as_float(r[0]) + __uint_as_float(r[1]); }
__device__ __forceinline__ float max3f(float a, float b, float c) { float r; asm("v_max3_f32 %0, %1, %2, %3" : "=v"(r) : "v"(a), "v"(b), "v"(c)); return r; }
enum { AM_CMP1 = 0, AM_CMP2 = 1, AM_SEL = 2, AM_WIN = 3 };

struct AttnWave {
    f32x16 o0, o1;
    f32x16 ls;
    float M, L;
};

template <int MODE, bool FIXM>
__device__ __forceinline__ void attn_tile(AttnWave& W, const bf16x8 (&qt)[4], const LAS unsigned char* Kl, const LAS unsigned char* Vl, int lane, int r32, int hi,
                                          int lim, bool diag, bool ledge, bool lanesel, float invl, LAS unsigned* imp_row, int jbase) {
    f32x16 s0, s1;
    const float sinit = 0.f;
    const unsigned lmask = (FIXM && MODE == AM_SEL && !lanesel) ? 0u : 0xffffffffu;
#pragma unroll
    for (int i = 0; i < 16; ++i) { s0[i] = sinit; s1[i] = sinit; }
    bf16x8 ka[2][4];
#pragma unroll
    for (int ks = 0; ks < 4; ++ks) { ka[0][ks] = *(const LAS bf16x8*)(Kl + r32 * AT_PITCH + (16 * ks + 8 * hi) * 2); ka[1][ks] = *(const LAS bf16x8*)(Kl + (32 + r32) * AT_PITCH + (16 * ks + 8 * hi) * 2); }
    __builtin_amdgcn_s_setprio(1);
#pragma unroll
    for (int ks = 0; ks < 4; ++ks) { s0 = __builtin_amdgcn_mfma_f32_32x32x16_bf16(ka[0][ks], qt[ks], s0, 0, 0, 0); s1 = __builtin_amdgcn_mfma_f32_32x32x16_bf16(ka[1][ks], qt[ks], s1, 0, 0, 0); }
    __builtin_amdgcn_s_setprio(0);
    s16x4 va[2][2][2][2];
    if (MODE != AM_CMP1) {
        const LAS unsigned char* vb = Vl + ((lane & 15) >> 2) * AT_PITCH + (16 * ((lane >> 4) & 1) + 4 * (lane & 3)) * 2 + (4 * hi) * AT_PITCH;
#pragma unroll
        for (int mt = 0; mt < 2; ++mt)
#pragma unroll
            for (int s = 0; s < 2; ++s) { const LAS unsigned char* vk = vb + (32 * mt + 16 * s) * AT_PITCH;
                va[mt][s][0][0] = ds_tr16((const LAS bf16_t*)(vk)); va[mt][s][0][1] = ds_tr16((const LAS bf16_t*)(vk + 8 * AT_PITCH));
                va[mt][s][1][0] = ds_tr16((const LAS bf16_t*)(vk + 64)); va[mt][s][1][1] = ds_tr16((const LAS bf16_t*)(vk + 8 * AT_PITCH + 64)); }
    }
    const float NEG = -INFINITY;
    if (MODE == AM_CMP1 || MODE == AM_CMP2) {
#pragma unroll
        for (int r = 0; r < 16; ++r) { const int k0 = (r & 3) + 8 * (r >> 2) + 4 * hi; s0[r] = (k0 < lim) ? s0[r] : NEG; s1[r] = (32 + k0 < lim) ? s1[r] : NEG; }
    } else {
        if (diag) {
#pragma unroll
            for (int r = 0; r < 16; ++r) { const int k0 = (r & 3) + 8 * (r >> 2) + 4 * hi; s0[r] = (k0 <= lim) ? s0[r] : NEG; s1[r] = (32 + k0 <= lim) ? s1[r] : NEG; }
        }
        if (MODE == AM_WIN && ledge) {
#pragma unroll
            for (int r = 0; r < 16; ++r) { const int k0 = (r & 3) + 8 * (r >> 2) + 4 * hi; s0[r] = (k0 > lim) ? s0[r] : NEG; s1[r] = (32 + k0 > lim) ? s1[r] : NEG; }
        }
    }
    float Mn = W.M;
    if (MODE != AM_CMP2 && !FIXM) {
        float mx = max3f(s0[0], s1[0], s0[1]);
#pragma unroll
        for (int r = 1; r < 15; ++r) mx = max3f(mx, s1[r], s0[r + 1]);
        mx = max3f(mx, s1[15], s1[15]);
        mx = xhalf_max(mx);
        if (MODE == AM_SEL) mx = lanesel ? mx : NEG;
        Mn = fmaxf(W.M, mx);
    }
    const float Msub = (MODE == AM_SEL && !lanesel) ? INFINITY : Mn;
    float ps = 0.f;
    if (FIXM) {
        if (MODE == AM_SEL || MODE == AM_WIN) {
#pragma unroll
            for (int r = 0; r < 16; ++r) { s0[r] = __builtin_amdgcn_exp2f(s0[r]); s1[r] = __builtin_amdgcn_exp2f(s1[r]); }
        } else {
#pragma unroll
            for (int r = 0; r < 16; ++r) { s0[r] = __builtin_amdgcn_exp2f(s0[r]); s1[r] = __builtin_amdgcn_exp2f(s1[r]); ps += s0[r] + s1[r]; }
        }
    } else {
#pragma unroll
        for (int r = 0; r < 16; ++r) { s0[r] = __builtin_amdgcn_exp2f(s0[r] - Msub); s1[r] = __builtin_amdgcn_exp2f(s1[r] - Msub); ps += s0[r] + s1[r]; }
    }
    if (MODE == AM_CMP1) {
        ps = xhalf_sum(ps);
        if (FIXM) { W.L += ps; return; }
        const float alpha = __builtin_amdgcn_exp2f(W.M - Mn);
        W.L = W.L * alpha + ps; W.M = Mn;
        return;
    }
    if (MODE == AM_CMP2) {
#pragma unroll
        for (int r = 0; r < 16; ++r) { s0[r] *= invl; s1[r] *= invl; }
#pragma unroll
        for (int i = 0; i < 4; ++i) {
            const float q0 = (s0[4 * i] + s0[4 * i + 1]) + (s0[4 * i + 2] + s0[4 * i + 3]), q1 = (s1[4 * i] + s1[4 * i + 1]) + (s1[4 * i + 2] + s1[4 * i + 3]);
            const int j0 = jbase + 2 * i + hi, j1 = j0 + 8;
            LDS_ADD(imp_row + j0, (unsigned)(q0 * 268435456.f + 0.5f)); LDS_ADD(imp_row + j1, (unsigned)(q1 * 268435456.f + 0.5f));
            LDS_ADD(imp_row + j0 + 1, (unsigned)(s0[4 * i + 3] * 268435456.f + 0.5f)); if (j1 + 1 < 64) LDS_ADD(imp_row + j1 + 1, (unsigned)(s1[4 * i + 3] * 268435456.f + 0.5f));
        }
    } else {
        if (!(FIXM && (MODE == AM_SEL || MODE == AM_WIN))) ps = xhalf_sum(ps);
        if (!FIXM && __builtin_amdgcn_ballot_w64(Mn != W.M) != 0ull) {
            const float alpha = __builtin_amdgcn_exp2f(W.M - Mn);
            W.L *= alpha;
#pragma unroll
            for (int r = 0; r < 16; ++r) { W.o0[r] *= alpha; W.o1[r] *= alpha; }
            W.M = Mn;
        }
        W.L += ps;
    }
    __builtin_amdgcn_s_setprio(1);
#pragma unroll
    for (int mt = 0; mt < 2; ++mt)
#pragma unroll
        for (int s = 0; s < 2; ++s) {
            const f32x16& sv = mt ? s1 : s0;
            bf16x8 pb;
            { unsigned w0 = pk2(sv[8 * s + 0], sv[8 * s + 1]), w1 = pk2(sv[8 * s + 2], sv[8 * s + 3]), w2 = pk2(sv[8 * s + 4], sv[8 * s + 5]), w3 = pk2(sv[8 * s + 6], sv[8 * s + 7]);
              if (FIXM && MODE == AM_SEL) { w0 &= lmask; w1 &= lmask; w2 &= lmask; w3 &= lmask; }
              const u32x4 wv = {w0, w1, w2, w3}; pb = __builtin_bit_cast(bf16x8, wv); }
            const s16x4 a00 = va[mt][s][0][0], a01 = va[mt][s][0][1], a10 = va[mt][s][1][0], a11 = va[mt][s][1][1];
            const bf16x8 av0 = {a00[0], a00[1], a00[2], a00[3], a01[0], a01[1], a01[2], a01[3]}, av1 = {a10[0], a10[1], a10[2], a10[3], a11[0], a11[1], a11[2], a11[3]};
            W.o0 = __builtin_amdgcn_mfma_f32_32x32x16_bf16(av0, pb, W.o0, 0, 0, 0);
            W.o1 = __builtin_amdgcn_mfma_f32_32x32x16_bf16(av1, pb, W.o1, 0, 0, 0);
            if (FIXM && (MODE == AM_SEL || MODE == AM_WIN)) { const bf16x8 ones = {0x3f80, 0x3f80, 0x3f80, 0x3f80, 0x3f80, 0x3f80, 0x3f80, 0x3f80}; W.ls = __builtin_amdgcn_mfma_f32_32x32x16_bf16(ones, pb, W.ls, 0, 0, 0); }
        }
    __builtin_amdgcn_s_setprio(0);
}

__device__ __forceinline__ void at_store_tile(LAS unsigned char* lds, int buf, int tid, const u32x4& kr, const u32x4& vr) {
    const int key = tid >> 3, ch = tid & 7;
    *(LAS u32x4*)(lds + (2 * buf) * AT_TILE + key * AT_PITCH + ch * 16) = kr;
    *(LAS u32x4*)(lds + (2 * buf + 1) * AT_TILE + key * AT_PITCH + ch * 16) = vr;
}

#define ATT_TILE(MODE_, ...) do { if (fixm) attn_tile<MODE_, true>(__VA_ARGS__); else attn_tile<MODE_, false>(__VA_ARGS__); } while (0)
__device__ __forceinline__ void ph_attn(const OP& p, int l, LAS unsigned char* lds, int bid, int nb) {
    const int tid = tid_(), lane = tid & 63, wave = tid >> 6, r32 = lane & 31, hi = lane >> 5;
    const int g = wave >> 1, qh = wave & 1, qloc = 32 * qh + r32;
    LAS unsigned* imp = (LAS unsigned*)(lds + AT_IMP);
    LAS unsigned* selm = (LAS unsigned*)(lds + AT_SELM);
    LAS unsigned char* ost = lds + AT_OST + wave * (32 * AT_OPITCH);
    const int key_ld = tid >> 3, ch_ld = tid & 7;
    float gq = fabsf(p.q_gain[l * 64 + lane]), gk = fabsf(p.k_gain[l * 64 + lane]);
#pragma unroll
    for (int o = 32; o >= 1; o >>= 1) { gq = fmaxf(gq, __shfl_xor(gq, o)); gk = fmaxf(gk, __shfl_xor(gk, o)); }
    const float sbound = 8.0f * gq * gk * 1.001f + 0.01f;
    const bool fixm = sbound < 40.0f;
    const float Mfix = sbound * AT_LOG2E;
    for (int round = 0;; ++round) {
        const int idx = round * nb + ((round & 1) ? (nb - 1 - bid) : bid);
        if (idx >= 1024) break;
        const int qb = 63 - (idx >> 4), b = (idx & 15) >> 1, kvh = idx & 1, hq = kvh * 4 + g;
        const int t = qb * 64 + qloc; const size_t tok = (size_t)b * NS + t;
        __syncthreads();
        for (int i = tid; i < 64 * 65; i += 512) imp[i] = 0u;
        if (tid < 2) selm[128 + tid] = 0u;
        bf16x8 qt[4];
#pragma unroll
        for (int ks = 0; ks < 4; ++ks) qt[ks] = *(const bf16x8*)(p.qn() + tok * 512 + hq * 64 + 16 * ks + 8 * hi);
        int nvis = t >= 31 ? ((t - 31) >> 4) + 1 : 0; nvis = nvis > NCMP ? NCMP : nvis;
        const int nvmax = (qb * 64 + 63 - 31) / 16 + 1 > NCMP ? NCMP : (qb * 64 + 63 - 31) / 16 + 1;
        const int ntc = (nvmax + 63) >> 6;
        const bf16_t* kcb = p.kc() + (size_t)b * 256 * 128 + kvh * 64 + ch_ld * 8;
        const bf16_t* vcb = p.vc() + (size_t)b * 256 * 128 + kvh * 64 + ch_ld * 8;
        AttnWave W;
        W.M = fixm ? Mfix : -1e30f; W.L = 0.f;
#pragma unroll
        for (int i = 0; i < 16; ++i) { W.o0[i] = 0.f; W.o1[i] = 0.f; }
        const float gate0 = p.gates()[tok * 32 + hq * 3 + 0], gate1 = p.gates()[tok * 32 + hq * 3 + 1], gate2 = p.gates()[tok * 32 + hq * 3 + 2];
        u32x4 kr, vr;
        kr = *(const u32x4*)(kcb + (size_t)key_ld * 128); vr = *(const u32x4*)(vcb + (size_t)key_ld * 128);
        at_store_tile(lds, 0, tid, kr, vr);
        __syncthreads();
        float invl = 0.f;
        for (int i = 0; i < 2 * ntc; ++i) {
            const int kt = i < ntc ? i : i - ntc, nx = i + 1, ktn = nx < ntc ? nx : nx - ntc;
            if (nx < 2 * ntc) { kr = *(const u32x4*)(kcb + (size_t)(64 * ktn + key_ld) * 128); vr = *(const u32x4*)(vcb + (size_t)(64 * ktn + key_ld) * 128); }
            const LAS unsigned char* Kl = lds + (2 * (i & 1)) * AT_TILE; const LAS unsigned char* Vl = Kl + AT_TILE;
            if (i < ntc) ATT_TILE(AM_CMP1, W, qt, Kl, Vl, lane, r32, hi, nvis - 64 * kt, false, false, true, 0.f, nullptr, 0);
            else { if (i == ntc) invl = 1.0f / fmaxf(W.L, 1e-30f);
                   ATT_TILE(AM_CMP2, W, qt, Kl, Vl, lane, r32, hi, nvis - 64 * kt, false, false, true, invl, imp + qloc * 65, 16 * kt); }
            if (nx < 2 * ntc) at_store_tile(lds, nx & 1, tid, kr, vr);
            __syncthreads();
        }
#pragma unroll
        for (int i = 0; i < 4; ++i) {
            *(LAS f32x4*)(ost + r32 * AT_OPITCH + (8 * i + 4 * hi) * 4) = (f32x4){gate0 * W.o0[4 * i], gate0 * W.o0[4 * i + 1], gate0 * W.o0[4 * i + 2], gate0 * W.o0[4 * i + 3]};
            *(LAS f32x4*)(ost + r32 * AT_OPITCH + (32 + 8 * i + 4 * hi) * 4) = (f32x4){gate0 * W.o1[4 * i], gate0 * W.o1[4 * i + 1], gate0 * W.o1[4 * i + 2], gate0 * W.o1[4 * i + 3]};
        }
        const bf16_t* kbs = p.ksv() + (size_t)b * NS * 256 + kvh * 64 + ch_ld * 8;
        kr = *(const u32x4*)(kbs + (size_t)key_ld * 256); vr = *(const u32x4*)(kbs + (size_t)key_ld * 256 + 128);
        {
            const int q = tid >> 3, part = tid & 7;
            const LAS unsigned* row = imp + q * 65 + part * 8;
            unsigned key[8];
#pragma unroll
            for (int i = 0; i < 8; ++i) { const int j = part * 8 + i; const unsigned v = (j == 0 || j == qb || j == qb - 1) ? 0xffffffffu : (row[i] | 64u);
                key[i] = (j <= qb) ? ((v & 0xffffffc0u) | (unsigned)(63 - j)) : 0u; }
            unsigned long long mask = 0ull; const int rounds = qb + 1 < 16 ? qb + 1 : 16;
            for (int it = 0; it < rounds; ++it) {
                unsigned best = key[0];
#pragma unroll
                for (int i = 1; i < 8; ++i) best = key[i] > best ? key[i] : best;
                { unsigned o;
                  o = (unsigned)__builtin_amdgcn_update_dpp(0, (int)best, 0xB1, 0xf, 0xf, false); best = best > o ? best : o;
                  o = (unsigned)__builtin_amdgcn_update_dpp(0, (int)best, 0x4E, 0xf, 0xf, false); best = best > o ? best : o;
                  o = (unsigned)__builtin_amdgcn_update_dpp(0, (int)best, 0x141, 0xf, 0xf, false); best = best > o ? best : o; }
                const int jw = 63 - (int)(best & 63u);
                mask |= 1ull << jw;
#pragma unroll
                for (int i = 0; i < 8; ++i) key[i] = (key[i] == best) ? 0u : key[i];
            }
            if (part == 0) { selm[2 * q] = (unsigned)mask; selm[2 * q + 1] = (unsigned)(mask >> 32);
                (void)__hip_atomic_fetch_or(selm + 128, (unsigned)mask, __ATOMIC_RELAXED, __HIP_MEMORY_SCOPE_WORKGROUP); (void)__hip_atomic_fetch_or(selm + 129, (unsigned)(mask >> 32), __ATOMIC_RELAXED, __HIP_MEMORY_SCOPE_WORKGROUP); }
        }
        __syncthreads();
        const unsigned long long mymask = (unsigned long long)selm[2 * qloc] | ((unsigned long long)selm[2 * qloc + 1] << 32);
        const unsigned long long umask = (unsigned long long)selm[128] | ((unsigned long long)selm[129] << 32);
        const bf16_t* kbw = p.kwv() + (size_t)b * NS * 256 + kvh * 64 + ch_ld * 8;
        const int j0w = qb - 8 > 0 ? qb - 8 : 0;
        int pw = 0;
#pragma unroll
        for (int ks = 0; ks < 4; ++ks) qt[ks] = *(const bf16x8*)(p.qr() + tok * 512 + hq * 64 + 16 * ks + 8 * hi);
        {
            W.M = fixm ? Mfix : -1e30f; W.L = 0.f;
#pragma unroll
            for (int i = 0; i < 16; ++i) { W.o0[i] = 0.f; W.o1[i] = 0.f; W.ls[i] = 0.f; }
            const bf16_t* kb = kbs;
            unsigned long long rem = umask & ~1ull;
            int j = 0;
            at_store_tile(lds, 0, tid, kr, vr);
            __syncthreads();

            for (int i = 0;; ++i) {
                const bool more = rem != 0ull; int jn = 0;
                if (more) { jn = __builtin_ctzll(rem); rem &= rem - 1; kr = *(const u32x4*)(kb + (size_t)(64 * jn + key_ld) * 256); vr = *(const u32x4*)(kb + (size_t)(64 * jn + key_ld) * 256 + 128); }
                else { kr = *(const u32x4*)(kbw + (size_t)(64 * j0w + key_ld) * 256); vr = *(const u32x4*)(kbw + (size_t)(64 * j0w + key_ld) * 256 + 128); }
                const LAS unsigned char* Kl = lds + (2 * (i & 1)) * AT_TILE; const LAS unsigned char* Vl = Kl + AT_TILE;
                ATT_TILE(AM_SEL, W, qt, Kl, Vl, lane, r32, hi, qloc, j == qb, false, ((mymask >> j) & 1ull) != 0ull, 0.f, nullptr, 0);
                at_store_tile(lds, (i + 1) & 1, tid, kr, vr);
                __syncthreads();
                if (!more) { pw = (i + 1) & 1; break; }
                j = jn;
            }
            if (fixm) W.L = W.ls[0];
            const float sc = gate1 / fmaxf(W.L, 1e-30f);
#pragma unroll
            for (int i = 0; i < 4; ++i) {
                LAS f32x4* p0 = (LAS f32x4*)(ost + r32 * AT_OPITCH + (8 * i + 4 * hi) * 4); LAS f32x4* p1 = (LAS f32x4*)(ost + r32 * AT_OPITCH + (32 + 8 * i + 4 * hi) * 4);
                *p0 = *p0 + (f32x4){sc * W.o0[4 * i], sc * W.o0[4 * i + 1], sc * W.o0[4 * i + 2], sc * W.o0[4 * i + 3]};
                *p1 = *p1 + (f32x4){sc * W.o1[4 * i], sc * W.o1[4 * i + 1], sc * W.o1[4 * i + 2], sc * W.o1[4 * i + 3]};
            }
        }
        {
            W.M = fixm ? Mfix : -1e30f; W.L = 0.f;
#pragma unroll
            for (int i = 0; i < 16; ++i) { W.o0[i] = 0.f; W.o1[i] = 0.f; W.ls[i] = 0.f; }
            const bf16_t* kb = kbw;
            const int j0 = j0w;
            for (int j = j0; j <= qb; ++j) {
                const int i = j - j0 + pw;
                if (j < qb) { kr = *(const u32x4*)(kb + (size_t)(64 * (j + 1) + key_ld) * 256); vr = *(const u32x4*)(kb + (size_t)(64 * (j + 1) + key_ld) * 256 + 128); }
                const LAS unsigned char* Kl = lds + (2 * (i & 1)) * AT_TILE; const LAS unsigned char* Vl = Kl + AT_TILE;
                ATT_TILE(AM_WIN, W, qt, Kl, Vl, lane, r32, hi, qloc, j == qb, j == qb - 8, true, 0.f, nullptr, 0);
                if (j < qb) at_store_tile(lds, (i + 1) & 1, tid, kr, vr);
                __syncthreads();
            }
            if (fixm) W.L = W.ls[0];
            const float sc = gate2 / fmaxf(W.L, 1e-30f);
#pragma unroll
            for (int i = 0; i < 4; ++i) {
                LAS f32x4* p0 = (LAS f32x4*)(ost + r32 * AT_OPITCH + (8 * i + 4 * hi) * 4); LAS f32x4* p1 = (LAS f32x4*)(ost + r32 * AT_OPITCH + (32 + 8 * i + 4 * hi) * 4);
                *p0 = *p0 + (f32x4){sc * W.o0[4 * i], sc * W.o0[4 * i + 1], sc * W.o0[4 * i + 2], sc * W.o0[4 * i + 3]};
                *p1 = *p1 + (f32x4){sc * W.o1[4 * i], sc * W.o1[4 * i + 1], sc * W.o1[4 * i + 2], sc * W.o1[4 * i + 3]};
            }
        }
        asm volatile("s_waitcnt lgkmcnt(0)" ::: "memory");
#pragma unroll
        for (int i = 0; i < 4; ++i) {
            const int row = 8 * i + (lane >> 3), c8 = lane & 7;
            const f32x4 a = *(const LAS f32x4*)(ost + row * AT_OPITCH + c8 * 32), bq = *(const LAS f32x4*)(ost + row * AT_OPITCH + c8 * 32 + 16);
            const u32x2 v = {pk4_e4m3(a.x * H8_SCALE, a.y * H8_SCALE, a.z * H8_SCALE, a.w * H8_SCALE), pk4_e4m3(bq.x * H8_SCALE, bq.y * H8_SCALE, bq.z * H8_SCALE, bq.w * H8_SCALE)};
            *(u32x2*)((unsigned char*)p.onsa() + ((size_t)b * NS + qb * 64 + 32 * qh + row) * 1024 + hq * 64 + c8 * 8) = v;
        }
    }
    __syncthreads();
}
__device__ __forceinline__ void dec8_e4m3(const u32x2 g, f32x4& a, f32x4& b) {
    const f32x2 a0 = __builtin_amdgcn_cvt_pk_f32_fp8((int)g.x, false), a1 = __builtin_amdgcn_cvt_pk_f32_fp8((int)g.x, true), b0 = __builtin_amdgcn_cvt_pk_f32_fp8((int)g.y, false), b1 = __builtin_amdgcn_cvt_pk_f32_fp8((int)g.y, true);
    a = (f32x4){a0.x, a0.y, a1.x, a1.y}; b = (f32x4){b0.x, b0.y, b1.x, b1.y};
}
struct EpiProjF {
    static constexpr bool PERM = true;
    bf16_t* merged; const bf16_t* ra; const bf16_t* sb; float dsc;
    static __device__ __forceinline__ unsigned base_off(const pg8::Unit& u, int wr, int wc, int fr, int fq) {
        unsigned b = (unsigned)(((u.pm * 256 + wr * 64 + fr) * ND + u.pn * 256 + wc * 32 + 8 * fq) * 2); asm volatile("" : "+v"(b)); return b; }
    __device__ __forceinline__ void mid(f32x4 (&acc)[2][2][4][2], const pg8::Unit& u, int wr, int wc, int fr, int fq) const {
        const unsigned b0 = base_off(u, wr, wc, fr, fq);
#pragma unroll
        for (int ai = 0; ai < 2; ++ai)
#pragma unroll
            for (int m = 0; m < 4; ++m) {
                const unsigned ro = b0 + (unsigned)((ai * 128 + m * 16) * ND * 2);
                u32x2 gv[2];
#pragma unroll
                for (int bj = 0; bj < 2; ++bj) gv[bj] = *(const u32x2*)((const unsigned char*)ra + (ro >> 1) + bj * 128);
#pragma unroll
                for (int bj = 0; bj < 2; ++bj) { f32x4 f0, f1; dec8_e4m3(gv[bj], f0, f1); acc[ai][bj][m][0] *= f0; acc[ai][bj][m][1] *= f1; }
            }
    }
    __device__ __forceinline__ void operator()(const f32x4 (&acc)[2][2][4][2], const pg8::Unit& u, int wr, int wc, int fr, int fq) const {
        const unsigned b0 = base_off(u, wr, wc, fr, fq);
        u32x2 gv[2][4][2];
#pragma unroll
        for (int ai = 0; ai < 2; ++ai)
#pragma unroll
            for (int m = 0; m < 4; ++m)
#pragma unroll
                for (int bj = 0; bj < 2; ++bj) gv[ai][m][bj] = *(const u32x2*)((const unsigned char*)sb + ((b0 + (unsigned)((ai * 128 + m * 16) * ND * 2)) >> 1) + bj * 128);
#pragma unroll
        for (int ai = 0; ai < 2; ++ai)
#pragma unroll
            for (int m = 0; m < 4; ++m) {
                const unsigned ro = b0 + (unsigned)((ai * 128 + m * 16) * ND * 2);
#pragma unroll
                for (int bj = 0; bj < 2; ++bj) { f32x4 f0, f1; dec8_e4m3(gv[ai][m][bj], f0, f1);
                    const f32x4 o0 = acc[ai][bj][m][0] * f0, o1 = acc[ai][bj][m][1] * f1;
                    *(u32x2*)((unsigned char*)merged + (ro >> 1) + bj * 128) = (u32x2){pk4_e4m3(o0.x * dsc, o0.y * dsc, o0.z * dsc, o0.w * dsc), pk4_e4m3(o1.x * dsc, o1.y * dsc, o1.z * dsc, o1.w * dsc)};
                }
            }
    }
};
template <bool XF32> struct EpiOut {
    static constexpr bool PERM = true;
    const float* xin; bf16_t* xb; const float* gt; float dsc;
    __device__ __forceinline__ void operator()(const f32x4 (&acc)[2][2][4][2], const pg8::Unit& u, int wr, int wc, int fr, int fq) const {
        const int row0 = u.pm * 256 + wr * 64 + fr, col0 = u.pn * 256 + wc * 32 + 8 * fq;
        const float* gp = gt + (size_t)(u.pm >> 4) * 6144 + col0;
        f32x4 g4[2][2];
#pragma unroll
        for (int bj = 0; bj < 2; ++bj)
#pragma unroll
            for (int n = 0; n < 2; ++n) g4[bj][n] = *(const f32x4*)(gp + bj * 128 + n * 4) * dsc;
#pragma unroll
        for (int ai = 0; ai < 2; ++ai) {
            f32x4 xv[4][2][2];
            if (XF32) {
#pragma unroll
                for (int m = 0; m < 4; ++m)
#pragma unroll
                    for (int bj = 0; bj < 2; ++bj) { const float* xp = xin + (size_t)(row0 + ai * 128 + m * 16) * ND + col0 + bj * 128; xv[m][bj][0] = *(const f32x4*)xp; xv[m][bj][1] = *(const f32x4*)(xp + 4); }
            } else {
                u32x4 r[4][2];
#pragma unroll
                for (int m = 0; m < 4; ++m)
#pragma unroll
                    for (int bj = 0; bj < 2; ++bj) r[m][bj] = *(const u32x4*)(xb + (size_t)(row0 + ai * 128 + m * 16) * ND + col0 + bj * 128);
#pragma unroll
                for (int m = 0; m < 4; ++m)
#pragma unroll
                    for (int bj = 0; bj < 2; ++bj) { const u32x4 q = r[m][bj];
                        xv[m][bj][0] = (f32x4){__uint_as_float(q.x << 16), __uint_as_float(q.x & 0xffff0000u), __uint_as_float(q.y << 16), __uint_as_float(q.y & 0xffff0000u)};
                        xv[m][bj][1] = (f32x4){__uint_as_float(q.z << 16), __uint_as_float(q.z & 0xffff0000u), __uint_as_float(q.w << 16), __uint_as_float(q.w & 0xffff0000u)}; }
            }
#pragma unroll
            for (int m = 0; m < 4; ++m)
#pragma unroll
                for (int bj = 0; bj < 2; ++bj) { const f32x4 o0 = xv[m][bj][0] + g4[bj][0] * acc[ai][bj][m][0], o1 = xv[m][bj][1] + g4[bj][1] * acc[ai][bj][m][1];
                    u32x4 w; w.x = pk2(o0.x, o0.y); w.y = pk2(o0.z, o0.w); w.z = pk2(o1.x, o1.y); w.w = pk2(o1.z, o1.w);
                    *(u32x4*)(xb + (size_t)(row0 + ai * 128 + m * 16) * ND + col0 + bj * 128) = w; }
        }
    }
};

struct EpiRouter {
    static constexpr bool PERM = true;
    float* logits; bf16_t* sact;
    __device__ __forceinline__ void operator()(const f32x4 (&acc)[2][2][4][2], const pg8::Unit& u, int wr, int wc, int fr, int fq) const {
        const int row0 = u.pm * 256 + wr * 64 + fr, cw = wc * 32 + 8 * fq;
        if (u.pn == 0) {
#pragma unroll
            for (int ai = 0; ai < 2; ++ai)
#pragma unroll
                for (int m = 0; m < 4; ++m) { float* rp = logits + (size_t)(row0 + ai * 128 + m * 16) * NE + cw;
#pragma unroll
                    for (int bj = 0; bj < 2; ++bj) { *(f32x4*)(rp + bj * 128) = acc[ai][bj][m][0]; *(f32x4*)(rp + bj * 128 + 4) = acc[ai][bj][m][1]; } }
        } else {
#pragma unroll
            for (int ai = 0; ai < 2; ++ai)
#pragma unroll
                for (int m = 0; m < 4; ++m) {
                    const f32x4 g0 = acc[ai][0][m][0], g1 = acc[ai][0][m][1], u0 = acc[ai][1][m][0], u1 = acc[ai][1][m][1];
                    u32x4 w; w.x = pk2(fsilu(g0.x) * u0.x, fsilu(g0.y) * u0.y); w.y = pk2(fsilu(g0.z) * u0.z, fsilu(g0.w) * u0.w);
                    w.z = pk2(fsilu(g1.x) * u1.x, fsilu(g1.y) * u1.y); w.w = pk2(fsilu(g1.z) * u1.z, fsilu(g1.w) * u1.w);
                    *(u32x4*)(sact + (size_t)(row0 + ai * 128 + m * 16) * 256 + (u.pn - 1) * 128 + cw) = w;
                }
        }
    }
};

__device__ __forceinline__ void ph_topk(const OP& p, int l, LAS unsigned char* lds, int bid, int nb) {
    const int tid = tid_(), lane = tid & 63, w = tid >> 6;
    LAS int* hist = (LAS int*)lds;
    const float* lg = p.logits(); int* idxp = p.idx(); float* wtp = p.wts(); int* slot = p.slot();
    __syncthreads();
    if (tid < 256) hist[tid] = 0;
    __syncthreads();
    const int CH = (NT + nb - 1) / nb, t0 = bid * CH, t1 = (t0 + CH) < NT ? (t0 + CH) : NT;
    float br[4];
#pragma unroll
    for (int i = 0; i < 4; ++i) br[i] = p.b_router[l * NE + i * 64 + lane];
    float lgn[4];
#pragma unroll
    for (int i = 0; i < 4; ++i) lgn[i] = (t0 + w < t1) ? lg[(size_t)(t0 + w) * NE + i * 64 + lane] : 0.f;
    for (int t = t0 + w; t < t1; t += 8) {
        unsigned key[4]; float affv[4];
#pragma unroll
        for (int i = 0; i < 4; ++i) { const int e = i * 64 + lane; const float aff = 1.0f / (1.0f + expf(-lgn[i])); affv[i] = aff; const float kf = fmaxf(aff + br[i], 1e-30f);
            key[i] = (__float_as_uint(kf) & 0xffffff00u) | (unsigned)(255 - e); }
        if (t + 8 < t1) {
#pragma unroll
            for (int i = 0; i < 4; ++i) lgn[i] = lg[(size_t)(t + 8) * NE + i * 64 + lane]; }
        int mye = 0;
#pragma unroll
        for (int r = 0; r < 8; ++r) {
            unsigned m = key[0] > key[1] ? key[0] : key[1]; { const unsigned m2 = key[2] > key[3] ? key[2] : key[3]; m = m > m2 ? m : m2; }
            { unsigned o;
              o = (unsigned)__builtin_amdgcn_update_dpp(0, (int)m, 0xB1, 0xf, 0xf, false); m = m > o ? m : o;
              o = (unsigned)__builtin_amdgcn_update_dpp(0, (int)m, 0x4E, 0xf, 0xf, false); m = m > o ? m : o;
              o = (unsigned)__builtin_amdgcn_update_dpp(0, (int)m, 0x141, 0xf, 0xf, false); m = m > o ? m : o;
              o = (unsigned)__builtin_amdgcn_update_dpp(0, (int)m, 0x140, 0xf, 0xf, false); m = m > o ? m : o; }
            const unsigned r0 = (unsigned)__builtin_amdgcn_readlane((int)m, 0), r1 = (unsigned)__builtin_amdgcn_readlane((int)m, 16), r2 = (unsigned)__builtin_amdgcn_readlane((int)m, 32), r3 = (unsigned)__builtin_amdgcn_readlane((int)m, 48);
            unsigned win = r0 > r1 ? r0 : r1; { const unsigned w2 = r2 > r3 ? r2 : r3; win = win > w2 ? win : w2; }
#pragma unroll
            for (int i = 0; i < 4; ++i) key[i] = (key[i] == win) ? 0u : key[i];
            if (lane == r) mye = 255 - (int)(win & 255u);
        }
        float av = 0.f;
        { const int sl = mye & 63, si = mye >> 6;
          const float a0 = __shfl(affv[0], sl), a1 = __shfl(affv[1], sl), a2 = __shfl(affv[2], sl), a3 = __shfl(affv[3], sl);
          const float sel = (si == 0) ? a0 : (si == 1) ? a1 : (si == 2) ? a2 : a3;
          if (lane < 8) av = sel; }
        float sum = av;
        sum += __shfl_xor(sum, 1); sum += __shfl_xor(sum, 2); sum += __shfl_xor(sum, 4);
        if (lane < 8) {
            idxp[(size_t)t * 8 + lane] = mye; wtp[(size_t)t * 8 + lane] = av / sum * 2.5f;
            slot[(size_t)t * 8 + lane] = __hip_atomic_fetch_add(hist + mye, 1, __ATOMIC_RELAXED, __HIP_MEMORY_SCOPE_WORKGROUP);
        }
    }
    __syncthreads();
    if (tid < 256) p.bhist()[bid * 256 + tid] = hist[tid];
    __syncthreads();
}
#define CW_NUNITS 64
__device__ __forceinline__ void ph_place(const OP& p, LAS unsigned char* lds, int bid, int nb) {
    const int tid = tid_();
    LAS int* pst = (LAS int*)lds;
    LAS int* cntl = pst + 260;
    LAS int* basel = cntl + 256;
    int* rtok = p.row_tok(); float* rw = p.row_w(); int* ue = p.unit_e(); const int* bh = p.bhist();
    LAS int* ptot = basel + 256;
    LAS int* pbase = ptot + 8 * 256;
    __syncthreads();
    { const int lane = tid & 63, wave = tid >> 6; int tot[4] = {0, 0, 0, 0}, base[4] = {0, 0, 0, 0};
      for (int b0 = wave; b0 < nb; b0 += 64) {
          int v[8][4];
#pragma unroll
          for (int k = 0; k < 8; ++k) { const int b = b0 + 8 * k;
#pragma unroll
              for (int i = 0; i < 4; ++i) v[k][i] = (b < nb) ? bh[b * 256 + i * 64 + lane] : 0; }
#pragma unroll
          for (int k = 0; k < 8; ++k) { const int b = b0 + 8 * k;
#pragma unroll
              for (int i = 0; i < 4; ++i) { tot[i] += v[k][i]; base[i] += (b < bid) ? v[k][i] : 0; } }
      }
#pragma unroll
      for (int i = 0; i < 4; ++i) { ptot[wave * 256 + i * 64 + lane] = tot[i]; pbase[wave * 256 + i * 64 + lane] = base[i]; } }
    __syncthreads();
    if (tid < 256) { int tot = 0, base = 0;
#pragma unroll
        for (int ww = 0; ww < 8; ++ww) { tot += ptot[ww * 256 + tid]; base += pbase[ww * 256 + tid]; }
        cntl[tid] = tot; basel[tid] = base; ptot[tid] = (tot + 255) & ~255; }
    __syncthreads();
    if (tid <= 256) { int run = 0;
        for (int e = 0; e < 256; ++e) run += (e < tid) ? ptot[e] : 0;
        pst[tid] = run; }
    __syncthreads();
    if (bid == 0) {
        if (tid < 256) { for (int i = pst[tid] >> 8; i < pst[tid + 1] >> 8; ++i) ue[i] = tid; }
        if (tid == 0) p.ctl()[CW_NUNITS] = (unsigned)(pst[NE] >> 8);
    }
    for (int e = bid; e < NE; e += nb) { for (int r = pst[e] + cntl[e] + tid; r < pst[e + 1]; r += 512) { rtok[r] = 0; rw[r] = -1.f; } }
    const int* idxp = p.idx(); const float* wtp = p.wts(); int* slot = p.slot();
    const int CH = (NT + nb - 1) / nb, a0 = bid * CH * 8, a1 = ((bid + 1) * CH < NT ? (bid + 1) * CH : NT) * 8;
    for (int a = a0 + tid; a < a1; a += 512) {
        const int e = idxp[a]; const int dest = pst[e] + basel[e] + slot[a];
        rtok[dest] = a >> 3; rw[dest] = wtp[a]; slot[a] = dest;
    }
    __syncthreads();
}

__device__ __forceinline__ int xcd_chunk(int L, int nwg) { const int q = nwg / 8, r = nwg % 8, xcd = L % 8, off = L / 8; return (xcd < r ? xcd * (q + 1) : r * (q + 1) + (xcd - r) * q) + off; }
struct GatherSched {
    const char* h; const char* W; const int* row_tok; const int* unit_e; int K, kstepA, ldb; int nunits2, G, c; int arow, brow;
    __device__ __forceinline__ bool next(int i, pg8::Unit& u) const { int L = i * G + c; if (L >= nunits2) return false; L = xcd_chunk(L, nunits2); u.pm = L >> 1; u.pn = L & 1; u.e = unit_e[u.pm]; return true; }
    __device__ __forceinline__ const char* a_base() const { return h; }
    __device__ __forceinline__ const char* b_base() const { return W; }
    __device__ __forceinline__ const char* a_ptr(const pg8::Unit&) const { return h; }
    __device__ __forceinline__ void a_off(const pg8::Unit& u, int tid, unsigned (&off)[2][2]) const {
#pragma unroll
        for (int i = 0; i < 2; ++i) { int R, C; pg8::stage_rc(tid * 16 + i * 8192, R, C);
#pragma unroll
            for (int hh = 0; hh < 2; ++hh) off[hh][i] = (unsigned)(row_tok[u.pm * 256 + hh * 128 + R] * arow + C * 2); }
    }
    __device__ __forceinline__ const char* b_ptr(const pg8::Unit& u) const { return W + ((size_t)u.e * 512 + u.pn * 256) * brow; }
};
struct EpiAct {
    static constexpr bool PERM = true;
    unsigned char* act8; float dsc;
    __device__ __forceinline__ void operator()(const f32x4 (&acc)[2][2][4][2], const pg8::Unit& u, int wr, int wc, int fr, int fq) const {
        const int row0 = u.pm * 256 + wr * 64 + fr, cw = u.pn * 128 + wc * 32 + 8 * fq;
#pragma unroll
        for (int ai = 0; ai < 2; ++ai)
#pragma unroll
            for (int m = 0; m < 4; ++m) {
                const f32x4 g0 = acc[ai][0][m][0] * dsc, g1 = acc[ai][0][m][1] * dsc, u0 = acc[ai][1][m][0] * (dsc * H8_SCALE), u1 = acc[ai][1][m][1] * (dsc * H8_SCALE);
                const u32x2 w = {pk4_e4m3(fsilu(g0.x) * u0.x, fsilu(g0.y) * u0.y, fsilu(g0.z) * u0.z, fsilu(g0.w) * u0.w), pk4_e4m3(fsilu(g1.x) * u1.x, fsilu(g1.y) * u1.y, fsilu(g1.z) * u1.z, fsilu(g1.w) * u1.w)};
                *(u32x2*)(act8 + (size_t)(row0 + ai * 128 + m * 16) * 256 + cw) = w;
            }
    }
};
struct DownSched {
    const char* act; const char* W; const int* unit_e; int K, kstepA, ldb; int nunits4, G, c; int arow, brow;
    __device__ __forceinline__ bool next(int i, pg8::Unit& u) const { int L = i * G + c; if (L >= nunits4) return false; L = xcd_chunk(L, nunits4); u.pm = L >> 2; u.pn = L & 3; u.e = unit_e[u.pm]; return true; }
    __device__ __forceinline__ const char* a_base() const { return act; }
    __device__ __forceinline__ const char* b_base() const { return W; }
    __device__ __forceinline__ const char* a_ptr(const pg8::Unit& u) const { return act + (size_t)u.pm * 256 * arow; }
    __device__ __forceinline__ void a_off(const pg8::Unit&, int tid, unsigned (&off)[2][2]) const {
#pragma unroll
        for (int i = 0; i < 2; ++i) { int R, C; pg8::stage_rc(tid * 16 + i * 8192, R, C);
#pragma unroll
            for (int hh = 0; hh < 2; ++hh) off[hh][i] = (unsigned)((hh * 128 + R) * arow + C * 2); }
    }
    __device__ __forceinline__ const char* b_ptr(const pg8::Unit& u) const { return W + ((size_t)u.e * ND + u.pn * 256) * brow; }
};
#define YS_SCALE 8.0f
__device__ __forceinline__ unsigned pk4_fp8(f32x4 v) {
    int w = __builtin_amdgcn_cvt_pk_fp8_f32(__builtin_amdgcn_fmed3f(v.x, -240.f, 240.f), __builtin_amdgcn_fmed3f(v.y, -240.f, 240.f), 0, false);
    w = __builtin_amdgcn_cvt_pk_fp8_f32(__builtin_amdgcn_fmed3f(v.z, -240.f, 240.f), __builtin_amdgcn_fmed3f(v.w, -240.f, 240.f), w, true); return (unsigned)w;
}
template <bool FP8> struct EpiY {
    static constexpr bool PERM = true;
    void* y; const float* row_w; float dsc;
    __device__ __forceinline__ void operator()(const f32x4 (&acc)[2][2][4][2], const pg8::Unit& u, int wr, int wc, int fr, int fq) const {
        const int row0 = u.pm * 256 + wr * 64 + fr, cw = u.pn * 256 + wc * 32 + 8 * fq;
        float rwv[2][4];
#pragma unroll
        for (int ai = 0; ai < 2; ++ai)
#pragma unroll
            for (int m = 0; m < 4; ++m) rwv[ai][m] = row_w ? row_w[row0 + ai * 128 + m * 16] : 1.0f;
#pragma unroll
        for (int ai = 0; ai < 2; ++ai)
#pragma unroll
            for (int m = 0; m < 4; ++m) {
                const float s = rwv[ai][m];
                if (s < 0.f) continue;
                if (FP8) { unsigned char* rp = (unsigned char*)y + (size_t)(row0 + ai * 128 + m * 16) * ND + cw; const float s8 = s * (YS_SCALE * dsc);
#pragma unroll
                    for (int bj = 0; bj < 2; ++bj) { const u32x2 w = {pk4_fp8(acc[ai][bj][m][0] * s8), pk4_fp8(acc[ai][bj][m][1] * s8)}; *(u32x2*)(rp + bj * 128) = w; } }
                else { bf16_t* rp = (bf16_t*)y + (size_t)(row0 + ai * 128 + m * 16) * ND + cw;
#pragma unroll
                    for (int bj = 0; bj < 2; ++bj) { const f32x4 v0 = acc[ai][bj][m][0] * s, v1 = acc[ai][bj][m][1] * s;
                        u32x4 w; w.x = pk2(v0.x, v0.y); w.y = pk2(v0.z, v0.w); w.z = pk2(v1.x, v1.y); w.w = pk2(v1.z, v1.w); *(u32x4*)(rp + bj * 128) = w; } }
            }
    }
};
__device__ __forceinline__ void ph_combine(const OP& p, int l, int bid, int nb) {
    const int lane = tid_() & 63, w = tid_() >> 6;
    const unsigned char* ys8 = (const unsigned char*)p.yslot(); const bf16_t* sh = p.shout(); const int* slot = p.slot(); const float* mod = p.mod(); bf16_t* hb = p.h();
    for (int t = bid * 8 + w; t < NT; t += nb * 8) {
        const float* mb = mod + ((size_t)l * NB + (t >> 12)) * 6144;
        int sl = 0; if (lane < 8) sl = slot[(size_t)t * 8 + lane];
        f32x4 accv[4];
#pragma unroll
        for (int i = 0; i < 4; ++i) { const u32x2 s2 = *(const u32x2*)(sh + (size_t)t * ND + i * 256 + lane * 4);
            accv[i] = (f32x4){__uint_as_float(s2.x << 16), __uint_as_float(s2.x & 0xffff0000u), __uint_as_float(s2.y << 16), __uint_as_float(s2.y & 0xffff0000u)}; }
        f32x4 ysum[4] = {(f32x4){0.f, 0.f, 0.f, 0.f}, (f32x4){0.f, 0.f, 0.f, 0.f}, (f32x4){0.f, 0.f, 0.f, 0.f}, (f32x4){0.f, 0.f, 0.f, 0.f}};
#pragma unroll
        for (int k = 0; k < 8; ++k) {
            const int r = __shfl(sl, k);
#pragma unroll
            for (int i = 0; i < 4; ++i) { const int y4 = *(const int*)(ys8 + (size_t)r * ND + i * 256 + lane * 4);
                const f32x2 lo = __builtin_amdgcn_cvt_pk_f32_fp8(y4, false), hi2 = __builtin_amdgcn_cvt_pk_f32_fp8(y4, true);
                ysum[i] += (f32x4){lo.x, lo.y, hi2.x, hi2.y}; }
        }
#pragma unroll
        for (int i = 0; i < 4; ++i) accv[i] += ysum[i] * (1.0f / YS_SCALE);
        float ss = 0.f; f32x4 xo[4]; bf16_t* xbp = p.xb();
#pragma unroll
        for (int i = 0; i < 4; ++i) { const int cidx = i * 256 + lane * 4; const u32x2 xr = *(const u32x2*)(xbp + (size_t)t * ND + cidx); const f32x4 g4 = *(const f32x4*)(mb + 5120 + cidx);
            const f32x4 xv = {__uint_as_float(xr.x << 16), __uint_as_float(xr.x & 0xffff0000u), __uint_as_float(xr.y << 16), __uint_as_float(xr.y & 0xffff0000u)};
            xo[i] = xv + g4 * accv[i];
            if (l + 1 < NL) { const u32x2 w = {pk2(xo[i].x, xo[i].y), pk2(xo[i].z, xo[i].w)}; *(u32x2*)(xbp + (size_t)t * ND + cidx) = w; }
            else *(f32x4*)(p.out + (size_t)t * ND + cidx) = xo[i];
            ss += xo[i].x * xo[i].x + xo[i].y * xo[i].y + xo[i].z * xo[i].z + xo[i].w * xo[i].w; }
        if (l + 1 < NL) {
#pragma unroll
            for (int o = 32; o >= 1; o >>= 1) ss += __shfl_xor(ss, o);
            const float rstd = rsqrtf(ss * (1.0f / ND) + 1e-6f);
            const float* mn = mod + ((size_t)(l + 1) * NB + (t >> 12)) * 6144;
#pragma unroll
            for (int i = 0; i < 4; ++i) { const int cidx = i * 256 + lane * 4; const f32x4 sc = *(const f32x4*)(mn + 1024 + cidx), s0 = *(const f32x4*)(mn + cidx);
                u32x2 o; o.x = pk2(xo[i].x * rstd * (1.f + sc.x) + s0.x, xo[i].y * rstd * (1.f + sc.y) + s0.y); o.y = pk2(xo[i].z * rstd * (1.f + sc.z) + s0.z, xo[i].w * rstd * (1.f + sc.w) + s0.w);
                *(u32x2*)(hb + (size_t)t * ND + cidx) = o; }
        }
    }
}
#ifndef ATTN_TWICE
#define ATTN_TWICE
#endif
#ifndef OPT_PHASES_B
#define OPT_PHASES_B \
        if (IN(OPH_CMP1)) REP(OPH_CMP1) { ph_rope(p, bid, nb); \
            { CmpSched S; S.kvraw = (const char*)p.kvraw(); S.w1 = (const char*)(p.Wt_w1() + (size_t)l * 2 * 256 * 2048); S.K = 512; S.kstepA = 512; S.ldb = 2048; S.G = nb; S.c = bid; \
              EpiCmp E{p.cpart()}; pg8::gemm_phase<EpiCmp, CmpSched, true>(lds, S, E); } \
            ph_gmlp(p, l, lds, bid, nb); SEAMK(OPH_CMP1, l); } \
        if (IN(OPH_CMP2)) REP(OPH_CMP2) { ph_cmp2(p, l, lds, bid, nb); SEAMK(OPH_CMP2, l); } \
        if (IN(OPH_ATTN)) { ph_attn(p, l, lds, bid, nb); SEAMK(OPH_ATTN, l); ATTN_TWICE } \
        if (IN(OPH_PROJ)) REP(OPH_PROJ) { \
            { pg8::DenseSched S; S.init(p.onsa(), ND / 2, (const char*)p.Wt_pn() + (size_t)l * ND * ND, NT, ND, ND / 2, nb, bid); EpiProjF E{p.merged(), p.sga(), p.sgb(), 1.0f / W8_SCALE}; pg8::gemm_phase<EpiProjF, pg8::DenseSched, true, true, true>(lds, S, E); } \
            SEAMK(OPH_PROJ, l); } \
        if (IN(OPH_OUT)) REP(OPH_OUT) { pg8::DenseSched S; S.init(p.merged(), ND / 2, (const char*)p.Wt_out() + (size_t)l * ND * ND, NT, ND, ND / 2, nb, bid); \
            EpiOut<l == 0> E{p.x, p.xb(), p.mod() + (size_t)l * NB * 6144 + 2048, 1.0f / (H8_SCALE * W8_SCALE)}; pg8::gemm_phase<EpiOut<l == 0>, pg8::DenseSched, true, false, true>(lds, S, E); SEAMK(OPH_OUT, l); } \
        if (IN(OPH_NORMF)) REP(OPH_NORMF) { ph_norm_b(p, p.xb(), l, 3072, 4096, bid, nb, (unsigned char*)p.yslot() + (size_t)MAXROWS2 * ND); SEAMK(OPH_NORMF, l); } \
        if (IN(OPH_ROUTER)) REP(OPH_ROUTER) { pg8::DenseSched S; S.init(p.h(), ND, p.Wt_rs() + (size_t)l * 768 * ND, NT, 768, ND, nb, bid); \
            EpiRouter E{p.logits(), p.sact()}; pg8::gemm_phase<EpiRouter, pg8::DenseSched, true>(lds, S, E); SEAMK(OPH_ROUTER, l); } \
        if (IN(OPH_TOPK)) REP(OPH_TOPK) { ph_topk(p, l, lds, bid, nb); SEAMK(OPH_TOPK, l); } \
        if (IN(OPH_PLACE)) REP(OPH_PLACE) { ph_place(p, lds, bid, nb); SEAMK(OPH_PLACE, l); } \
        if (IN(OPH_EGU)) REP(OPH_EGU) { GatherSched S; S.h = (const char*)p.yslot() + (size_t)MAXROWS2 * ND; S.W = (const char*)p.Wt_eg() + (size_t)l * NE * 512 * ND; S.row_tok = p.row_tok(); S.unit_e = p.unit_e(); \
            S.K = ND / 2; S.kstepA = 128; S.ldb = ND / 2; S.arow = ND; S.brow = ND;        \
            S.nunits2 = 2 * (int)__builtin_amdgcn_readfirstlane(p.ctl()[CW_NUNITS]); S.G = nb; S.c = bid; \
            EpiAct E{(unsigned char*)p.act(), 1.0f / (H8_SCALE * W8_SCALE)}; pg8::gemm_phase<EpiAct, GatherSched, true, false, true>(lds, S, E); SEAMK(OPH_EGU, l); } \
        if (IN(OPH_EDOWN)) REP(OPH_EDOWN) { \
            { DownSched S; S.act = (const char*)p.act(); S.W = (const char*)p.Wt_ed() + (size_t)l * NE * ND * 256; S.unit_e = p.unit_e(); S.K = 128; S.kstepA = 128; S.ldb = 128; S.arow = 256; S.brow = 256; \
              S.nunits4 = 4 * (int)__builtin_amdgcn_readfirstlane(p.ctl()[CW_NUNITS]); S.G = nb; S.c = bid; EpiY<true> E{p.yslot(), p.row_w(), 1.0f / (H8_SCALE * W8_SCALE)}; pg8::gemm_phase<EpiY<true>, DownSched, true, false, true>(lds, S, E); } \
            { pg8::DenseSched S; S.init(p.sact(), 256, p.Wt_ds() + (size_t)l * ND * 256, NT, ND, 256, nb, bid); EpiY<false> E{p.shout(), nullptr, 1.0f}; pg8::gemm_phase<EpiY<false>, pg8::DenseSched, true>(lds, S, E); } \
            SEAMK(OPH_EDOWN, l); } \
        if (IN(OPH_COMBINE)) REP(OPH_COMBINE) { ph_combine(p, l, bid, nb); SEAMK(OPH_COMBINE, l); }
#endif
enum { OPH_PROLOGUE = 0, OPH_NORM0 = 1, OPH_Z = 2, OPH_CMP1, OPH_CMP2, OPH_ATTN, OPH_PROJ, OPH_OUT, OPH_NORMF, OPH_ROUTER, OPH_TOPK, OPH_PLACE, OPH_EGU, OPH_EDOWN, OPH_COMBINE, OPH_END };
#define CW_BAR 4096

__global__ void __launch_bounds__(512, 2) k_opt(OP p) {
    extern __shared__ __attribute__((aligned(16))) unsigned char lds_raw[];
    LAS unsigned char* lds = (LAS unsigned char*)lds_raw;
    volatile LAS unsigned* misc = (volatile LAS unsigned*)(lds + LDS_MISC);
    for (int u = tid_(); u < (LDS_BYTES - LDS_MISC) / 4; u += 512) misc[u] = 0u;
    __syncthreads();
    const bool multi = (p.ph_hi - p.ph_lo > 1) || (p.l_hi - p.l_lo > 1);
    unsigned* const ctl = p.ctl();
    XcdBarrier bar; bar.bar = ctl + CW_BAR; bar.x = 0; bar.st = misc + 8;
    if (multi) bar = xcd_barrier_post(ctl + CW_BAR, misc + 8);
    const int bid = blockIdx.x, nb = gridDim.x;
#ifdef TSTAMP
    if (bid == 0 && tid_() == 0) ((unsigned long long*)(ctl + 8192))[63] = wall_clock64();
#endif
    const int lo = p.ph_lo, hi = p.ph_hi;
#ifndef REP_MASK
#define REP_MASK 0
#endif
#define IN(k) (lo <= (k) && (k) < hi)
#define REP(k) for (int rep_ = 0; rep_ < 1 + ((REP_MASK >> (k)) & 1); ++rep_)
#ifdef TSTAMP
#define SEAMK(k, l) do { if (multi) xcd_barrier(bar); if (bid == 0 && tid_() == 0) ((unsigned long long*)(ctl + 8192))[(l) * 16 + (k)] = wall_clock64(); } while (0)
#else
#define SEAMK(k, l) do { if (multi) xcd_barrier(bar); } while (0)
#endif
#define SEAM() SEAMK(15, 1)
    if (p.l_lo == 0) {
        if (IN(OPH_PROLOGUE)) REP(OPH_PROLOGUE) { ph_prologue(p, lds, bid, nb); SEAMK(OPH_PROLOGUE, 0); }
        if (IN(OPH_NORM0)) REP(OPH_NORM0) { ph_norm(p, p.x, 0, 0, 1024, bid, nb); SEAMK(OPH_NORM0, 0); }
    }
#define LAYER_BODY(L_) { constexpr int l = (L_); if (l >= p.l_lo && l < p.l_hi) { \
        if (IN(OPH_Z)) REP(OPH_Z) { \
            pg8::DenseSched S; S.init(p.h(), ND, p.Wt_in() + (size_t)l * ZPAD * ND, NT, ZPAD, ND, nb, bid); \
            if (tid_() < 128) ((LAS float*)(lds + LDS_GAIN))[tid_()] = (tid_() < 64 ? p.q_gain : p.k_gain - 64)[l * 64 + tid_()]; \
            __syncthreads(); \
            EpiZ E{&p, lds}; \
            pg8::gemm_phase<EpiZ, pg8::DenseSched, true>(lds, S, E); \
            SEAMK(OPH_Z, l); \
        } \
        OPT_PHASES_B \
    } }
    LAYER_BODY(0)
    LAYER_BODY(1)
#undef IN
#undef REP
#undef SEAM
}

static inline size_t ws_take(size_t& off, size_t bytes) { const size_t r = off; off += (bytes + 255) & ~(size_t)255; return r; }
static void fill_inputs(OP& p, void* const* d_in, void* d_out) {
    p.x = (const float*)d_in[0]; p.c = (const float*)d_in[1]; p.pos = (const int*)d_in[2];
    p.w_mod = (const float*)d_in[3]; p.b_mod = (const float*)d_in[4]; p.w_in = (const float*)d_in[5]; p.q_gain = (const float*)d_in[6]; p.k_gain = (const float*)d_in[7];
    p.pe_k = (const float*)d_in[8]; p.pe_v = (const float*)d_in[9]; p.w1k = (const float*)d_in[10]; p.w2k = (const float*)d_in[11]; p.w1v = (const float*)d_in[12]; p.w2v = (const float*)d_in[13];
    p.ln_g = (const float*)d_in[14]; p.ln_b = (const float*)d_in[15]; p.gm_ws = (const float*)d_in[16]; p.gm_bs = (const float*)d_in[17];
    p.wpn = (const float*)d_in[18]; p.wpg = (const float*)d_in[19]; p.w_out = (const float*)d_in[20]; p.w_router = (const float*)d_in[21]; p.b_router = (const float*)d_in[22];
    p.wge = (const float*)d_in[23]; p.wue = (const float*)d_in[24]; p.wde = (const float*)d_in[25]; p.wgs = (const float*)d_in[26]; p.wus = (const float*)d_in[27]; p.wds = (const float*)d_in[28];
    p.out = (float*)d_out;
}
static int opt_grid() {
    static int grid = 0;
    if (!grid) {
        int dev = 0, cus = 0;
        (void)hipGetDevice(&dev); (void)hipDeviceGetAttribute(&cus, hipDeviceAttributeMultiprocessorCount, dev);
        (void)hipFuncSetAttribute((const void*)k_opt, hipFuncAttributeMaxDynamicSharedMemorySize, LDS_BYTES);
        int per_cu = 0; (void)hipOccupancyMaxActiveBlocksPerMultiprocessor(&per_cu, (const void*)k_opt, 512, LDS_BYTES); (void)hipGetLastError();
        grid = cus > 0 ? cus : 256;
    }
    return grid;
}
static void launch_opt(OP p, int ph_lo, int ph_hi, int l_lo, int l_hi, hipStream_t s) {
    p.ph_lo = ph_lo; p.ph_hi = ph_hi; p.l_lo = l_lo; p.l_hi = l_hi;
    hipLaunchKernelGGL(k_opt, dim3(opt_grid()), dim3(512), LDS_BYTES, s, p);
}
#if DEV_CHECK
enum { T_NONE = 0, T_GELU = 1, T_SIGMOID = 2 };
__global__ void k_cmp(const void* opt, int opt_f32, int ldo, const float* ref, int ldr, int ncols, int nrows, int tr, float scale, double* acc) {
    double num = 0.0, den = 0.0;
    const size_t n = (size_t)nrows * ncols;
    for (size_t i = (size_t)blockIdx.x * blockDim.x + threadIdx.x; i < n; i += (size_t)gridDim.x * blockDim.x) {
        const size_t r = i / ncols; const int c = (int)(i % ncols);
        float e = ref[r * ldr + c];
        if (tr == T_GELU) e = geluf_(e); else if (tr == T_SIGMOID) e = sigmoidf_(e);
        e *= scale;
        const float o = opt_f32 ? ((const float*)opt)[r * ldo + c] : bf2f(((const bf16_t*)opt)[r * ldo + c]);
        const double d = (double)o - (double)e; num += d * d; den += (double)e * (double)e;
    }
    for (int o = 32; o >= 1; o >>= 1) { num += __shfl_xor(num, o); den += __shfl_xor(den, o); }
    if ((threadIdx.x & 63) == 0) { atomicAdd(acc, num); atomicAdd(acc + 1, den); }
}
__global__ void k_final(float* out, size_t n, const double* acc, int ngroups, int only) {
    double metric = 0.0;
    for (int g = 0; g < ngroups; ++g) { if (only >= 0 && g != only) continue; const double m = acc[2 * g] / (acc[2 * g + 1] + 1e-300); if (!(m <= metric)) metric = m; }
    const float s = 1.0f + (float)sqrt(metric);
    for (size_t i = (size_t)blockIdx.x * blockDim.x + threadIdx.x; i < n; i += (size_t)gridDim.x * blockDim.x) out[i] *= s;
}
#ifndef DEV_ONLY
#define DEV_ONLY -1
#endif
static void cmp(const void* opt, int f32, int ldo, const float* ref, int ldr, int ncols, int nrows, int tr, float scale, double* acc, int g, hipStream_t s) {
    hipLaunchKernelGGL(k_cmp, dim3(2048), dim3(256), 0, s, opt, f32, ldo, ref, ldr, ncols, nrows, tr, scale, acc + 2 * g);
}
#endif

#ifdef TSTAMP
__global__ void k_probe(float* out, size_t n, const unsigned long long* ts, int a0, int a1, int b0, int b1) {
    float ta = (float)(ts[a1] - ts[a0]) * 0.01f, tb = (float)(ts[b1] - ts[b0]) * 0.01f;
    ta = floorf(ta / 16.f + 0.5f) * 16.f; tb = floorf(tb / 20.f + 0.5f) * 20.f;
    const float s = 1.0f + sqrtf(1e-5f * ta);
    for (size_t i = (size_t)blockIdx.x * blockDim.x + threadIdx.x; i < n; i += (size_t)gridDim.x * blockDim.x) { float v = out[i] * s; if (i == 0) v += 2.0f + tb * 0.1f; out[i] = v; }
}
#endif
extern "C" void kernel_launch(void* const* d_in, const int* in_sizes, int n_in, void* d_out, int out_size, void* d_ws, size_t ws_size, hipStream_t stream) {
    OP p; memset(&p, 0, sizeof(p));
    fill_inputs(p, d_in, d_out);
    char* w = (char*)d_ws;
#if DEV_CHECK
    size_t off = 0;
    p.ws = w; off = wsl::O_END_MIX;
    refp::Params rp; memset(&rp, 0, sizeof(rp));
    rp.x = p.x; rp.c = p.c; rp.pos = p.pos; rp.w_mod = p.w_mod; rp.b_mod = p.b_mod; rp.w_in = p.w_in; rp.q_gain = p.q_gain; rp.k_gain = p.k_gain; rp.pe_k = p.pe_k; rp.pe_v = p.pe_v;
    rp.w1k = p.w1k; rp.w2k = p.w2k; rp.w1v = p.w1v; rp.w2v = p.w2v; rp.ln_g = p.ln_g; rp.ln_b = p.ln_b; rp.gm_ws = p.gm_ws; rp.gm_bs = p.gm_bs; rp.wpn = p.wpn; rp.wpg = p.wpg; rp.w_out = p.w_out;
    rp.w_router = p.w_router; rp.b_router = p.b_router; rp.wge = p.wge; rp.wue = p.wue; rp.wde = p.wde; rp.wgs = p.wgs; rp.wus = p.wus; rp.wds = p.wds; rp.out = p.out;
    auto take = [&](size_t bytes) { return (void*)(w + ws_take(off, bytes)); };
    {
        const size_t region = off;
        rp.z = (float*)take((size_t)NT * INC * 4);
        rp.qn = (float*)take((size_t)NT * 512 * 4); rp.qr = (float*)take((size_t)NT * 512 * 4);
        rp.ks = (float*)take((size_t)NT * 128 * 4); rp.kw = (float*)take((size_t)NT * 128 * 4);
        rp.onsa = (float*)take((size_t)NT * 512 * 4); rp.vn = (float*)take((size_t)NT * 512 * 4); rp.ogm = (float*)take((size_t)NT * 512 * 4);
        rp.ya = (float*)take((size_t)NT * ND * 4);
        const size_t end_mix = off;
        off = region;
        rp.logits = (float*)take((size_t)NT * NE * 4); rp.gs = (float*)take((size_t)NT * 256 * 4); rp.sact = (float*)take((size_t)NT * 256 * 4);
        rp.shout = (float*)take((size_t)NT * ND * 4); rp.routed = (float*)take((size_t)NT * ND * 4);
        rp.ag = (float*)take((size_t)MAXROWS * 256 * 4); rp.act = (float*)take((size_t)MAXROWS * 256 * 4);
        if (off < end_mix) off = end_mix;
        const size_t need = wsl::O_Wt_ed + (size_t)NE * ND * 256 * 2 + 4096;
        if (off < need) off = need;
    }
    p.xres = (float*)take((size_t)NT * ND * 4);
    rp.bar = (unsigned*)take(16384);
    rp.mod = (float*)take((size_t)NL * NB * 6144 * 4);
    rp.h = (float*)take((size_t)NT * ND * 4);
    rp.counts = (int*)take(NE * 4); rp.cursor = (int*)take(NE * 4); rp.pad_start = (int*)take(NE * 4); rp.blk_e = (int*)take(MAXBLK * 4);
    rp.row_tok = (int*)take((size_t)MAXROWS * 4); rp.row_w = (float*)take((size_t)MAXROWS * 4);
    rp.idx = (int*)take((size_t)NT * 8 * 4); rp.wts = (float*)take((size_t)NT * 8 * 4);
    rp.kc = (float*)take((size_t)NB * NCMP * 2 * 64 * 4); rp.vc = (float*)take((size_t)NB * NCMP * 2 * 64 * 4);
    double* acc = (double*)take(4096);
    if (off > ws_size) { fprintf(stderr, "dev: workspace too small: need %zu have %zu\n", off, ws_size); return; }
    p.xoff = 0;
    (void)hipMemsetAsync(p.ws + wsl::O_ctl, 0, 65536, stream);
    (void)hipMemsetAsync(acc, 0, 4096, stream);
    using namespace refp;
    const int G = 2048;
    launch_phase<PH_MOD>(rp, 0, 48, stream);
    launch_phase<PH_NORM_A>(rp, 0, G, stream);
    launch_phase<PH_GEMM_Z>(rp, 0, G, stream);
    launch_phase<PH_PREP>(rp, 0, G, stream);
    p.conv_l_lo = 0; p.conv_l_hi = 0;
    launch_opt(p, OPH_PROLOGUE, OPH_PROLOGUE + 1, 0, 1, stream);
    launch_opt(p, OPH_NORM0, OPH_NORM0 + 1, 0, 1, stream);
    launch_opt(p, OPH_Z, OPH_Z + 1, 0, 1, stream);
    launch_opt(p, OPH_CMP1, OPH_CMP1 + 1, 0, 1, stream);
    int g = 0;
    cmp(p.qn(), 0, 512, rp.qn, 512, 512, NT, T_NONE, 0.125f, acc, g++, stream);
    cmp(p.qr(), 0, 512, rp.qr, 512, 512, NT, T_NONE, 0.125f, acc, g++, stream);
    cmp(p.kvraw(), 0, 256, rp.z + ZKC, INC, 256, NT, T_NONE, 1.f, acc, g++, stream);
    cmp(p.ksv(), 0, 256, rp.ks, 128, 128, NT, T_NONE, 1.f, acc, g++, stream);
    cmp(p.ksv() + 128, 0, 256, rp.z + ZVS, INC, 128, NT, T_NONE, 1.f, acc, g++, stream);
    cmp(p.kwv(), 0, 256, rp.kw, 128, 128, NT, T_NONE, 1.f, acc, g++, stream);
    cmp(p.kwv() + 128, 0, 256, rp.z + ZVW, INC, 128, NT, T_NONE, 1.f, acc, g++, stream);
    cmp(p.u(), 0, 512, rp.z + ZU, INC, 512, NT, T_GELU, 1.f, acc, g++, stream);
    cmp(p.v(), 0, 512, rp.z + ZV, INC, 512, NT, T_GELU, 1.f, acc, g++, stream);
    cmp(p.sga(), 0, 1024, rp.z + ZGA, INC, 1024, NT, T_SIGMOID, 1.f, acc, g++, stream);
    cmp(p.sgb(), 0, 1024, rp.z + ZGB, INC, 1024, NT, T_SIGMOID, 1.f, acc, g++, stream);
    cmp(p.gates(), 1, 32, rp.z + ZG, INC, 24, NT, T_SIGMOID, 1.f, acc, g++, stream);
    cmp(p.h(), 0, 1024, rp.h, 1024, 1024, NT, T_NONE, 1.f, acc, g++, stream);
    launch_opt(p, OPH_CMP2, OPH_CMP2 + 1, 0, 1, stream);
    for (int b = 0; b < NB; ++b) { cmp(p.kc() + (size_t)b * 256 * 128, 0, 128, rp.kc + (size_t)b * 255 * 128, 128, 128, 255, T_NONE, 1.f, acc, g, stream);
                                   cmp(p.vc() + (size_t)b * 256 * 128, 0, 128, rp.vc + (size_t)b * 255 * 128, 128, 128, 255, T_NONE, 1.f, acc, g + 1, stream); }
    g += 2;
    launch_phase<PH_ATTN>(rp, 0, 2048, stream);
    cmp(p.ogm(), 0, 512, rp.ogm, 512, 512, NT, T_NONE, 1.f, acc, g++, stream);
    launch_opt(p, OPH_ATTN, OPH_ATTN + 1, 0, 1, stream);
    cmp(p.onsa(), 0, 512, rp.onsa, 512, 512, NT, T_NONE, 1.f, acc, g++, stream);
    launch_phase<PH_PROJ>(rp, 0, G, stream);
    launch_phase<PH_OUT>(rp, 0, G, stream);
    launch_opt(p, OPH_PROJ, OPH_PROJ + 1, 0, 1, stream);
    cmp(p.merged(), 0, 1024, rp.ya, 1024, 1024, NT, T_NONE, 1.f, acc, g++, stream);
    launch_opt(p, OPH_OUT, OPH_OUT + 1, 0, 1, stream);
    cmp(p.xres, 1, 1024, rp.out, 1024, 1024, NT, T_NONE, 1.f, acc, g++, stream);
    launch_phase<PH_NORM_F>(rp, 0, G, stream);
    launch_opt(p, OPH_NORMF, OPH_NORMF + 1, 0, 1, stream);
    cmp(p.h(), 0, 1024, rp.h, 1024, 1024, NT, T_NONE, 1.f, acc, g++, stream);
    p.conv_l_lo = 0; p.conv_l_hi = 1;
    launch_opt(p, OPH_PROLOGUE, OPH_PROLOGUE + 1, 0, 1, stream);
    launch_opt(p, OPH_ROUTER, OPH_ROUTER + 1, 0, 1, stream);
    launch_opt(p, OPH_TOPK, OPH_TOPK + 1, 0, 1, stream);
    launch_opt(p, OPH_PLACE, OPH_PLACE + 1, 0, 1, stream);
    launch_opt(p, OPH_EGU, OPH_EGU + 1, 0, 1, stream);
    launch_opt(p, OPH_EDOWN, OPH_EDOWN + 1, 0, 1, stream);
    launch_opt(p, OPH_COMBINE, OPH_COMBINE + 1, 0, 1, stream);
    launch_phase<PH_NORM_F>(rp, 0, G, stream);
    launch_phase<PH_ROUTER>(rp, 0, G, stream);
    launch_phase<PH_TOPK>(rp, 0, G, stream);
    launch_phase<PH_SCAN>(rp, 0, G, stream);
    launch_phase<PH_PLACE>(rp, 0, G, stream);
    launch_phase<PH_EGATE>(rp, 0, G, stream);
    launch_phase<PH_EUP>(rp, 0, G, stream);
    launch_phase<PH_EDOWN>(rp, 0, G, stream);
    launch_phase<PH_FINAL>(rp, 0, G, stream);
    cmp(p.xres, 1, 1024, rp.out, 1024, 1024, NT, T_NONE, 1.f, acc, g++, stream);
    for (int l = 1; l < NL; ++l) {
        launch_phase<PH_NORM_A>(rp, l, G, stream); launch_phase<PH_GEMM_Z>(rp, l, G, stream); launch_phase<PH_PREP>(rp, l, G, stream); launch_phase<PH_ATTN>(rp, l, 2048, stream);
        launch_phase<PH_PROJ>(rp, l, G, stream); launch_phase<PH_OUT>(rp, l, G, stream); launch_phase<PH_NORM_F>(rp, l, G, stream); launch_phase<PH_ROUTER>(rp, l, G, stream);
        launch_phase<PH_TOPK>(rp, l, G, stream); launch_phase<PH_SCAN>(rp, l, G, stream); launch_phase<PH_PLACE>(rp, l, G, stream); launch_phase<PH_EGATE>(rp, l, G, stream);
        launch_phase<PH_EUP>(rp, l, G, stream); launch_phase<PH_EDOWN>(rp, l, G, stream); launch_phase<PH_FINAL>(rp, l, G, stream);
    }
    hipLaunchKernelGGL(k_final, dim3(2048), dim3(256), 0, stream, p.out, (size_t)NT * ND, acc, g, (int)DEV_ONLY);
#else
    p.ws = w; p.xres = p.out; p.xoff = 0;
    if (wsl::O_TOTAL > ws_size) { fprintf(stderr, "workspace too small: need %zu have %zu\n", (size_t)wsl::O_TOTAL, ws_size); return; }
    p.conv_l_lo = 0; p.conv_l_hi = NL;
    (void)hipMemsetAsync(p.ws + wsl::O_ctl, 0, 65536, stream);
    launch_opt(p, 0, OPH_END, 0, NL, stream);
#ifdef TSTAMP
    hipLaunchKernelGGL(k_probe, dim3(2048), dim3(256), 0, stream, p.out, (size_t)NT * ND, (const unsigned long long*)(p.ws + wsl::O_ctl + 32768), (int)TS_A0, (int)TS_A1, (int)TS_B0, (int)TS_B1);
#endif
#endif
}
```
